# Optimizing an MI355X kernel written in HIP

```python
import jax, jax.numpy as jnp
from jax import lax
import numpy as np

D_MODEL = 1024
BATCH = 8
SEQ = 2048
DEPTH = 4

GRID_W = 64
CTX_LEN = 256
N_MIXERS = 3
EPS = 1e-6
CHUNK = 128
A_WIDTH = D_MODEL
A_GROUPS = 8
A_GROUP_DIM = A_WIDTH // A_GROUPS
HEAD_DIM = 128
N_HEADS = D_MODEL // HEAD_DIM
N_KV_HEADS = 2
Q_PER_KV = N_HEADS // N_KV_HEADS
Q_BLOCK = 128
ROPE_THETA = 10000.0
POOL_WINDOWS = (2, 4, 8, 16)
POOL_GROUPS = len(POOL_WINDOWS)
POOL_GROUP_DIM = D_MODEL // POOL_GROUPS
N_EXPERTS = 16
EXPERT_DIM = 1024
CAPACITY_FACTOR = 2

kernel_name = "hybrid_interleaved_gmlp_gqa_pool_ecmoe_dit"


def rms_norm(x, g):
    xf = x.astype(jnp.float32)
    y = xf * lax.rsqrt(jnp.mean(xf * xf, axis=-1, keepdims=True) + EPS)
    return (y * g.astype(jnp.float32)).astype(x.dtype)


def layer_norm(x, g):
    xf = x.astype(jnp.float32)
    mu = jnp.mean(xf, axis=-1, keepdims=True)
    xc = xf - mu
    y = xc * lax.rsqrt(jnp.mean(xc * xc, axis=-1, keepdims=True) + EPS)
    return (y * g.astype(jnp.float32)).astype(x.dtype)


def modulate(h, shift, scale):
    return h * (1 + scale) + shift


def chunk_gmlp(h, w_in, v_g, s_w, s_b, w_out):
    b, n, _ = h.shape
    z = jax.nn.gelu(h @ w_in)
    u, v = jnp.split(z, 2, axis=-1)
    v = layer_norm(v, v_g)
    v = v.reshape(b, n // CHUNK, CHUNK, A_GROUPS, A_GROUP_DIM)
    v = jnp.einsum('gpq,bcqgd->bcpgd', s_w, v) + s_b.T[:, :, None]
    return (u * v.reshape(b, n, A_WIDTH)) @ w_out


def axial_rope(n):
    rows = n // GRID_W
    row = jnp.repeat(jnp.arange(rows, dtype=jnp.float32), GRID_W)
    col = jnp.tile(jnp.arange(GRID_W, dtype=jnp.float32), rows)
    n_freq = HEAD_DIM // 4
    inv = jnp.power(ROPE_THETA, -jnp.arange(n_freq, dtype=jnp.float32) / n_freq)
    ang = jnp.concatenate([row[:, None] * inv, col[:, None] * inv], axis=-1)
    return jnp.cos(ang), jnp.sin(ang)


def apply_rope(x, cos, sin):
    x1, x2 = jnp.split(x.astype(jnp.float32), 2, axis=-1)
    cos = cos[None, :, None, :]
    sin = sin[None, :, None, :]
    return jnp.concatenate([x1 * cos - x2 * sin, x1 * sin + x2 * cos], axis=-1).astype(x.dtype)


def attend(qb, k, v):
    s = jnp.einsum('bqkgd,bskd->bkgqs', qb, k).astype(jnp.float32) * (HEAD_DIM ** -0.5)
    p = jax.nn.softmax(s, axis=-1).astype(v.dtype)
    return jnp.einsum('bkgqs,bskd->bqkgd', p, v)


def gqa_attention(h, hc, w_in, q_g, k_g, w_out, with_ctx_queries):
    b, n, _ = h.shape
    qd = N_HEADS * HEAD_DIM
    kvd = N_KV_HEADS * HEAD_DIM

    def proj_q(t):
        return rms_norm((t @ w_in[:, :qd]).reshape(b, -1, N_HEADS, HEAD_DIM), q_g)

    def proj_kv(t):
        kv = t @ w_in[:, qd:]
        k = rms_norm(kv[..., :kvd].reshape(b, -1, N_KV_HEADS, HEAD_DIM), k_g)
        return k, kv[..., kvd:].reshape(b, -1, N_KV_HEADS, HEAD_DIM)

    cos, sin = axial_rope(n)
    q = apply_rope(proj_q(h), cos, sin)
    k, v = proj_kv(h)
    k = apply_rope(k, cos, sin)
    kc, vc = proj_kv(hc)
    k_all = jnp.concatenate([kc, k], axis=1)
    v_all = jnp.concatenate([vc, v], axis=1)
    qb = q.reshape(b, n // Q_BLOCK, Q_BLOCK, N_KV_HEADS, Q_PER_KV, HEAD_DIM).transpose(1, 0, 2, 3, 4, 5)
    o = lax.map(lambda blk: attend(blk, k_all, v_all), qb)
    y = o.transpose(1, 0, 2, 3, 4, 5).reshape(b, n, qd) @ w_out
    yc = None
    if with_ctx_queries:
        m = hc.shape[1]
        qc = proj_q(hc).reshape(b, m, N_KV_HEADS, Q_PER_KV, HEAD_DIM)
        yc = attend(qc, kc, vc).reshape(b, m, qd) @ w_out
    return y, yc


def centred_window_mean(x, w):
    b, n, d = x.shape
    half = w // 2
    xp = jnp.pad(x.astype(jnp.float32), ((0, 0), (half, half), (0, 0)))
    cs = jnp.concatenate([jnp.zeros((b, 1, d), jnp.float32), jnp.cumsum(xp, axis=1)], axis=1)
    s = cs[:, w:w + n] - cs[:, :n]
    t = jnp.arange(n)
    cnt = (jnp.minimum(t + half - 1, n - 1) - jnp.maximum(t - half, 0) + 1).astype(jnp.float32)
    return (s / cnt[None, :, None]).astype(x.dtype)


def multiscale_pool(h, w_in, w_grp, scale):
    b, n, _ = h.shape
    z = (h @ w_in).reshape(b, n, POOL_GROUPS, POOL_GROUP_DIM)
    pooled = jnp.stack([centred_window_mean(z[:, :, gi], w) - z[:, :, gi]
                        for gi, w in enumerate(POOL_WINDOWS)], axis=2)
    y = jnp.einsum('bngd,gde->bnge', pooled, w_grp).reshape(b, n, D_MODEL)
    return y * scale


def expert_choice_ffn(h, router_w, w_gate, w_up, w_down):
    b, n, d = h.shape
    cap = CAPACITY_FACTOR * n // N_EXPERTS
    aff = jax.nn.softmax((h @ router_w).astype(jnp.float32), axis=-1)
    g, idx = lax.top_k(jnp.swapaxes(aff, 1, 2), cap)
    xin = jax.vmap(lambda hb, ib: hb[ib])(h, idx)
    hid = jax.nn.silu(jnp.einsum('becd,edf->becf', xin, w_gate)) * jnp.einsum('becd,edf->becf', xin, w_up)
    y = jnp.einsum('becf,efd->becd', hid, w_down) * g[..., None].astype(h.dtype)
    return jax.vmap(lambda yb, ib: jax.ops.segment_sum(yb.reshape(-1, d), ib.reshape(-1), num_segments=n))(y, idx)


def setup_inputs(seed: int = 0) -> dict:
    key = jax.random.key(seed)
    ks = iter(jax.random.split(key, 32))
    D = D_MODEL
    n_a = (DEPTH + 2) // 3
    n_b = (DEPTH + 1) // 3
    n_c = DEPTH // 3

    def nrm(shape, scale):
        return jax.random.normal(next(ks), shape, jnp.float32) * scale

    def gain(shape):
        return 1.0 + nrm(shape, 0.1)

    return {
        "x": nrm((BATCH, SEQ, D), 1.0),
        "c": nrm((BATCH, D), 1.0),
        "ctx": nrm((BATCH, CTX_LEN, D), 1.0),
        "c_ctx": nrm((D,), 1.0),
        "mod_w": nrm((DEPTH, D, 6 * D), D ** -0.5),
        "mod_b": nrm((DEPTH, 6 * D), 0.02),
        "norm1_g": gain((DEPTH, D)),
        "norm2_g": gain((DEPTH, D)),
        "router_w": nrm((DEPTH, D, N_EXPERTS), D ** -0.5),
        "exp_w_gate": nrm((DEPTH, N_EXPERTS, D, EXPERT_DIM), D ** -0.5),
        "exp_w_up": nrm((DEPTH, N_EXPERTS, D, EXPERT_DIM), D ** -0.5),
        "exp_w_down": nrm((DEPTH, N_EXPERTS, EXPERT_DIM, D), EXPERT_DIM ** -0.5),
        "g_w_in": nrm((n_a, D, 2 * A_WIDTH), D ** -0.5),
        "g_v_norm_g": gain((n_a, A_WIDTH)),
        "g_spatial_w": nrm((n_a, A_GROUPS, CHUNK, CHUNK), CHUNK ** -0.5),
        "g_spatial_b": gain((n_a, A_GROUPS, CHUNK)),
        "g_w_out": nrm((n_a, A_WIDTH, D), A_WIDTH ** -0.5),
        "att_w_in": nrm((n_b, D, (N_HEADS + 2 * N_KV_HEADS) * HEAD_DIM), D ** -0.5),
        "att_q_norm_g": gain((n_b, HEAD_DIM)),
        "att_k_norm_g": gain((n_b, HEAD_DIM)),
        "att_w_out": nrm((n_b, N_HEADS * HEAD_DIM, D), (N_HEADS * HEAD_DIM) ** -0.5),
        "p_w_in": nrm((n_c, D, D), D ** -0.5),
        "p_w_group": nrm((n_c, POOL_GROUPS, POOL_GROUP_DIM, POOL_GROUP_DIM), POOL_GROUP_DIM ** -0.5),
        "p_scale": gain((n_c, D)),
    }


def reference(x, c, ctx, c_ctx, mod_w, mod_b, norm1_g, norm2_g, router_w, exp_w_gate, exp_w_up,
              exp_w_down, g_w_in, g_v_norm_g, g_spatial_w, g_spatial_b, g_w_out, att_w_in,
              att_q_norm_g, att_k_norm_g, att_w_out, p_w_in, p_w_group, p_scale):
    for i in range(DEPTH):
        kind = i % N_MIXERS
        j = i // N_MIXERS
        update_ctx = any(l % N_MIXERS == 1 for l in range(i + 1, DEPTH))
        read_ctx = update_ctx or kind == 1

        m_lat = jax.nn.silu(c) @ mod_w[i] + mod_b[i]
        sh1, sc1, gt1, sh2, sc2, gt2 = jnp.split(m_lat[:, None, :], 6, axis=-1)
        h = modulate(rms_norm(x, norm1_g[i]), sh1, sc1)
        hc = None
        if read_ctx:
            m_ctx = jax.nn.silu(c_ctx) @ mod_w[i] + mod_b[i]
            csh1, csc1, cgt1, csh2, csc2, cgt2 = jnp.split(m_ctx, 6)
            hc = modulate(rms_norm(ctx, norm1_g[i]), csh1, csc1)

        yc = None
        if kind == 0:
            y = chunk_gmlp(h, g_w_in[j], g_v_norm_g[j], g_spatial_w[j], g_spatial_b[j], g_w_out[j])
            if update_ctx:
                yc = chunk_gmlp(hc, g_w_in[j], g_v_norm_g[j], g_spatial_w[j], g_spatial_b[j], g_w_out[j])
        elif kind == 1:
            y, yc = gqa_attention(h, hc, att_w_in[j], att_q_norm_g[j], att_k_norm_g[j], att_w_out[j], update_ctx)
        else:
            y = multiscale_pool(h, p_w_in[j], p_w_group[j], p_scale[j])
            if update_ctx:
                yc = multiscale_pool(hc, p_w_in[j], p_w_group[j], p_scale[j])

        x = x + gt1 * y
        h = modulate(rms_norm(x, norm2_g[i]), sh2, sc2)
        x = x + gt2 * expert_choice_ffn(h, router_w[i], exp_w_gate[i], exp_w_up[i], exp_w_down[i])
        if update_ctx:
            ctx = ctx + cgt1 * yc
            hc = modulate(rms_norm(ctx, norm2_g[i]), csh2, csc2)
            ctx = ctx + cgt2 * expert_choice_ffn(hc, router_w[i], exp_w_gate[i], exp_w_up[i], exp_w_down[i])
    return x
```

```cpp
#include <hip/hip_runtime.h>
#include <cstdio>
#include <cstdint>

#ifndef MK_PER_PHASE
#define MK_PER_PHASE 0
#endif

#define LAS __attribute__((address_space(3)))
#define GAS __attribute__((address_space(1)))
typedef unsigned short bf16_t;
typedef short bf16x8 __attribute__((ext_vector_type(8)));
typedef short s16x4 __attribute__((ext_vector_type(4)));
typedef float f32x2 __attribute__((ext_vector_type(2)));
typedef float f32x4 __attribute__((ext_vector_type(4)));
typedef float f32x16 __attribute__((ext_vector_type(16)));
typedef unsigned u32x2 __attribute__((ext_vector_type(2)));
typedef unsigned u32x4 __attribute__((ext_vector_type(4)));

constexpr int D = 1024, NB = 8, SEQ = 2048, T = NB * SEQ, CL = 256, TC = NB * CL, TT = T + TC, NE = 16, CAP = 256, CCAP = 32, NTILE = 144;
constexpr int SKV = CL + SEQ;
constexpr float EPS = 1e-6f;
constexpr int NWAVES = 8, NTHR = 512;

constexpr size_t al256(size_t x) { return (x + 255) / 256 * 256; }
constexpr size_t WS_CTL   = 0;
constexpr size_t CTL_BYTES = 65536;
constexpr size_t WS_MODV  = WS_CTL + CTL_BYTES;
constexpr size_t WS_AFF   = WS_MODV + al256((size_t)4 * 9 * 6144 * 4);
constexpr size_t WS_SLOT  = WS_AFF + (size_t)TT * 16 * 4;
constexpr size_t WS_GATE  = WS_SLOT + (size_t)TT * 16 * 4;
constexpr size_t WS_WSW   = WS_GATE + (size_t)NTILE * 256 * 4;
constexpr size_t WS_WGIN  = WS_WSW + (size_t)2 * 8 * 128 * 128 * 2;
constexpr size_t WS_WGOUT = WS_WGIN + (size_t)2 * 2048 * 1024 * 2;
constexpr size_t WS_WAIN  = WS_WGOUT + (size_t)2 * 1024 * 1024 * 2;
constexpr size_t WS_WAOUT = WS_WAIN + (size_t)1536 * 1024 * 2;
constexpr size_t WS_WPIN  = WS_WAOUT + (size_t)1024 * 1024 * 2;
constexpr size_t WS_WPGRP = WS_WPIN + (size_t)1024 * 1024 * 2;
constexpr size_t WS_WUP   = WS_WPGRP + (size_t)4 * 256 * 256 * 2;
constexpr size_t WS_WDN   = WS_WUP + (size_t)4 * 16 * 2048 * 1024 * 2;
constexpr size_t WS_XC    = WS_WDN + (size_t)4 * 16 * 1024 * 1024 * 2;
constexpr size_t WS_H     = WS_XC + (size_t)TC * D * 4;
constexpr size_t WS_S1    = WS_H + (size_t)TT * D * 2;
constexpr size_t WS_S2    = WS_S1 + (size_t)TT * 2048 * 2;
constexpr size_t WS_QB    = WS_S2 + (size_t)TT * D * 2;
constexpr size_t WS_KB    = WS_QB + (size_t)T * D * 2;
constexpr size_t WS_VB    = WS_KB + (size_t)NB * 2 * SKV * 128 * 2;
constexpr size_t WS_XIN   = WS_VB + (size_t)NB * 2 * SKV * 128 * 2;
constexpr size_t WS_HID   = WS_XIN + (size_t)NTILE * 256 * D * 2;
constexpr size_t WS_YEXP  = WS_HID + (size_t)NTILE * 256 * D * 2;
constexpr size_t WS_END   = WS_YEXP + (size_t)NTILE * 256 * D * 2;

constexpr int RING_BYTES = 131072, MISC_OFF = RING_BYTES, LDS_BYTES = RING_BYTES + 1024;

__device__ __forceinline__ unsigned cvt_pk_bf16(float lo, float hi) { unsigned r; asm volatile("v_cvt_pk_bf16_f32 %0, %1, %2" : "=v"(r) : "v"(lo), "v"(hi)); return r; }
__device__ __forceinline__ float bf_lo(unsigned u) { return __uint_as_float(u << 16); }
__device__ __forceinline__ float bf_hi(unsigned u) { return __uint_as_float(u & 0xffff0000u); }
__device__ __forceinline__ float bf2f(bf16_t b) { return __uint_as_float(((unsigned)b) << 16); }
__device__ __forceinline__ bf16_t f2bf(float f) { return (bf16_t)(cvt_pk_bf16(f, 0.f) & 0xffffu); }
__device__ __forceinline__ float wave_sum(float v) {
#pragma unroll
    for (int o = 1; o < 64; o <<= 1) v += __shfl_xor(v, o);
    return v;
}
__device__ __forceinline__ float wave_max(float v) {
#pragma unroll
    for (int o = 1; o < 64; o <<= 1) v = fmaxf(v, __shfl_xor(v, o));
    return v;
}
__device__ __forceinline__ int opaque_tid() { int t = threadIdx.x; asm volatile("" : "+v"(t)); return t; }
__device__ __forceinline__ float silu_f(float x) { return x / (1.f + __expf(-x)); }
__device__ __forceinline__ float gelu_tanh_f(float x) {
    const float z = 0.7978845608028654f * (x + 0.044715f * x * x * x);
    return x / (1.f + __expf(-2.f * z));
}
#define LDS_WAIT() asm volatile("s_waitcnt lgkmcnt(0)" ::: "memory")

#define XB_TMO      128
#define XB_XCNT(j)  (256  + 64 * (j))
#define XB_XSUB(j)  (1280 + 64 * (j))
#define XB_XGEN(j)  (2304 + 64 * (j))
#define XB_TOP      3328
#define XB_TOPGEN   3392
#define XCD_BAR_WORDS 3456
#define XB_SPIN_CAP (1u << 22)
__device__ __forceinline__ unsigned xb_ld(unsigned* p)              { return __hip_atomic_load(p, __ATOMIC_RELAXED, __HIP_MEMORY_SCOPE_AGENT); }
__device__ __forceinline__ unsigned xb_add(unsigned* p, unsigned v) { return __hip_atomic_fetch_add(p, v, __ATOMIC_RELAXED, __HIP_MEMORY_SCOPE_AGENT); }
__device__ __forceinline__ unsigned xb_xcc_id() { return (unsigned)__builtin_amdgcn_s_getreg((3 << 11) | 20) & 0xFu; }
#define XB_SPIN(cond, bar) do { unsigned _sp = 0; while (cond) { __builtin_amdgcn_s_sleep(1); \
    if ((++_sp & 255u) == 0u) { if (xb_ld(&(bar)[XB_TMO])) break; if (_sp > XB_SPIN_CAP) { atomicAdd(&(bar)[XB_TMO], 1u); break; } } } } while (0)
struct XcdBarrier { unsigned* bar; unsigned x; volatile LAS unsigned* st; };
__device__ __forceinline__ XcdBarrier xcd_barrier_post(unsigned* bar, volatile LAS unsigned* st) {
    XcdBarrier b; b.bar = bar; b.x = xb_xcc_id(); b.st = st;
    if (threadIdx.x == 0) (void)xb_add(&bar[XB_XCNT(b.x)], 1u);
    return b;
}
__device__ __forceinline__ void xcd_barrier_complete(unsigned* bar, unsigned x, unsigned& nloc, unsigned& nx) {
    const unsigned G = gridDim.x * gridDim.y * gridDim.z;
    unsigned sum, cnt, mine, sp = 0u;
    for (;;) {
        sum = 0u; cnt = 0u; mine = 0u;
#pragma unroll
        for (unsigned j = 0; j < 16; ++j) { const unsigned c = xb_ld(&bar[XB_XCNT(j)]); sum += c; cnt += (c > 0u) ? 1u : 0u; mine = (j == x) ? c : mine; }
        if (sum == G) break;
        __builtin_amdgcn_s_sleep(1);
        if ((++sp & 255u) == 0u) { if (xb_ld(&bar[XB_TMO])) break; if (sp > XB_SPIN_CAP) { atomicAdd(&bar[XB_TMO], 1u); break; } }
    }
    nloc = mine > 0u ? mine : 1u; nx = cnt > 0u ? cnt : 1u;
}
__device__ __forceinline__ void xcd_barrier(const XcdBarrier& b) {
    asm volatile("s_waitcnt vmcnt(0)" ::: "memory");
    __syncthreads();
    if (threadIdx.x == 0) {
        unsigned* bar = b.bar;
        __builtin_amdgcn_s_waitcnt(0);
        unsigned nloc = b.st[0], nx = b.st[1];
        if (nloc == 0u) { xcd_barrier_complete(bar, b.x, nloc, nx); b.st[0] = nloc; b.st[1] = nx; }
        const unsigned old = xb_add(&bar[XB_XSUB(b.x)], 1u);
        const unsigned gen = old / nloc;
        if (old + 1u == (gen + 1u) * nloc) {
            __builtin_amdgcn_fence(__ATOMIC_RELEASE, "agent");
            asm volatile("s_waitcnt vmcnt(0)" ::: "memory");
            const unsigned og = xb_add(&bar[XB_TOP], 1u);
            const unsigned tg = og / nx;
            if (og + 1u == (tg + 1u) * nx) xb_add(&bar[XB_TOPGEN], 1u);
            else XB_SPIN(xb_ld(&bar[XB_TOPGEN]) == tg, bar);
            __builtin_amdgcn_fence(__ATOMIC_ACQUIRE, "agent");
            xb_add(&bar[XB_XGEN(b.x)], 1u);
            asm volatile("s_waitcnt vmcnt(0)" ::: "memory");
        } else {
            XB_SPIN(xb_ld(&bar[XB_XGEN(b.x)]) == gen, bar);
            __builtin_amdgcn_fence(__ATOMIC_ACQUIRE, "agent");
            asm volatile("s_waitcnt vmcnt(0)" ::: "memory");
        }
    }
    __syncthreads();
}

namespace pg8 {
constexpr int BM = 256, BK = 64, HALF = 128, HTB = HALF * BK * 2, NXCD = 8, WGM = 8;
__host__ __device__ __forceinline__ int lds_byte(int r, int c) { const int st = (r >> 4) * 2 + (c >> 5), rr = r & 15, cc = c & 31, ob = rr * 64 + cc * 2; return st * 1024 + (ob ^ (((ob >> 9) & 1) << 5)); }
__host__ __device__ __forceinline__ void stage_rc(int b, int& R, int& C) { const int st = b / 1024, sb = b % 1024, swz = sb ^ (((sb >> 9) & 1) << 5); R = (st >> 1) * 16 + swz / 64; C = (st & 1) * 32 + (swz % 64) / 2; }
__host__ __device__ __forceinline__ int perm32(int rho) { const int n = rho >> 4, i = rho & 15; return 8 * (i >> 2) + 4 * n + (i & 3); }
struct Unit { int pm, pn; };

template <class Epi, class Sched>
__device__ __forceinline__ void gemm_phase(LAS unsigned char* lds, const int K, const int lda, const int ldb, const Sched& S, const Epi& E) {
    const int tid = opaque_tid(), wid = __builtin_amdgcn_readfirstlane(tid >> 6), lane = tid & 63, wr = wid >> 2, wc = wid & 3, fr = lane & 15, fq = lane >> 4;
    const int nt = K / BK;
    unsigned voffA[2], voffB[2];
#pragma unroll
    for (int i = 0; i < 2; ++i) { int R, C; stage_rc(tid * 16 + i * 8192, R, C); const int Rb = Epi::PERM ? ((R & ~31) + perm32(R & 31)) : R;
        voffA[i] = (unsigned)(R * lda + C) * 2u; voffB[i] = (unsigned)(Rb * ldb + C) * 2u; }
    const size_t kstep = (size_t)(BK * 2);
    const size_t hstepA = (size_t)HALF * lda * 2, hstepB = (size_t)HALF * ldb * 2;
    const unsigned ldsw = (unsigned)wid * 1024u;
    const int aoff = lds_byte(wr * 64 + fr, fq * 8), boff = lds_byte(wc * 32 + fr, fq * 8);
#define PG8_SA(b, h) (((b) * 2 + (h)) * HTB)
#define PG8_SB(b, h) ((4 + (b) * 2 + (h)) * HTB)
#define PG8_STAGE(bufoff, gbase, voff) do { _Pragma("unroll") for (int _i = 0; _i < 2; ++_i) \
        __builtin_amdgcn_global_load_lds((const unsigned*)((const char*)(gbase) + (voff)[_i]), (LAS unsigned*)(lds + (bufoff) + ldsw + _i * 8192), 16, 0, 0); } while (0)
#define PG8_LDA(dst, b, h) do { _Pragma("unroll") for (int m = 0; m < 4; ++m) _Pragma("unroll") for (int k = 0; k < 2; ++k) dst[m][k] = *(const LAS bf16x8*)(lds + PG8_SA(b, h) + aoff + m * 2048 + k * 1024); } while (0)
#define PG8_LDB(dst, b, h) do { _Pragma("unroll") for (int n = 0; n < 2; ++n) _Pragma("unroll") for (int k = 0; k < 2; ++k) dst[n][k] = *(const LAS bf16x8*)(lds + PG8_SB(b, h) + boff + n * 2048 + k * 1024); } while (0)
#define PG8_MMA(ai, bj, At, Bt) do { __builtin_amdgcn_s_setprio(1); _Pragma("unroll") for (int m = 0; m < 4; ++m) _Pragma("unroll") for (int n = 0; n < 2; ++n) _Pragma("unroll") for (int k = 0; k < 2; ++k) \
        acc[ai][bj][m][n] = __builtin_amdgcn_mfma_f32_16x16x32_bf16(Bt[n][k], At[m][k], acc[ai][bj][m][n], 0, 0, 0); __builtin_amdgcn_s_setprio(0); } while (0)
#define PG8_WAIT_V(n) asm volatile("s_waitcnt vmcnt(" #n ")" ::: "memory")
#define PG8_WAIT_L(n) asm volatile("s_waitcnt lgkmcnt(" #n ")" ::: "memory")
#define PG8_BAR __builtin_amdgcn_s_barrier()
#define PG8_SCHED __builtin_amdgcn_sched_barrier(0)
    Unit cur, nxt; int ui = 0;
    if (!S.next(0, cur)) return;
    f32x4 acc[2][2][4][2];
#pragma unroll
    for (int a = 0; a < 2; ++a)
#pragma unroll
        for (int b = 0; b < 2; ++b)
#pragma unroll
            for (int m = 0; m < 4; ++m)
#pragma unroll
                for (int n = 0; n < 2; ++n) acc[a][b][m][n] = (f32x4){0.f, 0.f, 0.f, 0.f};
    bf16x8 At[4][2], B0[2][2], B1[2][2];
    const char* cA = S.aptr(cur); const char* cB = S.bptr(cur);
    PG8_STAGE(PG8_SB(0, 0), cB, voffB); PG8_STAGE(PG8_SB(0, 1), cB + hstepB, voffB); PG8_STAGE(PG8_SA(0, 0), cA, voffA); PG8_STAGE(PG8_SA(0, 1), cA + hstepA, voffA);
    if (wr == 1) PG8_BAR;
    PG8_WAIT_V(2); PG8_BAR;
    PG8_STAGE(PG8_SB(1, 0), cB + kstep, voffB); PG8_STAGE(PG8_SA(1, 0), cA + kstep, voffA); PG8_STAGE(PG8_SB(1, 1), cB + hstepB + kstep, voffB);
    PG8_WAIT_V(6); PG8_BAR;
    for (;;) {
        const bool has_next = S.next(ui + 1, nxt);
        const char* nA = has_next ? S.aptr(nxt) : cA; const char* nB = has_next ? S.bptr(nxt) : cB;
        for (int t = 0; t < nt; t += 2) {
            const bool last = (t == nt - 2);
            const char* a1 = cA + (size_t)(t + 1) * kstep;
            const char* a2 = last ? nA : cA + (size_t)(t + 2) * kstep; const char* b2 = last ? nB : cB + (size_t)(t + 2) * kstep;
            const char* a3 = a2 + kstep; const char* b3 = b2 + kstep;
            PG8_LDB(B0, 0, 0); PG8_LDB(B1, 0, 1); PG8_SCHED; PG8_LDA(At, 0, 0); PG8_STAGE(PG8_SA(1, 1), a1 + hstepA, voffA);
            PG8_WAIT_V(8); PG8_WAIT_L(0); PG8_BAR; PG8_MMA(0, 0, At, B0); PG8_MMA(0, 1, At, B1); PG8_BAR; PG8_SCHED;
            PG8_LDA(At, 0, 1); PG8_STAGE(PG8_SB(0, 0), b2, voffB); PG8_STAGE(PG8_SB(0, 1), b2 + hstepB, voffB); PG8_STAGE(PG8_SA(0, 0), a2, voffA);
            PG8_WAIT_V(8); PG8_WAIT_L(0); PG8_BAR; PG8_MMA(1, 0, At, B0); PG8_MMA(1, 1, At, B1); PG8_BAR; PG8_SCHED;
            PG8_LDB(B0, 1, 0); PG8_LDB(B1, 1, 1); PG8_SCHED; PG8_LDA(At, 1, 0); PG8_STAGE(PG8_SA(0, 1), a2 + hstepA, voffA);
            PG8_WAIT_V(8); PG8_WAIT_L(0); PG8_BAR; PG8_MMA(0, 0, At, B0); PG8_MMA(0, 1, At, B1); PG8_BAR; PG8_SCHED;
            PG8_LDA(At, 1, 1); PG8_STAGE(PG8_SB(1, 0), b3, voffB); PG8_STAGE(PG8_SB(1, 1), b3 + hstepB, voffB); PG8_STAGE(PG8_SA(1, 0), a3, voffA);
            PG8_WAIT_V(8); PG8_WAIT_L(0); PG8_BAR; PG8_MMA(1, 0, At, B0); PG8_MMA(1, 1, At, B1); PG8_BAR; PG8_SCHED;
        }
        if (wr == 0) PG8_BAR;
        E(acc, cur, wr, wc, fr, fq);
        if (!has_next) break;
#pragma unroll
        for (int a = 0; a < 2; ++a)
#pragma unroll
            for (int b = 0; b < 2; ++b)
#pragma unroll
                for (int m = 0; m < 4; ++m)
#pragma unroll
                    for (int n = 0; n < 2; ++n) acc[a][b][m][n] = (f32x4){0.f, 0.f, 0.f, 0.f};
        cur = nxt; cA = nA; cB = nB; ++ui;
        if (wr == 1) PG8_BAR;
    }
    PG8_WAIT_V(0);
    PG8_BAR;
#undef PG8_SA
#undef PG8_SB
#undef PG8_STAGE
#undef PG8_LDA
#undef PG8_LDB
#undef PG8_MMA
#undef PG8_WAIT_V
#undef PG8_WAIT_L
#undef PG8_BAR
#undef PG8_SCHED
}

struct SchedDense {
    const bf16_t* A; const bf16_t* Bt; int a_pm_stride, a_pn_stride, b_pn_stride;
    int nM, nN, nwg, extra, G, c;
    __device__ __forceinline__ bool next(int i, Unit& u) const {
        const int L = i * G + c; if (L >= nwg + extra) return false;
        if (L >= nwg) { const int x = L - nwg; u.pm = nM + (x >> 1); u.pn = 4 + (x & 1); return true; }
        int wgid = L; { const int q = nwg / NXCD, r = nwg % NXCD, xcd = wgid % NXCD, off = wgid / NXCD; wgid = (xcd < r ? xcd * (q + 1) : r * (q + 1) + (xcd - r) * q) + off; }
        const int nig = WGM * nN, gid = wgid / nig, fm = gid * WGM, gsz = (nM - fm) < WGM ? (nM - fm) : WGM;
        u.pm = fm + ((wgid % nig) % gsz); u.pn = (wgid % nig) / gsz; return true;
    }
    __device__ __forceinline__ const char* aptr(const Unit& u) const { return (const char*)(A + (size_t)u.pm * a_pm_stride + (size_t)u.pn * a_pn_stride); }
    __device__ __forceinline__ const char* bptr(const Unit& u) const { return (const char*)(Bt + (size_t)u.pn * b_pn_stride); }
};
struct SchedMoE {
    const bf16_t* A; const bf16_t* Bt; int nbt, nn, G, vcu;
    __device__ __forceinline__ bool next(int i, Unit& u) const {
        const int L = i * G + vcu, per_e = nbt * nn; if (L >= NE * per_e) return false;
        const int e = L / per_e, rem = L - e * per_e, bt = rem / nn, j = rem - bt * nn;
        u.pm = bt < 8 ? e * 8 + bt : 128 + e; u.pn = e * nn + j; return true;
    }
    __device__ __forceinline__ const char* aptr(const Unit& u) const { return (const char*)(A + (size_t)u.pm * 256 * D); }
    __device__ __forceinline__ const char* bptr(const Unit& u) const { return (const char*)(Bt + (size_t)u.pn * 256 * D); }
};

struct EpiA {
    static constexpr bool PERM = true;
    bf16_t* O; int ldc; int act; bf16_t* VB;
    __device__ __forceinline__ void operator()(const f32x4 (&acc)[2][2][4][2], const Unit& u, int wr, int wc, int fr, int fq) const {
        const int row0 = u.pm * BM + wr * 64 + fr, cl = wc * 32 + 8 * fq;
        const bool vtile = (VB != nullptr) && (u.pn == 5);
#pragma unroll
        for (int ai = 0; ai < 2; ++ai)
#pragma unroll
            for (int m = 0; m < 4; ++m) {
                const int r = row0 + ai * HALF + m * 16;
#pragma unroll
                for (int bj = 0; bj < 2; ++bj) {
                    f32x4 v0 = acc[ai][bj][m][0], v1 = acc[ai][bj][m][1];
                    if (act) {
#pragma unroll
                        for (int j = 0; j < 4; ++j) { v0[j] = gelu_tanh_f(v0[j]); v1[j] = gelu_tanh_f(v1[j]); } }
                    u32x4 w; w.x = cvt_pk_bf16(v0[0], v0[1]); w.y = cvt_pk_bf16(v0[2], v0[3]); w.z = cvt_pk_bf16(v1[0], v1[1]); w.w = cvt_pk_bf16(v1[2], v1[3]);
                    bf16_t* dst;
                    if (vtile) { int b, pos; if (r < T) { b = r >> 11; pos = CL + (r & (SEQ - 1)); } else { const int rc = r - T; b = rc >> 8; pos = rc & (CL - 1); }
                        dst = VB + ((size_t)(b * 2 + bj) * SKV + pos) * 128 + cl; }
                    else dst = O + (size_t)r * ldc + u.pn * BM + bj * HALF + cl;
                    *(u32x4*)dst = w; } }
    }
};
struct EpiB {
    static constexpr bool PERM = false;
    const float* xs_lat; const float* xs_ctx; float* xd_lat; float* xd_ctx; const float* gt; const float* colscale;
    __device__ __forceinline__ void operator()(const f32x4 (&acc)[2][2][4][2], const Unit& u, int wr, int wc, int fr, int fq) const {
        const int row0 = u.pm * BM + wr * 64 + fr, col0 = u.pn * BM + wc * 32 + 4 * fq;
        const bool isctx = row0 >= T;
        const int mrow = isctx ? 8 : (row0 >> 11);
        const float* xs = isctx ? xs_ctx - (size_t)T * D : xs_lat; float* xd = isctx ? xd_ctx - (size_t)T * D : xd_lat;
        f32x4 gv[2][2];
#pragma unroll
        for (int bj = 0; bj < 2; ++bj)
#pragma unroll
            for (int n = 0; n < 2; ++n) { const int c = col0 + bj * HALF + n * 16; gv[bj][n] = *(const f32x4*)(gt + (size_t)mrow * 6144 + c);
                if (colscale) gv[bj][n] = gv[bj][n] * *(const f32x4*)(colscale + c); }
#pragma unroll
        for (int ai = 0; ai < 2; ++ai)
#pragma unroll
            for (int m = 0; m < 4; ++m) { const size_t off = (size_t)(row0 + ai * HALF + m * 16) * D + col0;
#pragma unroll
                for (int bj = 0; bj < 2; ++bj)
#pragma unroll
                    for (int n = 0; n < 2; ++n) { const f32x4 xo = *(const f32x4*)(xs + off + bj * HALF + n * 16);
                        *(f32x4*)(xd + off + bj * HALF + n * 16) = xo + gv[bj][n] * acc[ai][bj][m][n]; } }
    }
};
struct EpiC {
    static constexpr bool PERM = true;
    bf16_t* HID;
    __device__ __forceinline__ void operator()(const f32x4 (&acc)[2][2][4][2], const Unit& u, int wr, int wc, int fr, int fq) const {
        const int n8 = u.pn & 7, rl = wr * 64 + fr, cl = n8 * 128 + wc * 32 + 8 * fq;
        bf16_t* base = HID + (size_t)u.pm * 256 * D;
#pragma unroll
        for (int ai = 0; ai < 2; ++ai)
#pragma unroll
            for (int m = 0; m < 4; ++m) {
                float h[8];
#pragma unroll
                for (int n = 0; n < 2; ++n)
#pragma unroll
                    for (int j = 0; j < 4; ++j) { const float g = acc[ai][0][m][n][j], up = acc[ai][1][m][n][j]; h[n * 4 + j] = silu_f(g) * up; }
                u32x4 w; w.x = cvt_pk_bf16(h[0], h[1]); w.y = cvt_pk_bf16(h[2], h[3]); w.z = cvt_pk_bf16(h[4], h[5]); w.w = cvt_pk_bf16(h[6], h[7]);
                *(u32x4*)(base + (size_t)(rl + ai * HALF + m * 16) * D + cl) = w; }
    }
};
struct EpiD {
    static constexpr bool PERM = true;
    bf16_t* Y; const float* gate;
    __device__ __forceinline__ void operator()(const f32x4 (&acc)[2][2][4][2], const Unit& u, int wr, int wc, int fr, int fq) const {
        const int n4 = u.pn & 3, rl = wr * 64 + fr, cl = n4 * 256 + wc * 32 + 8 * fq;
        bf16_t* base = Y + (size_t)u.pm * 256 * D; const float* gp = gate + (size_t)u.pm * 256;
#pragma unroll
        for (int ai = 0; ai < 2; ++ai)
#pragma unroll
            for (int m = 0; m < 4; ++m) { const int r = rl + ai * HALF + m * 16; const float g = gp[r];
#pragma unroll
                for (int bj = 0; bj < 2; ++bj) { const f32x4 v0 = acc[ai][bj][m][0] * g, v1 = acc[ai][bj][m][1] * g;
                    u32x4 w; w.x = cvt_pk_bf16(v0[0], v0[1]); w.y = cvt_pk_bf16(v0[2], v0[3]); w.z = cvt_pk_bf16(v1[0], v1[1]); w.w = cvt_pk_bf16(v1[2], v1[3]);
                    *(u32x4*)(base + (size_t)r * D + bj * HALF + cl) = w; } }
    }
};
}

namespace att {
constexpr int QBLK = 32, KVBLK = 64;
constexpr float SCALE = 0.088388347648318440f;
constexpr float THR = 8.f;
constexpr int SHM_V = KVBLK * 128 * 2, SHM_K = KVBLK * 128 * 2;
#define KSWZ(row, colB) ((row) * 256 + ((colB) ^ (((row) & 7) << 4)))
#define SBAR() __builtin_amdgcn_sched_barrier(0)
__device__ __forceinline__ int crow(int r, int hi) { return (r & 3) + 8 * (r >> 2) + 4 * hi; }
__device__ __forceinline__ void partialSM(f32x16& p0, f32x16& p1, float& m_reg, float& mn, float& alpha) {
    constexpr float C = SCALE * 1.4426950408889634f;
    float pmax = p0[0];
#pragma unroll
    for (int r = 1; r < 16; ++r) pmax = fmaxf(pmax, p0[r]);
#pragma unroll
    for (int r = 0; r < 16; ++r) pmax = fmaxf(pmax, p1[r]);
    { auto rr = __builtin_amdgcn_permlane32_swap(__float_as_uint(pmax), __float_as_uint(pmax), false, false);
      pmax = fmaxf(__uint_as_float(rr[0]), __uint_as_float(rr[1])); }
    if (__builtin_expect(__all(pmax - m_reg <= THR / SCALE), 1)) { mn = m_reg; alpha = 1.f; }
    else { mn = fmaxf(m_reg, pmax); alpha = __builtin_amdgcn_exp2f((m_reg - mn) * C); m_reg = mn; }
    float mnC = -mn * C;
#pragma unroll
    for (int r = 0; r < 16; ++r) p0[r] = fmaf(p0[r], C, mnC);
#pragma unroll
    for (int r = 0; r < 16; ++r) p1[r] = fmaf(p1[r], C, mnC);
#pragma unroll
    for (int r = 0; r < 16; ++r) p0[r] = __builtin_amdgcn_exp2f(p0[r]);
}
__device__ __forceinline__ void finishSM(f32x16& p0, f32x16& p1, float alpha, float& l_reg, bf16x8& pa0, bf16x8& pa1, bf16x8& pa2, bf16x8& pa3) {
#pragma unroll
    for (int r = 0; r < 16; ++r) p1[r] = __builtin_amdgcn_exp2f(p1[r]);
    float ps = 0;
#pragma unroll
    for (int r = 0; r < 16; ++r) ps += p0[r];
#pragma unroll
    for (int r = 0; r < 16; ++r) ps += p1[r];
    { auto rr = __builtin_amdgcn_permlane32_swap(__float_as_uint(ps), __float_as_uint(ps), false, false);
      ps = __uint_as_float(rr[0]) + __uint_as_float(rr[1]); }
    l_reg = l_reg * alpha + ps;
#define PK4(P, BASE, OUT) do { unsigned a0 = cvt_pk_bf16(P[BASE + 0], P[BASE + 1]), a1 = cvt_pk_bf16(P[BASE + 2], P[BASE + 3]);   \
    unsigned b0 = cvt_pk_bf16(P[BASE + 4], P[BASE + 5]), b1 = cvt_pk_bf16(P[BASE + 6], P[BASE + 7]);                              \
    auto r0 = __builtin_amdgcn_permlane32_swap(a0, b0, false, false); auto r1 = __builtin_amdgcn_permlane32_swap(a1, b1, false, false); \
    u32x4 w = {r0[0], r1[0], r0[1], r1[1]}; OUT = *reinterpret_cast<bf16x8*>(&w); } while (0)
    PK4(p0, 0, pa0); PK4(p0, 8, pa1); PK4(p1, 0, pa2); PK4(p1, 8, pa3);
#undef PK4
}
__device__ __forceinline__ void qkt(f32x16& p0, f32x16& p1, const LAS unsigned char* Ks, const bf16x8* qr, int r32, int hi) {
    p0 = f32x16{}; p1 = f32x16{};
#pragma unroll
    for (int d0 = 0; d0 < 8; ++d0) { int cb = (d0 * 16 + hi * 8) * 2;
        bf16x8 b0 = *reinterpret_cast<const LAS bf16x8*>(Ks + KSWZ(r32, cb));
        bf16x8 b1 = *reinterpret_cast<const LAS bf16x8*>(Ks + KSWZ(32 + r32, cb));
        p0 = __builtin_amdgcn_mfma_f32_32x32x16_bf16(b0, qr[d0], p0, 0, 0, 0);
        p1 = __builtin_amdgcn_mfma_f32_32x32x16_bf16(b1, qr[d0], p1, 0, 0, 0); }
}
__device__ __forceinline__ int v_st(int k, int c) { const int kk = (k & ~0xC) | ((k & 4) << 1) | ((k & 8) >> 1); return ((kk >> 3) * 4 + (c >> 5)) * 512 + ((kk & 7) * 32 + (c & 31)) * 2; }
__device__ __forceinline__ int v_rd_base(int lane) { return ((lane & 3) << 3) | (((lane >> 2) & 3) << 6) | (((lane >> 4) & 1) << 5) | (((lane >> 5) & 1) << 8); }
constexpr int v_rd_off(int d0, int ks, int half) { return d0 * 512 + ks * 4096 + half * 2048; }
template <int OFF> __device__ __forceinline__ s16x4 tr_read(int vb) {
    s16x4 r; asm volatile("ds_read_b64_tr_b16 %0, %1 offset:%2" : "=&v"(r) : "v"(vb), "i"(OFF) : "memory"); return r;
}
template <int D0> __device__ __forceinline__ void pv_one(f32x16& od, int vb, bf16x8 pa0, bf16x8 pa1, bf16x8 pa2, bf16x8 pa3) {
    const s16x4 l0 = tr_read<v_rd_off(D0, 0, 0)>(vb), h0 = tr_read<v_rd_off(D0, 0, 1)>(vb), l1 = tr_read<v_rd_off(D0, 1, 0)>(vb), h1 = tr_read<v_rd_off(D0, 1, 1)>(vb);
    const s16x4 l2 = tr_read<v_rd_off(D0, 2, 0)>(vb), h2 = tr_read<v_rd_off(D0, 2, 1)>(vb), l3 = tr_read<v_rd_off(D0, 3, 0)>(vb), h3 = tr_read<v_rd_off(D0, 3, 1)>(vb);
    asm volatile("s_waitcnt lgkmcnt(0)" ::: "memory"); SBAR();
#define PK(L, H) (bf16x8){L[0], L[1], L[2], L[3], H[0], H[1], H[2], H[3]}
    od = __builtin_amdgcn_mfma_f32_32x32x16_bf16(pa0, PK(l0, h0), od, 0, 0, 0);
    od = __builtin_amdgcn_mfma_f32_32x32x16_bf16(pa1, PK(l1, h1), od, 0, 0, 0);
    od = __builtin_amdgcn_mfma_f32_32x32x16_bf16(pa2, PK(l2, h2), od, 0, 0, 0);
    od = __builtin_amdgcn_mfma_f32_32x32x16_bf16(pa3, PK(l3, h3), od, 0, 0, 0);
#undef PK
}
__device__ __forceinline__ void pv_d0(f32x16* o, int vb, bf16x8 pa0, bf16x8 pa1, bf16x8 pa2, bf16x8 pa3) {
    pv_one<0>(o[0], vb, pa0, pa1, pa2, pa3); pv_one<1>(o[1], vb, pa0, pa1, pa2, pa3); pv_one<2>(o[2], vb, pa0, pa1, pa2, pa3); pv_one<3>(o[3], vb, pa0, pa1, pa2, pa3);
}
template <int LDQ, int LDO>
__device__ __forceinline__ void attn_body(const bf16_t* __restrict__ Qb, const bf16_t* __restrict__ Kh, const bf16_t* __restrict__ Vh, bf16_t* __restrict__ Ob, int seq, LAS unsigned char* lds) {
    constexpr int LDK = 128;
    const int tid = opaque_tid(), wid = tid >> 6, lane = tid & 63, r32 = lane & 31, hi = lane >> 5;
    LAS unsigned char* V_lds = lds; LAS unsigned char* K_lds = lds + 2 * SHM_V;
    LAS float* ws = (LAS float*)(lds + 2 * SHM_V + 2 * SHM_K) + wid * 64; LAS float* li_l = ws; LAS float* al_l = ws + 32;
    float m_reg = -1e30f, l_reg = 0; f32x16 o[4] = {}; bf16x8 qr[8];
    const bf16_t* Qw = Qb + (long)(wid * QBLK + r32) * LDQ + hi * 8;
#pragma unroll
    for (int d0 = 0; d0 < 8; ++d0) qr[d0] = *reinterpret_cast<const bf16x8*>(Qw + d0 * 16);
    const int sr = tid >> 4, sc = (tid & 15) * 8, vst0 = v_st(sr, sc), vst1 = v_st(32 + sr, sc);
    const int vb0 = (int)(unsigned)(uintptr_t)V_lds + v_rd_base(lane);
    struct { bf16x8 vs0, vs1, ks0, ks1; } sr_[2];
#define SLOAD(i, k0) do { sr_[i].vs0 = *reinterpret_cast<const bf16x8*>(&Vh[(long)((k0) + sr) * LDK + sc]); sr_[i].vs1 = *reinterpret_cast<const bf16x8*>(&Vh[(long)((k0) + 32 + sr) * LDK + sc]); \
    sr_[i].ks0 = *reinterpret_cast<const bf16x8*>(&Kh[(long)((k0) + sr) * LDK + sc]); sr_[i].ks1 = *reinterpret_cast<const bf16x8*>(&Kh[(long)((k0) + 32 + sr) * LDK + sc]); } while (0)
#define SWRITE(b, i) do { *(LAS bf16x8*)(V_lds + (b) * SHM_V + vst0) = sr_[i].vs0;          \
    *(LAS bf16x8*)(V_lds + (b) * SHM_V + vst1) = sr_[i].vs1; int kc = sc * 2;               \
    *(LAS bf16x8*)(K_lds + (b) * SHM_K + KSWZ(sr, kc)) = sr_[i].ks0;                       \
    *(LAS bf16x8*)(K_lds + (b) * SHM_K + KSWZ(32 + sr, kc)) = sr_[i].ks1; } while (0)
#define SWAIT() asm volatile("s_waitcnt vmcnt(4)" ::: "memory")
#define RESC(a) do { if (__any((a) < 1.f)) { if (hi == 0) al_l[r32] = (a); asm volatile("s_waitcnt lgkmcnt(0)" ::: "memory"); \
    for (int d = 0; d < 4; ++d) for (int r = 0; r < 16; ++r) o[d][r] *= al_l[crow(r, hi)]; } } while (0)
    f32x16 pA0, pA1, pB0, pB1; float mnA, mnB, alA, alB; bf16x8 pa0, pa1, pa2, pa3; const int NT = seq / KVBLK;
    constexpr int SE = 0, SO = 1;
    SLOAD(SE, 0); asm volatile("s_waitcnt vmcnt(0)" ::: "memory"); SWRITE(0, SE); __syncthreads();
    qkt(pA0, pA1, K_lds, qr, r32, hi); partialSM(pA0, pA1, m_reg, mnA, alA);
    SLOAD(SO, KVBLK); if (2 < NT) SLOAD(SE, 2 * KVBLK);
    SWAIT(); SWRITE(1, SO); __syncthreads();
    for (int j = 1; j + 1 < NT; j += 2) {
        SBAR(); qkt(pB0, pB1, K_lds + SHM_K, qr, r32, hi);
        finishSM(pA0, pA1, alA, l_reg, pa0, pa1, pa2, pa3); SBAR();
        SLOAD(SO, (j + 2) * KVBLK); SBAR();
        pv_d0(o, vb0, pa0, pa1, pa2, pa3); partialSM(pB0, pB1, m_reg, mnB, alB);
        __syncthreads(); SWAIT(); SWRITE(0, SE);
        RESC(alB); __syncthreads();
        SBAR(); qkt(pA0, pA1, K_lds, qr, r32, hi);
        finishSM(pB0, pB1, alB, l_reg, pa0, pa1, pa2, pa3); SBAR();
        if (j + 3 < NT) SLOAD(SE, (j + 3) * KVBLK); SBAR();
        pv_d0(o, vb0 + (int)SHM_V, pa0, pa1, pa2, pa3); partialSM(pA0, pA1, m_reg, mnA, alA);
        __syncthreads(); SWAIT(); SWRITE(1, SO);
        RESC(alA); __syncthreads();
    }
    SBAR(); qkt(pB0, pB1, K_lds + SHM_K, qr, r32, hi);
    finishSM(pA0, pA1, alA, l_reg, pa0, pa1, pa2, pa3); SBAR();
    pv_d0(o, vb0, pa0, pa1, pa2, pa3); partialSM(pB0, pB1, m_reg, mnB, alB);
    __syncthreads(); RESC(alB);
    finishSM(pB0, pB1, alB, l_reg, pa0, pa1, pa2, pa3); SBAR();
    pv_d0(o, vb0 + (int)SHM_V, pa0, pa1, pa2, pa3);
    if (hi == 0) li_l[r32] = l_reg; asm volatile("s_waitcnt lgkmcnt(0)" ::: "memory");
    float rli[16];
#pragma unroll
    for (int r = 0; r < 16; ++r) rli[r] = __builtin_amdgcn_rcpf(li_l[crow(r, hi)]);
    bf16_t* Ow = Ob + (long)(wid * QBLK) * LDO;
#pragma unroll
    for (int r = 0; r < 16; ++r) { int orow = crow(r, hi);
#pragma unroll
        for (int d0 = 0; d0 < 4; ++d0) Ow[(long)orow * LDO + d0 * 32 + r32] = f2bf(o[d0][r] * rli[r]); }
#undef SLOAD
#undef SWRITE
#undef SWAIT
#undef RESC
}
}

struct KArgs { const float* in[24]; float* out; unsigned char* ws; int ph_lo, ph_hi; };
enum { I_X = 0, I_C, I_CTX, I_CCTX, I_MODW, I_MODB, I_N1G, I_N2G, I_RW, I_WG, I_WU, I_WD, I_GWIN, I_GVG, I_GSW, I_GSB, I_GWOUT, I_AWIN, I_AQG, I_AKG, I_AWOUT, I_PWIN, I_PWG, I_PSC };

struct Fr {
    volatile LAS unsigned long long* PT;
    int G, bx, vcu;
    __device__ __forceinline__ unsigned long long ldp(int i) const { const unsigned long long v = PT[i];
        const unsigned lo = __builtin_amdgcn_readfirstlane((unsigned)v), hi = __builtin_amdgcn_readfirstlane((unsigned)(v >> 32)); return ((unsigned long long)hi << 32) | lo; }
    __device__ __forceinline__ const float* in(int i) const { return (const float*)(GAS const float*)ldp(i); }
    __device__ __forceinline__ float* out() const { return (float*)(GAS float*)ldp(24); }
    __device__ __forceinline__ unsigned char* ws() const { return (unsigned char*)(GAS unsigned char*)ldp(25); }
};
#define WSP(F, T_, OFF) ((T_*)((F).ws() + (OFF)))

__device__ __forceinline__ void tr_item(const float* W, int N, int k0, int n0, bf16_t* dst, int ldt, LAS float* scr, int lane) {
#pragma unroll 8
    for (int i = 0; i < 32; ++i) { const int kk = 2 * i + (lane >> 5); scr[kk * 33 + (lane & 31)] = W[(size_t)(k0 + kk) * N + n0 + (lane & 31)]; }
    LDS_WAIT(); asm volatile("" ::: "memory");
    const int c = lane & 7;
#pragma unroll
    for (int j = 0; j < 4; ++j) { const int n = (lane >> 3) + 8 * j; const LAS float* s = scr + (8 * c) * 33 + n;
        u32x4 o; o.x = cvt_pk_bf16(s[0 * 33], s[1 * 33]); o.y = cvt_pk_bf16(s[2 * 33], s[3 * 33]); o.z = cvt_pk_bf16(s[4 * 33], s[5 * 33]); o.w = cvt_pk_bf16(s[6 * 33], s[7 * 33]);
        *(u32x4*)(dst + (size_t)n * ldt + k0 + 8 * c) = o; }
    LDS_WAIT(); asm volatile("" ::: "memory");
}

__device__ __forceinline__ void p0_phase(const Fr& F, LAS unsigned char* lds) {
    const int tid = opaque_tid(), lane = tid & 63, wave = __builtin_amdgcn_readfirstlane(tid >> 6), gw = F.bx * NWAVES + wave, NGW = F.G * NWAVES; (void)gw; (void)NGW; (void)lane; (void)wave;
    unsigned char* const ws_ = F.ws();
    float* const modv_ = (float*)(ws_ + WS_MODV);
    bf16_t* const wsw_ = (bf16_t*)(ws_ + WS_WSW);
    bf16_t* const wgin_ = (bf16_t*)(ws_ + WS_WGIN);
    bf16_t* const wgout_ = (bf16_t*)(ws_ + WS_WGOUT);
    bf16_t* const wain_ = (bf16_t*)(ws_ + WS_WAIN);
    bf16_t* const waout_ = (bf16_t*)(ws_ + WS_WAOUT);
    bf16_t* const wpin_ = (bf16_t*)(ws_ + WS_WPIN);
    bf16_t* const wpgrp_ = (bf16_t*)(ws_ + WS_WPGRP);
    bf16_t* const wup_ = (bf16_t*)(ws_ + WS_WUP);
    bf16_t* const wdn_ = (bf16_t*)(ws_ + WS_WDN);
    const float* const in_I_AWIN = F.in(I_AWIN);
    const float* const in_I_AWOUT = F.in(I_AWOUT);
    const float* const in_I_C = F.in(I_C);
    const float* const in_I_CCTX = F.in(I_CCTX);
    const float* const in_I_GSW = F.in(I_GSW);
    const float* const in_I_GWIN = F.in(I_GWIN);
    const float* const in_I_GWOUT = F.in(I_GWOUT);
    const float* const in_I_MODB = F.in(I_MODB);
    const float* const in_I_MODW = F.in(I_MODW);
    const float* const in_I_PWG = F.in(I_PWG);
    const float* const in_I_PWIN = F.in(I_PWIN);
    const float* const in_I_WD = F.in(I_WD);
    const float* const in_I_WG = F.in(I_WG);
    const float* const in_I_WU = F.in(I_WU);

    LAS float* sact = (LAS float*)lds;
    LAS float* red = (LAS float*)(lds + 49152);
    for (int idx = tid; idx < 9 * 1024; idx += NTHR) { const int r = idx >> 10, k = idx & 1023; const float v = r < 8 ? in_I_C[r * 1024 + k] : in_I_CCTX[k]; sact[k * 12 + r] = silu_f(v); }
    __syncthreads();
    for (int chunk = F.bx; chunk < 384; chunk += F.G) {
        const int layer = chunk / 96, n = (chunk % 96) * 64 + lane, k0 = wave * 128;
        const float* wp = in_I_MODW + (size_t)layer * 1024 * 6144 + (size_t)k0 * 6144 + n;
        float acc[9];
#pragma unroll
        for (int r = 0; r < 9; ++r) acc[r] = 0.f;
#pragma unroll 8
        for (int kk = 0; kk < 128; ++kk) { const float w = wp[(size_t)kk * 6144]; const LAS float* sa = sact + (k0 + kk) * 12;
#pragma unroll
            for (int r = 0; r < 9; ++r) acc[r] += sa[r] * w; }
#pragma unroll
        for (int r = 0; r < 9; ++r) red[(wave * 9 + r) * 64 + lane] = acc[r];
        __syncthreads();
        for (int idx = tid; idx < 576; idx += NTHR) { const int r = idx >> 6, l = idx & 63; float s = 0.f;
#pragma unroll
            for (int w = 0; w < 8; ++w) s += red[(w * 9 + r) * 64 + l];
            const int nn = (chunk % 96) * 64 + l; modv_[(size_t)(layer * 9 + r) * 6144 + nn] = s + in_I_MODB[layer * 6144 + nn]; }
        __syncthreads();
    }
    __syncthreads();
    LAS float* scr = (LAS float*)(lds + wave * 16384);
    constexpr int NEXP = 4 * 16 * 3 * 512, NOTH = 1024 * 2 + 512 * 2 + 768 + 512 + 512 + 128;
    for (int it = gw; it < NEXP + NOTH; it += NGW) {
        if (it < NEXP) {
            const int mat = it >> 9, sub = it & 511, l = mat / 48, rem = mat % 48, e = rem / 3, which = rem % 3, k0 = (sub >> 5) * 64, n0 = (sub & 31) * 32;
            if (which < 2) { const float* W = (which == 0 ? in_I_WG : in_I_WU) + (size_t)(l * 16 + e) * 1024 * 1024;
                bf16_t* dst = wup_ + (size_t)l * 16 * 2048 * 1024 + (size_t)((e * 8 + (n0 >> 7)) * 256 + which * 128 + (n0 & 127)) * 1024;
                tr_item(W, 1024, k0, n0, dst, 1024, scr, lane); }
            else { const float* W = in_I_WD + (size_t)(l * 16 + e) * 1024 * 1024;
                bf16_t* dst = wdn_ + (size_t)l * 16 * 1024 * 1024 + (size_t)(e * 1024 + n0) * 1024;
                tr_item(W, 1024, k0, n0, dst, 1024, scr, lane); }
        } else {
            int r = it - NEXP;
            if (r < 2048) { const int j = r >> 10, sub = r & 1023, k0 = (sub >> 6) * 64, n0 = (sub & 63) * 32;
                tr_item(in_I_GWIN + (size_t)j * 1024 * 2048, 2048, k0, n0, wgin_ + (size_t)j * 2048 * 1024 + (size_t)n0 * 1024, 1024, scr, lane); continue; } r -= 2048;
            if (r < 1024) { const int j = r >> 9, sub = r & 511, k0 = (sub >> 5) * 64, n0 = (sub & 31) * 32;
                tr_item(in_I_GWOUT + (size_t)j * 1024 * 1024, 1024, k0, n0, wgout_ + (size_t)j * 1024 * 1024 + (size_t)n0 * 1024, 1024, scr, lane); continue; } r -= 1024;
            if (r < 768) { const int k0 = (r / 48) * 64, n0 = (r % 48) * 32;
                tr_item(in_I_AWIN, 1536, k0, n0, wain_ + (size_t)n0 * 1024, 1024, scr, lane); continue; } r -= 768;
            if (r < 512) { const int k0 = (r >> 5) * 64, n0 = (r & 31) * 32;
                tr_item(in_I_AWOUT, 1024, k0, n0, waout_ + (size_t)n0 * 1024, 1024, scr, lane); continue; } r -= 512;
            if (r < 512) { const int k0 = (r >> 5) * 64, n0 = (r & 31) * 32;
                tr_item(in_I_PWIN, 1024, k0, n0, wpin_ + (size_t)n0 * 1024, 1024, scr, lane); continue; } r -= 512;
            { const int g = r >> 5, sub = r & 31, k0 = (sub >> 3) * 64, n0 = (sub & 7) * 32;
                tr_item(in_I_PWG + (size_t)g * 256 * 256, 256, k0, n0, wpgrp_ + (size_t)g * 256 * 256 + (size_t)n0 * 256, 256, scr, lane); }
        }
    }
    for (int i4 = F.bx * NTHR + tid; i4 < 2 * 8 * 128 * 128 / 4; i4 += F.G * NTHR) { const f32x4 v = *(const f32x4*)(in_I_GSW + (size_t)i4 * 4);
        u32x2 o; o.x = cvt_pk_bf16(v[0], v[1]); o.y = cvt_pk_bf16(v[2], v[3]); *(u32x2*)(wsw_ + (size_t)i4 * 4) = o; }
}

__device__ __forceinline__ void norm_phase(const Fr& F, LAS unsigned char* lds, int layer, int which, int nrows, int comb, const float* xlat, const float* xctx, float* xlat_d, float* xctx_d) {
    const int tid = opaque_tid(), lane = tid & 63, wave = __builtin_amdgcn_readfirstlane(tid >> 6), gw = F.bx * NWAVES + wave, NGW = F.G * NWAVES; (void)gw; (void)NGW; (void)lane; (void)wave;
    unsigned char* const ws_ = F.ws();
    float* const modv_ = (float*)(ws_ + WS_MODV);
    float* const aff_ = (float*)(ws_ + WS_AFF);
    int* const slot_ = (int*)(ws_ + WS_SLOT);
    bf16_t* const H_ = (bf16_t*)(ws_ + WS_H);
    bf16_t* const YEXP_ = (bf16_t*)(ws_ + WS_YEXP);
    const float* const in_I_RW = F.in(I_RW);

    LAS unsigned char* rwl = lds;
    if (which == 2) {
        const float* rw = in_I_RW + (size_t)layer * 1024 * 16;
        for (int idx = tid; idx < 4096; idx += NTHR) { const int col = idx >> 2, e4 = idx & 3; *(LAS f32x4*)(rwl + col * 64 + (col >> 2) * 16 + e4 * 16) = *(const f32x4*)(rw + col * 16 + e4 * 4); }
        __syncthreads();
    }
    const float* ng = F.in(which == 2 ? I_N2G : I_N1G) + (size_t)layer * 1024;
    for (int r = gw; r < nrows; r += NGW) {
        const bool isctx = r >= T; const int rc = r - T; const int b = isctx ? (rc >> 8) : (r >> 11); const int mrow = isctx ? 8 : b;
        const float* xp = isctx ? xctx + (size_t)rc * D : xlat + (size_t)r * D;
        f32x4 v[4];
#pragma unroll
        for (int j = 0; j < 4; ++j) v[j] = *(const f32x4*)(xp + lane * 4 + 256 * j);
        if (comb >= 0) {
            f32x4 a[4];
#pragma unroll
            for (int j = 0; j < 4; ++j) a[j] = (f32x4){0.f, 0.f, 0.f, 0.f};
            const int sl = slot_[(size_t)r * 16 + (lane & 15)];
            for (int e = 0; e < 16; ++e) {
                const int s = __builtin_amdgcn_readfirstlane(__shfl(sl, e));
                if (s >= 0) {
                    const int tile = isctx ? 128 + e : e * 8 + b, rin = isctx ? b * 32 + s : s;
                    const bf16_t* yp = YEXP_ + ((size_t)tile * 256 + rin) * D + lane * 4;
#pragma unroll
                    for (int j = 0; j < 4; ++j) { const u32x2 w = *(const u32x2*)(yp + 256 * j); a[j][0] += bf_lo(w.x); a[j][1] += bf_hi(w.x); a[j][2] += bf_lo(w.y); a[j][3] += bf_hi(w.y); }
                }
            }
            const float* g2 = modv_ + (size_t)(comb * 9 + mrow) * 6144 + 5 * 1024 + lane * 4;
            float* xd = isctx ? xctx_d + (size_t)rc * D : xlat_d + (size_t)r * D;
#pragma unroll
            for (int j = 0; j < 4; ++j) { v[j] = v[j] + *(const f32x4*)(g2 + 256 * j) * a[j]; *(f32x4*)(xd + lane * 4 + 256 * j) = v[j]; }
        }
        if (which == 0) continue;
        float ss = 0.f;
#pragma unroll
        for (int j = 0; j < 4; ++j) ss += (v[j][0] * v[j][0] + v[j][1] * v[j][1]) + (v[j][2] * v[j][2] + v[j][3] * v[j][3]);
        const float rstd = rsqrtf(wave_sum(ss) * (1.f / D) + EPS);
        const float* mv = modv_ + (size_t)(layer * 9 + mrow) * 6144 + (which == 2 ? 3 * 1024 : 0) + lane * 4;
        bf16_t* hp = H_ + (size_t)r * D + lane * 4;
        f32x4 h[4];
#pragma unroll
        for (int j = 0; j < 4; ++j) { const f32x4 g = *(const f32x4*)(ng + lane * 4 + 256 * j), sh = *(const f32x4*)(mv + 256 * j), sc = *(const f32x4*)(mv + 1024 + 256 * j);
            h[j] = (v[j] * rstd * g) * (sc + 1.f) + sh;
            u32x2 o; o.x = cvt_pk_bf16(h[j][0], h[j][1]); o.y = cvt_pk_bf16(h[j][2], h[j][3]); *(u32x2*)(hp + 256 * j) = o; }
        if (which == 2) {
            float p[16];
#pragma unroll
            for (int e = 0; e < 16; ++e) p[e] = 0.f;
#pragma unroll
            for (int j = 0; j < 4; ++j)
#pragma unroll
                for (int i = 0; i < 4; ++i) { const int col = lane * 4 + 256 * j + i; const LAS unsigned char* rp = rwl + col * 64 + (col >> 2) * 16; const float hv = h[j][i];
#pragma unroll
                    for (int e4 = 0; e4 < 4; ++e4) { const f32x4 w = *(const LAS f32x4*)(rp + e4 * 16); p[e4 * 4 + 0] += hv * w[0]; p[e4 * 4 + 1] += hv * w[1]; p[e4 * 4 + 2] += hv * w[2]; p[e4 * 4 + 3] += hv * w[3]; } }
            float mx = -1e30f;
#pragma unroll
            for (int e = 0; e < 16; ++e) { p[e] = wave_sum(p[e]); mx = fmaxf(mx, p[e]); }
            float sum = 0.f;
#pragma unroll
            for (int e = 0; e < 16; ++e) { p[e] = expf(p[e] - mx); sum += p[e]; }
            const float inv = 1.f / sum; float mine = 0.f;
#pragma unroll
            for (int e = 0; e < 16; ++e) mine = (lane == e) ? p[e] * inv : mine;
            if (lane < 16) { aff_[(size_t)r * 16 + lane] = mine; slot_[(size_t)r * 16 + lane] = -1; }
        }
    }
}

__device__ __forceinline__ void topk_phase(const Fr& F, LAS unsigned char* lds, bool with_ctx) {
    const int tid = opaque_tid(), lane = tid & 63, wave = __builtin_amdgcn_readfirstlane(tid >> 6), gw = F.bx * NWAVES + wave, NGW = F.G * NWAVES; (void)gw; (void)NGW; (void)lane; (void)wave;
    unsigned char* const ws_ = F.ws();
    float* const aff_ = (float*)(ws_ + WS_AFF);
    int* const slot_ = (int*)(ws_ + WS_SLOT);
    float* const gate_ = (float*)(ws_ + WS_GATE);
    bf16_t* const H_ = (bf16_t*)(ws_ + WS_H);
    bf16_t* const XIN_ = (bf16_t*)(ws_ + WS_XIN);

    LAS unsigned long long* key = (LAS unsigned long long*)lds;
    LAS int* sel = (LAS int*)(lds + 16384);
    const int nunits = with_ctx ? 256 : 128;
    for (int u = F.bx; u < nunits; u += F.G) {
        const bool isctx = u >= 128; const int uu = isctx ? u - 128 : u, e = uu >> 3, b = uu & 7;
        const int N = isctx ? CL : SEQ, cap = isctx ? CCAP : CAP, row0 = isctx ? T + b * CL : b * SEQ;
        for (int s = tid; s < N; s += NTHR) { const unsigned bits = __float_as_uint(aff_[(size_t)(row0 + s) * 16 + e]); key[s] = ((unsigned long long)bits << 32) | (unsigned)(N - 1 - s); }
        __syncthreads();
        for (int k = 2; k <= N; k <<= 1)
            for (int j = k >> 1; j > 0; j >>= 1) {
                for (int p = tid; p < N / 2; p += NTHR) { const int i = ((p & ~(j - 1)) << 1) | (p & (j - 1)), l = i | j;
                    const unsigned long long a = key[i], c = key[l]; const bool desc = (i & k) == 0;
                    if ((a < c) == desc) { key[i] = c; key[l] = a; } }
                __syncthreads();
            }
        const int tile = isctx ? 128 + e : uu, rbase = isctx ? b * 32 : 0;
        if (tid < cap) { const unsigned long long kk = key[tid]; const int s = N - 1 - (int)(unsigned)(kk & 0xffffffffu); sel[tid] = s;
            gate_[(size_t)tile * 256 + rbase + tid] = __uint_as_float((unsigned)(kk >> 32));
            slot_[(size_t)(row0 + s) * 16 + e] = tid; }
        __syncthreads();
        const int sub = tid >> 7, c16 = tid & 127;
        for (int sl = sub; sl < cap; sl += 4) { const int s = sel[sl];
            *(u32x4*)(XIN_ + ((size_t)tile * 256 + rbase + sl) * D + c16 * 8) = *(const u32x4*)(H_ + (size_t)(row0 + s) * D + c16 * 8); }
        __syncthreads();
    }
}

__device__ __forceinline__ void spatial_phase(const Fr& F, LAS unsigned char* lds, int j, int nunits) {
    const int tid = opaque_tid(), lane = tid & 63, wave = __builtin_amdgcn_readfirstlane(tid >> 6), gw = F.bx * NWAVES + wave, NGW = F.G * NWAVES; (void)gw; (void)NGW; (void)lane; (void)wave;
    unsigned char* const ws_ = F.ws();
    bf16_t* const wsw_ = (bf16_t*)(ws_ + WS_WSW);
    bf16_t* const S1_ = (bf16_t*)(ws_ + WS_S1);
    bf16_t* const S2_ = (bf16_t*)(ws_ + WS_S2);
    const float* const in_I_GSB = F.in(I_GSB);
    const float* const in_I_GVG = F.in(I_GVG);

    constexpr int LDT = 136;
    LAS float* stat = (LAS float*)lds;
    LAS bf16_t* As = (LAS bf16_t*)(lds + 1024);
    LAS bf16_t* Bs = (LAS bf16_t*)(lds + 1024 + 128 * LDT * 2);
    const float* vg = in_I_GVG + (size_t)j * 1024; const float* sb = in_I_GSB + (size_t)j * 8 * 128;
    const bf16_t* sw = wsw_ + (size_t)j * 8 * 128 * 128;
    const int r32 = lane & 31, hi = lane >> 5;
    for (int u = F.bx; u < nunits; u += F.G) {
        const int r0 = u * 128;
#pragma nounroll
        for (int rr = wave * 16; rr < wave * 16 + 16; ++rr) {
            const bf16_t* vp = S1_ + (size_t)(r0 + rr) * 2048 + 1024 + lane * 8;
            const u32x4 w0 = *(const u32x4*)vp, w1 = *(const u32x4*)(vp + 512);
            float x[16];
#pragma unroll
            for (int i = 0; i < 4; ++i) { x[2 * i] = bf_lo(w0[i]); x[2 * i + 1] = bf_hi(w0[i]); x[8 + 2 * i] = bf_lo(w1[i]); x[8 + 2 * i + 1] = bf_hi(w1[i]); }
            float s = 0.f;
#pragma unroll
            for (int i = 0; i < 16; ++i) s += x[i];
            const float mean = wave_sum(s) * (1.f / 1024.f); float q = 0.f;
#pragma unroll
            for (int i = 0; i < 16; ++i) { const float d = x[i] - mean; q += d * d; }
            const float rstd = rsqrtf(wave_sum(q) * (1.f / 1024.f) + EPS);
            if (lane == 0) { stat[rr * 2] = mean; stat[rr * 2 + 1] = rstd; }
        }
        __syncthreads();
#pragma nounroll
        for (int g = 0; g < 8; ++g) {
#pragma unroll
            for (int i = 0; i < 4; ++i) { const int id = tid + NTHR * i, p = id >> 4, qc = id & 15;
                *(LAS u32x4*)(As + p * LDT + qc * 8) = *(const u32x4*)(sw + (size_t)g * 128 * 128 + p * 128 + qc * 8); }
#pragma unroll
            for (int i = 0; i < 4; ++i) { const int id = tid + NTHR * i, q = id & 127, dc = id >> 7;
                const u32x4 w = *(const u32x4*)(S1_ + (size_t)(r0 + q) * 2048 + 1024 + g * 128 + dc * 8);
                const float mean = stat[q * 2], rstd = stat[q * 2 + 1];
                const f32x4 g0 = *(const f32x4*)(vg + g * 128 + dc * 8), g1 = *(const f32x4*)(vg + g * 128 + dc * 8 + 4);
                float x[8];
#pragma unroll
                for (int k = 0; k < 4; ++k) { x[2 * k] = bf_lo(w[k]); x[2 * k + 1] = bf_hi(w[k]); }
#pragma unroll
                for (int k = 0; k < 8; ++k) { const float gg = k < 4 ? g0[k & 3] : g1[k & 3]; Bs[(dc * 8 + k) * LDT + q] = f2bf((x[k] - mean) * rstd * gg); } }
            __syncthreads();
            const int pw = (wave >> 1) * 32, dw = (wave & 1) * 64;
            f32x16 acc0 = {}, acc1 = {};
#pragma unroll
            for (int ks = 0; ks < 8; ++ks) {
                const bf16x8 a = *(const LAS bf16x8*)(As + (pw + r32) * LDT + ks * 16 + hi * 8);
                const bf16x8 b0 = *(const LAS bf16x8*)(Bs + (dw + r32) * LDT + ks * 16 + hi * 8);
                const bf16x8 b1 = *(const LAS bf16x8*)(Bs + (dw + 32 + r32) * LDT + ks * 16 + hi * 8);
                acc0 = __builtin_amdgcn_mfma_f32_32x32x16_bf16(a, b0, acc0, 0, 0, 0);
                acc1 = __builtin_amdgcn_mfma_f32_32x32x16_bf16(a, b1, acc1, 0, 0, 0);
            }
#pragma unroll
            for (int r = 0; r < 16; ++r) { const int p = pw + att::crow(r, hi); const float bias = sb[g * 128 + p];
                const size_t ro = (size_t)(r0 + p);
                const int c0 = g * 128 + dw + r32;
                const float u0 = bf2f(S1_[ro * 2048 + c0]), u1 = bf2f(S1_[ro * 2048 + c0 + 32]);
                S2_[ro * D + c0] = f2bf((acc0[r] + bias) * u0); S2_[ro * D + c0 + 32] = f2bf((acc1[r] + bias) * u1); }
            __syncthreads();
        }
    }
}

__device__ __forceinline__ void qknorm_phase(const Fr& F) {
    const int tid = opaque_tid(), lane = tid & 63, wave = __builtin_amdgcn_readfirstlane(tid >> 6), gw = F.bx * NWAVES + wave, NGW = F.G * NWAVES; (void)gw; (void)NGW; (void)lane; (void)wave;
    unsigned char* const ws_ = F.ws();
    bf16_t* const S1_ = (bf16_t*)(ws_ + WS_S1);
    bf16_t* const QB_ = (bf16_t*)(ws_ + WS_QB);
    bf16_t* const KB_ = (bf16_t*)(ws_ + WS_KB);
    const float* const in_I_AKG = F.in(I_AKG);
    const float* const in_I_AQG = F.in(I_AQG);

    const float* qg = in_I_AQG; const float* kg = in_I_AKG;
    const float qg0 = qg[lane], qg1 = qg[lane + 64], kg0 = kg[lane], kg1 = kg[lane + 64];
    const float inv = exp2f(-(float)(lane & 31) * (13.287712379549449f / 32.f));
    for (int r = gw; r < TT; r += NGW) {
        const bool isctx = r >= T; const int rc = r - T; const int b = isctx ? (rc >> 8) : (r >> 11); const int s = isctx ? (rc & (CL - 1)) : (r & (SEQ - 1));
        const bf16_t* src = S1_ + (size_t)r * 2048;
        float cs = 1.f, sn = 0.f;
        if (!isctx) { const float pos = (float)(lane < 32 ? (s >> 6) : (s & 63)); const float ang = pos * inv; cs = cosf(ang); sn = sinf(ang); }
        for (int hh = isctx ? 8 : 0; hh < 10; ++hh) {
            const bool isk = hh >= 8; const int cb = isk ? 1024 + (hh - 8) * 128 : hh * 128;
            float a = bf2f(src[cb + lane]), c = bf2f(src[cb + lane + 64]);
            const float rs = rsqrtf(wave_sum(a * a + c * c) * (1.f / 128.f) + EPS);
            a = a * rs * (isk ? kg0 : qg0); c = c * rs * (isk ? kg1 : qg1);
            const float o1 = a * cs - c * sn, o2 = a * sn + c * cs;
            bf16_t* dst = isk ? KB_ + ((size_t)(b * 2 + (hh - 8)) * SKV + (isctx ? s : CL + s)) * 128 : QB_ + (size_t)r * D + hh * 128;
            dst[lane] = f2bf(o1); dst[lane + 64] = f2bf(o2);
        }
    }
}

__device__ __forceinline__ void pool_phase(const Fr& F) {
    const int tid = opaque_tid(), lane = tid & 63, wave = __builtin_amdgcn_readfirstlane(tid >> 6), gw = F.bx * NWAVES + wave, NGW = F.G * NWAVES; (void)gw; (void)NGW; (void)lane; (void)wave;
    unsigned char* const ws_ = F.ws();
    bf16_t* const S1_ = (bf16_t*)(ws_ + WS_S1);
    bf16_t* const S2_ = (bf16_t*)(ws_ + WS_S2);

    for (int id = F.bx * NTHR + tid; id < T * 128; id += F.G * NTHR) {
        const int r = id >> 7, c8 = id & 127, gi = c8 >> 5, half = 1 << gi, s = r & (SEQ - 1);
        const int lo = max(s - half, 0), hi = min(s + half - 1, SEQ - 1);
        float acc[8];
#pragma unroll
        for (int k = 0; k < 8; ++k) acc[k] = 0.f;
        const bf16_t* zp = S1_ + (size_t)(r - s) * 2048 + c8 * 8;
        for (int t = lo; t <= hi; ++t) { const u32x4 w = *(const u32x4*)(zp + (size_t)t * 2048);
#pragma unroll
            for (int k = 0; k < 4; ++k) { acc[2 * k] += bf_lo(w[k]); acc[2 * k + 1] += bf_hi(w[k]); } }
        const u32x4 w = *(const u32x4*)(zp + (size_t)s * 2048); const float ic = 1.f / (float)(hi - lo + 1);
        float o[8];
#pragma unroll
        for (int k = 0; k < 4; ++k) { o[2 * k] = acc[2 * k] * ic - bf_lo(w[k]); o[2 * k + 1] = acc[2 * k + 1] * ic - bf_hi(w[k]); }
        u32x4 ov; ov.x = cvt_pk_bf16(o[0], o[1]); ov.y = cvt_pk_bf16(o[2], o[3]); ov.z = cvt_pk_bf16(o[4], o[5]); ov.w = cvt_pk_bf16(o[6], o[7]);
        *(u32x4*)(S2_ + (size_t)r * D + c8 * 8) = ov;
    }
}

__global__ void __launch_bounds__(NTHR, 2) fwd_kernel(KArgs args) {
    extern __shared__ __attribute__((aligned(16))) unsigned char lds_raw[];
    LAS unsigned char* lds = (LAS unsigned char*)lds_raw;
    volatile LAS unsigned* MISC = (volatile LAS unsigned*)(lds + MISC_OFF);
    Fr F;
    F.PT = (volatile LAS unsigned long long*)(lds + MISC_OFF + 256);
    F.G = gridDim.x; F.bx = blockIdx.x; F.vcu = (F.G % 8 == 0) ? (F.bx % 8) * (F.G / 8) + F.bx / 8 : F.bx;
    { const int t0 = threadIdx.x;
      if (t0 < 64) MISC[t0] = 0u;
      if (t0 < 24) F.PT[t0] = (unsigned long long)args.in[t0];
      if (t0 == 24) F.PT[24] = (unsigned long long)args.out;
      if (t0 == 25) F.PT[25] = (unsigned long long)args.ws; }
    __syncthreads();
    XcdBarrier bar = xcd_barrier_post((unsigned*)(F.ws() + WS_CTL), MISC + 8);
    const int lo = args.ph_lo, hi = args.ph_hi;
    int p = 0;
#define RUN(...) do { if (lo <= p && p < hi) { __VA_ARGS__; if (p + 1 < hi) xcd_barrier(bar); } ++p; } while (0)

#ifndef NO_P0
    RUN(p0_phase(F, lds));
#endif
#pragma nounroll
    for (int L = 0; L < 4; ++L) {
        const int kind = L % 3, jm = L / 3;
        const bool with_ctx = (L == 0);
        RUN({
            float* xo = F.out(); float* xc = WSP(F, float, WS_XC);
#ifndef NO_NORM
            norm_phase(F, lds, L, 1, (L <= 1) ? TT : T, L - 1, (L == 0) ? F.in(I_X) : xo, (L == 0) ? F.in(I_CTX) : xc, xo, xc);
#endif
        });
        RUN({
            unsigned char* ws = F.ws();
            pg8::SchedDense S; S.A = (bf16_t*)(ws + WS_H); S.G = F.G; S.c = F.bx; S.a_pn_stride = 0; S.a_pm_stride = 256 * D; S.b_pn_stride = 256 * D; S.extra = 0;
            pg8::EpiA E; E.O = (bf16_t*)(ws + WS_S1); E.ldc = 2048; E.act = 0; E.VB = nullptr;
            if (kind == 0) { S.Bt = (bf16_t*)(ws + WS_WGIN) + (size_t)jm * 2048 * 1024; S.nM = with_ctx ? 72 : 64; S.nN = 8; E.act = 1; }
            else if (kind == 1) { S.Bt = (bf16_t*)(ws + WS_WAIN); S.nM = 64; S.nN = 6; S.extra = 16; E.VB = (bf16_t*)(ws + WS_VB); }
            else { S.Bt = (bf16_t*)(ws + WS_WPIN); S.nM = 64; S.nN = 4; }
            S.nwg = S.nM * S.nN;
            #ifndef NO_GA
            pg8::gemm_phase<pg8::EpiA, pg8::SchedDense>(lds, D, D, D, S, E);
#endif
        });
        if (kind == 0) {
#ifndef NO_SPAT
            RUN(spatial_phase(F, lds, jm, with_ctx ? 144 : 128));
#endif
        }
        else if (kind == 1) {
#ifndef NO_QKN
            RUN(qknorm_phase(F));
#endif
            RUN({
                unsigned char* ws = F.ws();
                const bf16_t* QB = (const bf16_t*)(ws + WS_QB); const bf16_t* KB = (const bf16_t*)(ws + WS_KB); const bf16_t* VB = (const bf16_t*)(ws + WS_VB); bf16_t* S2 = (bf16_t*)(ws + WS_S2);
                for (int i = 0; i * F.G + F.vcu < 512; ++i) { const int Lu = i * F.G + F.vcu, bk = Lu >> 5, w = Lu & 31, b = bk >> 1, kvh = bk & 1, h = kvh * 4 + (w >> 3), qb = w & 7;
#ifndef NO_ATT
                    att::attn_body<D, D>(QB + ((size_t)(b * SEQ + qb * 256)) * D + h * 128, KB + (size_t)bk * SKV * 128, VB + (size_t)bk * SKV * 128,
                                         S2 + ((size_t)(b * SEQ + qb * 256)) * D + h * 128, SKV, lds);
#endif
                    __syncthreads(); }
            });
        } else {
#ifndef NO_POOL
            RUN(pool_phase(F));
#endif
        }
        RUN({
            unsigned char* ws = F.ws();
            pg8::SchedDense S; S.A = (bf16_t*)(ws + WS_S2); S.G = F.G; S.c = F.bx; S.a_pm_stride = 256 * D; S.a_pn_stride = 0; S.b_pn_stride = 256 * D; S.extra = 0; S.nN = 4; S.nM = 64;
            pg8::EpiB E; E.xd_lat = F.out(); E.xd_ctx = (float*)(ws + WS_XC); E.xs_lat = (L == 0) ? F.in(I_X) : E.xd_lat; E.xs_ctx = (L == 0) ? F.in(I_CTX) : E.xd_ctx;
            E.gt = (const float*)(ws + WS_MODV) + (size_t)L * 9 * 6144 + 2 * 1024; E.colscale = nullptr;
            int K = D, ldb = D;
            if (kind == 0) { S.Bt = (bf16_t*)(ws + WS_WGOUT) + (size_t)jm * 1024 * 1024; S.nM = with_ctx ? 72 : 64; }
            else if (kind == 1) { S.Bt = (bf16_t*)(ws + WS_WAOUT); }
            else { S.Bt = (bf16_t*)(ws + WS_WPGRP); S.a_pn_stride = 256; S.b_pn_stride = 256 * 256; K = 256; ldb = 256; E.colscale = F.in(I_PSC); }
            S.nwg = S.nM * S.nN;
            #ifndef NO_GB
            pg8::gemm_phase<pg8::EpiB, pg8::SchedDense>(lds, K, D, ldb, S, E);
#endif
        });
        RUN({
            float* xo = F.out(); float* xc = WSP(F, float, WS_XC);
#ifndef NO_NORM
            norm_phase(F, lds, L, 2, with_ctx ? TT : T, -1, xo, xc, xo, xc);
#endif
        });
#ifndef NO_TOPK
        RUN(topk_phase(F, lds, with_ctx));
#endif
        RUN({
            unsigned char* ws = F.ws();
            pg8::SchedMoE S; S.A = (bf16_t*)(ws + WS_XIN); S.Bt = (bf16_t*)(ws + WS_WUP) + (size_t)L * 16 * 2048 * 1024; S.nbt = with_ctx ? 9 : 8; S.nn = 8; S.G = F.G; S.vcu = F.vcu;
            pg8::EpiC E; E.HID = (bf16_t*)(ws + WS_HID);
            #ifndef NO_GC
            pg8::gemm_phase<pg8::EpiC, pg8::SchedMoE>(lds, D, D, D, S, E);
#endif
        });
        RUN({
            unsigned char* ws = F.ws();
            pg8::SchedMoE S; S.A = (bf16_t*)(ws + WS_HID); S.Bt = (bf16_t*)(ws + WS_WDN) + (size_t)L * 16 * 1024 * 1024; S.nbt = with_ctx ? 9 : 8; S.nn = 4; S.G = F.G; S.vcu = F.vcu;
            pg8::EpiD E; E.Y = (bf16_t*)(ws + WS_YEXP); E.gate = (const float*)(ws + WS_GATE);
            #ifndef NO_GD
            pg8::gemm_phase<pg8::EpiD, pg8::SchedMoE>(lds, D, D, D, S, E);
#endif
        });
    }
    RUN({
        float* xo = F.out(); float* xc = WSP(F, float, WS_XC);
#ifndef NO_NORM
        norm_phase(F, lds, 3, 0, T, 3, xo, xc, xo, xc);
#endif
    });
#undef RUN
}

constexpr int N_PHASES = 1 + 8 + 9 + 8 + 8 + 1;

extern "C" void kernel_launch(void* const* d_in, const int* in_sizes, int n_in, void* d_out, int out_size, void* d_ws, size_t ws_size, hipStream_t stream) {
    static int grid = 0;
    if (grid == 0) {
        if (n_in != 24 || out_size != T * D || ws_size < WS_END) { fprintf(stderr, "kernel_launch: unexpected shapes (n_in %d out %d ws %zu need %zu)\n", n_in, out_size, ws_size, (size_t)WS_END); grid = -1; return; }
        int dev = 0, cus = 0;
        if (hipGetDevice(&dev) != hipSuccess || hipDeviceGetAttribute(&cus, hipDeviceAttributeMultiprocessorCount, dev) != hipSuccess) { grid = -1; return; }
        if (hipFuncSetAttribute((const void*)fwd_kernel, hipFuncAttributeMaxDynamicSharedMemorySize, LDS_BYTES) != hipSuccess) { fprintf(stderr, "kernel_launch: hipFuncSetAttribute failed\n"); grid = -1; return; }
        (void)hipGetLastError();
        grid = cus;
    }
    if (grid < 0) return;
    (void)hipMemsetAsync((char*)d_ws + WS_CTL, 0, CTL_BYTES, stream);
    KArgs a{};
    for (int i = 0; i < 24; ++i) a.in[i] = (const float*)d_in[i];
    a.out = (float*)d_out; a.ws = (unsigned char*)d_ws;
#if MK_PER_PHASE
    for (int k = 0; k < N_PHASES; ++k) { a.ph_lo = k; a.ph_hi = k + 1; hipLaunchKernelGGL(fwd_kernel, dim3(grid), dim3(NTHR), LDS_BYTES, stream, a); }
#else
    a.ph_lo = 0; a.ph_hi = N_PHASES;
    hipLaunchKernelGGL(fwd_kernel, dim3(grid), dim3(NTHR), LDS_BYTES, stream, a);
#endif
    const hipError_t le = hipPeekAtLastError();
    if (le != hipSuccess) fprintf(stderr, "kernel_launch: launch failed: %s\n", hipGetErrorName(le));
}
```

```cpp
#include <hip/hip_runtime.h>
#include <cstdio>
#include <cstdint>

#ifndef REPEAT_MASK
#define REPEAT_MASK 0u
#endif
#ifndef MK_PER_PHASE
#define MK_PER_PHASE 0
#endif

#define LAS __attribute__((address_space(3)))
#define GAS __attribute__((address_space(1)))
typedef unsigned short bf16_t;
typedef short bf16x8 __attribute__((ext_vector_type(8)));
typedef short s16x4 __attribute__((ext_vector_type(4)));
typedef float f32x2 __attribute__((ext_vector_type(2)));
typedef float f32x4 __attribute__((ext_vector_type(4)));
typedef float f32x16 __attribute__((ext_vector_type(16)));
typedef unsigned u32x2 __attribute__((ext_vector_type(2)));
typedef unsigned u32x4 __attribute__((ext_vector_type(4)));

constexpr int D = 1024, NB = 8, SEQ = 2048, T = NB * SEQ, CL = 256, TC = NB * CL, TT = T + TC, NE = 16, CAP = 256, CCAP = 32, NTILE = 144;
constexpr int SKV = CL + SEQ;
constexpr float EPS = 1e-6f;
constexpr int NWAVES = 8, NTHR = 512;

constexpr size_t al256(size_t x) { return (x + 255) / 256 * 256; }
constexpr size_t WS_CTL   = 0;
constexpr size_t CTL_BYTES = 65536;
constexpr size_t WS_MODV  = WS_CTL + CTL_BYTES;
constexpr size_t WS_AFF   = WS_MODV + al256((size_t)4 * 9 * 6144 * 4);
constexpr size_t WS_SLOT  = WS_AFF + (size_t)TT * 16 * 4;
constexpr size_t WS_GATE  = WS_SLOT + (size_t)TT * 16 * 4;
constexpr size_t WS_WSW   = WS_GATE + (size_t)NTILE * 256 * 4;
constexpr size_t WS_WGIN  = WS_WSW + (size_t)2 * 8 * 128 * 128 * 2;
constexpr size_t WS_WGOUT = WS_WGIN + (size_t)2 * 2048 * 1024 * 2;
constexpr size_t WS_WAIN  = WS_WGOUT + (size_t)2 * 1024 * 1024 * 2;
constexpr size_t WS_WAOUT = WS_WAIN + (size_t)1536 * 1024 * 2;
constexpr size_t WS_WPIN  = WS_WAOUT + (size_t)1024 * 1024 * 2;
constexpr size_t WS_WPGRP = WS_WPIN + (size_t)1024 * 1024 * 2;
constexpr size_t WS_WUP   = WS_WPGRP + (size_t)4 * 256 * 256 * 2;
constexpr size_t WS_WDN   = WS_WUP + (size_t)4 * 16 * 2048 * 1024 * 2;
constexpr size_t WS_XC    = WS_WDN + (size_t)4 * 16 * 1024 * 1024 * 2;
constexpr size_t WS_H     = WS_XC + (size_t)TC * D * 4;
constexpr size_t WS_S1    = WS_H + (size_t)TT * D * 2;
constexpr size_t WS_S2    = WS_S1 + (size_t)TT * 2048 * 2;
constexpr size_t WS_QB    = WS_S2 + (size_t)TT * D * 2;
constexpr size_t WS_KB    = WS_QB + (size_t)T * D * 2;
constexpr size_t WS_VB    = WS_KB + (size_t)NB * 2 * SKV * 128 * 2;
constexpr size_t WS_XIN   = WS_VB + (size_t)NB * 2 * SKV * 128 * 2;
constexpr size_t WS_HID   = WS_XIN + (size_t)NTILE * 256 * D * 2;
constexpr size_t WS_YEXP  = WS_HID + (size_t)NTILE * 256 * D * 2;
constexpr size_t WS_END   = WS_YEXP + (size_t)NTILE * 256 * D * 2;

constexpr int RING_BYTES = 131072, MISC_OFF = RING_BYTES, LDS_BYTES = RING_BYTES + 1024;

__device__ __forceinline__ unsigned cvt_pk_bf16(float lo, float hi) { unsigned r; asm volatile("v_cvt_pk_bf16_f32 %0, %1, %2" : "=v"(r) : "v"(lo), "v"(hi)); return r; }
__device__ __forceinline__ float bf_lo(unsigned u) { return __uint_as_float(u << 16); }
__device__ __forceinline__ float bf_hi(unsigned u) { return __uint_as_float(u & 0xffff0000u); }
__device__ __forceinline__ float bf2f(bf16_t b) { return __uint_as_float(((unsigned)b) << 16); }
__device__ __forceinline__ bf16_t f2bf(float f) { return (bf16_t)(cvt_pk_bf16(f, 0.f) & 0xffffu); }
template <int K> __device__ __forceinline__ float swz_xor(float v) { return __int_as_float(__builtin_amdgcn_ds_swizzle(__float_as_int(v), 0x1F | (K << 10))); }
__device__ __forceinline__ float half_sum(float v) { v += swz_xor<1>(v); v += swz_xor<2>(v); v += swz_xor<4>(v); v += swz_xor<8>(v); v += swz_xor<16>(v); return v; }
__device__ __forceinline__ float half_max(float v) { v = fmaxf(v, swz_xor<1>(v)); v = fmaxf(v, swz_xor<2>(v)); v = fmaxf(v, swz_xor<4>(v)); v = fmaxf(v, swz_xor<8>(v)); v = fmaxf(v, swz_xor<16>(v)); return v; }
__device__ __forceinline__ float wave_sum(float v) { v = half_sum(v); auto rr = __builtin_amdgcn_permlane32_swap(__float_as_uint(v), __float_as_uint(v), false, false); return __uint_as_float(rr[0]) + __uint_as_float(rr[1]); }
__device__ __forceinline__ float wave_max(float v) { v = half_max(v); auto rr = __builtin_amdgcn_permlane32_swap(__float_as_uint(v), __float_as_uint(v), false, false); return fmaxf(__uint_as_float(rr[0]), __uint_as_float(rr[1])); }
__device__ __forceinline__ float xor32(float v, bool hi) { auto rr = __builtin_amdgcn_permlane32_swap(__float_as_uint(v), __float_as_uint(v), false, false); return __uint_as_float(hi ? rr[0] : rr[1]); }
__device__ __forceinline__ int opaque_tid() { int t = threadIdx.x; asm volatile("" : "+v"(t)); return t; }
__device__ __forceinline__ float silu_f(float x) { return x / (1.f + __expf(-x)); }
__device__ __forceinline__ float gelu_tanh_f(float x) {
    const float z = 0.7978845608028654f * (x + 0.044715f * x * x * x);
    return x / (1.f + __expf(-2.f * z));
}
#define LDS_WAIT() asm volatile("s_waitcnt lgkmcnt(0)" ::: "memory")

#define XB_TMO      128
#define XB_XCNT(j)  (256  + 64 * (j))
#define XB_XSUB(j)  (1280 + 64 * (j))
#define XB_XGEN(j)  (2304 + 64 * (j))
#define XB_TOP      3328
#define XB_TOPGEN   3392
#define XCD_BAR_WORDS 3456
#define XB_SPIN_CAP (1u << 22)
__device__ __forceinline__ unsigned xb_ld(unsigned* p)              { return __hip_atomic_load(p, __ATOMIC_RELAXED, __HIP_MEMORY_SCOPE_AGENT); }
__device__ __forceinline__ unsigned xb_add(unsigned* p, unsigned v) { return __hip_atomic_fetch_add(p, v, __ATOMIC_RELAXED, __HIP_MEMORY_SCOPE_AGENT); }
__device__ __forceinline__ unsigned xb_xcc_id() { return (unsigned)__builtin_amdgcn_s_getreg((3 << 11) | 20) & 0xFu; }
#define XB_SPIN(cond, bar) do { unsigned _sp = 0; while (cond) { __builtin_amdgcn_s_sleep(1); \
    if ((++_sp & 255u) == 0u) { if (xb_ld(&(bar)[XB_TMO])) break; if (_sp > XB_SPIN_CAP) { atomicAdd(&(bar)[XB_TMO], 1u); break; } } } } while (0)
struct XcdBarrier { unsigned* bar; unsigned x; volatile LAS unsigned* st; };
__device__ __forceinline__ XcdBarrier xcd_barrier_post(unsigned* bar, volatile LAS unsigned* st) {
    XcdBarrier b; b.bar = bar; b.x = xb_xcc_id(); b.st = st;
    if (threadIdx.x == 0) (void)xb_add(&bar[XB_XCNT(b.x)], 1u);
    return b;
}
__device__ __forceinline__ void xcd_barrier_complete(unsigned* bar, unsigned x, unsigned& nloc, unsigned& nx) {
    const unsigned G = gridDim.x * gridDim.y * gridDim.z;
    unsigned sum, cnt, mine, sp = 0u;
    for (;;) {
        sum = 0u; cnt = 0u; mine = 0u;
#pragma unroll
        for (unsigned j = 0; j < 16; ++j) { const unsigned c = xb_ld(&bar[XB_XCNT(j)]); sum += c; cnt += (c > 0u) ? 1u : 0u; }
        mine = xb_ld(&bar[XB_XCNT(x)]);
        if (sum == G) break;
        __builtin_amdgcn_s_sleep(1);
        if ((++sp & 255u) == 0u) { if (xb_ld(&bar[XB_TMO])) break; if (sp > XB_SPIN_CAP) { atomicAdd(&bar[XB_TMO], 1u); break; } }
    }
    nloc = mine > 0u ? mine : 1u; nx = cnt > 0u ? cnt : 1u;
}
__device__ __forceinline__ void xcd_barrier(const XcdBarrier& b) {
    asm volatile("s_waitcnt vmcnt(0)" ::: "memory");
    __syncthreads();
    if (threadIdx.x == 0) {
        unsigned* bar = b.bar;
        __builtin_amdgcn_s_waitcnt(0);
        unsigned nloc = b.st[0], nx = b.st[1];
        if (nloc == 0u) { xcd_barrier_complete(bar, b.x, nloc, nx); b.st[0] = nloc; b.st[1] = nx; }
        const unsigned old = xb_add(&bar[XB_XSUB(b.x)], 1u);
        const unsigned gen = old / nloc;
        if (old + 1u == (gen + 1u) * nloc) {
            __builtin_amdgcn_fence(__ATOMIC_RELEASE, "agent");
            asm volatile("s_waitcnt vmcnt(0)" ::: "memory");
            const unsigned og = xb_add(&bar[XB_TOP], 1u);
            const unsigned tg = og / nx;
            if (og + 1u == (tg + 1u) * nx) xb_add(&bar[XB_TOPGEN], 1u);
            else XB_SPIN(xb_ld(&bar[XB_TOPGEN]) == tg, bar);
            __builtin_amdgcn_fence(__ATOMIC_ACQUIRE, "agent");
            xb_add(&bar[XB_XGEN(b.x)], 1u);
            asm volatile("s_waitcnt vmcnt(0)" ::: "memory");
        } else {
            XB_SPIN(xb_ld(&bar[XB_XGEN(b.x)]) == gen, bar);
            __builtin_amdgcn_fence(__ATOMIC_ACQUIRE, "agent");
            asm volatile("s_waitcnt vmcnt(0)" ::: "memory");
        }
    }
    __syncthreads();
}

namespace pg8 {
constexpr int BM = 256, BK = 64, HALF = 128, HTB = HALF * BK * 2, NXCD = 8, WGM = 8;
__host__ __device__ __forceinline__ int lds_byte(int r, int c) { const int st = (r >> 4) * 2 + (c >> 5), rr = r & 15, cc = c & 31, ob = rr * 64 + cc * 2; return st * 1024 + (ob ^ (((ob >> 9) & 1) << 5)); }
__host__ __device__ __forceinline__ void stage_rc(int b, int& R, int& C) { const int st = b / 1024, sb = b % 1024, swz = sb ^ (((sb >> 9) & 1) << 5); R = (st >> 1) * 16 + swz / 64; C = (st & 1) * 32 + (swz % 64) / 2; }
__host__ __device__ __forceinline__ int perm32(int rho) { const int n = rho >> 4, i = rho & 15; return 8 * (i >> 2) + 4 * n + (i & 3); }
struct Unit { int pm, pn; };

template <class Epi, class Sched>
__device__ __forceinline__ void gemm_phase(LAS unsigned char* lds, const int K, const int lda, const int ldb, const Sched& S, const Epi& E) {
    const int tid = opaque_tid(), wid = __builtin_amdgcn_readfirstlane(tid >> 6), lane = tid & 63, wr = wid >> 2, wc = wid & 3, fr = lane & 15, fq = lane >> 4;
    const int nt = K / BK;
    unsigned voffA[2], voffB[2];
#pragma unroll
    for (int i = 0; i < 2; ++i) { int R, C; stage_rc(tid * 16 + i * 8192, R, C); const int Rb = Epi::PERM ? ((R & ~31) + perm32(R & 31)) : R;
        voffA[i] = (unsigned)(R * lda + C) * 2u; voffB[i] = (unsigned)(Rb * ldb + C) * 2u; }
    const size_t kstep = (size_t)(BK * 2);
    const size_t hstepA = (size_t)HALF * lda * 2, hstepB = (size_t)HALF * ldb * 2;
    const unsigned ldsw = (unsigned)wid * 1024u;
    const int aoff = lds_byte(wr * 64 + fr, fq * 8), boff = lds_byte(wc * 32 + fr, fq * 8);
#define PG8_SA(b, h) (((b) * 2 + (h)) * HTB)
#define PG8_SB(b, h) ((4 + (b) * 2 + (h)) * HTB)
#define PG8_STAGE(bufoff, gbase, voff) do { _Pragma("unroll") for (int _i = 0; _i < 2; ++_i) \
        __builtin_amdgcn_global_load_lds((const unsigned*)((const char*)(gbase) + (voff)[_i]), (LAS unsigned*)(lds + (bufoff) + ldsw + _i * 8192), 16, 0, 0); } while (0)
#define PG8_LDA(dst, b, h) do { _Pragma("unroll") for (int m = 0; m < 4; ++m) _Pragma("unroll") for (int k = 0; k < 2; ++k) dst[m][k] = *(const LAS bf16x8*)(lds + PG8_SA(b, h) + aoff + m * 2048 + k * 1024); } while (0)
#define PG8_LDB(dst, b, h) do { _Pragma("unroll") for (int n = 0; n < 2; ++n) _Pragma("unroll") for (int k = 0; k < 2; ++k) dst[n][k] = *(const LAS bf16x8*)(lds + PG8_SB(b, h) + boff + n * 2048 + k * 1024); } while (0)
#define PG8_MMA(ai, bj, At, Bt) do { __builtin_amdgcn_s_setprio(1); _Pragma("unroll") for (int m = 0; m < 4; ++m) _Pragma("unroll") for (int n = 0; n < 2; ++n) _Pragma("unroll") for (int k = 0; k < 2; ++k) \
        acc[ai][bj][m][n] = __builtin_amdgcn_mfma_f32_16x16x32_bf16(Bt[n][k], At[m][k], acc[ai][bj][m][n], 0, 0, 0); __builtin_amdgcn_s_setprio(0); } while (0)
#define PG8_WAIT_V(n) asm volatile("s_waitcnt vmcnt(" #n ")" ::: "memory")
#define PG8_WAIT_L(n) asm volatile("s_waitcnt lgkmcnt(" #n ")" ::: "memory")
#define PG8_BAR __builtin_amdgcn_s_barrier()
#define PG8_SCHED __builtin_amdgcn_sched_barrier(0)
    Unit cur, nxt; int ui = 0;
    if (!S.next(0, cur)) return;
    f32x4 acc[2][2][4][2];
#pragma unroll
    for (int a = 0; a < 2; ++a)
#pragma unroll
        for (int b = 0; b < 2; ++b)
#pragma unroll
            for (int m = 0; m < 4; ++m)
#pragma unroll
                for (int n = 0; n < 2; ++n) acc[a][b][m][n] = (f32x4){0.f, 0.f, 0.f, 0.f};
    bf16x8 At[4][2], B0[2][2], B1[2][2];
    const char* cA = S.aptr(cur); const char* cB = S.bptr(cur);
    PG8_STAGE(PG8_SB(0, 0), cB, voffB); PG8_STAGE(PG8_SB(0, 1), cB + hstepB, voffB); PG8_STAGE(PG8_SA(0, 0), cA, voffA); PG8_STAGE(PG8_SA(0, 1), cA + hstepA, voffA);
    if (wr == 1) PG8_BAR;
    PG8_WAIT_V(2); PG8_BAR;
    PG8_STAGE(PG8_SB(1, 0), cB + kstep, voffB); PG8_STAGE(PG8_SA(1, 0), cA + kstep, voffA); PG8_STAGE(PG8_SB(1, 1), cB + hstepB + kstep, voffB);
    PG8_WAIT_V(6); PG8_BAR;
    for (;;) {
        const bool has_next = S.next(ui + 1, nxt);
        const char* nA = has_next ? S.aptr(nxt) : cA; const char* nB = has_next ? S.bptr(nxt) : cB;
        for (int t = 0; t < nt; t += 2) {
            const bool last = (t == nt - 2);
            const char* a1 = cA + (size_t)(t + 1) * kstep;
            const char* a2 = last ? nA : cA + (size_t)(t + 2) * kstep; const char* b2 = last ? nB : cB + (size_t)(t + 2) * kstep;
            const char* a3 = a2 + kstep; const char* b3 = b2 + kstep;
            PG8_LDB(B0, 0, 0); PG8_LDB(B1, 0, 1); PG8_SCHED; PG8_LDA(At, 0, 0); PG8_STAGE(PG8_SA(1, 1), a1 + hstepA, voffA);
            PG8_WAIT_V(8); PG8_WAIT_L(0); PG8_BAR; PG8_MMA(0, 0, At, B0); PG8_MMA(0, 1, At, B1); PG8_BAR; PG8_SCHED;
            PG8_LDA(At, 0, 1); PG8_STAGE(PG8_SB(0, 0), b2, voffB); PG8_STAGE(PG8_SB(0, 1), b2 + hstepB, voffB); PG8_STAGE(PG8_SA(0, 0), a2, voffA);
            PG8_WAIT_V(8); PG8_WAIT_L(0); PG8_BAR; PG8_MMA(1, 0, At, B0); PG8_MMA(1, 1, At, B1); PG8_BAR; PG8_SCHED;
            PG8_LDB(B0, 1, 0); PG8_LDB(B1, 1, 1); PG8_SCHED; PG8_LDA(At, 1, 0); PG8_STAGE(PG8_SA(0, 1), a2 + hstepA, voffA);
            PG8_WAIT_V(8); PG8_WAIT_L(0); PG8_BAR; PG8_MMA(0, 0, At, B0); PG8_MMA(0, 1, At, B1); PG8_BAR; PG8_SCHED;
            PG8_LDA(At, 1, 1); PG8_STAGE(PG8_SB(1, 0), b3, voffB); PG8_STAGE(PG8_SB(1, 1), b3 + hstepB, voffB); PG8_STAGE(PG8_SA(1, 0), a3, voffA);
            PG8_WAIT_V(8); PG8_WAIT_L(0); PG8_BAR; PG8_MMA(1, 0, At, B0); PG8_MMA(1, 1, At, B1); PG8_BAR; PG8_SCHED;
        }
        if (wr == 0) PG8_BAR;
        E(acc, cur, wr, wc, fr, fq);
        if (!has_next) break;
#pragma unroll
        for (int a = 0; a < 2; ++a)
#pragma unroll
            for (int b = 0; b < 2; ++b)
#pragma unroll
                for (int m = 0; m < 4; ++m)
#pragma unroll
                    for (int n = 0; n < 2; ++n) acc[a][b][m][n] = (f32x4){0.f, 0.f, 0.f, 0.f};
        cur = nxt; cA = nA; cB = nB; ++ui;
        if (wr == 1) PG8_BAR;
    }
    PG8_WAIT_V(0);
    PG8_BAR;
#undef PG8_SA
#undef PG8_SB
#undef PG8_STAGE
#undef PG8_LDA
#undef PG8_LDB
#undef PG8_MMA
#undef PG8_WAIT_V
#undef PG8_WAIT_L
#undef PG8_BAR
#undef PG8_SCHED
}

struct SchedDense {
    const bf16_t* A; const bf16_t* Bt; int a_pm_stride, a_pn_stride, b_pn_stride;
    int nM, nN, nwg, extra, G, c;
    __device__ __forceinline__ bool next(int i, Unit& u) const {
        const int L = i * G + c; if (L >= nwg + extra) return false;
        if (L >= nwg) { const int x = L - nwg; u.pm = nM + (x >> 1); u.pn = 4 + (x & 1); return true; }
        int wgid = L; { const int q = nwg / NXCD, r = nwg % NXCD, xcd = wgid % NXCD, off = wgid / NXCD; wgid = (xcd < r ? xcd * (q + 1) : r * (q + 1) + (xcd - r) * q) + off; }
        const int nig = WGM * nN, gid = wgid / nig, fm = gid * WGM, gsz = (nM - fm) < WGM ? (nM - fm) : WGM;
        u.pm = fm + ((wgid % nig) % gsz); u.pn = (wgid % nig) / gsz; return true;
    }
    __device__ __forceinline__ const char* aptr(const Unit& u) const { return (const char*)(A + (size_t)u.pm * a_pm_stride + (size_t)u.pn * a_pn_stride); }
    __device__ __forceinline__ const char* bptr(const Unit& u) const { return (const char*)(Bt + (size_t)u.pn * b_pn_stride); }
};
struct SchedMoE {
    const bf16_t* A; const bf16_t* Bt; int nbt, nn, G, vcu;
    __device__ __forceinline__ bool next(int i, Unit& u) const {
        const int L = i * G + vcu, per_e = nbt * nn; if (L >= NE * per_e) return false;
        const int e = L / per_e, rem = L - e * per_e, bt = rem / nn, j = rem - bt * nn;
        u.pm = bt < 8 ? e * 8 + bt : 128 + e; u.pn = e * nn + j; return true;
    }
    __device__ __forceinline__ const char* aptr(const Unit& u) const { return (const char*)(A + (size_t)u.pm * 256 * D); }
    __device__ __forceinline__ const char* bptr(const Unit& u) const { return (const char*)(Bt + (size_t)u.pn * 256 * D); }
};

struct EpiA {
    static constexpr bool PERM = true;
    bf16_t* O; int ldc; int act; bf16_t* VB;
    __device__ __forceinline__ void operator()(const f32x4 (&acc)[2][2][4][2], const Unit& u, int wr, int wc, int fr, int fq) const {
        const int row0 = u.pm * BM + wr * 64 + fr, cl = wc * 32 + 8 * fq;
        const bool vtile = (VB != nullptr) && (u.pn == 5);
#pragma unroll
        for (int ai = 0; ai < 2; ++ai)
#pragma unroll
            for (int m = 0; m < 4; ++m) {
                const int r = row0 + ai * HALF + m * 16;
#pragma unroll
                for (int bj = 0; bj < 2; ++bj) {
                    f32x4 v0 = acc[ai][bj][m][0], v1 = acc[ai][bj][m][1];
                    if (act) {
#pragma unroll
                        for (int j = 0; j < 4; ++j) { v0[j] = gelu_tanh_f(v0[j]); v1[j] = gelu_tanh_f(v1[j]); } }
                    u32x4 w; w.x = cvt_pk_bf16(v0[0], v0[1]); w.y = cvt_pk_bf16(v0[2], v0[3]); w.z = cvt_pk_bf16(v1[0], v1[1]); w.w = cvt_pk_bf16(v1[2], v1[3]);
                    bf16_t* dst;
                    if (vtile) { int b, pos; if (r < T) { b = r >> 11; pos = CL + (r & (SEQ - 1)); } else { const int rc = r - T; b = rc >> 8; pos = rc & (CL - 1); }
                        dst = VB + ((size_t)(b * 2 + bj) * SKV + pos) * 128 + cl; }
                    else dst = O + (size_t)r * ldc + u.pn * BM + bj * HALF + cl;
                    *(u32x4*)dst = w; } }
    }
};
struct EpiB {
    static constexpr bool PERM = false;
    const float* xs_lat; const float* xs_ctx; float* xd_lat; float* xd_ctx; const float* gt; const float* colscale;
    __device__ __forceinline__ void operator()(const f32x4 (&acc)[2][2][4][2], const Unit& u, int wr, int wc, int fr, int fq) const {
        const int row0 = u.pm * BM + wr * 64 + fr, col0 = u.pn * BM + wc * 32 + 4 * fq;
        const bool isctx = row0 >= T;
        const int mrow = isctx ? 8 : (row0 >> 11);
        const float* xs = isctx ? xs_ctx - (size_t)T * D : xs_lat; float* xd = isctx ? xd_ctx - (size_t)T * D : xd_lat;
        f32x4 gv[2][2];
#pragma unroll
        for (int bj = 0; bj < 2; ++bj)
#pragma unroll
            for (int n = 0; n < 2; ++n) { const int c = col0 + bj * HALF + n * 16; gv[bj][n] = *(const f32x4*)(gt + (size_t)mrow * 6144 + c);
                if (colscale) gv[bj][n] = gv[bj][n] * *(const f32x4*)(colscale + c); }
#pragma unroll
        for (int ai = 0; ai < 2; ++ai)
#pragma unroll
            for (int m = 0; m < 4; ++m) { const size_t off = (size_t)(row0 + ai * HALF + m * 16) * D + col0;
#pragma unroll
                for (int bj = 0; bj < 2; ++bj)
#pragma unroll
                    for (int n = 0; n < 2; ++n) { const f32x4 xo = *(const f32x4*)(xs + off + bj * HALF + n * 16);
                        *(f32x4*)(xd + off + bj * HALF + n * 16) = xo + gv[bj][n] * acc[ai][bj][m][n]; } }
    }
};
struct EpiC {
    static constexpr bool PERM = true;
    bf16_t* HID;
    __device__ __forceinline__ void operator()(const f32x4 (&acc)[2][2][4][2], const Unit& u, int wr, int wc, int fr, int fq) const {
        const int n8 = u.pn & 7, rl = wr * 64 + fr, cl = n8 * 128 + wc * 32 + 8 * fq;
        bf16_t* base = HID + (size_t)u.pm * 256 * D;
#pragma unroll
        for (int ai = 0; ai < 2; ++ai)
#pragma unroll
            for (int m = 0; m < 4; ++m) {
                float h[8];
#pragma unroll
                for (int n = 0; n < 2; ++n)
#pragma unroll
                    for (int j = 0; j < 4; ++j) { const float g = acc[ai][0][m][n][j], up = acc[ai][1][m][n][j]; h[n * 4 + j] = silu_f(g) * up; }
                u32x4 w; w.x = cvt_pk_bf16(h[0], h[1]); w.y = cvt_pk_bf16(h[2], h[3]); w.z = cvt_pk_bf16(h[4], h[5]); w.w = cvt_pk_bf16(h[6], h[7]);
                *(u32x4*)(base + (size_t)(rl + ai * HALF + m * 16) * D + cl) = w; }
    }
};
struct EpiD {
    static constexpr bool PERM = true;
    bf16_t* Y; const float* gate;
    __device__ __forceinline__ void operator()(const f32x4 (&acc)[2][2][4][2], const Unit& u, int wr, int wc, int fr, int fq) const {
        const int n4 = u.pn & 3, rl = wr * 64 + fr, cl = n4 * 256 + wc * 32 + 8 * fq;
        bf16_t* base = Y + (size_t)u.pm * 256 * D; const float* gp = gate + (size_t)u.pm * 256;
#pragma unroll
        for (int ai = 0; ai < 2; ++ai)
#pragma unroll
            for (int m = 0; m < 4; ++m) { const int r = rl + ai * HALF + m * 16; const float g = gp[r];
#pragma unroll
                for (int bj = 0; bj < 2; ++bj) { const f32x4 v0 = acc[ai][bj][m][0] * g, v1 = acc[ai][bj][m][1] * g;
                    u32x4 w; w.x = cvt_pk_bf16(v0[0], v0[1]); w.y = cvt_pk_bf16(v0[2], v0[3]); w.z = cvt_pk_bf16(v1[0], v1[1]); w.w = cvt_pk_bf16(v1[2], v1[3]);
                    *(u32x4*)(base + (size_t)r * D + bj * HALF + cl) = w; } }
    }
};
}

namespace att {
constexpr int QBLK = 32, KVBLK = 64;
constexpr float SCALE = 0.088388347648318440f;
constexpr float THR = 8.f;
constexpr int SHM_V = KVBLK * 128 * 2, SHM_K = KVBLK * 128 * 2;
#define KSWZ(row, colB) ((row) * 256 + ((colB) ^ (((row) & 7) << 4)))
#define SBAR() __builtin_amdgcn_sched_barrier(0)
__device__ __forceinline__ int crow(int r, int hi) { return (r & 3) + 8 * (r >> 2) + 4 * hi; }
__device__ __forceinline__ void partialSM(f32x16& p0, f32x16& p1, float& m_reg, float& mn, float& alpha) {
    constexpr float C = SCALE * 1.4426950408889634f;
    float pmax = p0[0];
#pragma unroll
    for (int r = 1; r < 16; ++r) pmax = fmaxf(pmax, p0[r]);
#pragma unroll
    for (int r = 0; r < 16; ++r) pmax = fmaxf(pmax, p1[r]);
    { auto rr = __builtin_amdgcn_permlane32_swap(__float_as_uint(pmax), __float_as_uint(pmax), false, false);
      pmax = fmaxf(__uint_as_float(rr[0]), __uint_as_float(rr[1])); }
    if (__builtin_expect(__all(pmax - m_reg <= THR / SCALE), 1)) { mn = m_reg; alpha = 1.f; }
    else { mn = fmaxf(m_reg, pmax); alpha = __builtin_amdgcn_exp2f((m_reg - mn) * C); m_reg = mn; }
    float mnC = -mn * C;
#pragma unroll
    for (int r = 0; r < 16; ++r) p0[r] = fmaf(p0[r], C, mnC);
#pragma unroll
    for (int r = 0; r < 16; ++r) p1[r] = fmaf(p1[r], C, mnC);
#pragma unroll
    for (int r = 0; r < 16; ++r) p0[r] = __builtin_amdgcn_exp2f(p0[r]);
}
__device__ __forceinline__ void finishSM(f32x16& p0, f32x16& p1, float alpha, float& l_reg, bf16x8& pa0, bf16x8& pa1, bf16x8& pa2, bf16x8& pa3) {
#pragma unroll
    for (int r = 0; r < 16; ++r) p1[r] = __builtin_amdgcn_exp2f(p1[r]);
    float ps = 0;
#pragma unroll
    for (int r = 0; r < 16; ++r) ps += p0[r];
#pragma unroll
    for (int r = 0; r < 16; ++r) ps += p1[r];
    { auto rr = __builtin_amdgcn_permlane32_swap(__float_as_uint(ps), __float_as_uint(ps), false, false);
      ps = __uint_as_float(rr[0]) + __uint_as_float(rr[1]); }
    l_reg = l_reg * alpha + ps;
#define PK4(P, BASE, OUT) do { unsigned a0 = cvt_pk_bf16(P[BASE + 0], P[BASE + 1]), a1 = cvt_pk_bf16(P[BASE + 2], P[BASE + 3]);   \
    unsigned b0 = cvt_pk_bf16(P[BASE + 4], P[BASE + 5]), b1 = cvt_pk_bf16(P[BASE + 6], P[BASE + 7]);                              \
    auto r0 = __builtin_amdgcn_permlane32_swap(a0, b0, false, false); auto r1 = __builtin_amdgcn_permlane32_swap(a1, b1, false, false); \
    u32x4 w = {r0[0], r1[0], r0[1], r1[1]}; OUT = *reinterpret_cast<bf16x8*>(&w); } while (0)
    PK4(p0, 0, pa0); PK4(p0, 8, pa1); PK4(p1, 0, pa2); PK4(p1, 8, pa3);
#undef PK4
}
__device__ __forceinline__ void qkt(f32x16& p0, f32x16& p1, const LAS unsigned char* Ks, const bf16x8* qr, int r32, int hi) {
    p0 = f32x16{}; p1 = f32x16{};
#pragma unroll
    for (int d0 = 0; d0 < 8; ++d0) { int cb = (d0 * 16 + hi * 8) * 2;
        bf16x8 b0 = *reinterpret_cast<const LAS bf16x8*>(Ks + KSWZ(r32, cb));
        bf16x8 b1 = *reinterpret_cast<const LAS bf16x8*>(Ks + KSWZ(32 + r32, cb));
        p0 = __builtin_amdgcn_mfma_f32_32x32x16_bf16(b0, qr[d0], p0, 0, 0, 0);
        p1 = __builtin_amdgcn_mfma_f32_32x32x16_bf16(b1, qr[d0], p1, 0, 0, 0); }
}
__device__ __forceinline__ int v_st(int k, int c) { const int kk = (k & ~0xC) | ((k & 4) << 1) | ((k & 8) >> 1); return ((kk >> 3) * 4 + (c >> 5)) * 512 + ((kk & 7) * 32 + (c & 31)) * 2; }
__device__ __forceinline__ int v_rd_base(int lane) { return ((lane & 3) << 3) | (((lane >> 2) & 3) << 6) | (((lane >> 4) & 1) << 5) | (((lane >> 5) & 1) << 8); }
constexpr int v_rd_off(int d0, int ks, int half) { return d0 * 512 + ks * 4096 + half * 2048; }
template <int OFF> __device__ __forceinline__ s16x4 tr_read(int vb) {
    s16x4 r; asm volatile("ds_read_b64_tr_b16 %0, %1 offset:%2" : "=&v"(r) : "v"(vb), "i"(OFF) : "memory"); return r;
}
template <int D0> __device__ __forceinline__ void pv_one(f32x16& od, int vb, bf16x8 pa0, bf16x8 pa1, bf16x8 pa2, bf16x8 pa3) {
    const s16x4 l0 = tr_read<v_rd_off(D0, 0, 0)>(vb), h0 = tr_read<v_rd_off(D0, 0, 1)>(vb), l1 = tr_read<v_rd_off(D0, 1, 0)>(vb), h1 = tr_read<v_rd_off(D0, 1, 1)>(vb);
    const s16x4 l2 = tr_read<v_rd_off(D0, 2, 0)>(vb), h2 = tr_read<v_rd_off(D0, 2, 1)>(vb), l3 = tr_read<v_rd_off(D0, 3, 0)>(vb), h3 = tr_read<v_rd_off(D0, 3, 1)>(vb);
    asm volatile("s_waitcnt lgkmcnt(0)" ::: "memory"); SBAR();
#define PK(L, H) (bf16x8){L[0], L[1], L[2], L[3], H[0], H[1], H[2], H[3]}
    od = __builtin_amdgcn_mfma_f32_32x32x16_bf16(pa0, PK(l0, h0), od, 0, 0, 0);
    od = __builtin_amdgcn_mfma_f32_32x32x16_bf16(pa1, PK(l1, h1), od, 0, 0, 0);
    od = __builtin_amdgcn_mfma_f32_32x32x16_bf16(pa2, PK(l2, h2), od, 0, 0, 0);
    od = __builtin_amdgcn_mfma_f32_32x32x16_bf16(pa3, PK(l3, h3), od, 0, 0, 0);
#undef PK
}
__device__ __forceinline__ void pv_d0(f32x16* o, int vb, bf16x8 pa0, bf16x8 pa1, bf16x8 pa2, bf16x8 pa3) {
    pv_one<0>(o[0], vb, pa0, pa1, pa2, pa3); pv_one<1>(o[1], vb, pa0, pa1, pa2, pa3); pv_one<2>(o[2], vb, pa0, pa1, pa2, pa3); pv_one<3>(o[3], vb, pa0, pa1, pa2, pa3);
}
template <int LDQ, int LDO>
__device__ __forceinline__ void attn_body(const bf16_t* __restrict__ Qb, const bf16_t* __restrict__ Kh, const bf16_t* __restrict__ Vh, bf16_t* __restrict__ Ob, int seq, LAS unsigned char* lds) {
    constexpr int LDK = 128;
    const int tid = opaque_tid(), wid = tid >> 6, lane = tid & 63, r32 = lane & 31, hi = lane >> 5;
    LAS unsigned char* V_lds = lds; LAS unsigned char* K_lds = lds + 2 * SHM_V;
    LAS float* ws = (LAS float*)(lds + 2 * SHM_V + 2 * SHM_K) + wid * 64; LAS float* li_l = ws; LAS float* al_l = ws + 32;
    float m_reg = -1e30f, l_reg = 0; f32x16 o[4] = {}; bf16x8 qr[8];
    const bf16_t* Qw = Qb + (long)(wid * QBLK + r32) * LDQ + hi * 8;
#pragma unroll
    for (int d0 = 0; d0 < 8; ++d0) qr[d0] = *reinterpret_cast<const bf16x8*>(Qw + d0 * 16);
    const int sr = tid >> 4, sc = (tid & 15) * 8, vst0 = v_st(sr, sc), vst1 = v_st(32 + sr, sc);
    const int vb0 = (int)(unsigned)(uintptr_t)V_lds + v_rd_base(lane);
    struct { bf16x8 vs0, vs1, ks0, ks1; } sr_[2];
#define SLOAD(i, k0) do { sr_[i].vs0 = *reinterpret_cast<const bf16x8*>(&Vh[(long)((k0) + sr) * LDK + sc]); sr_[i].vs1 = *reinterpret_cast<const bf16x8*>(&Vh[(long)((k0) + 32 + sr) * LDK + sc]); \
    sr_[i].ks0 = *reinterpret_cast<const bf16x8*>(&Kh[(long)((k0) + sr) * LDK + sc]); sr_[i].ks1 = *reinterpret_cast<const bf16x8*>(&Kh[(long)((k0) + 32 + sr) * LDK + sc]); } while (0)
#define SWRITE(b, i) do { *(LAS bf16x8*)(V_lds + (b) * SHM_V + vst0) = sr_[i].vs0;          \
    *(LAS bf16x8*)(V_lds + (b) * SHM_V + vst1) = sr_[i].vs1; int kc = sc * 2;               \
    *(LAS bf16x8*)(K_lds + (b) * SHM_K + KSWZ(sr, kc)) = sr_[i].ks0;                       \
    *(LAS bf16x8*)(K_lds + (b) * SHM_K + KSWZ(32 + sr, kc)) = sr_[i].ks1; } while (0)
#define SWAIT() asm volatile("s_waitcnt vmcnt(4)" ::: "memory")
#define RESC(a) do { if (__any((a) < 1.f)) { if (hi == 0) al_l[r32] = (a); asm volatile("s_waitcnt lgkmcnt(0)" ::: "memory"); \
    for (int d = 0; d < 4; ++d) for (int r = 0; r < 16; ++r) o[d][r] *= al_l[crow(r, hi)]; } } while (0)
    f32x16 pA0, pA1, pB0, pB1; float mnA, mnB, alA, alB; bf16x8 pa0, pa1, pa2, pa3; const int NT = seq / KVBLK;
    constexpr int SE = 0, SO = 1;
    SLOAD(SE, 0); asm volatile("s_waitcnt vmcnt(0)" ::: "memory"); SWRITE(0, SE); __syncthreads();
    qkt(pA0, pA1, K_lds, qr, r32, hi); partialSM(pA0, pA1, m_reg, mnA, alA);
    SLOAD(SO, KVBLK); if (2 < NT) SLOAD(SE, 2 * KVBLK);
    SWAIT(); SWRITE(1, SO); __syncthreads();
    for (int j = 1; j + 1 < NT; j += 2) {
        SBAR(); qkt(pB0, pB1, K_lds + SHM_K, qr, r32, hi);
        finishSM(pA0, pA1, alA, l_reg, pa0, pa1, pa2, pa3); SBAR();
        SLOAD(SO, (j + 2) * KVBLK); SBAR();
        pv_d0(o, vb0, pa0, pa1, pa2, pa3); partialSM(pB0, pB1, m_reg, mnB, alB);
        __syncthreads(); SWAIT(); SWRITE(0, SE);
        RESC(alB); __syncthreads();
        SBAR(); qkt(pA0, pA1, K_lds, qr, r32, hi);
        finishSM(pB0, pB1, alB, l_reg, pa0, pa1, pa2, pa3); SBAR();
        if (j + 3 < NT) SLOAD(SE, (j + 3) * KVBLK); SBAR();
        pv_d0(o, vb0 + (int)SHM_V, pa0, pa1, pa2, pa3); partialSM(pA0, pA1, m_reg, mnA, alA);
        __syncthreads(); SWAIT(); SWRITE(1, SO);
        RESC(alA); __syncthreads();
    }
    SBAR(); qkt(pB0, pB1, K_lds + SHM_K, qr, r32, hi);
    finishSM(pA0, pA1, alA, l_reg, pa0, pa1, pa2, pa3); SBAR();
    pv_d0(o, vb0, pa0, pa1, pa2, pa3); partialSM(pB0, pB1, m_reg, mnB, alB);
    __syncthreads(); RESC(alB);
    finishSM(pB0, pB1, alB, l_reg, pa0, pa1, pa2, pa3); SBAR();
    pv_d0(o, vb0 + (int)SHM_V, pa0, pa1, pa2, pa3);
    if (hi == 0) li_l[r32] = l_reg; asm volatile("s_waitcnt lgkmcnt(0)" ::: "memory");
    float rli[16];
#pragma unroll
    for (int r = 0; r < 16; ++r) rli[r] = __builtin_amdgcn_rcpf(li_l[crow(r, hi)]);
    bf16_t* Ow = Ob + (long)(wid * QBLK) * LDO;
#pragma unroll
    for (int r = 0; r < 16; ++r) { int orow = crow(r, hi);
#pragma unroll
        for (int d0 = 0; d0 < 4; ++d0) Ow[(long)orow * LDO + d0 * 32 + r32] = f2bf(o[d0][r] * rli[r]); }
#undef SLOAD
#undef SWRITE
#undef SWAIT
#undef RESC
}
}

struct KArgs { const float* in[24]; float* out; unsigned char* ws; int ph_lo, ph_hi; };
enum { I_X = 0, I_C, I_CTX, I_CCTX, I_MODW, I_MODB, I_N1G, I_N2G, I_RW, I_WG, I_WU, I_WD, I_GWIN, I_GVG, I_GSW, I_GSB, I_GWOUT, I_AWIN, I_AQG, I_AKG, I_AWOUT, I_PWIN, I_PWG, I_PSC };

struct Fr {
    volatile LAS unsigned long long* PT;
    int G, bx, vcu;
    __device__ __forceinline__ unsigned long long ldp(int i) const { const unsigned long long v = PT[i];
        const unsigned lo = __builtin_amdgcn_readfirstlane((unsigned)v), hi = __builtin_amdgcn_readfirstlane((unsigned)(v >> 32)); return ((unsigned long long)hi << 32) | lo; }
    __device__ __forceinline__ const float* in(int i) const { return (const float*)(GAS const float*)ldp(i); }
    __device__ __forceinline__ float* out() const { return (float*)(GAS float*)ldp(24); }
    __device__ __forceinline__ unsigned char* ws() const { return (unsigned char*)(GAS unsigned char*)ldp(25); }
};
#define WSP(F, T_, OFF) ((T_*)((F).ws() + (OFF)))

__device__ __forceinline__ void tr_item(const float* W, int N, int k0, int n0, bf16_t* dst, int ldt, LAS float* scr, int lane) {
#pragma unroll 8
    for (int i = 0; i < 32; ++i) { const int kk = 2 * i + (lane >> 5); scr[kk * 33 + (lane & 31)] = W[(size_t)(k0 + kk) * N + n0 + (lane & 31)]; }
    LDS_WAIT(); asm volatile("" ::: "memory");
    const int c = lane & 7;
#pragma unroll
    for (int j = 0; j < 4; ++j) { const int n = (lane >> 3) + 8 * j; const LAS float* s = scr + (8 * c) * 33 + n;
        u32x4 o; o.x = cvt_pk_bf16(s[0 * 33], s[1 * 33]); o.y = cvt_pk_bf16(s[2 * 33], s[3 * 33]); o.z = cvt_pk_bf16(s[4 * 33], s[5 * 33]); o.w = cvt_pk_bf16(s[6 * 33], s[7 * 33]);
        *(u32x4*)(dst + (size_t)n * ldt + k0 + 8 * c) = o; }
    LDS_WAIT(); asm volatile("" ::: "memory");
}

__device__ __forceinline__ void p0_phase(const Fr& F, LAS unsigned char* lds) {
    const int tid = opaque_tid(), lane = tid & 63, wave = __builtin_amdgcn_readfirstlane(tid >> 6), gw = F.bx * NWAVES + wave, NGW = F.G * NWAVES; (void)gw; (void)NGW; (void)lane; (void)wave;
    unsigned char* const ws_ = F.ws();
    float* const modv_ = (float*)(ws_ + WS_MODV);
    bf16_t* const wsw_ = (bf16_t*)(ws_ + WS_WSW);
    bf16_t* const wgin_ = (bf16_t*)(ws_ + WS_WGIN);
    bf16_t* const wgout_ = (bf16_t*)(ws_ + WS_WGOUT);
    bf16_t* const wain_ = (bf16_t*)(ws_ + WS_WAIN);
    bf16_t* const waout_ = (bf16_t*)(ws_ + WS_WAOUT);
    bf16_t* const wpin_ = (bf16_t*)(ws_ + WS_WPIN);
    bf16_t* const wpgrp_ = (bf16_t*)(ws_ + WS_WPGRP);
    bf16_t* const wup_ = (bf16_t*)(ws_ + WS_WUP);
    bf16_t* const wdn_ = (bf16_t*)(ws_ + WS_WDN);
    const float* const in_I_AWIN = F.in(I_AWIN);
    const float* const in_I_AWOUT = F.in(I_AWOUT);
    const float* const in_I_C = F.in(I_C);
    const float* const in_I_CCTX = F.in(I_CCTX);
    const float* const in_I_GSW = F.in(I_GSW);
    const float* const in_I_GWIN = F.in(I_GWIN);
    const float* const in_I_GWOUT = F.in(I_GWOUT);
    const float* const in_I_MODB = F.in(I_MODB);
    const float* const in_I_MODW = F.in(I_MODW);
    const float* const in_I_PWG = F.in(I_PWG);
    const float* const in_I_PWIN = F.in(I_PWIN);
    const float* const in_I_WD = F.in(I_WD);
    const float* const in_I_WG = F.in(I_WG);
    const float* const in_I_WU = F.in(I_WU);

    LAS float* sact = (LAS float*)lds;
    LAS float* red = (LAS float*)(lds + 49152);
    for (int idx = tid; idx < 9 * 1024; idx += NTHR) { const int r = idx >> 10, k = idx & 1023; const float v = r < 8 ? in_I_C[r * 1024 + k] : in_I_CCTX[k]; sact[k * 12 + r] = silu_f(v); }
    __syncthreads();
    for (int chunk = F.bx; chunk < 384; chunk += F.G) {
        const int layer = chunk / 96, n = (chunk % 96) * 64 + lane, k0 = wave * 128;
        const float* wp = in_I_MODW + (size_t)layer * 1024 * 6144 + (size_t)k0 * 6144 + n;
        float acc[9];
#pragma unroll
        for (int r = 0; r < 9; ++r) acc[r] = 0.f;
#pragma unroll 8
        for (int kk = 0; kk < 128; ++kk) { const float w = wp[(size_t)kk * 6144]; const LAS float* sa = sact + (k0 + kk) * 12;
#pragma unroll
            for (int r = 0; r < 9; ++r) acc[r] += sa[r] * w; }
#pragma unroll
        for (int r = 0; r < 9; ++r) red[(wave * 9 + r) * 64 + lane] = acc[r];
        __syncthreads();
        for (int idx = tid; idx < 576; idx += NTHR) { const int r = idx >> 6, l = idx & 63; float s = 0.f;
#pragma unroll
            for (int w = 0; w < 8; ++w) s += red[(w * 9 + r) * 64 + l];
            const int nn = (chunk % 96) * 64 + l; modv_[(size_t)(layer * 9 + r) * 6144 + nn] = s + in_I_MODB[layer * 6144 + nn]; }
        __syncthreads();
    }
    __syncthreads();
    LAS float* scr = (LAS float*)(lds + wave * 16384);
    constexpr int NEXP = 4 * 16 * 3 * 512, NOTH = 1024 * 2 + 512 * 2 + 768 + 512 + 512 + 128;
    for (int it = gw; it < NEXP + NOTH; it += NGW) {
        if (it < NEXP) {
            const int mat = it >> 9, sub = it & 511, l = mat / 48, rem = mat % 48, e = rem / 3, which = rem % 3, k0 = (sub >> 5) * 64, n0 = (sub & 31) * 32;
            if (which < 2) { const float* W = (which == 0 ? in_I_WG : in_I_WU) + (size_t)(l * 16 + e) * 1024 * 1024;
                bf16_t* dst = wup_ + (size_t)l * 16 * 2048 * 1024 + (size_t)((e * 8 + (n0 >> 7)) * 256 + which * 128 + (n0 & 127)) * 1024;
                tr_item(W, 1024, k0, n0, dst, 1024, scr, lane); }
            else { const float* W = in_I_WD + (size_t)(l * 16 + e) * 1024 * 1024;
                bf16_t* dst = wdn_ + (size_t)l * 16 * 1024 * 1024 + (size_t)(e * 1024 + n0) * 1024;
                tr_item(W, 1024, k0, n0, dst, 1024, scr, lane); }
        } else {
            int r = it - NEXP;
            if (r < 2048) { const int j = r >> 10, sub = r & 1023, k0 = (sub >> 6) * 64, n0 = (sub & 63) * 32;
                tr_item(in_I_GWIN + (size_t)j * 1024 * 2048, 2048, k0, n0, wgin_ + (size_t)j * 2048 * 1024 + (size_t)n0 * 1024, 1024, scr, lane); continue; } r -= 2048;
            if (r < 1024) { const int j = r >> 9, sub = r & 511, k0 = (sub >> 5) * 64, n0 = (sub & 31) * 32;
                tr_item(in_I_GWOUT + (size_t)j * 1024 * 1024, 1024, k0, n0, wgout_ + (size_t)j * 1024 * 1024 + (size_t)n0 * 1024, 1024, scr, lane); continue; } r -= 1024;
            if (r < 768) { const int k0 = (r / 48) * 64, n0 = (r % 48) * 32;
                tr_item(in_I_AWIN, 1536, k0, n0, wain_ + (size_t)n0 * 1024, 1024, scr, lane); continue; } r -= 768;
            if (r < 512) { const int k0 = (r >> 5) * 64, n0 = (r & 31) * 32;
                tr_item(in_I_AWOUT, 1024, k0, n0, waout_ + (size_t)n0 * 1024, 1024, scr, lane); continue; } r -= 512;
            if (r < 512) { const int k0 = (r >> 5) * 64, n0 = (r & 31) * 32;
                tr_item(in_I_PWIN, 1024, k0, n0, wpin_ + (size_t)n0 * 1024, 1024, scr, lane); continue; } r -= 512;
            { const int g = r >> 5, sub = r & 31, k0 = (sub >> 3) * 64, n0 = (sub & 7) * 32;
                tr_item(in_I_PWG + (size_t)g * 256 * 256, 256, k0, n0, wpgrp_ + (size_t)g * 256 * 256 + (size_t)n0 * 256, 256, scr, lane); }
        }
    }
    for (int i4 = F.bx * NTHR + tid; i4 < 2 * 8 * 128 * 128 / 4; i4 += F.G * NTHR) { const f32x4 v = *(const f32x4*)(in_I_GSW + (size_t)i4 * 4);
        u32x2 o; o.x = cvt_pk_bf16(v[0], v[1]); o.y = cvt_pk_bf16(v[2], v[3]); *(u32x2*)(wsw_ + (size_t)i4 * 4) = o; }
}

template <int R>
__device__ __forceinline__ void norm_rows(const int r0, const bool isctx, const int lane, const int layer, const int which, const int comb,
                                          const float* xsrc, float* xdst, const float* modv_, const float* ng, const int* slot_, const bf16_t* YEXP_, bf16_t* H_, float* aff_, int* slotw_, const LAS unsigned char* rwl) {
    const int rc0 = r0 - T; const int b = isctx ? (rc0 >> 8) : (r0 >> 11); const int mrow = isctx ? 8 : b;
    f32x4 v[R][4];
#pragma unroll
    for (int q = 0; q < R; ++q)
#pragma unroll
        for (int j = 0; j < 4; ++j) v[q][j] = *(const f32x4*)(xsrc + (size_t)q * D + lane * 4 + 256 * j);
#ifndef NO_NR_COMB
    if (comb >= 0) {
        int sl[R];
#pragma unroll
        for (int q = 0; q < R; ++q) sl[q] = slot_[(size_t)(r0 + q) * 16 + (lane & 15)];
        f32x4 a[R][4];
#pragma unroll
        for (int q = 0; q < R; ++q)
#pragma unroll
            for (int j = 0; j < 4; ++j) a[q][j] = (f32x4){0.f, 0.f, 0.f, 0.f};
#pragma nounroll
        for (int e = 0; e < 16; ++e) {
            u32x2 w[R][4];
#pragma unroll
            for (int q = 0; q < R; ++q) {
                const int s = __builtin_amdgcn_readlane(sl[q], e);
                if (s >= 0) {
                    const int tile = isctx ? 128 + e : e * 8 + b, rin = isctx ? (((rc0 + q) >> 8) * 32 + s) : s;
                    const bf16_t* yp = YEXP_ + ((size_t)tile * 256 + rin) * D + lane * 4;
#pragma unroll
                    for (int j = 0; j < 4; ++j) w[q][j] = *(const u32x2*)(yp + 256 * j);
                } else {
#pragma unroll
                    for (int j = 0; j < 4; ++j) w[q][j] = (u32x2){0u, 0u};
                }
            }
#pragma unroll
            for (int q = 0; q < R; ++q)
#pragma unroll
                for (int j = 0; j < 4; ++j) { a[q][j][0] += bf_lo(w[q][j].x); a[q][j][1] += bf_hi(w[q][j].x); a[q][j][2] += bf_lo(w[q][j].y); a[q][j][3] += bf_hi(w[q][j].y); }
        }
        const float* g2 = modv_ + (size_t)(comb * 9 + mrow) * 6144 + 5 * 1024 + lane * 4;
#pragma unroll
        for (int j = 0; j < 4; ++j) { const f32x4 gg = *(const f32x4*)(g2 + 256 * j);
#pragma unroll
            for (int q = 0; q < R; ++q) { v[q][j] = v[q][j] + gg * a[q][j]; *(f32x4*)(xdst + (size_t)q * D + lane * 4 + 256 * j) = v[q][j]; } }
    }
#endif
    if (which == 0) return;
    float rstd[R];
#pragma unroll
    for (int q = 0; q < R; ++q) { float ss = 0.f;
#pragma unroll
        for (int j = 0; j < 4; ++j) ss += (v[q][j][0] * v[q][j][0] + v[q][j][1] * v[q][j][1]) + (v[q][j][2] * v[q][j][2] + v[q][j][3] * v[q][j][3]);
        rstd[q] = ss; }
#pragma unroll
    for (int q = 0; q < R; ++q) rstd[q] = rsqrtf(wave_sum(rstd[q]) * (1.f / D) + EPS);
    const float* mv = modv_ + (size_t)(layer * 9 + mrow) * 6144 + (which == 2 ? 3 * 1024 : 0) + lane * 4;
#pragma unroll
    for (int j = 0; j < 4; ++j) { const f32x4 g = *(const f32x4*)(ng + lane * 4 + 256 * j), sh = *(const f32x4*)(mv + 256 * j), sc = *(const f32x4*)(mv + 1024 + 256 * j);
#pragma unroll
        for (int q = 0; q < R; ++q) { v[q][j] = (v[q][j] * rstd[q] * g) * (sc + 1.f) + sh;
            u32x2 o; o.x = cvt_pk_bf16(v[q][j][0], v[q][j][1]); o.y = cvt_pk_bf16(v[q][j][2], v[q][j][3]); *(u32x2*)(H_ + (size_t)(r0 + q) * D + lane * 4 + 256 * j) = o; } }
#ifndef NO_NR_ROUTER
    if (which == 2) {
#pragma unroll
        for (int q = 0; q < R; ++q) {
            float p[16];
#pragma unroll
            for (int e = 0; e < 16; ++e) p[e] = 0.f;
#pragma unroll
            for (int j = 0; j < 4; ++j)
#pragma unroll
                for (int i = 0; i < 4; ++i) { const int col = lane * 4 + 256 * j + i; const LAS unsigned char* rp = rwl + col * 64 + (col >> 2) * 16; const float hv = v[q][j][i];
#pragma unroll
                    for (int e4 = 0; e4 < 4; ++e4) { const f32x4 w = *(const LAS f32x4*)(rp + e4 * 16); p[e4 * 4 + 0] += hv * w[0]; p[e4 * 4 + 1] += hv * w[1]; p[e4 * 4 + 2] += hv * w[2]; p[e4 * 4 + 3] += hv * w[3]; } }
            const bool b5 = (lane & 32) != 0, b4 = (lane & 16) != 0, b3 = (lane & 8) != 0, b2 = (lane & 4) != 0;
            float k8[8], k4[4], k2[2];
#pragma unroll
            for (int e = 0; e < 8; ++e) { const float send = b5 ? p[e] : p[e + 8]; k8[e] = (b5 ? p[e + 8] : p[e]) + xor32(send, b5); }
#pragma unroll
            for (int e = 0; e < 4; ++e) { const float send = b4 ? k8[e] : k8[e + 4]; k4[e] = (b4 ? k8[e + 4] : k8[e]) + swz_xor<16>(send); }
#pragma unroll
            for (int e = 0; e < 2; ++e) { const float send = b3 ? k4[e] : k4[e + 2]; k2[e] = (b3 ? k4[e + 2] : k4[e]) + swz_xor<8>(send); }
            float lg; { const float send = b2 ? k2[0] : k2[1]; lg = (b2 ? k2[1] : k2[0]) + swz_xor<4>(send); }
            lg += swz_xor<2>(lg); lg += swz_xor<1>(lg);
            const float mx = wave_max(lg), ex = __expf(lg - mx), sum = wave_sum(ex) * 0.25f;
            const int eid = (lane >> 2) & 15;
            if ((lane & 3) == 0) aff_[(size_t)(r0 + q) * 16 + eid] = ex / sum;
            if (lane < 16) slotw_[(size_t)(r0 + q) * 16 + lane] = -1;
            asm volatile("" ::: "memory"); __builtin_amdgcn_sched_barrier(0);
        }
    }
#endif
}
__device__ __forceinline__ void norm_phase(const Fr& F, LAS unsigned char* lds, int layer, int which, int nrows, int comb, const float* xlat, const float* xctx, float* xlat_d, float* xctx_d) {
    const int tid = opaque_tid(), lane = tid & 63, wave = __builtin_amdgcn_readfirstlane(tid >> 6), gw = F.bx * NWAVES + wave, NGW = F.G * NWAVES;
    unsigned char* const ws_ = F.ws();
    float* const modv_ = (float*)(ws_ + WS_MODV); float* const aff_ = (float*)(ws_ + WS_AFF); int* const slot_ = (int*)(ws_ + WS_SLOT);
    bf16_t* const H_ = (bf16_t*)(ws_ + WS_H); bf16_t* const YEXP_ = (bf16_t*)(ws_ + WS_YEXP);
    LAS unsigned char* rwl = lds;
    if (which == 2) {
        const float* rw = F.in(I_RW) + (size_t)layer * 1024 * 16;
        for (int idx = tid; idx < 4096; idx += NTHR) { const int col = idx >> 2, e4 = idx & 3; *(LAS f32x4*)(rwl + col * 64 + (col >> 2) * 16 + e4 * 16) = *(const f32x4*)(rw + col * 16 + e4 * 4); }
        __syncthreads();
    }
    const float* ng = F.in(which == 2 ? I_N2G : I_N1G) + (size_t)layer * 1024;
#pragma nounroll
    for (int g4 = gw; g4 < T / 2; g4 += NGW) { const int r0 = g4 * 2;
        norm_rows<2>(r0, false, lane, layer, which, comb, xlat + (size_t)r0 * D, xlat_d + (size_t)r0 * D, modv_, ng, slot_, YEXP_, H_, aff_, slot_, rwl); }
    if (nrows > T) {
#pragma nounroll
        for (int r = T + gw; r < nrows; r += NGW)
            norm_rows<1>(r, true, lane, layer, which, comb, xctx + (size_t)(r - T) * D, xctx_d + (size_t)(r - T) * D, modv_, ng, slot_, YEXP_, H_, aff_, slot_, rwl);
    }
}

__device__ __forceinline__ void topk_phase(const Fr& F, LAS unsigned char* lds, bool with_ctx) {
    const int tid = opaque_tid();
    unsigned char* const ws_ = F.ws();
    float* const aff_ = (float*)(ws_ + WS_AFF); int* const slot_ = (int*)(ws_ + WS_SLOT); float* const gate_ = (float*)(ws_ + WS_GATE);
    bf16_t* const H_ = (bf16_t*)(ws_ + WS_H); bf16_t* const XIN_ = (bf16_t*)(ws_ + WS_XIN);
    LAS unsigned long long* key = (LAS unsigned long long*)lds;
    LAS int* sel = (LAS int*)(lds + 16384);
    const int nunits = with_ctx ? 256 : 128;
    for (int u = F.bx; u < nunits; u += F.G) {
        const bool isctx = u >= 128; const int uu = isctx ? u - 128 : u, e = uu >> 3, b = uu & 7;
        const int N = isctx ? CL : SEQ, cap = isctx ? CCAP : CAP, row0 = isctx ? T + b * CL : b * SEQ;
        for (int s = tid; s < N; s += NTHR) { const unsigned bits = __float_as_uint(aff_[(size_t)(row0 + s) * 16 + e]); key[s] = ((unsigned long long)bits << 32) | (unsigned)(N - 1 - s); }
        __syncthreads();
        for (int k = 2; k <= N; k <<= 1)
            for (int j = k >> 1; j > 0; j >>= 1) {
                for (int p = tid; p < N / 2; p += NTHR) { const int i = ((p & ~(j - 1)) << 1) | (p & (j - 1)), l = i | j;
                    const unsigned long long a = key[i], c = key[l]; const bool desc = (i & k) == 0;
                    if ((a < c) == desc) { key[i] = c; key[l] = a; } }
                __syncthreads();
            }
        const int tile = isctx ? 128 + e : uu, rbase = isctx ? b * 32 : 0;
        if (tid < cap) { const unsigned long long kk = key[tid]; const int s = N - 1 - (int)(unsigned)(kk & 0xffffffffu); sel[tid] = s;
            gate_[(size_t)tile * 256 + rbase + tid] = __uint_as_float((unsigned)(kk >> 32));
            slot_[(size_t)(row0 + s) * 16 + e] = tid; }
        __syncthreads();
        const int sub = tid >> 7, c16 = tid & 127;
#pragma nounroll
        for (int sl0 = sub; sl0 < cap; sl0 += 32) {
            u32x4 tmp[8];
#pragma unroll
            for (int k = 0; k < 8; ++k) { const int s = sel[sl0 + 4 * k]; tmp[k] = *(const u32x4*)(H_ + (size_t)(row0 + s) * D + c16 * 8); }
#pragma unroll
            for (int k = 0; k < 8; ++k) *(u32x4*)(XIN_ + ((size_t)tile * 256 + rbase + sl0 + 4 * k) * D + c16 * 8) = tmp[k];
        }
        __syncthreads();
    }
}

template <int OFF> __device__ __forceinline__ s16x4 sp_tr_read(int vb) {
    s16x4 r; asm volatile("ds_read_b64_tr_b16 %0, %1 offset:%2" : "=&v"(r) : "v"(vb), "i"(OFF) : "memory"); return r;
}
template <int KS> __device__ __forceinline__ void sp_kstep(f32x16& acc0, f32x16& acc1, const LAS bf16_t* Ap, int vb) {
    constexpr int LDB2 = 320;
    const bf16x8 a = *(const LAS bf16x8*)(Ap + KS * 16);
    const s16x4 l0 = sp_tr_read<(16 * KS) * LDB2>(vb), h0 = sp_tr_read<(16 * KS + 4) * LDB2>(vb);
    const s16x4 l1 = sp_tr_read<(16 * KS) * LDB2 + 64>(vb), h1 = sp_tr_read<(16 * KS + 4) * LDB2 + 64>(vb);
    asm volatile("s_waitcnt lgkmcnt(0)" ::: "memory"); __builtin_amdgcn_sched_barrier(0);
    const bf16x8 b0 = (bf16x8){l0[0], l0[1], l0[2], l0[3], h0[0], h0[1], h0[2], h0[3]};
    const bf16x8 b1 = (bf16x8){l1[0], l1[1], l1[2], l1[3], h1[0], h1[1], h1[2], h1[3]};
    acc0 = __builtin_amdgcn_mfma_f32_32x32x16_bf16(b0, a, acc0, 0, 0, 0);
    acc1 = __builtin_amdgcn_mfma_f32_32x32x16_bf16(b1, a, acc1, 0, 0, 0);
}
__device__ __forceinline__ void spatial_phase(const Fr& F, LAS unsigned char* lds, int j, int nunits) {
    const int tid = opaque_tid(), lane = tid & 63, wave = __builtin_amdgcn_readfirstlane(tid >> 6);
    unsigned char* const ws_ = F.ws();
    const bf16_t* const wsw_ = (const bf16_t*)(ws_ + WS_WSW); const bf16_t* const S1_ = (const bf16_t*)(ws_ + WS_S1); bf16_t* const S2_ = (bf16_t*)(ws_ + WS_S2);
    constexpr int LDA = 136, LDB = 160;
    LAS float* stat = (LAS float*)lds;
    LAS bf16_t* As = (LAS bf16_t*)(lds + 1024);
    LAS bf16_t* Bs = (LAS bf16_t*)(lds + 1024 + 128 * LDA * 2);
    const float* vg = F.in(I_GVG) + (size_t)j * 1024; const float* sb = F.in(I_GSB) + (size_t)j * 8 * 128;
    const bf16_t* sw = wsw_ + (size_t)j * 8 * 128 * 128;
    const int r32 = lane & 31, hi = lane >> 5;
    const int pw = (wave >> 1) * 32, dw = (wave & 1) * 64;
    const LAS bf16_t* Ap = As + (pw + r32) * LDA + hi * 8;
    const int vb = (int)(unsigned)(uintptr_t)Bs + (8 * hi + ((lane & 15) >> 2)) * (LDB * 2) + (dw + 16 * ((lane >> 4) & 1) + 4 * (lane & 3)) * 2;
    for (int u = F.bx; u < nunits; u += F.G) {
        const int r0 = u * 128;
#pragma nounroll
        for (int rr = wave * 16; rr < wave * 16 + 16; rr += 4) {
            u32x4 w0[4], w1[4];
#pragma unroll
            for (int q = 0; q < 4; ++q) { const bf16_t* vp = S1_ + (size_t)(r0 + rr + q) * 2048 + 1024 + lane * 8; w0[q] = *(const u32x4*)vp; w1[q] = *(const u32x4*)(vp + 512); }
            float s1[4], s2[4];
#pragma unroll
            for (int q = 0; q < 4; ++q) { float a = 0.f, c = 0.f;
#pragma unroll
                for (int i = 0; i < 4; ++i) { const float x0 = bf_lo(w0[q][i]), x1 = bf_hi(w0[q][i]), x2 = bf_lo(w1[q][i]), x3 = bf_hi(w1[q][i]); a += (x0 + x1) + (x2 + x3); c += (x0 * x0 + x1 * x1) + (x2 * x2 + x3 * x3); }
                s1[q] = a; s2[q] = c; }
#pragma unroll
            for (int q = 0; q < 4; ++q) { s1[q] = wave_sum(s1[q]); s2[q] = wave_sum(s2[q]); }
#pragma unroll
            for (int q = 0; q < 4; ++q) { const float mean = s1[q] * (1.f / 1024.f), var = fmaxf(s2[q] * (1.f / 1024.f) - mean * mean, 0.f);
                if (lane == 0) { stat[(rr + q) * 2] = mean; stat[(rr + q) * 2 + 1] = rsqrtf(var + EPS); } }
        }
        __syncthreads();
#pragma nounroll
        for (int g = 0; g < 8; ++g) {
#pragma unroll
            for (int i = 0; i < 4; ++i) { const int id = tid + NTHR * i, p = id >> 4, qc = id & 15;
                *(LAS u32x4*)(As + p * LDA + qc * 8) = *(const u32x4*)(sw + (size_t)g * 128 * 128 + p * 128 + qc * 8); }
            u32x4 wv[4];
#pragma unroll
            for (int i = 0; i < 4; ++i) { const int id = tid + NTHR * i, q = id >> 4, dc = id & 15; wv[i] = *(const u32x4*)(S1_ + (size_t)(r0 + q) * 2048 + 1024 + g * 128 + dc * 8); }
            { const int dc = tid & 15; const f32x4 g0 = *(const f32x4*)(vg + g * 128 + dc * 8), g1 = *(const f32x4*)(vg + g * 128 + dc * 8 + 4);
#pragma unroll
              for (int i = 0; i < 4; ++i) { const int id = tid + NTHR * i, q = id >> 4; const float mean = stat[q * 2], rstd = stat[q * 2 + 1];
                float x[8];
#pragma unroll
                for (int k = 0; k < 4; ++k) { x[2 * k] = (bf_lo(wv[i][k]) - mean) * rstd; x[2 * k + 1] = (bf_hi(wv[i][k]) - mean) * rstd; }
                u32x4 o; o.x = cvt_pk_bf16(x[0] * g0[0], x[1] * g0[1]); o.y = cvt_pk_bf16(x[2] * g0[2], x[3] * g0[3]); o.z = cvt_pk_bf16(x[4] * g1[0], x[5] * g1[1]); o.w = cvt_pk_bf16(x[6] * g1[2], x[7] * g1[3]);
                *(LAS u32x4*)(Bs + q * LDB + dc * 8) = o; } }
            __syncthreads();
            f32x16 acc0 = {}, acc1 = {};
            sp_kstep<0>(acc0, acc1, Ap, vb); sp_kstep<1>(acc0, acc1, Ap, vb); sp_kstep<2>(acc0, acc1, Ap, vb); sp_kstep<3>(acc0, acc1, Ap, vb);
            sp_kstep<4>(acc0, acc1, Ap, vb); sp_kstep<5>(acc0, acc1, Ap, vb); sp_kstep<6>(acc0, acc1, Ap, vb); sp_kstep<7>(acc0, acc1, Ap, vb);
            const int p = pw + r32; const float bias = sb[g * 128 + p];
            const size_t ro = (size_t)(r0 + p); const int c0 = g * 128 + dw + 4 * hi;
            u32x2 uu[2][4];
#pragma unroll
            for (int t = 0; t < 4; ++t) { uu[0][t] = *(const u32x2*)(S1_ + ro * 2048 + c0 + 8 * t); uu[1][t] = *(const u32x2*)(S1_ + ro * 2048 + c0 + 32 + 8 * t); }
#pragma unroll
            for (int t = 0; t < 4; ++t) {
                u32x2 o0, o1;
                o0.x = cvt_pk_bf16((acc0[4 * t] + bias) * bf_lo(uu[0][t].x), (acc0[4 * t + 1] + bias) * bf_hi(uu[0][t].x)); o0.y = cvt_pk_bf16((acc0[4 * t + 2] + bias) * bf_lo(uu[0][t].y), (acc0[4 * t + 3] + bias) * bf_hi(uu[0][t].y));
                o1.x = cvt_pk_bf16((acc1[4 * t] + bias) * bf_lo(uu[1][t].x), (acc1[4 * t + 1] + bias) * bf_hi(uu[1][t].x)); o1.y = cvt_pk_bf16((acc1[4 * t + 2] + bias) * bf_lo(uu[1][t].y), (acc1[4 * t + 3] + bias) * bf_hi(uu[1][t].y));
                *(u32x2*)(S2_ + ro * D + c0 + 8 * t) = o0; *(u32x2*)(S2_ + ro * D + c0 + 32 + 8 * t) = o1; }
            __syncthreads();
        }
    }
}

__device__ __forceinline__ void qknorm_phase(const Fr& F) {
    const int tid = opaque_tid(), lane = tid & 63, wave = __builtin_amdgcn_readfirstlane(tid >> 6), gw = F.bx * NWAVES + wave, NGW = F.G * NWAVES;
    unsigned char* const ws_ = F.ws();
    const bf16_t* const S1_ = (const bf16_t*)(ws_ + WS_S1); bf16_t* const QB_ = (bf16_t*)(ws_ + WS_QB); bf16_t* const KB_ = (bf16_t*)(ws_ + WS_KB);
    const float* qg = F.in(I_AQG); const float* kg = F.in(I_AKG);
    const int hsel = lane >> 5, l5 = lane & 31;
    const f32x2 qg0 = *(const f32x2*)(qg + 2 * l5), qg1 = *(const f32x2*)(qg + 64 + 2 * l5), kg0 = *(const f32x2*)(kg + 2 * l5), kg1 = *(const f32x2*)(kg + 64 + 2 * l5);
    const float inv0 = exp2f(-(float)((2 * l5) & 31) * (13.287712379549449f / 32.f)), inv1 = exp2f(-(float)((2 * l5 + 1) & 31) * (13.287712379549449f / 32.f));
#pragma nounroll
    for (int g2 = gw; g2 < T / 2; g2 += NGW) {
        const int r0 = g2 * 2, b = r0 >> 11;
        unsigned u0[2][5], u1[2][5];
#pragma unroll
        for (int q = 0; q < 2; ++q)
#pragma unroll
            for (int ps = 0; ps < 5; ++ps) { const int hh = 2 * ps + hsel; const bf16_t* src = S1_ + (size_t)(r0 + q) * 2048 + (hh < 8 ? hh * 128 : 1024 + (hh - 8) * 128) + 2 * l5;
                u0[q][ps] = *(const unsigned*)src; u1[q][ps] = *(const unsigned*)(src + 64); }
#pragma unroll
        for (int q = 0; q < 2; ++q) {
            const int s = (r0 + q) & (SEQ - 1); const float pos = (float)(l5 < 16 ? (s >> 6) : (s & 63));
            float c0, s0, c1, s1; __sincosf(pos * inv0, &s0, &c0); __sincosf(pos * inv1, &s1, &c1);
            { c0 = cosf(pos * inv0); s0 = sinf(pos * inv0); c1 = cosf(pos * inv1); s1 = sinf(pos * inv1); }
#pragma unroll
            for (int ps = 0; ps < 5; ++ps) { const int hh = 2 * ps + hsel; const bool isk = ps == 4;
                float a0 = bf_lo(u0[q][ps]), a1 = bf_hi(u0[q][ps]), e0 = bf_lo(u1[q][ps]), e1 = bf_hi(u1[q][ps]);
                const float rs = rsqrtf(half_sum((a0 * a0 + a1 * a1) + (e0 * e0 + e1 * e1)) * (1.f / 128.f) + EPS);
                const f32x2 ga = isk ? kg0 : qg0, gb = isk ? kg1 : qg1;
                a0 *= rs * ga.x; a1 *= rs * ga.y; e0 *= rs * gb.x; e1 *= rs * gb.y;
                const float o10 = a0 * c0 - e0 * s0, o11 = a1 * c1 - e1 * s1, o20 = a0 * s0 + e0 * c0, o21 = a1 * s1 + e1 * c1;
                bf16_t* dst = isk ? KB_ + ((size_t)(b * 2 + (hh - 8)) * SKV + CL + s) * 128 + 2 * l5 : QB_ + (size_t)(r0 + q) * D + hh * 128 + 2 * l5;
                *(unsigned*)dst = cvt_pk_bf16(o10, o11); *(unsigned*)(dst + 64) = cvt_pk_bf16(o20, o21); }
        }
    }
#pragma nounroll
    for (int rc = gw; rc < TC; rc += NGW) {
        const int b = rc >> 8, s = rc & (CL - 1);
        const bf16_t* src = S1_ + (size_t)(T + rc) * 2048 + 1024 + hsel * 128 + 2 * l5;
        const unsigned u0 = *(const unsigned*)src, u1 = *(const unsigned*)(src + 64);
        float a0 = bf_lo(u0), a1 = bf_hi(u0), e0 = bf_lo(u1), e1 = bf_hi(u1);
        const float rs = rsqrtf(half_sum((a0 * a0 + a1 * a1) + (e0 * e0 + e1 * e1)) * (1.f / 128.f) + EPS);
        bf16_t* dst = KB_ + ((size_t)(b * 2 + hsel) * SKV + s) * 128 + 2 * l5;
        *(unsigned*)dst = cvt_pk_bf16(a0 * rs * kg0.x, a1 * rs * kg0.y); *(unsigned*)(dst + 64) = cvt_pk_bf16(e0 * rs * kg1.x, e1 * rs * kg1.y);
    }
}

template <int W> __device__ __forceinline__ void pool_item(const bf16_t* zb  , int s, bf16_t* dst) {
    constexpr int half = W / 2;
    u32x4 w[W];
#pragma unroll
    for (int k = 0; k < W; ++k) { int t = s - half + k; t = t < 0 ? 0 : (t > SEQ - 1 ? SEQ - 1 : t); w[k] = *(const u32x4*)(zb + (size_t)t * 2048); }
    float acc[8];
#pragma unroll
    for (int c = 0; c < 8; ++c) acc[c] = 0.f;
#pragma unroll
    for (int k = 0; k < W; ++k) { const int t = s - half + k; const float m = (t >= 0 && t < SEQ) ? 1.f : 0.f;
#pragma unroll
        for (int c = 0; c < 4; ++c) { acc[2 * c] += m * bf_lo(w[k][c]); acc[2 * c + 1] += m * bf_hi(w[k][c]); } }
    const int lo = s - half < 0 ? 0 : s - half, hi = s + half - 1 > SEQ - 1 ? SEQ - 1 : s + half - 1; const float ic = 1.f / (float)(hi - lo + 1);
    const u32x4 zc = w[half];
    float o[8];
#pragma unroll
    for (int c = 0; c < 4; ++c) { o[2 * c] = acc[2 * c] * ic - bf_lo(zc[c]); o[2 * c + 1] = acc[2 * c + 1] * ic - bf_hi(zc[c]); }
    u32x4 ov; ov.x = cvt_pk_bf16(o[0], o[1]); ov.y = cvt_pk_bf16(o[2], o[3]); ov.z = cvt_pk_bf16(o[4], o[5]); ov.w = cvt_pk_bf16(o[6], o[7]);
    *(u32x4*)dst = ov;
}
__device__ __forceinline__ void pool_phase(const Fr& F) {
    const int tid = opaque_tid(), lane = tid & 63, wave = __builtin_amdgcn_readfirstlane(tid >> 6);
    unsigned char* const ws_ = F.ws();
    const bf16_t* const S1_ = (const bf16_t*)(ws_ + WS_S1); bf16_t* const S2_ = (bf16_t*)(ws_ + WS_S2);
    const int gi = wave & 3, c8 = gi * 32 + (lane & 31), rsub = (wave >> 2) * 2 + (lane >> 5);
#pragma nounroll
    for (int r4 = F.bx; r4 < T / 4; r4 += F.G) {
        const int r = r4 * 4 + rsub, s = r & (SEQ - 1);
        const bf16_t* zb = S1_ + (size_t)(r - s) * 2048 + c8 * 8; bf16_t* dst = S2_ + (size_t)r * D + c8 * 8;
        if (gi == 0) pool_item<2>(zb, s, dst); else if (gi == 1) pool_item<4>(zb, s, dst); else if (gi == 2) pool_item<8>(zb, s, dst); else pool_item<16>(zb, s, dst);
    }
}

__global__ void __launch_bounds__(NTHR, 2) fwd_kernel(KArgs args) {
    extern __shared__ __attribute__((aligned(16))) unsigned char lds_raw[];
    LAS unsigned char* lds = (LAS unsigned char*)lds_raw;
    volatile LAS unsigned* MISC = (volatile LAS unsigned*)(lds + MISC_OFF);
    Fr F;
    F.PT = (volatile LAS unsigned long long*)(lds + MISC_OFF + 256);
    F.G = gridDim.x; F.bx = blockIdx.x; F.vcu = (F.G % 8 == 0) ? (F.bx % 8) * (F.G / 8) + F.bx / 8 : F.bx;
    { const int t0 = threadIdx.x;
      if (t0 < 64) MISC[t0] = 0u;
      if (t0 < 24) F.PT[t0] = (unsigned long long)args.in[t0];
      if (t0 == 24) F.PT[24] = (unsigned long long)args.out;
      if (t0 == 25) F.PT[25] = (unsigned long long)args.ws; }
    __syncthreads();
    XcdBarrier bar = xcd_barrier_post((unsigned*)(F.ws() + WS_CTL), MISC + 8);
    const int lo = args.ph_lo, hi = args.ph_hi;
    int p = 0;
#define RUN(...) RUNC(31, __VA_ARGS__)
#define RUNC(cls, ...) do { if (lo <= p && p < hi) { _Pragma("nounroll") for (int rep_ = 0; rep_ < 1 + (int)((REPEAT_MASK >> (cls)) & 1u); ++rep_) { __VA_ARGS__; if (REPEAT_MASK) __syncthreads(); } if (p + 1 < hi) xcd_barrier(bar); } ++p; } while (0)

#ifndef NO_P0
    RUNC(0, p0_phase(F, lds));
#endif
#pragma nounroll
    for (int L = 0; L < 4; ++L) {
        const int kind = L % 3, jm = L / 3;
        const bool with_ctx = (L == 0);
        RUN({
            float* xo = F.out(); float* xc = WSP(F, float, WS_XC);
#ifndef NO_NORM
            norm_phase(F, lds, L, 1, (L <= 1) ? TT : T, L - 1, (L == 0) ? F.in(I_X) : xo, (L == 0) ? F.in(I_CTX) : xc, xo, xc);
#endif
        });
        RUNC(2, {
            unsigned char* ws = F.ws();
            pg8::SchedDense S; S.A = (bf16_t*)(ws + WS_H); S.G = F.G; S.c = F.bx; S.a_pn_stride = 0; S.a_pm_stride = 256 * D; S.b_pn_stride = 256 * D; S.extra = 0;
            pg8::EpiA E; E.O = (bf16_t*)(ws + WS_S1); E.ldc = 2048; E.act = 0; E.VB = nullptr;
            if (kind == 0) { S.Bt = (bf16_t*)(ws + WS_WGIN) + (size_t)jm * 2048 * 1024; S.nM = with_ctx ? 72 : 64; S.nN = 8; E.act = 1; }
            else if (kind == 1) { S.Bt = (bf16_t*)(ws + WS_WAIN); S.nM = 64; S.nN = 6; S.extra = 16; E.VB = (bf16_t*)(ws + WS_VB); }
            else { S.Bt = (bf16_t*)(ws + WS_WPIN); S.nM = 64; S.nN = 4; }
            S.nwg = S.nM * S.nN;
            #ifndef NO_GA
            pg8::gemm_phase<pg8::EpiA, pg8::SchedDense>(lds, D, D, D, S, E);
#endif
        });
        if (kind == 0) {
#ifndef NO_SPAT
            RUNC(3, spatial_phase(F, lds, jm, with_ctx ? 144 : 128));
#endif
        }
        else if (kind == 1) {
#ifndef NO_QKN
            RUNC(4, qknorm_phase(F));
#endif
            RUNC(5, {
                unsigned char* ws = F.ws();
                const bf16_t* QB = (const bf16_t*)(ws + WS_QB); const bf16_t* KB = (const bf16_t*)(ws + WS_KB); const bf16_t* VB = (const bf16_t*)(ws + WS_VB); bf16_t* S2 = (bf16_t*)(ws + WS_S2);
                for (int i = 0; i * F.G + F.vcu < 512; ++i) { const int Lu = i * F.G + F.vcu, bk = Lu >> 5, w = Lu & 31, b = bk >> 1, kvh = bk & 1, h = kvh * 4 + (w >> 3), qb = w & 7;
#ifndef NO_ATT
                    att::attn_body<D, D>(QB + ((size_t)(b * SEQ + qb * 256)) * D + h * 128, KB + (size_t)bk * SKV * 128, VB + (size_t)bk * SKV * 128,
                                         S2 + ((size_t)(b * SEQ + qb * 256)) * D + h * 128, SKV, lds);
#endif
                    __syncthreads(); }
            });
        } else {
#ifndef NO_POOL
            RUNC(6, pool_phase(F));
#endif
        }
        RUN({
            unsigned char* ws = F.ws();
            pg8::SchedDense S; S.A = (bf16_t*)(ws + WS_S2); S.G = F.G; S.c = F.bx; S.a_pm_stride = 256 * D; S.a_pn_stride = 0; S.b_pn_stride = 256 * D; S.extra = 0; S.nN = 4; S.nM = 64;
            pg8::EpiB E; E.xd_lat = F.out(); E.xd_ctx = (float*)(ws + WS_XC); E.xs_lat = (L == 0) ? F.in(I_X) : E.xd_lat; E.xs_ctx = (L == 0) ? F.in(I_CTX) : E.xd_ctx;
            E.gt = (const float*)(ws + WS_MODV) + (size_t)L * 9 * 6144 + 2 * 1024; E.colscale = nullptr;
            int K = D, ldb = D;
            if (kind == 0) { S.Bt = (bf16_t*)(ws + WS_WGOUT) + (size_t)jm * 1024 * 1024; S.nM = with_ctx ? 72 : 64; }
            else if (kind == 1) { S.Bt = (bf16_t*)(ws + WS_WAOUT); }
            else { S.Bt = (bf16_t*)(ws + WS_WPGRP); S.a_pn_stride = 256; S.b_pn_stride = 256 * 256; K = 256; ldb = 256; E.colscale = F.in(I_PSC); }
            S.nwg = S.nM * S.nN;
            #ifndef NO_GB
            pg8::gemm_phase<pg8::EpiB, pg8::SchedDense>(lds, K, D, ldb, S, E);
#endif
        });
        RUNC(8, {
            float* xo = F.out(); float* xc = WSP(F, float, WS_XC);
#ifndef NO_NORM
            norm_phase(F, lds, L, 2, with_ctx ? TT : T, -1, xo, xc, xo, xc);
#endif
        });
#ifndef NO_TOPK
        RUNC(9, topk_phase(F, lds, with_ctx));
#endif
        RUNC(10, {
            unsigned char* ws = F.ws();
            pg8::SchedMoE S; S.A = (bf16_t*)(ws + WS_XIN); S.Bt = (bf16_t*)(ws + WS_WUP) + (size_t)L * 16 * 2048 * 1024; S.nbt = with_ctx ? 9 : 8; S.nn = 8; S.G = F.G; S.vcu = F.vcu;
            pg8::EpiC E; E.HID = (bf16_t*)(ws + WS_HID);
            #ifndef NO_GC
            pg8::gemm_phase<pg8::EpiC, pg8::SchedMoE>(lds, D, D, D, S, E);
#endif
        });
        RUNC(11, {
            unsigned char* ws = F.ws();
            pg8::SchedMoE S; S.A = (bf16_t*)(ws + WS_HID); S.Bt = (bf16_t*)(ws + WS_WDN) + (size_t)L * 16 * 1024 * 1024; S.nbt = with_ctx ? 9 : 8; S.nn = 4; S.G = F.G; S.vcu = F.vcu;
            pg8::EpiD E; E.Y = (bf16_t*)(ws + WS_YEXP); E.gate = (const float*)(ws + WS_GATE);
            #ifndef NO_GD
            pg8::gemm_phase<pg8::EpiD, pg8::SchedMoE>(lds, D, D, D, S, E);
#endif
        });
    }
    RUN({
        float* xo = F.out(); float* xc = WSP(F, float, WS_XC);
#ifndef NO_NORM
        norm_phase(F, lds, 3, 0, T, 3, xo, xc, xo, xc);
#endif
    });
#undef RUN
#undef RUNC
}

constexpr int N_PHASES = 1 + 8 + 9 + 8 + 8 + 1;

extern "C" void kernel_launch(void* const* d_in, const int* in_sizes, int n_in, void* d_out, int out_size, void* d_ws, size_t ws_size, hipStream_t stream) {
    static int grid = 0;
    if (grid == 0) {
        if (n_in != 24 || out_size != T * D || ws_size < WS_END) { fprintf(stderr, "kernel_launch: unexpected shapes (n_in %d out %d ws %zu need %zu)\n", n_in, out_size, ws_size, (size_t)WS_END); grid = -1; return; }
        int dev = 0, cus = 0;
        if (hipGetDevice(&dev) != hipSuccess || hipDeviceGetAttribute(&cus, hipDeviceAttributeMultiprocessorCount, dev) != hipSuccess) { grid = -1; return; }
        if (hipFuncSetAttribute((const void*)fwd_kernel, hipFuncAttributeMaxDynamicSharedMemorySize, LDS_BYTES) != hipSuccess) { fprintf(stderr, "kernel_launch: hipFuncSetAttribute failed\n"); grid = -1; return; }
        (void)hipGetLastError();
        grid = cus;
    }
    if (grid < 0) return;
    (void)hipMemsetAsync((char*)d_ws + WS_CTL, 0, CTL_BYTES, stream);
    KArgs a{};
    for (int i = 0; i < 24; ++i) a.in[i] = (const float*)d_in[i];
    a.out = (float*)d_out; a.ws = (unsigned char*)d_ws;
#if MK_PER_PHASE
    for (int k = 0; k < N_PHASES; ++k) { a.ph_lo = k; a.ph_hi = k + 1; hipLaunchKernelGGL(fwd_kernel, dim3(grid), dim3(NTHR), LDS_BYTES, stream, a); }
#else
    a.ph_lo = 0; a.ph_hi = N_PHASES;
    hipLaunchKernelGGL(fwd_kernel, dim3(grid), dim3(NTHR), LDS_BYTES, stream, a);
#endif
    const hipError_t le = hipPeekAtLastError();
    if (le != hipSuccess) fprintf(stderr, "kernel_launch: launch failed: %s\n", hipGetErrorName(le));
}
```

```cpp
#include <hip/hip_runtime.h>
#include <cstdio>
#include <cstdint>

#ifndef REPEAT_MASK
#define REPEAT_MASK 0u
#endif
#ifndef MK_PER_PHASE
#define MK_PER_PHASE 0
#endif

#define LAS __attribute__((address_space(3)))
#define GAS __attribute__((address_space(1)))
typedef unsigned short bf16_t;
typedef short bf16x8 __attribute__((ext_vector_type(8)));
typedef short s16x4 __attribute__((ext_vector_type(4)));
typedef float f32x2 __attribute__((ext_vector_type(2)));
typedef float f32x4 __attribute__((ext_vector_type(4)));
typedef float f32x16 __attribute__((ext_vector_type(16)));
typedef unsigned u32x2 __attribute__((ext_vector_type(2)));
typedef unsigned u32x4 __attribute__((ext_vector_type(4)));

constexpr int D = 1024, NB = 8, SEQ = 2048, T = NB * SEQ, CL = 256, TC = NB * CL, TT = T + TC, NE = 16, CAP = 256, CCAP = 32, NTILE = 144;
constexpr int SKV = CL + SEQ;
constexpr float EPS = 1e-6f;
constexpr int NWAVES = 8, NTHR = 512;

constexpr size_t al256(size_t x) { return (x + 255) / 256 * 256; }
constexpr size_t WS_CTL   = 0;
constexpr size_t CTL_BYTES = 65536;
constexpr size_t WS_MODV  = WS_CTL + CTL_BYTES;
constexpr size_t WS_AFF   = WS_MODV + al256((size_t)4 * 9 * 6144 * 4);
constexpr size_t WS_SLOT  = WS_AFF + (size_t)TT * 16 * 4;
constexpr size_t WS_GATE  = WS_SLOT + (size_t)TT * 16 * 4;
constexpr size_t WS_WSW   = WS_GATE + (size_t)NTILE * 256 * 4;
constexpr size_t WS_WGIN  = WS_WSW + (size_t)2 * 8 * 128 * 128 * 2;
constexpr size_t WS_WGOUT = WS_WGIN + (size_t)2 * 2048 * 1024 * 2;
constexpr size_t WS_WAIN  = WS_WGOUT + (size_t)2 * 1024 * 1024 * 2;
constexpr size_t WS_WAOUT = WS_WAIN + (size_t)1536 * 1024 * 2;
constexpr size_t WS_WPIN  = WS_WAOUT + (size_t)1024 * 1024 * 2;
constexpr size_t WS_WPGRP = WS_WPIN + (size_t)1024 * 1024 * 2;
constexpr size_t WS_WUP   = WS_WPGRP + (size_t)4 * 256 * 256 * 2;
constexpr size_t WS_WDN   = WS_WUP + (size_t)4 * 16 * 2048 * 1024 * 2;
constexpr size_t WS_XC    = WS_WDN + (size_t)4 * 16 * 1024 * 1024 * 2;
constexpr size_t WS_H     = WS_XC + (size_t)TC * D * 4;
constexpr size_t WS_S1    = WS_H + (size_t)TT * D * 2;
constexpr size_t WS_S2    = WS_S1 + (size_t)TT * 2048 * 2;
constexpr size_t WS_QB    = WS_S2 + (size_t)TT * D * 2;
constexpr size_t WS_KB    = WS_QB + (size_t)T * D * 2;
constexpr size_t WS_VB    = WS_KB + (size_t)NB * 2 * SKV * 128 * 2;
constexpr size_t WS_IDX   = WS_VB + (size_t)NB * 2 * SKV * 128 * 2;
constexpr size_t WS_HID   = WS_IDX + (size_t)NTILE * 256 * 4;
constexpr size_t WS_YEXP  = WS_HID + (size_t)NTILE * 256 * D * 2;
constexpr size_t WS_END   = WS_YEXP + (size_t)NTILE * 256 * D * 2;

constexpr int RING_BYTES = 131072, MISC_OFF = RING_BYTES, LDS_BYTES = RING_BYTES + 1024;

__device__ __forceinline__ unsigned cvt_pk_bf16(float lo, float hi) { unsigned r; asm volatile("v_cvt_pk_bf16_f32 %0, %1, %2" : "=v"(r) : "v"(lo), "v"(hi)); return r; }
__device__ __forceinline__ float bf_lo(unsigned u) { return __uint_as_float(u << 16); }
__device__ __forceinline__ float bf_hi(unsigned u) { return __uint_as_float(u & 0xffff0000u); }
__device__ __forceinline__ float bf2f(bf16_t b) { return __uint_as_float(((unsigned)b) << 16); }
__device__ __forceinline__ bf16_t f2bf(float f) { return (bf16_t)(cvt_pk_bf16(f, 0.f) & 0xffffu); }
template <int K> __device__ __forceinline__ float swz_xor(float v) { return __int_as_float(__builtin_amdgcn_ds_swizzle(__float_as_int(v), 0x1F | (K << 10))); }
__device__ __forceinline__ float half_sum(float v) { v += swz_xor<1>(v); v += swz_xor<2>(v); v += swz_xor<4>(v); v += swz_xor<8>(v); v += swz_xor<16>(v); return v; }
__device__ __forceinline__ float half_max(float v) { v = fmaxf(v, swz_xor<1>(v)); v = fmaxf(v, swz_xor<2>(v)); v = fmaxf(v, swz_xor<4>(v)); v = fmaxf(v, swz_xor<8>(v)); v = fmaxf(v, swz_xor<16>(v)); return v; }
__device__ __forceinline__ float wave_sum(float v) { v = half_sum(v); auto rr = __builtin_amdgcn_permlane32_swap(__float_as_uint(v), __float_as_uint(v), false, false); return __uint_as_float(rr[0]) + __uint_as_float(rr[1]); }
__device__ __forceinline__ float wave_max(float v) { v = half_max(v); auto rr = __builtin_amdgcn_permlane32_swap(__float_as_uint(v), __float_as_uint(v), false, false); return fmaxf(__uint_as_float(rr[0]), __uint_as_float(rr[1])); }
__device__ __forceinline__ float xor32(float v, bool hi) { auto rr = __builtin_amdgcn_permlane32_swap(__float_as_uint(v), __float_as_uint(v), false, false); return __uint_as_float(hi ? rr[0] : rr[1]); }
__device__ __forceinline__ int opaque_tid() { int t = threadIdx.x; asm volatile("" : "+v"(t)); return t; }
__device__ __forceinline__ float silu_f(float x) { return x / (1.f + __expf(-x)); }
__device__ __forceinline__ float gelu_tanh_f(float x) {
    const float z = 0.7978845608028654f * (x + 0.044715f * x * x * x);
    return x / (1.f + __expf(-2.f * z));
}
#define LDS_WAIT() asm volatile("s_waitcnt lgkmcnt(0)" ::: "memory")

#define XB_TMO      128
#define XB_XCNT(j)  (256  + 64 * (j))
#define XB_XSUB(j)  (1280 + 64 * (j))
#define XB_XGEN(j)  (2304 + 64 * (j))
#define XB_TOP      3328
#define XB_TOPGEN   3392
#define XCD_BAR_WORDS 3456
#define XB_SPIN_CAP (1u << 22)
__device__ __forceinline__ unsigned xb_ld(unsigned* p)              { return __hip_atomic_load(p, __ATOMIC_RELAXED, __HIP_MEMORY_SCOPE_AGENT); }
__device__ __forceinline__ unsigned xb_add(unsigned* p, unsigned v) { return __hip_atomic_fetch_add(p, v, __ATOMIC_RELAXED, __HIP_MEMORY_SCOPE_AGENT); }
__device__ __forceinline__ unsigned xb_xcc_id() { return (unsigned)__builtin_amdgcn_s_getreg((3 << 11) | 20) & 0xFu; }
#define XB_SPIN(cond, bar) do { unsigned _sp = 0; while (cond) { __builtin_amdgcn_s_sleep(1); \
    if ((++_sp & 255u) == 0u) { if (xb_ld(&(bar)[XB_TMO])) break; if (_sp > XB_SPIN_CAP) { atomicAdd(&(bar)[XB_TMO], 1u); break; } } } } while (0)
struct XcdBarrier { unsigned* bar; unsigned x; volatile LAS unsigned* st; };
__device__ __forceinline__ XcdBarrier xcd_barrier_post(unsigned* bar, volatile LAS unsigned* st) {
    XcdBarrier b; b.bar = bar; b.x = xb_xcc_id(); b.st = st;
    if (threadIdx.x == 0) (void)xb_add(&bar[XB_XCNT(b.x)], 1u);
    return b;
}
__device__ __forceinline__ void xcd_barrier_complete(unsigned* bar, unsigned x, unsigned& nloc, unsigned& nx) {
    const unsigned G = gridDim.x * gridDim.y * gridDim.z;
    unsigned sum, cnt, mine, sp = 0u;
    for (;;) {
        sum = 0u; cnt = 0u; mine = 0u;
#pragma unroll
        for (unsigned j = 0; j < 16; ++j) { const unsigned c = xb_ld(&bar[XB_XCNT(j)]); sum += c; cnt += (c > 0u) ? 1u : 0u; }
        mine = xb_ld(&bar[XB_XCNT(x)]);
        if (sum == G) break;
        __builtin_amdgcn_s_sleep(1);
        if ((++sp & 255u) == 0u) { if (xb_ld(&bar[XB_TMO])) break; if (sp > XB_SPIN_CAP) { atomicAdd(&bar[XB_TMO], 1u); break; } }
    }
    nloc = mine > 0u ? mine : 1u; nx = cnt > 0u ? cnt : 1u;
}
__device__ __forceinline__ void xcd_barrier(const XcdBarrier& b) {
    asm volatile("s_waitcnt vmcnt(0)" ::: "memory");
    __syncthreads();
    if (threadIdx.x == 0) {
        unsigned* bar = b.bar;
        __builtin_amdgcn_s_waitcnt(0);
        unsigned nloc = b.st[0], nx = b.st[1];
        if (nloc == 0u) { xcd_barrier_complete(bar, b.x, nloc, nx); b.st[0] = nloc; b.st[1] = nx; }
        const unsigned old = xb_add(&bar[XB_XSUB(b.x)], 1u);
        const unsigned gen = old / nloc;
        if (old + 1u == (gen + 1u) * nloc) {
            __builtin_amdgcn_fence(__ATOMIC_RELEASE, "agent");
            asm volatile("s_waitcnt vmcnt(0)" ::: "memory");
            const unsigned og = xb_add(&bar[XB_TOP], 1u);
            const unsigned tg = og / nx;
            if (og + 1u == (tg + 1u) * nx) xb_add(&bar[XB_TOPGEN], 1u);
            else XB_SPIN(xb_ld(&bar[XB_TOPGEN]) == tg, bar);
            __builtin_amdgcn_fence(__ATOMIC_ACQUIRE, "agent");
            xb_add(&bar[XB_XGEN(b.x)], 1u);
            asm volatile("s_waitcnt vmcnt(0)" ::: "memory");
        } else {
            XB_SPIN(xb_ld(&bar[XB_XGEN(b.x)]) == gen, bar);
            __builtin_amdgcn_fence(__ATOMIC_ACQUIRE, "agent");
            asm volatile("s_waitcnt vmcnt(0)" ::: "memory");
        }
    }
    __syncthreads();
}

namespace pg8 {
constexpr int BM = 256, BK = 64, HALF = 128, HTB = HALF * BK * 2, NXCD = 8, WGM = 8;
__host__ __device__ __forceinline__ int lds_byte(int r, int c) { const int st = (r >> 4) * 2 + (c >> 5), rr = r & 15, cc = c & 31, ob = rr * 64 + cc * 2; return st * 1024 + (ob ^ (((ob >> 9) & 1) << 5)); }
__host__ __device__ __forceinline__ void stage_rc(int b, int& R, int& C) { const int st = b / 1024, sb = b % 1024, swz = sb ^ (((sb >> 9) & 1) << 5); R = (st >> 1) * 16 + swz / 64; C = (st & 1) * 32 + (swz % 64) / 2; }
__host__ __device__ __forceinline__ int perm32(int rho) { const int n = rho >> 4, i = rho & 15; return 8 * (i >> 2) + 4 * n + (i & 3); }
struct Unit { int pm, pn; };

template <class Epi, class Sched>
__device__ __forceinline__ void gemm_phase(LAS unsigned char* lds, const int K, const int lda, const int ldb, const Sched& S, const Epi& E) {
    const int tid = opaque_tid(), wid = __builtin_amdgcn_readfirstlane(tid >> 6), lane = tid & 63, wr = wid >> 2, wc = wid & 3, fr = lane & 15, fq = lane >> 4;
    const int nt = K / BK;
    constexpr bool GATHER = Sched::GATHER;
    unsigned voffA[2], voffB[2]; int rowA[2];
#pragma unroll
    for (int i = 0; i < 2; ++i) { int R, C; stage_rc(tid * 16 + i * 8192, R, C); const int Rb = Epi::PERM ? ((R & ~31) + perm32(R & 31)) : R;
        voffA[i] = GATHER ? (unsigned)C * 2u : (unsigned)(R * lda + C) * 2u; voffB[i] = (unsigned)(Rb * ldb + C) * 2u; rowA[i] = R; }
    unsigned gA[2][2], gN[2][2];
    const size_t kstep = (size_t)(BK * 2);
    const size_t hstepA = (size_t)HALF * lda * 2, hstepB = (size_t)HALF * ldb * 2;
    const unsigned ldsw = (unsigned)wid * 1024u;
    const int aoff = lds_byte(wr * 64 + fr, fq * 8), boff = lds_byte(wc * 32 + fr, fq * 8);
#define PG8_SA(b, h) (((b) * 2 + (h)) * HTB)
#define PG8_SB(b, h) ((4 + (b) * 2 + (h)) * HTB)
#define PG8_STAGE(bufoff, gbase, voff) do { _Pragma("unroll") for (int _i = 0; _i < 2; ++_i) \
        __builtin_amdgcn_global_load_lds((const unsigned*)((const char*)(gbase) + (voff)[_i]), (LAS unsigned*)(lds + (bufoff) + ldsw + _i * 8192), 16, 0, 0); } while (0)
#define PG8_STAGE_A(bufoff, ubase, kb, h, nx) do { if constexpr (GATHER) { unsigned _v[2]; _v[0] = ((nx) ? gN[h][0] : gA[h][0]) + voffA[0]; _v[1] = ((nx) ? gN[h][1] : gA[h][1]) + voffA[1]; \
        PG8_STAGE(bufoff, (const char*)S.abase() + (kb), _v); } else { PG8_STAGE(bufoff, (ubase) + (size_t)(h) * hstepA + (kb), voffA); } } while (0)
#define PG8_LOADG(u, g) do { if constexpr (GATHER) { const int* _ip = S.idx(u); _Pragma("unroll") for (int _h = 0; _h < 2; ++_h) _Pragma("unroll") for (int _i = 0; _i < 2; ++_i) \
        g[_h][_i] = (unsigned)_ip[_h * HALF + rowA[_i]] * (unsigned)(lda * 2); } } while (0)
#define PG8_LDA(dst, b, h) do { _Pragma("unroll") for (int m = 0; m < 4; ++m) _Pragma("unroll") for (int k = 0; k < 2; ++k) dst[m][k] = *(const LAS bf16x8*)(lds + PG8_SA(b, h) + aoff + m * 2048 + k * 1024); } while (0)
#define PG8_LDB(dst, b, h) do { _Pragma("unroll") for (int n = 0; n < 2; ++n) _Pragma("unroll") for (int k = 0; k < 2; ++k) dst[n][k] = *(const LAS bf16x8*)(lds + PG8_SB(b, h) + boff + n * 2048 + k * 1024); } while (0)
#define PG8_MMA(ai, bj, At, Bt) do { __builtin_amdgcn_s_setprio(1); _Pragma("unroll") for (int m = 0; m < 4; ++m) _Pragma("unroll") for (int n = 0; n < 2; ++n) _Pragma("unroll") for (int k = 0; k < 2; ++k) \
        acc[ai][bj][m][n] = __builtin_amdgcn_mfma_f32_16x16x32_bf16(Bt[n][k], At[m][k], acc[ai][bj][m][n], 0, 0, 0); __builtin_amdgcn_s_setprio(0); } while (0)
#define PG8_WAIT_V(n) asm volatile("s_waitcnt vmcnt(" #n ")" ::: "memory")
#define PG8_WAIT_L(n) asm volatile("s_waitcnt lgkmcnt(" #n ")" ::: "memory")
#define PG8_BAR __builtin_amdgcn_s_barrier()
#define PG8_SCHED __builtin_amdgcn_sched_barrier(0)
    Unit cur, nxt; int ui = 0;
    if (!S.next(0, cur)) return;
    f32x4 acc[2][2][4][2];
#pragma unroll
    for (int a = 0; a < 2; ++a)
#pragma unroll
        for (int b = 0; b < 2; ++b)
#pragma unroll
            for (int m = 0; m < 4; ++m)
#pragma unroll
                for (int n = 0; n < 2; ++n) acc[a][b][m][n] = (f32x4){0.f, 0.f, 0.f, 0.f};
    bf16x8 At[4][2], B0[2][2], B1[2][2];
    const char* cA = GATHER ? (const char*)nullptr : S.aptr(cur); const char* cB = S.bptr(cur);
    PG8_LOADG(cur, gA);
    PG8_STAGE(PG8_SB(0, 0), cB, voffB); PG8_STAGE(PG8_SB(0, 1), cB + hstepB, voffB); PG8_STAGE_A(PG8_SA(0, 0), cA, 0, 0, false); PG8_STAGE_A(PG8_SA(0, 1), cA, 0, 1, false);
    if (wr == 1) PG8_BAR;
    PG8_WAIT_V(2); PG8_BAR;
    PG8_STAGE(PG8_SB(1, 0), cB + kstep, voffB); PG8_STAGE_A(PG8_SA(1, 0), cA, kstep, 0, false); PG8_STAGE(PG8_SB(1, 1), cB + hstepB + kstep, voffB);
    PG8_WAIT_V(6); PG8_BAR;
    for (;;) {
        const bool has_next = S.next(ui + 1, nxt);
        const char* nA = (has_next && !GATHER) ? S.aptr(nxt) : cA; const char* nB = has_next ? S.bptr(nxt) : cB;
        if (has_next) PG8_LOADG(nxt, gN); else { if constexpr (GATHER) {
#pragma unroll
            for (int h_ = 0; h_ < 2; ++h_) { gN[h_][0] = gA[h_][0]; gN[h_][1] = gA[h_][1]; } } }
        for (int t = 0; t < nt; t += 2) {
            const bool last = (t == nt - 2);
            const size_t k1 = (size_t)(t + 1) * kstep, k2 = last ? 0 : (size_t)(t + 2) * kstep, k3 = k2 + kstep;
            const char* a2 = last ? nA : cA; const char* b2 = last ? nB : cB + (size_t)(t + 2) * kstep;
            const char* b3 = b2 + kstep;
            PG8_LDB(B0, 0, 0); PG8_LDB(B1, 0, 1); PG8_SCHED; PG8_LDA(At, 0, 0); PG8_STAGE_A(PG8_SA(1, 1), cA, k1, 1, false);
            PG8_WAIT_V(8); PG8_WAIT_L(0); PG8_BAR; PG8_MMA(0, 0, At, B0); PG8_MMA(0, 1, At, B1); PG8_BAR; PG8_SCHED;
            PG8_LDA(At, 0, 1); PG8_STAGE(PG8_SB(0, 0), b2, voffB); PG8_STAGE(PG8_SB(0, 1), b2 + hstepB, voffB); PG8_STAGE_A(PG8_SA(0, 0), a2, k2, 0, last);
            PG8_WAIT_V(8); PG8_WAIT_L(0); PG8_BAR; PG8_MMA(1, 0, At, B0); PG8_MMA(1, 1, At, B1); PG8_BAR; PG8_SCHED;
            PG8_LDB(B0, 1, 0); PG8_LDB(B1, 1, 1); PG8_SCHED; PG8_LDA(At, 1, 0); PG8_STAGE_A(PG8_SA(0, 1), a2, k2, 1, last);
            PG8_WAIT_V(8); PG8_WAIT_L(0); PG8_BAR; PG8_MMA(0, 0, At, B0); PG8_MMA(0, 1, At, B1); PG8_BAR; PG8_SCHED;
            PG8_LDA(At, 1, 1); PG8_STAGE(PG8_SB(1, 0), b3, voffB); PG8_STAGE(PG8_SB(1, 1), b3 + hstepB, voffB); PG8_STAGE_A(PG8_SA(1, 0), a2, k3, 0, last);
            PG8_WAIT_V(8); PG8_WAIT_L(0); PG8_BAR; PG8_MMA(1, 0, At, B0); PG8_MMA(1, 1, At, B1); PG8_BAR; PG8_SCHED;
        }
        if (wr == 0) PG8_BAR;
        E(acc, cur, wr, wc, fr, fq);
        if (!has_next) break;
#pragma unroll
        for (int a = 0; a < 2; ++a)
#pragma unroll
            for (int b = 0; b < 2; ++b)
#pragma unroll
                for (int m = 0; m < 4; ++m)
#pragma unroll
                    for (int n = 0; n < 2; ++n) acc[a][b][m][n] = (f32x4){0.f, 0.f, 0.f, 0.f};
        cur = nxt; cA = nA; cB = nB; ++ui;
        if constexpr (GATHER) {
#pragma unroll
            for (int h_ = 0; h_ < 2; ++h_) { gA[h_][0] = gN[h_][0]; gA[h_][1] = gN[h_][1]; } }
        if (wr == 1) PG8_BAR;
    }
    PG8_WAIT_V(0);
    PG8_BAR;
#undef PG8_SA
#undef PG8_SB
#undef PG8_STAGE
#undef PG8_STAGE_A
#undef PG8_LOADG
#undef PG8_LDA
#undef PG8_LDB
#undef PG8_MMA
#undef PG8_WAIT_V
#undef PG8_WAIT_L
#undef PG8_BAR
#undef PG8_SCHED
}

struct SchedDense {
    static constexpr bool GATHER = false;
    __device__ __forceinline__ const char* abase() const { return nullptr; }
    __device__ __forceinline__ const int* idx(const Unit&) const { return nullptr; }
    const bf16_t* A; const bf16_t* Bt; int a_pm_stride, a_pn_stride, b_pn_stride;
    int nM, nN, nwg, extra, G, c;
    __device__ __forceinline__ bool next(int i, Unit& u) const {
        const int L = i * G + c; if (L >= nwg + extra) return false;
        if (L >= nwg) { const int x = L - nwg; u.pm = nM + (x >> 1); u.pn = 4 + (x & 1); return true; }
        int wgid = L; { const int q = nwg / NXCD, r = nwg % NXCD, xcd = wgid % NXCD, off = wgid / NXCD; wgid = (xcd < r ? xcd * (q + 1) : r * (q + 1) + (xcd - r) * q) + off; }
        const int nig = WGM * nN, gid = wgid / nig, fm = gid * WGM, gsz = (nM - fm) < WGM ? (nM - fm) : WGM;
        u.pm = fm + ((wgid % nig) % gsz); u.pn = (wgid % nig) / gsz; return true;
    }
    __device__ __forceinline__ const char* aptr(const Unit& u) const { return (const char*)(A + (size_t)u.pm * a_pm_stride + (size_t)u.pn * a_pn_stride); }
    __device__ __forceinline__ const char* bptr(const Unit& u) const { return (const char*)(Bt + (size_t)u.pn * b_pn_stride); }
};
template <bool GATHER_>
struct SchedMoE {
    static constexpr bool GATHER = GATHER_;
    const bf16_t* A; const bf16_t* Bt; const int* IDX; int nbt, nn, G, vcu;
    __device__ __forceinline__ bool next(int i, Unit& u) const {
        const int L = i * G + vcu, per_e = nbt * nn; if (L >= NE * per_e) return false;
        const int e = L / per_e, rem = L - e * per_e, bt = rem / nn, j = rem - bt * nn;
        u.pm = bt < 8 ? e * 8 + bt : 128 + e; u.pn = e * nn + j; return true;
    }
    __device__ __forceinline__ const char* aptr(const Unit& u) const { return (const char*)(A + (size_t)u.pm * 256 * D); }
    __device__ __forceinline__ const char* abase() const { return (const char*)A; }
    __device__ __forceinline__ const int* idx(const Unit& u) const { return IDX + (size_t)u.pm * 256; }
    __device__ __forceinline__ const char* bptr(const Unit& u) const { return (const char*)(Bt + (size_t)u.pn * 256 * D); }
};

struct EpiA {
    static constexpr bool PERM = true;
    bf16_t* O; int ldc; int act; bf16_t* VB;
    __device__ __forceinline__ void operator()(const f32x4 (&acc)[2][2][4][2], const Unit& u, int wr, int wc, int fr, int fq) const {
        const int row0 = u.pm * BM + wr * 64 + fr, cl = wc * 32 + 8 * fq;
        const bool vtile = (VB != nullptr) && (u.pn == 5);
#pragma unroll
        for (int ai = 0; ai < 2; ++ai)
#pragma unroll
            for (int m = 0; m < 4; ++m) {
                const int r = row0 + ai * HALF + m * 16;
#pragma unroll
                for (int bj = 0; bj < 2; ++bj) {
                    f32x4 v0 = acc[ai][bj][m][0], v1 = acc[ai][bj][m][1];
                    if (act) {
#pragma unroll
                        for (int j = 0; j < 4; ++j) { v0[j] = gelu_tanh_f(v0[j]); v1[j] = gelu_tanh_f(v1[j]); } }
                    u32x4 w; w.x = cvt_pk_bf16(v0[0], v0[1]); w.y = cvt_pk_bf16(v0[2], v0[3]); w.z = cvt_pk_bf16(v1[0], v1[1]); w.w = cvt_pk_bf16(v1[2], v1[3]);
                    bf16_t* dst;
                    if (vtile) { int b, pos; if (r < T) { b = r >> 11; pos = CL + (r & (SEQ - 1)); } else { const int rc = r - T; b = rc >> 8; pos = rc & (CL - 1); }
                        dst = VB + ((size_t)(b * 2 + bj) * SKV + pos) * 128 + cl; }
                    else dst = O + (size_t)r * ldc + u.pn * BM + bj * HALF + cl;
                    *(u32x4*)dst = w; } }
    }
};
struct EpiB {
    static constexpr bool PERM = false;
    const float* xs_lat; const float* xs_ctx; float* xd_lat; float* xd_ctx; const float* gt; const float* colscale;
    __device__ __forceinline__ void operator()(const f32x4 (&acc)[2][2][4][2], const Unit& u, int wr, int wc, int fr, int fq) const {
        const int row0 = u.pm * BM + wr * 64 + fr, col0 = u.pn * BM + wc * 32 + 4 * fq;
        const bool isctx = row0 >= T;
        const int mrow = isctx ? 8 : (row0 >> 11);
        const float* xs = isctx ? xs_ctx - (size_t)T * D : xs_lat; float* xd = isctx ? xd_ctx - (size_t)T * D : xd_lat;
        f32x4 gv[2][2];
#pragma unroll
        for (int bj = 0; bj < 2; ++bj)
#pragma unroll
            for (int n = 0; n < 2; ++n) { const int c = col0 + bj * HALF + n * 16; gv[bj][n] = *(const f32x4*)(gt + (size_t)mrow * 6144 + c);
                if (colscale) gv[bj][n] = gv[bj][n] * *(const f32x4*)(colscale + c); }
#pragma unroll
        for (int ai = 0; ai < 2; ++ai)
#pragma unroll
            for (int m = 0; m < 4; ++m) { const size_t off = (size_t)(row0 + ai * HALF + m * 16) * D + col0;
#pragma unroll
                for (int bj = 0; bj < 2; ++bj)
#pragma unroll
                    for (int n = 0; n < 2; ++n) { const f32x4 xo = *(const f32x4*)(xs + off + bj * HALF + n * 16);
                        *(f32x4*)(xd + off + bj * HALF + n * 16) = xo + gv[bj][n] * acc[ai][bj][m][n]; } }
    }
};
struct EpiC {
    static constexpr bool PERM = true;
    bf16_t* HID;
    __device__ __forceinline__ void operator()(const f32x4 (&acc)[2][2][4][2], const Unit& u, int wr, int wc, int fr, int fq) const {
        const int n8 = u.pn & 7, rl = wr * 64 + fr, cl = n8 * 128 + wc * 32 + 8 * fq;
        bf16_t* base = HID + (size_t)u.pm * 256 * D;
#pragma unroll
        for (int ai = 0; ai < 2; ++ai)
#pragma unroll
            for (int m = 0; m < 4; ++m) {
                float h[8];
#pragma unroll
                for (int n = 0; n < 2; ++n)
#pragma unroll
                    for (int j = 0; j < 4; ++j) { const float g = acc[ai][0][m][n][j], up = acc[ai][1][m][n][j]; h[n * 4 + j] = silu_f(g) * up; }
                u32x4 w; w.x = cvt_pk_bf16(h[0], h[1]); w.y = cvt_pk_bf16(h[2], h[3]); w.z = cvt_pk_bf16(h[4], h[5]); w.w = cvt_pk_bf16(h[6], h[7]);
                *(u32x4*)(base + (size_t)(rl + ai * HALF + m * 16) * D + cl) = w; }
    }
};
struct EpiD {
    static constexpr bool PERM = true;
    bf16_t* Y; const float* gate;
    __device__ __forceinline__ void operator()(const f32x4 (&acc)[2][2][4][2], const Unit& u, int wr, int wc, int fr, int fq) const {
        const int n4 = u.pn & 3, rl = wr * 64 + fr, cl = n4 * 256 + wc * 32 + 8 * fq;
        bf16_t* base = Y + (size_t)u.pm * 256 * D; const float* gp = gate + (size_t)u.pm * 256;
#pragma unroll
        for (int ai = 0; ai < 2; ++ai)
#pragma unroll
            for (int m = 0; m < 4; ++m) { const int r = rl + ai * HALF + m * 16; const float g = gp[r];
#pragma unroll
                for (int bj = 0; bj < 2; ++bj) { const f32x4 v0 = acc[ai][bj][m][0] * g, v1 = acc[ai][bj][m][1] * g;
                    u32x4 w; w.x = cvt_pk_bf16(v0[0], v0[1]); w.y = cvt_pk_bf16(v0[2], v0[3]); w.z = cvt_pk_bf16(v1[0], v1[1]); w.w = cvt_pk_bf16(v1[2], v1[3]);
                    *(u32x4*)(base + (size_t)r * D + bj * HALF + cl) = w; } }
    }
};
}

namespace att {
constexpr int QBLK = 32, KVBLK = 64;
constexpr float SCALE = 0.088388347648318440f;
constexpr float THR = 8.f;
constexpr int SHM_V = KVBLK * 128 * 2, SHM_K = KVBLK * 128 * 2;
#define KSWZ(row, colB) ((row) * 256 + ((colB) ^ (((row) & 7) << 4)))
#define SBAR() __builtin_amdgcn_sched_barrier(0)
__device__ __forceinline__ int crow(int r, int hi) { return (r & 3) + 8 * (r >> 2) + 4 * hi; }
__device__ __forceinline__ void partialSM(f32x16& p0, f32x16& p1, float& m_reg, float& mn, float& alpha) {
    constexpr float C = SCALE * 1.4426950408889634f;
    float pmax = p0[0];
#pragma unroll
    for (int r = 1; r < 16; ++r) pmax = fmaxf(pmax, p0[r]);
#pragma unroll
    for (int r = 0; r < 16; ++r) pmax = fmaxf(pmax, p1[r]);
    { auto rr = __builtin_amdgcn_permlane32_swap(__float_as_uint(pmax), __float_as_uint(pmax), false, false);
      pmax = fmaxf(__uint_as_float(rr[0]), __uint_as_float(rr[1])); }
    if (__builtin_expect(__all(pmax - m_reg <= THR / SCALE), 1)) { mn = m_reg; alpha = 1.f; }
    else { mn = fmaxf(m_reg, pmax); alpha = __builtin_amdgcn_exp2f((m_reg - mn) * C); m_reg = mn; }
    float mnC = -mn * C;
#pragma unroll
    for (int r = 0; r < 16; ++r) p0[r] = fmaf(p0[r], C, mnC);
#pragma unroll
    for (int r = 0; r < 16; ++r) p1[r] = fmaf(p1[r], C, mnC);
#pragma unroll
    for (int r = 0; r < 16; ++r) p0[r] = __builtin_amdgcn_exp2f(p0[r]);
}
__device__ __forceinline__ void finishSM(f32x16& p0, f32x16& p1, float alpha, float& l_reg, bf16x8& pa0, bf16x8& pa1, bf16x8& pa2, bf16x8& pa3) {
#pragma unroll
    for (int r = 0; r < 16; ++r) p1[r] = __builtin_amdgcn_exp2f(p1[r]);
    float ps = 0;
#pragma unroll
    for (int r = 0; r < 16; ++r) ps += p0[r];
#pragma unroll
    for (int r = 0; r < 16; ++r) ps += p1[r];
    { auto rr = __builtin_amdgcn_permlane32_swap(__float_as_uint(ps), __float_as_uint(ps), false, false);
      ps = __uint_as_float(rr[0]) + __uint_as_float(rr[1]); }
    l_reg = l_reg * alpha + ps;
#define PK4(P, BASE, OUT) do { unsigned a0 = cvt_pk_bf16(P[BASE + 0], P[BASE + 1]), a1 = cvt_pk_bf16(P[BASE + 2], P[BASE + 3]);   \
    unsigned b0 = cvt_pk_bf16(P[BASE + 4], P[BASE + 5]), b1 = cvt_pk_bf16(P[BASE + 6], P[BASE + 7]);                              \
    auto r0 = __builtin_amdgcn_permlane32_swap(a0, b0, false, false); auto r1 = __builtin_amdgcn_permlane32_swap(a1, b1, false, false); \
    u32x4 w = {r0[0], r1[0], r0[1], r1[1]}; OUT = *reinterpret_cast<bf16x8*>(&w); } while (0)
    PK4(p0, 0, pa0); PK4(p0, 8, pa1); PK4(p1, 0, pa2); PK4(p1, 8, pa3);
#undef PK4
}
__device__ __forceinline__ void qkt(f32x16& p0, f32x16& p1, const LAS unsigned char* Ks, const bf16x8* qr, int r32, int hi) {
    p0 = f32x16{}; p1 = f32x16{};
#pragma unroll
    for (int d0 = 0; d0 < 8; ++d0) { int cb = (d0 * 16 + hi * 8) * 2;
        bf16x8 b0 = *reinterpret_cast<const LAS bf16x8*>(Ks + KSWZ(r32, cb));
        bf16x8 b1 = *reinterpret_cast<const LAS bf16x8*>(Ks + KSWZ(32 + r32, cb));
        p0 = __builtin_amdgcn_mfma_f32_32x32x16_bf16(b0, qr[d0], p0, 0, 0, 0);
        p1 = __builtin_amdgcn_mfma_f32_32x32x16_bf16(b1, qr[d0], p1, 0, 0, 0); }
}
__device__ __forceinline__ int v_st(int k, int c) { const int kk = (k & ~0xC) | ((k & 4) << 1) | ((k & 8) >> 1); return ((kk >> 3) * 4 + (c >> 5)) * 512 + ((kk & 7) * 32 + (c & 31)) * 2; }
__device__ __forceinline__ int v_rd_base(int lane) { return ((lane & 3) << 3) | (((lane >> 2) & 3) << 6) | (((lane >> 4) & 1) << 5) | (((lane >> 5) & 1) << 8); }
constexpr int v_rd_off(int d0, int ks, int half) { return d0 * 512 + ks * 4096 + half * 2048; }
template <int OFF> __device__ __forceinline__ s16x4 tr_read(int vb) {
    s16x4 r; asm volatile("ds_read_b64_tr_b16 %0, %1 offset:%2" : "=&v"(r) : "v"(vb), "i"(OFF) : "memory"); return r;
}
template <int D0> __device__ __forceinline__ void pv_one(f32x16& od, int vb, bf16x8 pa0, bf16x8 pa1, bf16x8 pa2, bf16x8 pa3) {
    const s16x4 l0 = tr_read<v_rd_off(D0, 0, 0)>(vb), h0 = tr_read<v_rd_off(D0, 0, 1)>(vb), l1 = tr_read<v_rd_off(D0, 1, 0)>(vb), h1 = tr_read<v_rd_off(D0, 1, 1)>(vb);
    const s16x4 l2 = tr_read<v_rd_off(D0, 2, 0)>(vb), h2 = tr_read<v_rd_off(D0, 2, 1)>(vb), l3 = tr_read<v_rd_off(D0, 3, 0)>(vb), h3 = tr_read<v_rd_off(D0, 3, 1)>(vb);
    asm volatile("s_waitcnt lgkmcnt(0)" ::: "memory"); SBAR();
#define PK(L, H) (bf16x8){L[0], L[1], L[2], L[3], H[0], H[1], H[2], H[3]}
    od = __builtin_amdgcn_mfma_f32_32x32x16_bf16(pa0, PK(l0, h0), od, 0, 0, 0);
    od = __builtin_amdgcn_mfma_f32_32x32x16_bf16(pa1, PK(l1, h1), od, 0, 0, 0);
    od = __builtin_amdgcn_mfma_f32_32x32x16_bf16(pa2, PK(l2, h2), od, 0, 0, 0);
    od = __builtin_amdgcn_mfma_f32_32x32x16_bf16(pa3, PK(l3, h3), od, 0, 0, 0);
#undef PK
}
__device__ __forceinline__ void pv_d0(f32x16* o, int vb, bf16x8 pa0, bf16x8 pa1, bf16x8 pa2, bf16x8 pa3) {
    pv_one<0>(o[0], vb, pa0, pa1, pa2, pa3); pv_one<1>(o[1], vb, pa0, pa1, pa2, pa3); pv_one<2>(o[2], vb, pa0, pa1, pa2, pa3); pv_one<3>(o[3], vb, pa0, pa1, pa2, pa3);
}
template <int LDQ, int LDO>
__device__ __forceinline__ void attn_body(const bf16_t* __restrict__ Qb, const bf16_t* __restrict__ Kh, const bf16_t* __restrict__ Vh, bf16_t* __restrict__ Ob, int seq, LAS unsigned char* lds) {
    constexpr int LDK = 128;
    const int tid = opaque_tid(), wid = tid >> 6, lane = tid & 63, r32 = lane & 31, hi = lane >> 5;
    LAS unsigned char* V_lds = lds; LAS unsigned char* K_lds = lds + 2 * SHM_V;
    LAS float* ws = (LAS float*)(lds + 2 * SHM_V + 2 * SHM_K) + wid * 64; LAS float* li_l = ws; LAS float* al_l = ws + 32;
    float m_reg = -1e30f, l_reg = 0; f32x16 o[4] = {}; bf16x8 qr[8];
    const bf16_t* Qw = Qb + (long)(wid * QBLK + r32) * LDQ + hi * 8;
#pragma unroll
    for (int d0 = 0; d0 < 8; ++d0) qr[d0] = *reinterpret_cast<const bf16x8*>(Qw + d0 * 16);
    const int sr = tid >> 4, sc = (tid & 15) * 8, vst0 = v_st(sr, sc), vst1 = v_st(32 + sr, sc);
    const int vb0 = (int)(unsigned)(uintptr_t)V_lds + v_rd_base(lane);
    struct { bf16x8 vs0, vs1, ks0, ks1; } sr_[2];
#define SLOAD(i, k0) do { sr_[i].vs0 = *reinterpret_cast<const bf16x8*>(&Vh[(long)((k0) + sr) * LDK + sc]); sr_[i].vs1 = *reinterpret_cast<const bf16x8*>(&Vh[(long)((k0) + 32 + sr) * LDK + sc]); \
    sr_[i].ks0 = *reinterpret_cast<const bf16x8*>(&Kh[(long)((k0) + sr) * LDK + sc]); sr_[i].ks1 = *reinterpret_cast<const bf16x8*>(&Kh[(long)((k0) + 32 + sr) * LDK + sc]); } while (0)
#define SWRITE(b, i) do { *(LAS bf16x8*)(V_lds + (b) * SHM_V + vst0) = sr_[i].vs0;          \
    *(LAS bf16x8*)(V_lds + (b) * SHM_V + vst1) = sr_[i].vs1; int kc = sc * 2;               \
    *(LAS bf16x8*)(K_lds + (b) * SHM_K + KSWZ(sr, kc)) = sr_[i].ks0;                       \
    *(LAS bf16x8*)(K_lds + (b) * SHM_K + KSWZ(32 + sr, kc)) = sr_[i].ks1; } while (0)
#define SWAIT() asm volatile("s_waitcnt vmcnt(4)" ::: "memory")
#define RESC(a) do { if (__any((a) < 1.f)) { if (hi == 0) al_l[r32] = (a); asm volatile("s_waitcnt lgkmcnt(0)" ::: "memory"); \
    for (int d = 0; d < 4; ++d) for (int r = 0; r < 16; ++r) o[d][r] *= al_l[crow(r, hi)]; } } while (0)
    f32x16 pA0, pA1, pB0, pB1; float mnA, mnB, alA, alB; bf16x8 pa0, pa1, pa2, pa3; const int NT = seq / KVBLK;
    constexpr int SE = 0, SO = 1;
    SLOAD(SE, 0); asm volatile("s_waitcnt vmcnt(0)" ::: "memory"); SWRITE(0, SE); __syncthreads();
    qkt(pA0, pA1, K_lds, qr, r32, hi); partialSM(pA0, pA1, m_reg, mnA, alA);
    SLOAD(SO, KVBLK); if (2 < NT) SLOAD(SE, 2 * KVBLK);
    SWAIT(); SWRITE(1, SO); __syncthreads();
    for (int j = 1; j + 1 < NT; j += 2) {
        SBAR(); qkt(pB0, pB1, K_lds + SHM_K, qr, r32, hi);
        finishSM(pA0, pA1, alA, l_reg, pa0, pa1, pa2, pa3); SBAR();
        SLOAD(SO, (j + 2) * KVBLK); SBAR();
        pv_d0(o, vb0, pa0, pa1, pa2, pa3); partialSM(pB0, pB1, m_reg, mnB, alB);
        __syncthreads(); SWAIT(); SWRITE(0, SE);
        RESC(alB); __syncthreads();
        SBAR(); qkt(pA0, pA1, K_lds, qr, r32, hi);
        finishSM(pB0, pB1, alB, l_reg, pa0, pa1, pa2, pa3); SBAR();
        if (j + 3 < NT) SLOAD(SE, (j + 3) * KVBLK); SBAR();
        pv_d0(o, vb0 + (int)SHM_V, pa0, pa1, pa2, pa3); partialSM(pA0, pA1, m_reg, mnA, alA);
        __syncthreads(); SWAIT(); SWRITE(1, SO);
        RESC(alA); __syncthreads();
    }
    SBAR(); qkt(pB0, pB1, K_lds + SHM_K, qr, r32, hi);
    finishSM(pA0, pA1, alA, l_reg, pa0, pa1, pa2, pa3); SBAR();
    pv_d0(o, vb0, pa0, pa1, pa2, pa3); partialSM(pB0, pB1, m_reg, mnB, alB);
    __syncthreads(); RESC(alB);
    finishSM(pB0, pB1, alB, l_reg, pa0, pa1, pa2, pa3); SBAR();
    pv_d0(o, vb0 + (int)SHM_V, pa0, pa1, pa2, pa3);
    if (hi == 0) li_l[r32] = l_reg; asm volatile("s_waitcnt lgkmcnt(0)" ::: "memory");
    float rli[16];
#pragma unroll
    for (int r = 0; r < 16; ++r) rli[r] = __builtin_amdgcn_rcpf(li_l[crow(r, hi)]);
    bf16_t* Ow = Ob + (long)(wid * QBLK) * LDO;
#pragma unroll
    for (int r = 0; r < 16; ++r) { int orow = crow(r, hi);
#pragma unroll
        for (int d0 = 0; d0 < 4; ++d0) Ow[(long)orow * LDO + d0 * 32 + r32] = f2bf(o[d0][r] * rli[r]); }
#undef SLOAD
#undef SWRITE
#undef SWAIT
#undef RESC
}
}

struct KArgs { const float* in[24]; float* out; unsigned char* ws; int ph_lo, ph_hi; };
enum { I_X = 0, I_C, I_CTX, I_CCTX, I_MODW, I_MODB, I_N1G, I_N2G, I_RW, I_WG, I_WU, I_WD, I_GWIN, I_GVG, I_GSW, I_GSB, I_GWOUT, I_AWIN, I_AQG, I_AKG, I_AWOUT, I_PWIN, I_PWG, I_PSC };

struct Fr {
    volatile LAS unsigned long long* PT;
    int G, bx, vcu;
    __device__ __forceinline__ unsigned long long ldp(int i) const { const unsigned long long v = PT[i];
        const unsigned lo = __builtin_amdgcn_readfirstlane((unsigned)v), hi = __builtin_amdgcn_readfirstlane((unsigned)(v >> 32)); return ((unsigned long long)hi << 32) | lo; }
    __device__ __forceinline__ const float* in(int i) const { return (const float*)(GAS const float*)ldp(i); }
    __device__ __forceinline__ float* out() const { return (float*)(GAS float*)ldp(24); }
    __device__ __forceinline__ unsigned char* ws() const { return (unsigned char*)(GAS unsigned char*)ldp(25); }
};
#define WSP(F, T_, OFF) ((T_*)((F).ws() + (OFF)))

__device__ __forceinline__ void tr_item(const float* W, int N, int k0, int n0, bf16_t* dst, int ldt, LAS float* scr, int lane) {
#pragma unroll 8
    for (int i = 0; i < 32; ++i) { const int kk = 2 * i + (lane >> 5); scr[kk * 33 + (lane & 31)] = W[(size_t)(k0 + kk) * N + n0 + (lane & 31)]; }
    LDS_WAIT(); asm volatile("" ::: "memory");
    const int c = lane & 7;
#pragma unroll
    for (int j = 0; j < 4; ++j) { const int n = (lane >> 3) + 8 * j; const LAS float* s = scr + (8 * c) * 33 + n;
        u32x4 o; o.x = cvt_pk_bf16(s[0 * 33], s[1 * 33]); o.y = cvt_pk_bf16(s[2 * 33], s[3 * 33]); o.z = cvt_pk_bf16(s[4 * 33], s[5 * 33]); o.w = cvt_pk_bf16(s[6 * 33], s[7 * 33]);
        *(u32x4*)(dst + (size_t)n * ldt + k0 + 8 * c) = o; }
    LDS_WAIT(); asm volatile("" ::: "memory");
}

__device__ __forceinline__ void p0_phase(const Fr& F, LAS unsigned char* lds) {
    const int tid = opaque_tid(), lane = tid & 63, wave = __builtin_amdgcn_readfirstlane(tid >> 6), gw = F.bx * NWAVES + wave, NGW = F.G * NWAVES; (void)gw; (void)NGW; (void)lane; (void)wave;
    unsigned char* const ws_ = F.ws();
    float* const modv_ = (float*)(ws_ + WS_MODV);
    bf16_t* const wsw_ = (bf16_t*)(ws_ + WS_WSW);
    bf16_t* const wgin_ = (bf16_t*)(ws_ + WS_WGIN);
    bf16_t* const wgout_ = (bf16_t*)(ws_ + WS_WGOUT);
    bf16_t* const wain_ = (bf16_t*)(ws_ + WS_WAIN);
    bf16_t* const waout_ = (bf16_t*)(ws_ + WS_WAOUT);
    bf16_t* const wpin_ = (bf16_t*)(ws_ + WS_WPIN);
    bf16_t* const wpgrp_ = (bf16_t*)(ws_ + WS_WPGRP);
    bf16_t* const wup_ = (bf16_t*)(ws_ + WS_WUP);
    bf16_t* const wdn_ = (bf16_t*)(ws_ + WS_WDN);
    const float* const in_I_AWIN = F.in(I_AWIN);
    const float* const in_I_AWOUT = F.in(I_AWOUT);
    const float* const in_I_C = F.in(I_C);
    const float* const in_I_CCTX = F.in(I_CCTX);
    const float* const in_I_GSW = F.in(I_GSW);
    const float* const in_I_GWIN = F.in(I_GWIN);
    const float* const in_I_GWOUT = F.in(I_GWOUT);
    const float* const in_I_MODB = F.in(I_MODB);
    const float* const in_I_MODW = F.in(I_MODW);
    const float* const in_I_PWG = F.in(I_PWG);
    const float* const in_I_PWIN = F.in(I_PWIN);
    const float* const in_I_WD = F.in(I_WD);
    const float* const in_I_WG = F.in(I_WG);
    const float* const in_I_WU = F.in(I_WU);

    LAS float* sact = (LAS float*)lds;
    LAS float* red = (LAS float*)(lds + 49152);
    for (int idx = tid; idx < 9 * 1024; idx += NTHR) { const int r = idx >> 10, k = idx & 1023; const float v = r < 8 ? in_I_C[r * 1024 + k] : in_I_CCTX[k]; sact[k * 12 + r] = silu_f(v); }
    __syncthreads();
    for (int chunk = F.bx; chunk < 384; chunk += F.G) {
        const int layer = chunk / 96, n = (chunk % 96) * 64 + lane, k0 = wave * 128;
        const float* wp = in_I_MODW + (size_t)layer * 1024 * 6144 + (size_t)k0 * 6144 + n;
        float acc[9];
#pragma unroll
        for (int r = 0; r < 9; ++r) acc[r] = 0.f;
#pragma unroll 8
        for (int kk = 0; kk < 128; ++kk) { const float w = wp[(size_t)kk * 6144]; const LAS float* sa = sact + (k0 + kk) * 12;
#pragma unroll
            for (int r = 0; r < 9; ++r) acc[r] += sa[r] * w; }
#pragma unroll
        for (int r = 0; r < 9; ++r) red[(wave * 9 + r) * 64 + lane] = acc[r];
        __syncthreads();
        for (int idx = tid; idx < 576; idx += NTHR) { const int r = idx >> 6, l = idx & 63; float s = 0.f;
#pragma unroll
            for (int w = 0; w < 8; ++w) s += red[(w * 9 + r) * 64 + l];
            const int nn = (chunk % 96) * 64 + l; modv_[(size_t)(layer * 9 + r) * 6144 + nn] = s + in_I_MODB[layer * 6144 + nn]; }
        __syncthreads();
    }
    __syncthreads();
    LAS float* scr = (LAS float*)(lds + wave * 16384);
    constexpr int NEXP = 4 * 16 * 3 * 512, NOTH = 1024 * 2 + 512 * 2 + 768 + 512 + 512 + 128;
    for (int it = gw; it < NEXP + NOTH; it += NGW) {
        if (it < NEXP) {
            const int mat = it >> 9, sub = it & 511, l = mat / 48, rem = mat % 48, e = rem / 3, which = rem % 3, k0 = (sub >> 5) * 64, n0 = (sub & 31) * 32;
            if (which < 2) { const float* W = (which == 0 ? in_I_WG : in_I_WU) + (size_t)(l * 16 + e) * 1024 * 1024;
                bf16_t* dst = wup_ + (size_t)l * 16 * 2048 * 1024 + (size_t)((e * 8 + (n0 >> 7)) * 256 + which * 128 + (n0 & 127)) * 1024;
                tr_item(W, 1024, k0, n0, dst, 1024, scr, lane); }
            else { const float* W = in_I_WD + (size_t)(l * 16 + e) * 1024 * 1024;
                bf16_t* dst = wdn_ + (size_t)l * 16 * 1024 * 1024 + (size_t)(e * 1024 + n0) * 1024;
                tr_item(W, 1024, k0, n0, dst, 1024, scr, lane); }
        } else {
            int r = it - NEXP;
            if (r < 2048) { const int j = r >> 10, sub = r & 1023, k0 = (sub >> 6) * 64, n0 = (sub & 63) * 32;
                tr_item(in_I_GWIN + (size_t)j * 1024 * 2048, 2048, k0, n0, wgin_ + (size_t)j * 2048 * 1024 + (size_t)n0 * 1024, 1024, scr, lane); continue; } r -= 2048;
            if (r < 1024) { const int j = r >> 9, sub = r & 511, k0 = (sub >> 5) * 64, n0 = (sub & 31) * 32;
                tr_item(in_I_GWOUT + (size_t)j * 1024 * 1024, 1024, k0, n0, wgout_ + (size_t)j * 1024 * 1024 + (size_t)n0 * 1024, 1024, scr, lane); continue; } r -= 1024;
            if (r < 768) { const int k0 = (r / 48) * 64, n0 = (r % 48) * 32;
                tr_item(in_I_AWIN, 1536, k0, n0, wain_ + (size_t)n0 * 1024, 1024, scr, lane); continue; } r -= 768;
            if (r < 512) { const int k0 = (r >> 5) * 64, n0 = (r & 31) * 32;
                tr_item(in_I_AWOUT, 1024, k0, n0, waout_ + (size_t)n0 * 1024, 1024, scr, lane); continue; } r -= 512;
            if (r < 512) { const int k0 = (r >> 5) * 64, n0 = (r & 31) * 32;
                tr_item(in_I_PWIN, 1024, k0, n0, wpin_ + (size_t)n0 * 1024, 1024, scr, lane); continue; } r -= 512;
            { const int g = r >> 5, sub = r & 31, k0 = (sub >> 3) * 64, n0 = (sub & 7) * 32;
                tr_item(in_I_PWG + (size_t)g * 256 * 256, 256, k0, n0, wpgrp_ + (size_t)g * 256 * 256 + (size_t)n0 * 256, 256, scr, lane); }
        }
    }
    for (int i4 = F.bx * NTHR + tid; i4 < 2 * 8 * 128 * 128 / 4; i4 += F.G * NTHR) { const f32x4 v = *(const f32x4*)(in_I_GSW + (size_t)i4 * 4);
        u32x2 o; o.x = cvt_pk_bf16(v[0], v[1]); o.y = cvt_pk_bf16(v[2], v[3]); *(u32x2*)(wsw_ + (size_t)i4 * 4) = o; }
}

template <int R>
__device__ __forceinline__ void norm_rows(const int r0, const bool isctx, const int lane, const int layer, const int which, const int comb,
                                          const float* xsrc, float* xdst, const float* modv_, const float* ng, const int* slot_, const bf16_t* YEXP_, bf16_t* H_, float* aff_, int* slotw_, const LAS unsigned char* rwl) {
    const int rc0 = r0 - T; const int b = isctx ? (rc0 >> 8) : (r0 >> 11); const int mrow = isctx ? 8 : b;
    f32x4 v[R][4];
#pragma unroll
    for (int q = 0; q < R; ++q)
#pragma unroll
        for (int j = 0; j < 4; ++j) v[q][j] = *(const f32x4*)(xsrc + (size_t)q * D + lane * 4 + 256 * j);
#ifndef NO_NR_COMB
    if (comb >= 0) {
        int sl[R];
#pragma unroll
        for (int q = 0; q < R; ++q) sl[q] = slot_[(size_t)(r0 + q) * 16 + (lane & 15)];
        f32x4 a[R][4];
#pragma unroll
        for (int q = 0; q < R; ++q)
#pragma unroll
            for (int j = 0; j < 4; ++j) a[q][j] = (f32x4){0.f, 0.f, 0.f, 0.f};
#pragma nounroll
        for (int e = 0; e < 16; ++e) {
            u32x2 w[R][4];
#pragma unroll
            for (int q = 0; q < R; ++q) {
                const int s = __builtin_amdgcn_readlane(sl[q], e);
                if (s >= 0) {
                    const int tile = isctx ? 128 + e : e * 8 + b, rin = isctx ? (((rc0 + q) >> 8) * 32 + s) : s;
                    const bf16_t* yp = YEXP_ + ((size_t)tile * 256 + rin) * D + lane * 4;
#pragma unroll
                    for (int j = 0; j < 4; ++j) w[q][j] = *(const u32x2*)(yp + 256 * j);
                } else {
#pragma unroll
                    for (int j = 0; j < 4; ++j) w[q][j] = (u32x2){0u, 0u};
                }
            }
#pragma unroll
            for (int q = 0; q < R; ++q)
#pragma unroll
                for (int j = 0; j < 4; ++j) { a[q][j][0] += bf_lo(w[q][j].x); a[q][j][1] += bf_hi(w[q][j].x); a[q][j][2] += bf_lo(w[q][j].y); a[q][j][3] += bf_hi(w[q][j].y); }
        }
        const float* g2 = modv_ + (size_t)(comb * 9 + mrow) * 6144 + 5 * 1024 + lane * 4;
#pragma unroll
        for (int j = 0; j < 4; ++j) { const f32x4 gg = *(const f32x4*)(g2 + 256 * j);
#pragma unroll
            for (int q = 0; q < R; ++q) { v[q][j] = v[q][j] + gg * a[q][j]; *(f32x4*)(xdst + (size_t)q * D + lane * 4 + 256 * j) = v[q][j]; } }
    }
#endif
    if (which == 0) return;
    float rstd[R];
#pragma unroll
    for (int q = 0; q < R; ++q) { float ss = 0.f;
#pragma unroll
        for (int j = 0; j < 4; ++j) ss += (v[q][j][0] * v[q][j][0] + v[q][j][1] * v[q][j][1]) + (v[q][j][2] * v[q][j][2] + v[q][j][3] * v[q][j][3]);
        rstd[q] = ss; }
#pragma unroll
    for (int q = 0; q < R; ++q) rstd[q] = rsqrtf(wave_sum(rstd[q]) * (1.f / D) + EPS);
    const float* mv = modv_ + (size_t)(layer * 9 + mrow) * 6144 + (which == 2 ? 3 * 1024 : 0) + lane * 4;
#pragma unroll
    for (int j = 0; j < 4; ++j) { const f32x4 g = *(const f32x4*)(ng + lane * 4 + 256 * j), sh = *(const f32x4*)(mv + 256 * j), sc = *(const f32x4*)(mv + 1024 + 256 * j);
#pragma unroll
        for (int q = 0; q < R; ++q) { v[q][j] = (v[q][j] * rstd[q] * g) * (sc + 1.f) + sh;
            u32x2 o; o.x = cvt_pk_bf16(v[q][j][0], v[q][j][1]); o.y = cvt_pk_bf16(v[q][j][2], v[q][j][3]); *(u32x2*)(H_ + (size_t)(r0 + q) * D + lane * 4 + 256 * j) = o; } }
#ifndef NO_NR_ROUTER
    if (which == 2) {
#pragma unroll
        for (int q = 0; q < R; ++q) {
            float p[16];
#pragma unroll
            for (int e = 0; e < 16; ++e) p[e] = 0.f;
#pragma unroll
            for (int j = 0; j < 4; ++j)
#pragma unroll
                for (int i = 0; i < 4; ++i) { const int col = lane * 4 + 256 * j + i; const LAS unsigned char* rp = rwl + col * 64 + (col >> 2) * 16; const float hv = v[q][j][i];
#pragma unroll
                    for (int e4 = 0; e4 < 4; ++e4) { const f32x4 w = *(const LAS f32x4*)(rp + e4 * 16); p[e4 * 4 + 0] += hv * w[0]; p[e4 * 4 + 1] += hv * w[1]; p[e4 * 4 + 2] += hv * w[2]; p[e4 * 4 + 3] += hv * w[3]; } }
            const bool b5 = (lane & 32) != 0, b4 = (lane & 16) != 0, b3 = (lane & 8) != 0, b2 = (lane & 4) != 0;
            float k8[8], k4[4], k2[2];
#pragma unroll
            for (int e = 0; e < 8; ++e) { const float send = b5 ? p[e] : p[e + 8]; k8[e] = (b5 ? p[e + 8] : p[e]) + xor32(send, b5); }
#pragma unroll
            for (int e = 0; e < 4; ++e) { const float send = b4 ? k8[e] : k8[e + 4]; k4[e] = (b4 ? k8[e + 4] : k8[e]) + swz_xor<16>(send); }
#pragma unroll
            for (int e = 0; e < 2; ++e) { const float send = b3 ? k4[e] : k4[e + 2]; k2[e] = (b3 ? k4[e + 2] : k4[e]) + swz_xor<8>(send); }
            float lg; { const float send = b2 ? k2[0] : k2[1]; lg = (b2 ? k2[1] : k2[0]) + swz_xor<4>(send); }
            lg += swz_xor<2>(lg); lg += swz_xor<1>(lg);
            const float mx = wave_max(lg), ex = __expf(lg - mx), sum = wave_sum(ex) * 0.25f;
            const int eid = (lane >> 2) & 15;
            if ((lane & 3) == 0) aff_[(size_t)(r0 + q) * 16 + eid] = ex / sum;
            if (lane < 16) slotw_[(size_t)(r0 + q) * 16 + lane] = -1;
            asm volatile("" ::: "memory"); __builtin_amdgcn_sched_barrier(0);
        }
    }
#endif
}
__device__ __forceinline__ void norm_phase(const Fr& F, LAS unsigned char* lds, int layer, int which, int nrows, int comb, const float* xlat, const float* xctx, float* xlat_d, float* xctx_d) {
    const int tid = opaque_tid(), lane = tid & 63, wave = __builtin_amdgcn_readfirstlane(tid >> 6), gw = F.bx * NWAVES + wave, NGW = F.G * NWAVES;
    unsigned char* const ws_ = F.ws();
    float* const modv_ = (float*)(ws_ + WS_MODV); float* const aff_ = (float*)(ws_ + WS_AFF); int* const slot_ = (int*)(ws_ + WS_SLOT);
    bf16_t* const H_ = (bf16_t*)(ws_ + WS_H); bf16_t* const YEXP_ = (bf16_t*)(ws_ + WS_YEXP);
    LAS unsigned char* rwl = lds;
    if (which == 2) {
        const float* rw = F.in(I_RW) + (size_t)layer * 1024 * 16;
        for (int idx = tid; idx < 4096; idx += NTHR) { const int col = idx >> 2, e4 = idx & 3; *(LAS f32x4*)(rwl + col * 64 + (col >> 2) * 16 + e4 * 16) = *(const f32x4*)(rw + col * 16 + e4 * 4); }
        __syncthreads();
    }
    const float* ng = F.in(which == 2 ? I_N2G : I_N1G) + (size_t)layer * 1024;
#pragma nounroll
    for (int g4 = gw; g4 < T / 4; g4 += NGW) { const int r0 = g4 * 4;
        norm_rows<4>(r0, false, lane, layer, which, comb, xlat + (size_t)r0 * D, xlat_d + (size_t)r0 * D, modv_, ng, slot_, YEXP_, H_, aff_, slot_, rwl); }
    if (nrows > T) {
#pragma nounroll
        for (int r = T + gw; r < nrows; r += NGW)
            norm_rows<1>(r, true, lane, layer, which, comb, xctx + (size_t)(r - T) * D, xctx_d + (size_t)(r - T) * D, modv_, ng, slot_, YEXP_, H_, aff_, slot_, rwl);
    }
}

__device__ __forceinline__ void topk_phase(const Fr& F, LAS unsigned char* lds, bool with_ctx) {
    const int tid = opaque_tid();
    unsigned char* const ws_ = F.ws();
    float* const aff_ = (float*)(ws_ + WS_AFF); int* const slot_ = (int*)(ws_ + WS_SLOT); float* const gate_ = (float*)(ws_ + WS_GATE);
    int* const idx_ = (int*)(ws_ + WS_IDX);
    LAS unsigned long long* key = (LAS unsigned long long*)lds;
    const int nunits = with_ctx ? 256 : 128;
    for (int u = F.bx; u < nunits; u += F.G) {
        const bool isctx = u >= 128; const int uu = isctx ? u - 128 : u, e = uu >> 3, b = uu & 7;
        const int N = isctx ? CL : SEQ, cap = isctx ? CCAP : CAP, row0 = isctx ? T + b * CL : b * SEQ;
        for (int s = tid; s < N; s += NTHR) { const unsigned bits = __float_as_uint(aff_[(size_t)(row0 + s) * 16 + e]); key[s] = ((unsigned long long)bits << 32) | (unsigned)(N - 1 - s); }
        __syncthreads();
        for (int k = 2; k <= N; k <<= 1)
            for (int j = k >> 1; j > 0; j >>= 1) {
                for (int p = tid; p < N / 2; p += NTHR) { const int i = ((p & ~(j - 1)) << 1) | (p & (j - 1)), l = i | j;
                    const unsigned long long a = key[i], c = key[l]; const bool desc = (i & k) == 0;
                    if ((a < c) == desc) { key[i] = c; key[l] = a; } }
                __syncthreads();
            }
        const int tile = isctx ? 128 + e : uu, rbase = isctx ? b * 32 : 0;
        if (tid < cap) { const unsigned long long kk = key[tid]; const int s = N - 1 - (int)(unsigned)(kk & 0xffffffffu);
            idx_[(size_t)tile * 256 + rbase + tid] = row0 + s;
            gate_[(size_t)tile * 256 + rbase + tid] = __uint_as_float((unsigned)(kk >> 32));
            slot_[(size_t)(row0 + s) * 16 + e] = tid; }
        __syncthreads();
    }
}

template <int OFF> __device__ __forceinline__ s16x4 sp_tr_read(int vb) {
    s16x4 r; asm volatile("ds_read_b64_tr_b16 %0, %1 offset:%2" : "=&v"(r) : "v"(vb), "i"(OFF) : "memory"); return r;
}
template <int KS> __device__ __forceinline__ void sp_kstep(f32x16& acc0, f32x16& acc1, const LAS bf16_t* Ap, int vb) {
    constexpr int LDB2 = 320;
    const bf16x8 a = *(const LAS bf16x8*)(Ap + KS * 16);
    const s16x4 l0 = sp_tr_read<(16 * KS) * LDB2>(vb), h0 = sp_tr_read<(16 * KS + 4) * LDB2>(vb);
    const s16x4 l1 = sp_tr_read<(16 * KS) * LDB2 + 64>(vb), h1 = sp_tr_read<(16 * KS + 4) * LDB2 + 64>(vb);
    asm volatile("s_waitcnt lgkmcnt(0)" ::: "memory"); __builtin_amdgcn_sched_barrier(0);
    const bf16x8 b0 = (bf16x8){l0[0], l0[1], l0[2], l0[3], h0[0], h0[1], h0[2], h0[3]};
    const bf16x8 b1 = (bf16x8){l1[0], l1[1], l1[2], l1[3], h1[0], h1[1], h1[2], h1[3]};
    acc0 = __builtin_amdgcn_mfma_f32_32x32x16_bf16(b0, a, acc0, 0, 0, 0);
    acc1 = __builtin_amdgcn_mfma_f32_32x32x16_bf16(b1, a, acc1, 0, 0, 0);
}
__device__ __forceinline__ void spatial_phase(const Fr& F, LAS unsigned char* lds, int j, int nunits) {
    const int tid = opaque_tid(), lane = tid & 63, wave = __builtin_amdgcn_readfirstlane(tid >> 6);
    unsigned char* const ws_ = F.ws();
    const bf16_t* const wsw_ = (const bf16_t*)(ws_ + WS_WSW); const bf16_t* const S1_ = (const bf16_t*)(ws_ + WS_S1); bf16_t* const S2_ = (bf16_t*)(ws_ + WS_S2);
    constexpr int LDA = 136, LDB = 160;
    LAS float* stat = (LAS float*)lds;
    LAS bf16_t* As = (LAS bf16_t*)(lds + 1024);
    LAS bf16_t* Bs = (LAS bf16_t*)(lds + 1024 + 128 * LDA * 2);
    const float* vg = F.in(I_GVG) + (size_t)j * 1024; const float* sb = F.in(I_GSB) + (size_t)j * 8 * 128;
    const bf16_t* sw = wsw_ + (size_t)j * 8 * 128 * 128;
    const int r32 = lane & 31, hi = lane >> 5;
    const int pw = (wave >> 1) * 32, dw = (wave & 1) * 64;
    const LAS bf16_t* Ap = As + (pw + r32) * LDA + hi * 8;
    const int vb = (int)(unsigned)(uintptr_t)Bs + (8 * hi + ((lane & 15) >> 2)) * (LDB * 2) + (dw + 16 * ((lane >> 4) & 1) + 4 * (lane & 3)) * 2;
    for (int u = F.bx; u < nunits; u += F.G) {
        const int r0 = u * 128;
#pragma nounroll
        for (int rr = wave * 16; rr < wave * 16 + 16; rr += 4) {
            u32x4 w0[4], w1[4];
#pragma unroll
            for (int q = 0; q < 4; ++q) { const bf16_t* vp = S1_ + (size_t)(r0 + rr + q) * 2048 + 1024 + lane * 8; w0[q] = *(const u32x4*)vp; w1[q] = *(const u32x4*)(vp + 512); }
            float s1[4], s2[4];
#pragma unroll
            for (int q = 0; q < 4; ++q) { float a = 0.f, c = 0.f;
#pragma unroll
                for (int i = 0; i < 4; ++i) { const float x0 = bf_lo(w0[q][i]), x1 = bf_hi(w0[q][i]), x2 = bf_lo(w1[q][i]), x3 = bf_hi(w1[q][i]); a += (x0 + x1) + (x2 + x3); c += (x0 * x0 + x1 * x1) + (x2 * x2 + x3 * x3); }
                s1[q] = a; s2[q] = c; }
#pragma unroll
            for (int q = 0; q < 4; ++q) { s1[q] = wave_sum(s1[q]); s2[q] = wave_sum(s2[q]); }
#pragma unroll
            for (int q = 0; q < 4; ++q) { const float mean = s1[q] * (1.f / 1024.f), var = fmaxf(s2[q] * (1.f / 1024.f) - mean * mean, 0.f);
                if (lane == 0) { stat[(rr + q) * 2] = mean; stat[(rr + q) * 2 + 1] = rsqrtf(var + EPS); } }
        }
        __syncthreads();
#pragma nounroll
        for (int g = 0; g < 8; ++g) {
#pragma unroll
            for (int i = 0; i < 4; ++i) { const int id = tid + NTHR * i, p = id >> 4, qc = id & 15;
                *(LAS u32x4*)(As + p * LDA + qc * 8) = *(const u32x4*)(sw + (size_t)g * 128 * 128 + p * 128 + qc * 8); }
            u32x4 wv[4];
#pragma unroll
            for (int i = 0; i < 4; ++i) { const int id = tid + NTHR * i, q = id >> 4, dc = id & 15; wv[i] = *(const u32x4*)(S1_ + (size_t)(r0 + q) * 2048 + 1024 + g * 128 + dc * 8); }
            { const int dc = tid & 15; const f32x4 g0 = *(const f32x4*)(vg + g * 128 + dc * 8), g1 = *(const f32x4*)(vg + g * 128 + dc * 8 + 4);
#pragma unroll
              for (int i = 0; i < 4; ++i) { const int id = tid + NTHR * i, q = id >> 4; const float mean = stat[q * 2], rstd = stat[q * 2 + 1];
                float x[8];
#pragma unroll
                for (int k = 0; k < 4; ++k) { x[2 * k] = (bf_lo(wv[i][k]) - mean) * rstd; x[2 * k + 1] = (bf_hi(wv[i][k]) - mean) * rstd; }
                u32x4 o; o.x = cvt_pk_bf16(x[0] * g0[0], x[1] * g0[1]); o.y = cvt_pk_bf16(x[2] * g0[2], x[3] * g0[3]); o.z = cvt_pk_bf16(x[4] * g1[0], x[5] * g1[1]); o.w = cvt_pk_bf16(x[6] * g1[2], x[7] * g1[3]);
                *(LAS u32x4*)(Bs + q * LDB + dc * 8) = o; } }
            __syncthreads();
            f32x16 acc0 = {}, acc1 = {};
            sp_kstep<0>(acc0, acc1, Ap, vb); sp_kstep<1>(acc0, acc1, Ap, vb); sp_kstep<2>(acc0, acc1, Ap, vb); sp_kstep<3>(acc0, acc1, Ap, vb);
            sp_kstep<4>(acc0, acc1, Ap, vb); sp_kstep<5>(acc0, acc1, Ap, vb); sp_kstep<6>(acc0, acc1, Ap, vb); sp_kstep<7>(acc0, acc1, Ap, vb);
            const int p = pw + r32; const float bias = sb[g * 128 + p];
            const size_t ro = (size_t)(r0 + p); const int c0 = g * 128 + dw + 4 * hi;
            u32x2 uu[2][4];
#pragma unroll
            for (int t = 0; t < 4; ++t) { uu[0][t] = *(const u32x2*)(S1_ + ro * 2048 + c0 + 8 * t); uu[1][t] = *(const u32x2*)(S1_ + ro * 2048 + c0 + 32 + 8 * t); }
#pragma unroll
            for (int t = 0; t < 4; ++t) {
                u32x2 o0, o1;
                o0.x = cvt_pk_bf16((acc0[4 * t] + bias) * bf_lo(uu[0][t].x), (acc0[4 * t + 1] + bias) * bf_hi(uu[0][t].x)); o0.y = cvt_pk_bf16((acc0[4 * t + 2] + bias) * bf_lo(uu[0][t].y), (acc0[4 * t + 3] + bias) * bf_hi(uu[0][t].y));
                o1.x = cvt_pk_bf16((acc1[4 * t] + bias) * bf_lo(uu[1][t].x), (acc1[4 * t + 1] + bias) * bf_hi(uu[1][t].x)); o1.y = cvt_pk_bf16((acc1[4 * t + 2] + bias) * bf_lo(uu[1][t].y), (acc1[4 * t + 3] + bias) * bf_hi(uu[1][t].y));
                *(u32x2*)(S2_ + ro * D + c0 + 8 * t) = o0; *(u32x2*)(S2_ + ro * D + c0 + 32 + 8 * t) = o1; }
            __syncthreads();
        }
    }
}

__device__ __forceinline__ void qknorm_phase(const Fr& F) {
    const int tid = opaque_tid(), lane = tid & 63, wave = __builtin_amdgcn_readfirstlane(tid >> 6), gw = F.bx * NWAVES + wave, NGW = F.G * NWAVES;
    unsigned char* const ws_ = F.ws();
    const bf16_t* const S1_ = (const bf16_t*)(ws_ + WS_S1); bf16_t* const QB_ = (bf16_t*)(ws_ + WS_QB); bf16_t* const KB_ = (bf16_t*)(ws_ + WS_KB);
    const float* qg = F.in(I_AQG); const float* kg = F.in(I_AKG);
    const int hsel = lane >> 5, l5 = lane & 31;
    const f32x2 qg0 = *(const f32x2*)(qg + 2 * l5), qg1 = *(const f32x2*)(qg + 64 + 2 * l5), kg0 = *(const f32x2*)(kg + 2 * l5), kg1 = *(const f32x2*)(kg + 64 + 2 * l5);
    const float inv0 = exp2f(-(float)((2 * l5) & 31) * (13.287712379549449f / 32.f)), inv1 = exp2f(-(float)((2 * l5 + 1) & 31) * (13.287712379549449f / 32.f));
#pragma nounroll
    for (int g2 = gw; g2 < T / 2; g2 += NGW) {
        const int r0 = g2 * 2, b = r0 >> 11;
        unsigned u0[2][5], u1[2][5];
#pragma unroll
        for (int q = 0; q < 2; ++q)
#pragma unroll
            for (int ps = 0; ps < 5; ++ps) { const int hh = 2 * ps + hsel; const bf16_t* src = S1_ + (size_t)(r0 + q) * 2048 + (hh < 8 ? hh * 128 : 1024 + (hh - 8) * 128) + 2 * l5;
                u0[q][ps] = *(const unsigned*)src; u1[q][ps] = *(const unsigned*)(src + 64); }
#pragma unroll
        for (int q = 0; q < 2; ++q) {
            const int s = (r0 + q) & (SEQ - 1); const float pos = (float)(l5 < 16 ? (s >> 6) : (s & 63));
            float c0, s0, c1, s1; __sincosf(pos * inv0, &s0, &c0); __sincosf(pos * inv1, &s1, &c1);
            { c0 = cosf(pos * inv0); s0 = sinf(pos * inv0); c1 = cosf(pos * inv1); s1 = sinf(pos * inv1); }
#pragma unroll
            for (int ps = 0; ps < 5; ++ps) { const int hh = 2 * ps + hsel; const bool isk = ps == 4;
                float a0 = bf_lo(u0[q][ps]), a1 = bf_hi(u0[q][ps]), e0 = bf_lo(u1[q][ps]), e1 = bf_hi(u1[q][ps]);
                const float rs = rsqrtf(half_sum((a0 * a0 + a1 * a1) + (e0 * e0 + e1 * e1)) * (1.f / 128.f) + EPS);
                const f32x2 ga = isk ? kg0 : qg0, gb = isk ? kg1 : qg1;
                a0 *= rs * ga.x; a1 *= rs * ga.y; e0 *= rs * gb.x; e1 *= rs * gb.y;
                const float o10 = a0 * c0 - e0 * s0, o11 = a1 * c1 - e1 * s1, o20 = a0 * s0 + e0 * c0, o21 = a1 * s1 + e1 * c1;
                bf16_t* dst = isk ? KB_ + ((size_t)(b * 2 + (hh - 8)) * SKV + CL + s) * 128 + 2 * l5 : QB_ + (size_t)(r0 + q) * D + hh * 128 + 2 * l5;
                *(unsigned*)dst = cvt_pk_bf16(o10, o11); *(unsigned*)(dst + 64) = cvt_pk_bf16(o20, o21); }
        }
    }
#pragma nounroll
    for (int rc = gw; rc < TC; rc += NGW) {
        const int b = rc >> 8, s = rc & (CL - 1);
        const bf16_t* src = S1_ + (size_t)(T + rc) * 2048 + 1024 + hsel * 128 + 2 * l5;
        const unsigned u0 = *(const unsigned*)src, u1 = *(const unsigned*)(src + 64);
        float a0 = bf_lo(u0), a1 = bf_hi(u0), e0 = bf_lo(u1), e1 = bf_hi(u1);
        const float rs = rsqrtf(half_sum((a0 * a0 + a1 * a1) + (e0 * e0 + e1 * e1)) * (1.f / 128.f) + EPS);
        bf16_t* dst = KB_ + ((size_t)(b * 2 + hsel) * SKV + s) * 128 + 2 * l5;
        *(unsigned*)dst = cvt_pk_bf16(a0 * rs * kg0.x, a1 * rs * kg0.y); *(unsigned*)(dst + 64) = cvt_pk_bf16(e0 * rs * kg1.x, e1 * rs * kg1.y);
    }
}

template <int W> __device__ __forceinline__ void pool_item(const bf16_t* zb  , int s, bf16_t* dst) {
    constexpr int half = W / 2;
    u32x4 w[W];
#pragma unroll
    for (int k = 0; k < W; ++k) { int t = s - half + k; t = t < 0 ? 0 : (t > SEQ - 1 ? SEQ - 1 : t); w[k] = *(const u32x4*)(zb + (size_t)t * 2048); }
    float acc[8];
#pragma unroll
    for (int c = 0; c < 8; ++c) acc[c] = 0.f;
#pragma unroll
    for (int k = 0; k < W; ++k) { const int t = s - half + k; const float m = (t >= 0 && t < SEQ) ? 1.f : 0.f;
#pragma unroll
        for (int c = 0; c < 4; ++c) { acc[2 * c] += m * bf_lo(w[k][c]); acc[2 * c + 1] += m * bf_hi(w[k][c]); } }
    const int lo = s - half < 0 ? 0 : s - half, hi = s + half - 1 > SEQ - 1 ? SEQ - 1 : s + half - 1; const float ic = 1.f / (float)(hi - lo + 1);
    const u32x4 zc = w[half];
    float o[8];
#pragma unroll
    for (int c = 0; c < 4; ++c) { o[2 * c] = acc[2 * c] * ic - bf_lo(zc[c]); o[2 * c + 1] = acc[2 * c + 1] * ic - bf_hi(zc[c]); }
    u32x4 ov; ov.x = cvt_pk_bf16(o[0], o[1]); ov.y = cvt_pk_bf16(o[2], o[3]); ov.z = cvt_pk_bf16(o[4], o[5]); ov.w = cvt_pk_bf16(o[6], o[7]);
    *(u32x4*)dst = ov;
}
__device__ __forceinline__ void pool_phase(const Fr& F) {
    const int tid = opaque_tid(), lane = tid & 63, wave = __builtin_amdgcn_readfirstlane(tid >> 6);
    unsigned char* const ws_ = F.ws();
    const bf16_t* const S1_ = (const bf16_t*)(ws_ + WS_S1); bf16_t* const S2_ = (bf16_t*)(ws_ + WS_S2);
    const int gi = wave & 3, c8 = gi * 32 + (lane & 31), rsub = (wave >> 2) * 2 + (lane >> 5);
#pragma nounroll
    for (int r4 = F.bx; r4 < T / 4; r4 += F.G) {
        const int r = r4 * 4 + rsub, s = r & (SEQ - 1);
        const bf16_t* zb = S1_ + (size_t)(r - s) * 2048 + c8 * 8; bf16_t* dst = S2_ + (size_t)r * D + c8 * 8;
        if (gi == 0) pool_item<2>(zb, s, dst); else if (gi == 1) pool_item<4>(zb, s, dst); else if (gi == 2) pool_item<8>(zb, s, dst); else pool_item<16>(zb, s, dst);
    }
}

__global__ void __launch_bounds__(NTHR, 2) fwd_kernel(KArgs args) {
    extern __shared__ __attribute__((aligned(16))) unsigned char lds_raw[];
    LAS unsigned char* lds = (LAS unsigned char*)lds_raw;
    volatile LAS unsigned* MISC = (volatile LAS unsigned*)(lds + MISC_OFF);
    Fr F;
    F.PT = (volatile LAS unsigned long long*)(lds + MISC_OFF + 256);
    F.G = gridDim.x; F.bx = blockIdx.x; F.vcu = (F.G % 8 == 0) ? (F.bx % 8) * (F.G / 8) + F.bx / 8 : F.bx;
    { const int t0 = threadIdx.x;
      if (t0 < 64) MISC[t0] = 0u;
      if (t0 < 24) F.PT[t0] = (unsigned long long)args.in[t0];
      if (t0 == 24) F.PT[24] = (unsigned long long)args.out;
      if (t0 == 25) F.PT[25] = (unsigned long long)args.ws; }
    __syncthreads();
    XcdBarrier bar = xcd_barrier_post((unsigned*)(F.ws() + WS_CTL), MISC + 8);
    const int lo = args.ph_lo, hi = args.ph_hi;
    int p = 0;
#define RUN(...) RUNC(31, __VA_ARGS__)
#define RUNC(cls, ...) do { if (lo <= p && p < hi) { _Pragma("nounroll") for (int rep_ = 0; rep_ < 1 + (int)((REPEAT_MASK >> (cls)) & 1u); ++rep_) { __VA_ARGS__; if (REPEAT_MASK) __syncthreads(); } if (p + 1 < hi) xcd_barrier(bar); } ++p; } while (0)

#ifndef NO_P0
    RUNC(0, p0_phase(F, lds));
#endif
#pragma nounroll
    for (int L = 0; L < 4; ++L) {
        const int kind = L % 3, jm = L / 3;
        const bool with_ctx = (L == 0);
        RUN({
            float* xo = F.out(); float* xc = WSP(F, float, WS_XC);
#ifndef NO_NORM
            norm_phase(F, lds, L, 1, (L <= 1) ? TT : T, L - 1, (L == 0) ? F.in(I_X) : xo, (L == 0) ? F.in(I_CTX) : xc, xo, xc);
#endif
        });
        RUNC(2, {
            unsigned char* ws = F.ws();
            pg8::SchedDense S; S.A = (bf16_t*)(ws + WS_H); S.G = F.G; S.c = F.bx; S.a_pn_stride = 0; S.a_pm_stride = 256 * D; S.b_pn_stride = 256 * D; S.extra = 0;
            pg8::EpiA E; E.O = (bf16_t*)(ws + WS_S1); E.ldc = 2048; E.act = 0; E.VB = nullptr;
            if (kind == 0) { S.Bt = (bf16_t*)(ws + WS_WGIN) + (size_t)jm * 2048 * 1024; S.nM = with_ctx ? 72 : 64; S.nN = 8; E.act = 1; }
            else if (kind == 1) { S.Bt = (bf16_t*)(ws + WS_WAIN); S.nM = 64; S.nN = 6; S.extra = 16; E.VB = (bf16_t*)(ws + WS_VB); }
            else { S.Bt = (bf16_t*)(ws + WS_WPIN); S.nM = 64; S.nN = 4; }
            S.nwg = S.nM * S.nN;
            #ifndef NO_GA
            pg8::gemm_phase<pg8::EpiA, pg8::SchedDense>(lds, D, D, D, S, E);
#endif
        });
        if (kind == 0) {
#ifndef NO_SPAT
            RUNC(3, spatial_phase(F, lds, jm, with_ctx ? 144 : 128));
#endif
        }
        else if (kind == 1) {
#ifndef NO_QKN
            RUNC(4, qknorm_phase(F));
#endif
            RUNC(5, {
                unsigned char* ws = F.ws();
                const bf16_t* QB = (const bf16_t*)(ws + WS_QB); const bf16_t* KB = (const bf16_t*)(ws + WS_KB); const bf16_t* VB = (const bf16_t*)(ws + WS_VB); bf16_t* S2 = (bf16_t*)(ws + WS_S2);
                for (int i = 0; i * F.G + F.vcu < 512; ++i) { const int Lu = i * F.G + F.vcu, bk = Lu >> 5, w = Lu & 31, b = bk >> 1, kvh = bk & 1, h = kvh * 4 + (w >> 3), qb = w & 7;
#ifndef NO_ATT
                    att::attn_body<D, D>(QB + ((size_t)(b * SEQ + qb * 256)) * D + h * 128, KB + (size_t)bk * SKV * 128, VB + (size_t)bk * SKV * 128,
                                         S2 + ((size_t)(b * SEQ + qb * 256)) * D + h * 128, SKV, lds);
#endif
                    __syncthreads(); }
            });
        } else {
#ifndef NO_POOL
            RUNC(6, pool_phase(F));
#endif
        }
        RUN({
            unsigned char* ws = F.ws();
            pg8::SchedDense S; S.A = (bf16_t*)(ws + WS_S2); S.G = F.G; S.c = F.bx; S.a_pm_stride = 256 * D; S.a_pn_stride = 0; S.b_pn_stride = 256 * D; S.extra = 0; S.nN = 4; S.nM = 64;
            pg8::EpiB E; E.xd_lat = F.out(); E.xd_ctx = (float*)(ws + WS_XC); E.xs_lat = (L == 0) ? F.in(I_X) : E.xd_lat; E.xs_ctx = (L == 0) ? F.in(I_CTX) : E.xd_ctx;
            E.gt = (const float*)(ws + WS_MODV) + (size_t)L * 9 * 6144 + 2 * 1024; E.colscale = nullptr;
            int K = D, ldb = D;
            if (kind == 0) { S.Bt = (bf16_t*)(ws + WS_WGOUT) + (size_t)jm * 1024 * 1024; S.nM = with_ctx ? 72 : 64; }
            else if (kind == 1) { S.Bt = (bf16_t*)(ws + WS_WAOUT); }
            else { S.Bt = (bf16_t*)(ws + WS_WPGRP); S.a_pn_stride = 256; S.b_pn_stride = 256 * 256; K = 256; ldb = 256; E.colscale = F.in(I_PSC); }
            S.nwg = S.nM * S.nN;
            #ifndef NO_GB
            pg8::gemm_phase<pg8::EpiB, pg8::SchedDense>(lds, K, D, ldb, S, E);
#endif
        });
        RUNC(8, {
            float* xo = F.out(); float* xc = WSP(F, float, WS_XC);
#ifndef NO_NORM
            norm_phase(F, lds, L, 2, with_ctx ? TT : T, -1, xo, xc, xo, xc);
#endif
        });
#ifndef NO_TOPK
        RUNC(9, topk_phase(F, lds, with_ctx));
#endif
        RUNC(10, {
            unsigned char* ws = F.ws();
            pg8::SchedMoE<true> S; S.A = (bf16_t*)(ws + WS_H); S.IDX = (const int*)(ws + WS_IDX); S.Bt = (bf16_t*)(ws + WS_WUP) + (size_t)L * 16 * 2048 * 1024; S.nbt = with_ctx ? 9 : 8; S.nn = 8; S.G = F.G; S.vcu = F.vcu;
            pg8::EpiC E; E.HID = (bf16_t*)(ws + WS_HID);
            #ifndef NO_GC
            pg8::gemm_phase<pg8::EpiC, pg8::SchedMoE<true>>(lds, D, D, D, S, E);
#endif
        });
        RUNC(11, {
            unsigned char* ws = F.ws();
            pg8::SchedMoE<false> S; S.A = (bf16_t*)(ws + WS_HID); S.IDX = nullptr; S.Bt = (bf16_t*)(ws + WS_WDN) + (size_t)L * 16 * 1024 * 1024; S.nbt = with_ctx ? 9 : 8; S.nn = 4; S.G = F.G; S.vcu = F.vcu;
            pg8::EpiD E; E.Y = (bf16_t*)(ws + WS_YEXP); E.gate = (const float*)(ws + WS_GATE);
            #ifndef NO_GD
            pg8::gemm_phase<pg8::EpiD, pg8::SchedMoE<false>>(lds, D, D, D, S, E);
#endif
        });
    }
    RUN({
        float* xo = F.out(); float* xc = WSP(F, float, WS_XC);
#ifndef NO_NORM
        norm_phase(F, lds, 3, 0, T, 3, xo, xc, xo, xc);
#endif
    });
#undef RUN
#undef RUNC
}

constexpr int N_PHASES = 1 + 8 + 9 + 8 + 8 + 1;

extern "C" void kernel_launch(void* const* d_in, const int* in_sizes, int n_in, void* d_out, int out_size, void* d_ws, size_t ws_size, hipStream_t stream) {
    static int grid = 0;
    if (grid == 0) {
        if (n_in != 24 || out_size != T * D || ws_size < WS_END) { fprintf(stderr, "kernel_launch: unexpected shapes (n_in %d out %d ws %zu need %zu)\n", n_in, out_size, ws_size, (size_t)WS_END); grid = -1; return; }
        int dev = 0, cus = 0;
        if (hipGetDevice(&dev) != hipSuccess || hipDeviceGetAttribute(&cus, hipDeviceAttributeMultiprocessorCount, dev) != hipSuccess) { grid = -1; return; }
        if (hipFuncSetAttribute((const void*)fwd_kernel, hipFuncAttributeMaxDynamicSharedMemorySize, LDS_BYTES) != hipSuccess) { fprintf(stderr, "kernel_launch: hipFuncSetAttribute failed\n"); grid = -1; return; }
        (void)hipGetLastError();
        grid = cus;
    }
    if (grid < 0) return;
    (void)hipMemsetAsync((char*)d_ws + WS_CTL, 0, CTL_BYTES, stream);
    KArgs a{};
    for (int i = 0; i < 24; ++i) a.in[i] = (const float*)d_in[i];
    a.out = (float*)d_out; a.ws = (unsigned char*)d_ws;
#if MK_PER_PHASE
    for (int k = 0; k < N_PHASES; ++k) { a.ph_lo = k; a.ph_hi = k + 1; hipLaunchKernelGGL(fwd_kernel, dim3(grid), dim3(NTHR), LDS_BYTES, stream, a); }
#else
    a.ph_lo = 0; a.ph_hi = N_PHASES;
    hipLaunchKernelGGL(fwd_kernel, dim3(grid), dim3(NTHR), LDS_BYTES, stream, a);
#endif
    const hipError_t le = hipPeekAtLastError();
    if (le != hipSuccess) fprintf(stderr, "kernel_launch: launch failed: %s\n", hipGetErrorName(le));
}
```

```cpp
#include <hip/hip_runtime.h>
#include <cstdio>
#include <cstdint>

#ifndef REPEAT_MASK
#define REPEAT_MASK 0u
#endif
#ifndef MK_PER_PHASE
#define MK_PER_PHASE 0
#endif

#define LAS __attribute__((address_space(3)))
#define GAS __attribute__((address_space(1)))
typedef unsigned short bf16_t;
typedef short bf16x8 __attribute__((ext_vector_type(8)));
typedef short s16x4 __attribute__((ext_vector_type(4)));
typedef float f32x2 __attribute__((ext_vector_type(2)));
typedef float f32x4 __attribute__((ext_vector_type(4)));
typedef float f32x16 __attribute__((ext_vector_type(16)));
typedef unsigned u32x2 __attribute__((ext_vector_type(2)));
typedef unsigned u32x4 __attribute__((ext_vector_type(4)));

constexpr int D = 1024, NB = 8, SEQ = 2048, T = NB * SEQ, CL = 256, TC = NB * CL, TT = T + TC, NE = 16, CAP = 256, CCAP = 32, NTILE = 144;
constexpr int SKV = CL + SEQ;
constexpr float EPS = 1e-6f;
constexpr int NWAVES = 8, NTHR = 512;

constexpr size_t al256(size_t x) { return (x + 255) / 256 * 256; }
constexpr size_t WS_CTL   = 0;
constexpr size_t CTL_BYTES = 65536;
constexpr size_t WS_MODV  = WS_CTL + CTL_BYTES;
constexpr size_t WS_AFF   = WS_MODV + al256((size_t)4 * 9 * 6144 * 4);
constexpr size_t WS_SLOT  = WS_AFF + (size_t)TT * 16 * 4;
constexpr size_t WS_GATE  = WS_SLOT + (size_t)TT * 16 * 4;
constexpr size_t WS_WSW   = WS_GATE + (size_t)NTILE * 256 * 4;
constexpr size_t WS_WGIN  = WS_WSW + (size_t)2 * 8 * 128 * 128 * 2;
constexpr size_t WS_WGOUT = WS_WGIN + (size_t)2 * 2048 * 1024 * 2;
constexpr size_t WS_WAIN  = WS_WGOUT + (size_t)2 * 1024 * 1024 * 2;
constexpr size_t WS_WAOUT = WS_WAIN + (size_t)1536 * 1024 * 2;
constexpr size_t WS_WPIN  = WS_WAOUT + (size_t)1024 * 1024 * 2;
constexpr size_t WS_WPGRP = WS_WPIN + (size_t)1024 * 1024 * 2;
constexpr size_t WS_WUP   = WS_WPGRP + (size_t)4 * 256 * 256 * 2;
constexpr size_t WS_WDN   = WS_WUP + (size_t)4 * 16 * 2048 * 1024 * 2;
constexpr size_t WS_XC    = WS_WDN + (size_t)4 * 16 * 1024 * 1024 * 2;
constexpr size_t WS_H     = WS_XC + (size_t)TC * D * 4;
constexpr size_t WS_S1    = WS_H + (size_t)TT * D * 2;
constexpr size_t WS_S2    = WS_S1 + (size_t)TT * 2048 * 2;
constexpr size_t WS_QB    = WS_S2 + (size_t)TT * D * 2;
constexpr size_t WS_KB    = WS_QB + (size_t)T * D * 2;
constexpr size_t WS_VB    = WS_KB + (size_t)NB * 2 * SKV * 128 * 2;
constexpr size_t WS_IDX   = WS_VB + (size_t)NB * 2 * SKV * 128 * 2;
constexpr size_t WS_HID   = WS_IDX + (size_t)NTILE * 256 * 4;
constexpr size_t WS_YEXP  = WS_HID + (size_t)NTILE * 256 * D * 2;
constexpr size_t WS_END   = WS_YEXP + (size_t)NTILE * 256 * D * 2;

constexpr int RING_BYTES = 131072, MISC_OFF = RING_BYTES, LDS_BYTES = RING_BYTES + 1024;

__device__ __forceinline__ unsigned cvt_pk_bf16(float lo, float hi) { unsigned r; asm volatile("v_cvt_pk_bf16_f32 %0, %1, %2" : "=v"(r) : "v"(lo), "v"(hi)); return r; }
__device__ __forceinline__ float bf_lo(unsigned u) { return __uint_as_float(u << 16); }
__device__ __forceinline__ float bf_hi(unsigned u) { return __uint_as_float(u & 0xffff0000u); }
__device__ __forceinline__ float bf2f(bf16_t b) { return __uint_as_float(((unsigned)b) << 16); }
__device__ __forceinline__ bf16_t f2bf(float f) { return (bf16_t)(cvt_pk_bf16(f, 0.f) & 0xffffu); }
template <int K> __device__ __forceinline__ float swz_xor(float v) { return __int_as_float(__builtin_amdgcn_ds_swizzle(__float_as_int(v), 0x1F | (K << 10))); }
__device__ __forceinline__ float half_sum(float v) { v += swz_xor<1>(v); v += swz_xor<2>(v); v += swz_xor<4>(v); v += swz_xor<8>(v); v += swz_xor<16>(v); return v; }
__device__ __forceinline__ float half_max(float v) { v = fmaxf(v, swz_xor<1>(v)); v = fmaxf(v, swz_xor<2>(v)); v = fmaxf(v, swz_xor<4>(v)); v = fmaxf(v, swz_xor<8>(v)); v = fmaxf(v, swz_xor<16>(v)); return v; }
__device__ __forceinline__ float wave_sum(float v) { v = half_sum(v); auto rr = __builtin_amdgcn_permlane32_swap(__float_as_uint(v), __float_as_uint(v), false, false); return __uint_as_float(rr[0]) + __uint_as_float(rr[1]); }
__device__ __forceinline__ float wave_max(float v) { v = half_max(v); auto rr = __builtin_amdgcn_permlane32_swap(__float_as_uint(v), __float_as_uint(v), false, false); return fmaxf(__uint_as_float(rr[0]), __uint_as_float(rr[1])); }
__device__ __forceinline__ float xor32(float v, bool hi) { auto rr = __builtin_amdgcn_permlane32_swap(__float_as_uint(v), __float_as_uint(v), false, false); return __uint_as_float(hi ? rr[0] : rr[1]); }
__device__ __forceinline__ int opaque_tid() { int t = threadIdx.x; asm volatile("" : "+v"(t)); return t; }
__device__ __forceinline__ float silu_f(float x) { return x / (1.f + __expf(-x)); }
__device__ __forceinline__ float gelu_tanh_f(float x) {
    const float z = 0.7978845608028654f * (x + 0.044715f * x * x * x);
    return x / (1.f + __expf(-2.f * z));
}
#define LDS_WAIT() asm volatile("s_waitcnt lgkmcnt(0)" ::: "memory")

#define XB_TMO      128
#define XB_XCNT(j)  (256  + 64 * (j))
#define XB_XSUB(j)  (1280 + 64 * (j))
#define XB_XGEN(j)  (2304 + 64 * (j))
#define XB_TOP      3328
#define XB_TOPGEN   3392
#define XCD_BAR_WORDS 3456
#define XB_SPIN_CAP (1u << 22)
__device__ __forceinline__ unsigned xb_ld(unsigned* p)              { return __hip_atomic_load(p, __ATOMIC_RELAXED, __HIP_MEMORY_SCOPE_AGENT); }
__device__ __forceinline__ unsigned xb_add(unsigned* p, unsigned v) { return __hip_atomic_fetch_add(p, v, __ATOMIC_RELAXED, __HIP_MEMORY_SCOPE_AGENT); }
__device__ __forceinline__ unsigned xb_xcc_id() { return (unsigned)__builtin_amdgcn_s_getreg((3 << 11) | 20) & 0xFu; }
#define XB_SPIN(cond, bar) do { unsigned _sp = 0; while (cond) { __builtin_amdgcn_s_sleep(1); \
    if ((++_sp & 255u) == 0u) { if (xb_ld(&(bar)[XB_TMO])) break; if (_sp > XB_SPIN_CAP) { atomicAdd(&(bar)[XB_TMO], 1u); break; } } } } while (0)
struct XcdBarrier { unsigned* bar; unsigned x; volatile LAS unsigned* st; };
__device__ __forceinline__ XcdBarrier xcd_barrier_post(unsigned* bar, volatile LAS unsigned* st) {
    XcdBarrier b; b.bar = bar; b.x = xb_xcc_id(); b.st = st;
    if (threadIdx.x == 0) (void)xb_add(&bar[XB_XCNT(b.x)], 1u);
    return b;
}
__device__ __forceinline__ void xcd_barrier_complete(unsigned* bar, unsigned x, unsigned& nloc, unsigned& nx) {
    const unsigned G = gridDim.x * gridDim.y * gridDim.z;
    unsigned sum, cnt, mine, sp = 0u;
    for (;;) {
        sum = 0u; cnt = 0u; mine = 0u;
#pragma unroll
        for (unsigned j = 0; j < 16; ++j) { const unsigned c = xb_ld(&bar[XB_XCNT(j)]); sum += c; cnt += (c > 0u) ? 1u : 0u; }
        mine = xb_ld(&bar[XB_XCNT(x)]);
        if (sum == G) break;
        __builtin_amdgcn_s_sleep(1);
        if ((++sp & 255u) == 0u) { if (xb_ld(&bar[XB_TMO])) break; if (sp > XB_SPIN_CAP) { atomicAdd(&bar[XB_TMO], 1u); break; } }
    }
    nloc = mine > 0u ? mine : 1u; nx = cnt > 0u ? cnt : 1u;
}
__device__ __forceinline__ void xcd_barrier(const XcdBarrier& b) {
    asm volatile("s_waitcnt vmcnt(0)" ::: "memory");
    __syncthreads();
    if (threadIdx.x == 0) {
        unsigned* bar = b.bar;
        __builtin_amdgcn_s_waitcnt(0);
        unsigned nloc = b.st[0], nx = b.st[1];
        if (nloc == 0u) { xcd_barrier_complete(bar, b.x, nloc, nx); b.st[0] = nloc; b.st[1] = nx; }
        const unsigned old = xb_add(&bar[XB_XSUB(b.x)], 1u);
        const unsigned gen = old / nloc;
        if (old + 1u == (gen + 1u) * nloc) {
            __builtin_amdgcn_fence(__ATOMIC_RELEASE, "agent");
            asm volatile("s_waitcnt vmcnt(0)" ::: "memory");
            const unsigned og = xb_add(&bar[XB_TOP], 1u);
            const unsigned tg = og / nx;
            if (og + 1u == (tg + 1u) * nx) xb_add(&bar[XB_TOPGEN], 1u);
            else XB_SPIN(xb_ld(&bar[XB_TOPGEN]) == tg, bar);
            __builtin_amdgcn_fence(__ATOMIC_ACQUIRE, "agent");
            xb_add(&bar[XB_XGEN(b.x)], 1u);
            asm volatile("s_waitcnt vmcnt(0)" ::: "memory");
        } else {
            XB_SPIN(xb_ld(&bar[XB_XGEN(b.x)]) == gen, bar);
            __builtin_amdgcn_fence(__ATOMIC_ACQUIRE, "agent");
            asm volatile("s_waitcnt vmcnt(0)" ::: "memory");
        }
    }
    __syncthreads();
}

namespace pg8 {
constexpr int BM = 256, BK = 64, HALF = 128, HTB = HALF * BK * 2, NXCD = 8, WGM = 8;
__host__ __device__ __forceinline__ int lds_byte(int r, int c) { const int st = (r >> 4) * 2 + (c >> 5), rr = r & 15, cc = c & 31, ob = rr * 64 + cc * 2; return st * 1024 + (ob ^ (((ob >> 9) & 1) << 5)); }
__host__ __device__ __forceinline__ void stage_rc(int b, int& R, int& C) { const int st = b / 1024, sb = b % 1024, swz = sb ^ (((sb >> 9) & 1) << 5); R = (st >> 1) * 16 + swz / 64; C = (st & 1) * 32 + (swz % 64) / 2; }
__host__ __device__ __forceinline__ int perm32(int rho) { const int n = rho >> 4, i = rho & 15; return 8 * (i >> 2) + 4 * n + (i & 3); }
struct Unit { int pm, pn; };

template <class Epi, class Sched>
__device__ __forceinline__ void gemm_phase(LAS unsigned char* lds, const int K, const int lda, const int ldb, const Sched& S, const Epi& E) {
    const int tid = opaque_tid(), wid = __builtin_amdgcn_readfirstlane(tid >> 6), lane = tid & 63, wr = wid >> 2, wc = wid & 3, fr = lane & 15, fq = lane >> 4;
    const int nt = K / BK;
    constexpr bool GATHER = Sched::GATHER;
    unsigned voffA[2], voffB[2]; int rowA[2];
#pragma unroll
    for (int i = 0; i < 2; ++i) { int R, C; stage_rc(tid * 16 + i * 8192, R, C); const int Rb = Epi::PERM ? ((R & ~31) + perm32(R & 31)) : R;
        voffA[i] = GATHER ? (unsigned)C * 2u : (unsigned)(R * lda + C) * 2u; voffB[i] = (unsigned)(Rb * ldb + C) * 2u; rowA[i] = R; }
    unsigned gA[2][2], gN[2][2];
    const size_t kstep = (size_t)(BK * 2);
    const size_t hstepA = (size_t)HALF * lda * 2, hstepB = (size_t)HALF * ldb * 2;
    const unsigned ldsw = (unsigned)wid * 1024u;
    const int aoff = lds_byte(wr * 64 + fr, fq * 8), boff = lds_byte(wc * 32 + fr, fq * 8);
#define PG8_SA(b, h) (((b) * 2 + (h)) * HTB)
#define PG8_SB(b, h) ((4 + (b) * 2 + (h)) * HTB)
#define PG8_STAGE(bufoff, gbase, voff) do { _Pragma("unroll") for (int _i = 0; _i < 2; ++_i) \
        __builtin_amdgcn_global_load_lds((const unsigned*)((const char*)(gbase) + (voff)[_i]), (LAS unsigned*)(lds + (bufoff) + ldsw + _i * 8192), 16, 0, 0); } while (0)
#define PG8_STAGE_A(bufoff, ubase, kb, h, nx) do { if constexpr (GATHER) { unsigned _v[2]; _v[0] = ((nx) ? gN[h][0] : gA[h][0]) + voffA[0]; _v[1] = ((nx) ? gN[h][1] : gA[h][1]) + voffA[1]; \
        PG8_STAGE(bufoff, (const char*)S.abase() + (kb), _v); } else { PG8_STAGE(bufoff, (ubase) + (size_t)(h) * hstepA + (kb), voffA); } } while (0)
#define PG8_LOADG(u, g) do { if constexpr (GATHER) { const int* _ip = S.idx(u); _Pragma("unroll") for (int _h = 0; _h < 2; ++_h) _Pragma("unroll") for (int _i = 0; _i < 2; ++_i) \
        g[_h][_i] = (unsigned)_ip[_h * HALF + rowA[_i]] * (unsigned)(lda * 2); } } while (0)
#define PG8_LDA(dst, b, h) do { _Pragma("unroll") for (int m = 0; m < 4; ++m) _Pragma("unroll") for (int k = 0; k < 2; ++k) dst[m][k] = *(const LAS bf16x8*)(lds + PG8_SA(b, h) + aoff + m * 2048 + k * 1024); } while (0)
#define PG8_LDB(dst, b, h) do { _Pragma("unroll") for (int n = 0; n < 2; ++n) _Pragma("unroll") for (int k = 0; k < 2; ++k) dst[n][k] = *(const LAS bf16x8*)(lds + PG8_SB(b, h) + boff + n * 2048 + k * 1024); } while (0)
#define PG8_MMA(ai, bj, At, Bt) do { __builtin_amdgcn_s_setprio(1); _Pragma("unroll") for (int m = 0; m < 4; ++m) _Pragma("unroll") for (int n = 0; n < 2; ++n) _Pragma("unroll") for (int k = 0; k < 2; ++k) \
        acc[ai][bj][m][n] = __builtin_amdgcn_mfma_f32_16x16x32_bf16(Bt[n][k], At[m][k], acc[ai][bj][m][n], 0, 0, 0); __builtin_amdgcn_s_setprio(0); } while (0)
#define PG8_WAIT_V(n) asm volatile("s_waitcnt vmcnt(" #n ")" ::: "memory")
#define PG8_WAIT_L(n) asm volatile("s_waitcnt lgkmcnt(" #n ")" ::: "memory")
#define PG8_BAR __builtin_amdgcn_s_barrier()
#define PG8_SCHED __builtin_amdgcn_sched_barrier(0)
    Unit cur, nxt; int ui = 0;
    if (!S.next(0, cur)) return;
    f32x4 acc[2][2][4][2];
#pragma unroll
    for (int a = 0; a < 2; ++a)
#pragma unroll
        for (int b = 0; b < 2; ++b)
#pragma unroll
            for (int m = 0; m < 4; ++m)
#pragma unroll
                for (int n = 0; n < 2; ++n) acc[a][b][m][n] = (f32x4){0.f, 0.f, 0.f, 0.f};
    bf16x8 At[4][2], B0[2][2], B1[2][2];
    const char* cA = GATHER ? (const char*)nullptr : S.aptr(cur); const char* cB = S.bptr(cur);
    PG8_LOADG(cur, gA);
    PG8_STAGE(PG8_SB(0, 0), cB, voffB); PG8_STAGE(PG8_SB(0, 1), cB + hstepB, voffB); PG8_STAGE_A(PG8_SA(0, 0), cA, 0, 0, false); PG8_STAGE_A(PG8_SA(0, 1), cA, 0, 1, false);
    if (wr == 1) PG8_BAR;
    PG8_WAIT_V(2); PG8_BAR;
    PG8_STAGE(PG8_SB(1, 0), cB + kstep, voffB); PG8_STAGE_A(PG8_SA(1, 0), cA, kstep, 0, false); PG8_STAGE(PG8_SB(1, 1), cB + hstepB + kstep, voffB);
    PG8_WAIT_V(6); PG8_BAR;
    for (;;) {
        const bool has_next = S.next(ui + 1, nxt);
        const char* nA = (has_next && !GATHER) ? S.aptr(nxt) : cA; const char* nB = has_next ? S.bptr(nxt) : cB;
        if (has_next) PG8_LOADG(nxt, gN); else { if constexpr (GATHER) {
#pragma unroll
            for (int h_ = 0; h_ < 2; ++h_) { gN[h_][0] = gA[h_][0]; gN[h_][1] = gA[h_][1]; } } }
        for (int t = 0; t < nt; t += 2) {
            const bool last = (t == nt - 2);
            const size_t k1 = (size_t)(t + 1) * kstep, k2 = last ? 0 : (size_t)(t + 2) * kstep, k3 = k2 + kstep;
            const char* a2 = last ? nA : cA; const char* b2 = last ? nB : cB + (size_t)(t + 2) * kstep;
            const char* b3 = b2 + kstep;
            PG8_LDB(B0, 0, 0); PG8_LDB(B1, 0, 1); PG8_SCHED; PG8_LDA(At, 0, 0); PG8_STAGE_A(PG8_SA(1, 1), cA, k1, 1, false);
            PG8_WAIT_V(8); PG8_WAIT_L(0); PG8_BAR; PG8_MMA(0, 0, At, B0); PG8_MMA(0, 1, At, B1); PG8_BAR; PG8_SCHED;
            PG8_LDA(At, 0, 1); PG8_STAGE(PG8_SB(0, 0), b2, voffB); PG8_STAGE(PG8_SB(0, 1), b2 + hstepB, voffB); PG8_STAGE_A(PG8_SA(0, 0), a2, k2, 0, last);
            PG8_WAIT_V(8); PG8_WAIT_L(0); PG8_BAR; PG8_MMA(1, 0, At, B0); PG8_MMA(1, 1, At, B1); PG8_BAR; PG8_SCHED;
            PG8_LDB(B0, 1, 0); PG8_LDB(B1, 1, 1); PG8_SCHED; PG8_LDA(At, 1, 0); PG8_STAGE_A(PG8_SA(0, 1), a2, k2, 1, last);
            PG8_WAIT_V(8); PG8_WAIT_L(0); PG8_BAR; PG8_MMA(0, 0, At, B0); PG8_MMA(0, 1, At, B1); PG8_BAR; PG8_SCHED;
            PG8_LDA(At, 1, 1); PG8_STAGE(PG8_SB(1, 0), b3, voffB); PG8_STAGE(PG8_SB(1, 1), b3 + hstepB, voffB); PG8_STAGE_A(PG8_SA(1, 0), a2, k3, 0, last);
            PG8_WAIT_V(8); PG8_WAIT_L(0); PG8_BAR; PG8_MMA(1, 0, At, B0); PG8_MMA(1, 1, At, B1); PG8_BAR; PG8_SCHED;
        }
        if (wr == 0) PG8_BAR;
        E(acc, cur, wr, wc, fr, fq);
        if (!has_next) break;
#pragma unroll
        for (int a = 0; a < 2; ++a)
#pragma unroll
            for (int b = 0; b < 2; ++b)
#pragma unroll
                for (int m = 0; m < 4; ++m)
#pragma unroll
                    for (int n = 0; n < 2; ++n) acc[a][b][m][n] = (f32x4){0.f, 0.f, 0.f, 0.f};
        cur = nxt; cA = nA; cB = nB; ++ui;
        if constexpr (GATHER) {
#pragma unroll
            for (int h_ = 0; h_ < 2; ++h_) { gA[h_][0] = gN[h_][0]; gA[h_][1] = gN[h_][1]; } }
        if (wr == 1) PG8_BAR;
    }
    PG8_WAIT_V(0);
    PG8_BAR;
#undef PG8_SA
#undef PG8_SB
#undef PG8_STAGE
#undef PG8_STAGE_A
#undef PG8_LOADG
#undef PG8_LDA
#undef PG8_LDB
#undef PG8_MMA
#undef PG8_WAIT_V
#undef PG8_WAIT_L
#undef PG8_BAR
#undef PG8_SCHED
}

struct SchedDense {
    static constexpr bool GATHER = false;
    __device__ __forceinline__ const char* abase() const { return nullptr; }
    __device__ __forceinline__ const int* idx(const Unit&) const { return nullptr; }
    const bf16_t* A; const bf16_t* Bt; int a_pm_stride, a_pn_stride, b_pn_stride;
    int nM, nN, nwg, extra, G, c;
    __device__ __forceinline__ bool next(int i, Unit& u) const {
        const int L = i * G + c; if (L >= nwg + extra) return false;
        if (L >= nwg) { const int x = L - nwg; u.pm = nM + (x >> 1); u.pn = 4 + (x & 1); return true; }
        int wgid = L; { const int q = nwg / NXCD, r = nwg % NXCD, xcd = wgid % NXCD, off = wgid / NXCD; wgid = (xcd < r ? xcd * (q + 1) : r * (q + 1) + (xcd - r) * q) + off; }
        const int nig = WGM * nN, gid = wgid / nig, fm = gid * WGM, gsz = (nM - fm) < WGM ? (nM - fm) : WGM;
        u.pm = fm + ((wgid % nig) % gsz); u.pn = (wgid % nig) / gsz; return true;
    }
    __device__ __forceinline__ const char* aptr(const Unit& u) const { return (const char*)(A + (size_t)u.pm * a_pm_stride + (size_t)u.pn * a_pn_stride); }
    __device__ __forceinline__ const char* bptr(const Unit& u) const { return (const char*)(Bt + (size_t)u.pn * b_pn_stride); }
};
template <bool GATHER_>
struct SchedMoE {
    static constexpr bool GATHER = GATHER_;
    const bf16_t* A; const bf16_t* Bt; const int* IDX; int nbt, nn, G, vcu;
    __device__ __forceinline__ bool next(int i, Unit& u) const {
        const int L = i * G + vcu, per_e = nbt * nn; if (L >= NE * per_e) return false;
        const int e = L / per_e, rem = L - e * per_e, bt = rem / nn, j = rem - bt * nn;
        u.pm = bt < 8 ? e * 8 + bt : 128 + e; u.pn = e * nn + j; return true;
    }
    __device__ __forceinline__ const char* aptr(const Unit& u) const { return (const char*)(A + (size_t)u.pm * 256 * D); }
    __device__ __forceinline__ const char* abase() const { return (const char*)A; }
    __device__ __forceinline__ const int* idx(const Unit& u) const { return IDX + (size_t)u.pm * 256; }
    __device__ __forceinline__ const char* bptr(const Unit& u) const { return (const char*)(Bt + (size_t)u.pn * 256 * D); }
};

struct EpiA {
    static constexpr bool PERM = true;
    bf16_t* O; int ldc; int act; bf16_t* VB;
    __device__ __forceinline__ void operator()(const f32x4 (&acc)[2][2][4][2], const Unit& u, int wr, int wc, int fr, int fq) const {
        const int row0 = u.pm * BM + wr * 64 + fr, cl = wc * 32 + 8 * fq;
        const bool vtile = (VB != nullptr) && (u.pn == 5);
#pragma unroll
        for (int ai = 0; ai < 2; ++ai)
#pragma unroll
            for (int m = 0; m < 4; ++m) {
                const int r = row0 + ai * HALF + m * 16;
#pragma unroll
                for (int bj = 0; bj < 2; ++bj) {
                    f32x4 v0 = acc[ai][bj][m][0], v1 = acc[ai][bj][m][1];
                    if (act) {
#pragma unroll
                        for (int j = 0; j < 4; ++j) { v0[j] = gelu_tanh_f(v0[j]); v1[j] = gelu_tanh_f(v1[j]); } }
                    u32x4 w; w.x = cvt_pk_bf16(v0[0], v0[1]); w.y = cvt_pk_bf16(v0[2], v0[3]); w.z = cvt_pk_bf16(v1[0], v1[1]); w.w = cvt_pk_bf16(v1[2], v1[3]);
                    bf16_t* dst;
                    if (vtile) { int b, pos; if (r < T) { b = r >> 11; pos = CL + (r & (SEQ - 1)); } else { const int rc = r - T; b = rc >> 8; pos = rc & (CL - 1); }
                        dst = VB + ((size_t)(b * 2 + bj) * SKV + pos) * 128 + cl; }
                    else dst = O + (size_t)r * ldc + u.pn * BM + bj * HALF + cl;
                    *(u32x4*)dst = w; } }
    }
};
struct EpiB {
    static constexpr bool PERM = false;
    const float* xs_lat; const float* xs_ctx; float* xd_lat; float* xd_ctx; const float* gt; const float* colscale; int dry;
    __device__ __forceinline__ void operator()(const f32x4 (&acc)[2][2][4][2], const Unit& u, int wr, int wc, int fr, int fq) const {
        const int row0 = u.pm * BM + wr * 64 + fr, col0 = u.pn * BM + wc * 32 + 4 * fq;
        const bool isctx = row0 >= T;
        const int mrow = isctx ? 8 : (row0 >> 11);
        const float* xs = isctx ? xs_ctx - (size_t)T * D : xs_lat; float* xd = isctx ? xd_ctx - (size_t)T * D : xd_lat;
        f32x4 gv[2][2];
#pragma unroll
        for (int bj = 0; bj < 2; ++bj)
#pragma unroll
            for (int n = 0; n < 2; ++n) { const int c = col0 + bj * HALF + n * 16; gv[bj][n] = *(const f32x4*)(gt + (size_t)mrow * 6144 + c);
                if (colscale) gv[bj][n] = gv[bj][n] * *(const f32x4*)(colscale + c); }
#pragma unroll
        for (int ai = 0; ai < 2; ++ai)
#pragma unroll
            for (int m = 0; m < 4; ++m) { const size_t off = (size_t)(row0 + ai * HALF + m * 16) * D + col0;
#pragma unroll
                for (int bj = 0; bj < 2; ++bj)
#pragma unroll
                    for (int n = 0; n < 2; ++n) { const f32x4 xo = *(const f32x4*)(xs + off + bj * HALF + n * 16);
                        const f32x4 xn = xo + gv[bj][n] * acc[ai][bj][m][n]; if (!dry) *(f32x4*)(xd + off + bj * HALF + n * 16) = xn; } }
    }
};
struct EpiC {
    static constexpr bool PERM = true;
    bf16_t* HID;
    __device__ __forceinline__ void operator()(const f32x4 (&acc)[2][2][4][2], const Unit& u, int wr, int wc, int fr, int fq) const {
        const int n8 = u.pn & 7, rl = wr * 64 + fr, cl = n8 * 128 + wc * 32 + 8 * fq;
        bf16_t* base = HID + (size_t)u.pm * 256 * D;
#pragma unroll
        for (int ai = 0; ai < 2; ++ai)
#pragma unroll
            for (int m = 0; m < 4; ++m) {
                float h[8];
#pragma unroll
                for (int n = 0; n < 2; ++n)
#pragma unroll
                    for (int j = 0; j < 4; ++j) { const float g = acc[ai][0][m][n][j], up = acc[ai][1][m][n][j]; h[n * 4 + j] = silu_f(g) * up; }
                u32x4 w; w.x = cvt_pk_bf16(h[0], h[1]); w.y = cvt_pk_bf16(h[2], h[3]); w.z = cvt_pk_bf16(h[4], h[5]); w.w = cvt_pk_bf16(h[6], h[7]);
                *(u32x4*)(base + (size_t)(rl + ai * HALF + m * 16) * D + cl) = w; }
    }
};
struct EpiD {
    static constexpr bool PERM = true;
    bf16_t* Y; const float* gate;
    __device__ __forceinline__ void operator()(const f32x4 (&acc)[2][2][4][2], const Unit& u, int wr, int wc, int fr, int fq) const {
        const int n4 = u.pn & 3, rl = wr * 64 + fr, cl = n4 * 256 + wc * 32 + 8 * fq;
        bf16_t* base = Y + (size_t)u.pm * 256 * D; const float* gp = gate + (size_t)u.pm * 256;
#pragma unroll
        for (int ai = 0; ai < 2; ++ai)
#pragma unroll
            for (int m = 0; m < 4; ++m) { const int r = rl + ai * HALF + m * 16; const float g = gp[r];
#pragma unroll
                for (int bj = 0; bj < 2; ++bj) { const f32x4 v0 = acc[ai][bj][m][0] * g, v1 = acc[ai][bj][m][1] * g;
                    u32x4 w; w.x = cvt_pk_bf16(v0[0], v0[1]); w.y = cvt_pk_bf16(v0[2], v0[3]); w.z = cvt_pk_bf16(v1[0], v1[1]); w.w = cvt_pk_bf16(v1[2], v1[3]);
                    *(u32x4*)(base + (size_t)r * D + bj * HALF + cl) = w; } }
    }
};
}

namespace att {
constexpr int QBLK = 32, KVBLK = 64;
constexpr float SCALE = 0.088388347648318440f;
constexpr float THR = 8.f;
constexpr int SHM_V = KVBLK * 128 * 2, SHM_K = KVBLK * 128 * 2;
#define KSWZ(row, colB) ((row) * 256 + ((colB) ^ (((row) & 7) << 4)))
#define SBAR() __builtin_amdgcn_sched_barrier(0)
__device__ __forceinline__ int crow(int r, int hi) { return (r & 3) + 8 * (r >> 2) + 4 * hi; }
__device__ __forceinline__ void partialSM(f32x16& p0, f32x16& p1, float& m_reg, float& mn, float& alpha) {
    constexpr float C = SCALE * 1.4426950408889634f;
    float pmax = p0[0];
#pragma unroll
    for (int r = 1; r < 16; ++r) pmax = fmaxf(pmax, p0[r]);
#pragma unroll
    for (int r = 0; r < 16; ++r) pmax = fmaxf(pmax, p1[r]);
    { auto rr = __builtin_amdgcn_permlane32_swap(__float_as_uint(pmax), __float_as_uint(pmax), false, false);
      pmax = fmaxf(__uint_as_float(rr[0]), __uint_as_float(rr[1])); }
    if (__builtin_expect(__all(pmax - m_reg <= THR / SCALE), 1)) { mn = m_reg; alpha = 1.f; }
    else { mn = fmaxf(m_reg, pmax); alpha = __builtin_amdgcn_exp2f((m_reg - mn) * C); m_reg = mn; }
    float mnC = -mn * C;
#pragma unroll
    for (int r = 0; r < 16; ++r) p0[r] = fmaf(p0[r], C, mnC);
#pragma unroll
    for (int r = 0; r < 16; ++r) p1[r] = fmaf(p1[r], C, mnC);
#pragma unroll
    for (int r = 0; r < 16; ++r) p0[r] = __builtin_amdgcn_exp2f(p0[r]);
}
__device__ __forceinline__ void finishSM(f32x16& p0, f32x16& p1, float alpha, float& l_reg, bf16x8& pa0, bf16x8& pa1, bf16x8& pa2, bf16x8& pa3) {
#pragma unroll
    for (int r = 0; r < 16; ++r) p1[r] = __builtin_amdgcn_exp2f(p1[r]);
    float ps = 0;
#pragma unroll
    for (int r = 0; r < 16; ++r) ps += p0[r];
#pragma unroll
    for (int r = 0; r < 16; ++r) ps += p1[r];
    { auto rr = __builtin_amdgcn_permlane32_swap(__float_as_uint(ps), __float_as_uint(ps), false, false);
      ps = __uint_as_float(rr[0]) + __uint_as_float(rr[1]); }
    l_reg = l_reg * alpha + ps;
#define PK4(P, BASE, OUT) do { unsigned a0 = cvt_pk_bf16(P[BASE + 0], P[BASE + 1]), a1 = cvt_pk_bf16(P[BASE + 2], P[BASE + 3]);   \
    unsigned b0 = cvt_pk_bf16(P[BASE + 4], P[BASE + 5]), b1 = cvt_pk_bf16(P[BASE + 6], P[BASE + 7]);                              \
    auto r0 = __builtin_amdgcn_permlane32_swap(a0, b0, false, false); auto r1 = __builtin_amdgcn_permlane32_swap(a1, b1, false, false); \
    u32x4 w = {r0[0], r1[0], r0[1], r1[1]}; OUT = *reinterpret_cast<bf16x8*>(&w); } while (0)
    PK4(p0, 0, pa0); PK4(p0, 8, pa1); PK4(p1, 0, pa2); PK4(p1, 8, pa3);
#undef PK4
}
__device__ __forceinline__ void qkt(f32x16& p0, f32x16& p1, const LAS unsigned char* Ks, const bf16x8* qr, int r32, int hi) {
    p0 = f32x16{}; p1 = f32x16{};
#pragma unroll
    for (int d0 = 0; d0 < 8; ++d0) { int cb = (d0 * 16 + hi * 8) * 2;
        bf16x8 b0 = *reinterpret_cast<const LAS bf16x8*>(Ks + KSWZ(r32, cb));
        bf16x8 b1 = *reinterpret_cast<const LAS bf16x8*>(Ks + KSWZ(32 + r32, cb));
        p0 = __builtin_amdgcn_mfma_f32_32x32x16_bf16(b0, qr[d0], p0, 0, 0, 0);
        p1 = __builtin_amdgcn_mfma_f32_32x32x16_bf16(b1, qr[d0], p1, 0, 0, 0); }
}
__device__ __forceinline__ int v_st(int k, int c) { const int kk = (k & ~0xC) | ((k & 4) << 1) | ((k & 8) >> 1); return ((kk >> 3) * 4 + (c >> 5)) * 512 + ((kk & 7) * 32 + (c & 31)) * 2; }
__device__ __forceinline__ int v_rd_base(int lane) { return ((lane & 3) << 3) | (((lane >> 2) & 3) << 6) | (((lane >> 4) & 1) << 5) | (((lane >> 5) & 1) << 8); }
constexpr int v_rd_off(int d0, int ks, int half) { return d0 * 512 + ks * 4096 + half * 2048; }
template <int OFF> __device__ __forceinline__ s16x4 tr_read(int vb) {
    s16x4 r; asm volatile("ds_read_b64_tr_b16 %0, %1 offset:%2" : "=&v"(r) : "v"(vb), "i"(OFF) : "memory"); return r;
}
template <int D0> __device__ __forceinline__ void pv_one(f32x16& od, int vb, bf16x8 pa0, bf16x8 pa1, bf16x8 pa2, bf16x8 pa3) {
    const s16x4 l0 = tr_read<v_rd_off(D0, 0, 0)>(vb), h0 = tr_read<v_rd_off(D0, 0, 1)>(vb), l1 = tr_read<v_rd_off(D0, 1, 0)>(vb), h1 = tr_read<v_rd_off(D0, 1, 1)>(vb);
    const s16x4 l2 = tr_read<v_rd_off(D0, 2, 0)>(vb), h2 = tr_read<v_rd_off(D0, 2, 1)>(vb), l3 = tr_read<v_rd_off(D0, 3, 0)>(vb), h3 = tr_read<v_rd_off(D0, 3, 1)>(vb);
    asm volatile("s_waitcnt lgkmcnt(0)" ::: "memory"); SBAR();
#define PK(L, H) (bf16x8){L[0], L[1], L[2], L[3], H[0], H[1], H[2], H[3]}
    od = __builtin_amdgcn_mfma_f32_32x32x16_bf16(pa0, PK(l0, h0), od, 0, 0, 0);
    od = __builtin_amdgcn_mfma_f32_32x32x16_bf16(pa1, PK(l1, h1), od, 0, 0, 0);
    od = __builtin_amdgcn_mfma_f32_32x32x16_bf16(pa2, PK(l2, h2), od, 0, 0, 0);
    od = __builtin_amdgcn_mfma_f32_32x32x16_bf16(pa3, PK(l3, h3), od, 0, 0, 0);
#undef PK
}
__device__ __forceinline__ void pv_d0(f32x16* o, int vb, bf16x8 pa0, bf16x8 pa1, bf16x8 pa2, bf16x8 pa3) {
    pv_one<0>(o[0], vb, pa0, pa1, pa2, pa3); pv_one<1>(o[1], vb, pa0, pa1, pa2, pa3); pv_one<2>(o[2], vb, pa0, pa1, pa2, pa3); pv_one<3>(o[3], vb, pa0, pa1, pa2, pa3);
}
template <int LDQ, int LDO>
__device__ __forceinline__ void attn_body(const bf16_t* __restrict__ Qb, const bf16_t* __restrict__ Kh, const bf16_t* __restrict__ Vh, bf16_t* __restrict__ Ob, int seq, LAS unsigned char* lds) {
    constexpr int LDK = 128;
    const int tid = opaque_tid(), wid = tid >> 6, lane = tid & 63, r32 = lane & 31, hi = lane >> 5;
    LAS unsigned char* V_lds = lds; LAS unsigned char* K_lds = lds + 2 * SHM_V;
    LAS float* ws = (LAS float*)(lds + 2 * SHM_V + 2 * SHM_K) + wid * 64; LAS float* li_l = ws; LAS float* al_l = ws + 32;
    float m_reg = -1e30f, l_reg = 0; f32x16 o[4] = {}; bf16x8 qr[8];
    const bf16_t* Qw = Qb + (long)(wid * QBLK + r32) * LDQ + hi * 8;
#pragma unroll
    for (int d0 = 0; d0 < 8; ++d0) qr[d0] = *reinterpret_cast<const bf16x8*>(Qw + d0 * 16);
    const int sr = tid >> 4, sc = (tid & 15) * 8, vst0 = v_st(sr, sc), vst1 = v_st(32 + sr, sc);
    const int vb0 = (int)(unsigned)(uintptr_t)V_lds + v_rd_base(lane);
    struct { bf16x8 vs0, vs1, ks0, ks1; } sr_[2];
#define SLOAD(i, k0) do { sr_[i].vs0 = *reinterpret_cast<const bf16x8*>(&Vh[(long)((k0) + sr) * LDK + sc]); sr_[i].vs1 = *reinterpret_cast<const bf16x8*>(&Vh[(long)((k0) + 32 + sr) * LDK + sc]); \
    sr_[i].ks0 = *reinterpret_cast<const bf16x8*>(&Kh[(long)((k0) + sr) * LDK + sc]); sr_[i].ks1 = *reinterpret_cast<const bf16x8*>(&Kh[(long)((k0) + 32 + sr) * LDK + sc]); } while (0)
#define SWRITE(b, i) do { *(LAS bf16x8*)(V_lds + (b) * SHM_V + vst0) = sr_[i].vs0;          \
    *(LAS bf16x8*)(V_lds + (b) * SHM_V + vst1) = sr_[i].vs1; int kc = sc * 2;               \
    *(LAS bf16x8*)(K_lds + (b) * SHM_K + KSWZ(sr, kc)) = sr_[i].ks0;                       \
    *(LAS bf16x8*)(K_lds + (b) * SHM_K + KSWZ(32 + sr, kc)) = sr_[i].ks1; } while (0)
#define SWAIT() asm volatile("s_waitcnt vmcnt(4)" ::: "memory")
#define RESC(a) do { if (__any((a) < 1.f)) { if (hi == 0) al_l[r32] = (a); asm volatile("s_waitcnt lgkmcnt(0)" ::: "memory"); \
    for (int d = 0; d < 4; ++d) for (int r = 0; r < 16; ++r) o[d][r] *= al_l[crow(r, hi)]; } } while (0)
    f32x16 pA0, pA1, pB0, pB1; float mnA, mnB, alA, alB; bf16x8 pa0, pa1, pa2, pa3; const int NT = seq / KVBLK;
    constexpr int SE = 0, SO = 1;
    SLOAD(SE, 0); asm volatile("s_waitcnt vmcnt(0)" ::: "memory"); SWRITE(0, SE); __syncthreads();
    qkt(pA0, pA1, K_lds, qr, r32, hi); partialSM(pA0, pA1, m_reg, mnA, alA);
    SLOAD(SO, KVBLK); if (2 < NT) SLOAD(SE, 2 * KVBLK);
    SWAIT(); SWRITE(1, SO); __syncthreads();
    for (int j = 1; j + 1 < NT; j += 2) {
        SBAR(); qkt(pB0, pB1, K_lds + SHM_K, qr, r32, hi);
        finishSM(pA0, pA1, alA, l_reg, pa0, pa1, pa2, pa3); SBAR();
        SLOAD(SO, (j + 2) * KVBLK); SBAR();
        pv_d0(o, vb0, pa0, pa1, pa2, pa3); partialSM(pB0, pB1, m_reg, mnB, alB);
        __syncthreads(); SWAIT(); SWRITE(0, SE);
        RESC(alB); __syncthreads();
        SBAR(); qkt(pA0, pA1, K_lds, qr, r32, hi);
        finishSM(pB0, pB1, alB, l_reg, pa0, pa1, pa2, pa3); SBAR();
        if (j + 3 < NT) SLOAD(SE, (j + 3) * KVBLK); SBAR();
        pv_d0(o, vb0 + (int)SHM_V, pa0, pa1, pa2, pa3); partialSM(pA0, pA1, m_reg, mnA, alA);
        __syncthreads(); SWAIT(); SWRITE(1, SO);
        RESC(alA); __syncthreads();
    }
    SBAR(); qkt(pB0, pB1, K_lds + SHM_K, qr, r32, hi);
    finishSM(pA0, pA1, alA, l_reg, pa0, pa1, pa2, pa3); SBAR();
    pv_d0(o, vb0, pa0, pa1, pa2, pa3); partialSM(pB0, pB1, m_reg, mnB, alB);
    __syncthreads(); RESC(alB);
    finishSM(pB0, pB1, alB, l_reg, pa0, pa1, pa2, pa3); SBAR();
    pv_d0(o, vb0 + (int)SHM_V, pa0, pa1, pa2, pa3);
    if (hi == 0) li_l[r32] = l_reg; asm volatile("s_waitcnt lgkmcnt(0)" ::: "memory");
    float rli[16];
#pragma unroll
    for (int r = 0; r < 16; ++r) rli[r] = __builtin_amdgcn_rcpf(li_l[crow(r, hi)]);
    bf16_t* Ow = Ob + (long)(wid * QBLK) * LDO;
#pragma unroll
    for (int r = 0; r < 16; ++r) { int orow = crow(r, hi);
#pragma unroll
        for (int d0 = 0; d0 < 4; ++d0) Ow[(long)orow * LDO + d0 * 32 + r32] = f2bf(o[d0][r] * rli[r]); }
#undef SLOAD
#undef SWRITE
#undef SWAIT
#undef RESC
}
}

struct KArgs { const float* in[24]; float* out; unsigned char* ws; int ph_lo, ph_hi; };
enum { I_X = 0, I_C, I_CTX, I_CCTX, I_MODW, I_MODB, I_N1G, I_N2G, I_RW, I_WG, I_WU, I_WD, I_GWIN, I_GVG, I_GSW, I_GSB, I_GWOUT, I_AWIN, I_AQG, I_AKG, I_AWOUT, I_PWIN, I_PWG, I_PSC };

struct Fr {
    volatile LAS unsigned long long* PT;
    int G, bx, vcu;
    __device__ __forceinline__ unsigned long long ldp(int i) const { const unsigned long long v = PT[i];
        const unsigned lo = __builtin_amdgcn_readfirstlane((unsigned)v), hi = __builtin_amdgcn_readfirstlane((unsigned)(v >> 32)); return ((unsigned long long)hi << 32) | lo; }
    __device__ __forceinline__ const float* in(int i) const { return (const float*)(GAS const float*)ldp(i); }
    __device__ __forceinline__ float* out() const { return (float*)(GAS float*)ldp(24); }
    __device__ __forceinline__ unsigned char* ws() const { return (unsigned char*)(GAS unsigned char*)ldp(25); }
};
#define WSP(F, T_, OFF) ((T_*)((F).ws() + (OFF)))

__device__ __forceinline__ void tr_item(const float* W, int N, int k0, int n0, bf16_t* dst, int ldt, LAS float* scr, int lane) {
#pragma unroll 8
    for (int i = 0; i < 32; ++i) { const int kk = 2 * i + (lane >> 5); scr[kk * 33 + (lane & 31)] = W[(size_t)(k0 + kk) * N + n0 + (lane & 31)]; }
    LDS_WAIT(); asm volatile("" ::: "memory");
    const int c = lane & 7;
#pragma unroll
    for (int j = 0; j < 4; ++j) { const int n = (lane >> 3) + 8 * j; const LAS float* s = scr + (8 * c) * 33 + n;
        u32x4 o; o.x = cvt_pk_bf16(s[0 * 33], s[1 * 33]); o.y = cvt_pk_bf16(s[2 * 33], s[3 * 33]); o.z = cvt_pk_bf16(s[4 * 33], s[5 * 33]); o.w = cvt_pk_bf16(s[6 * 33], s[7 * 33]);
        *(u32x4*)(dst + (size_t)n * ldt + k0 + 8 * c) = o; }
    LDS_WAIT(); asm volatile("" ::: "memory");
}

__device__ __forceinline__ void p0_phase(const Fr& F, LAS unsigned char* lds) {
    const int tid = opaque_tid(), lane = tid & 63, wave = __builtin_amdgcn_readfirstlane(tid >> 6), gw = F.bx * NWAVES + wave, NGW = F.G * NWAVES; (void)gw; (void)NGW; (void)lane; (void)wave;
    unsigned char* const ws_ = F.ws();
    float* const modv_ = (float*)(ws_ + WS_MODV);
    bf16_t* const wsw_ = (bf16_t*)(ws_ + WS_WSW);
    bf16_t* const wgin_ = (bf16_t*)(ws_ + WS_WGIN);
    bf16_t* const wgout_ = (bf16_t*)(ws_ + WS_WGOUT);
    bf16_t* const wain_ = (bf16_t*)(ws_ + WS_WAIN);
    bf16_t* const waout_ = (bf16_t*)(ws_ + WS_WAOUT);
    bf16_t* const wpin_ = (bf16_t*)(ws_ + WS_WPIN);
    bf16_t* const wpgrp_ = (bf16_t*)(ws_ + WS_WPGRP);
    bf16_t* const wup_ = (bf16_t*)(ws_ + WS_WUP);
    bf16_t* const wdn_ = (bf16_t*)(ws_ + WS_WDN);
    const float* const in_I_AWIN = F.in(I_AWIN);
    const float* const in_I_AWOUT = F.in(I_AWOUT);
    const float* const in_I_C = F.in(I_C);
    const float* const in_I_CCTX = F.in(I_CCTX);
    const float* const in_I_GSW = F.in(I_GSW);
    const float* const in_I_GWIN = F.in(I_GWIN);
    const float* const in_I_GWOUT = F.in(I_GWOUT);
    const float* const in_I_MODB = F.in(I_MODB);
    const float* const in_I_MODW = F.in(I_MODW);
    const float* const in_I_PWG = F.in(I_PWG);
    const float* const in_I_PWIN = F.in(I_PWIN);
    const float* const in_I_WD = F.in(I_WD);
    const float* const in_I_WG = F.in(I_WG);
    const float* const in_I_WU = F.in(I_WU);

    LAS float* sact = (LAS float*)lds;
    LAS float* red = (LAS float*)(lds + 49152);
    for (int idx = tid; idx < 9 * 1024; idx += NTHR) { const int r = idx >> 10, k = idx & 1023; const float v = r < 8 ? in_I_C[r * 1024 + k] : in_I_CCTX[k]; sact[k * 12 + r] = silu_f(v); }
    __syncthreads();
    for (int chunk = F.bx; chunk < 384; chunk += F.G) {
        const int layer = chunk / 96, n = (chunk % 96) * 64 + lane, k0 = wave * 128;
        const float* wp = in_I_MODW + (size_t)layer * 1024 * 6144 + (size_t)k0 * 6144 + n;
        float acc[9];
#pragma unroll
        for (int r = 0; r < 9; ++r) acc[r] = 0.f;
#pragma unroll 8
        for (int kk = 0; kk < 128; ++kk) { const float w = wp[(size_t)kk * 6144]; const LAS float* sa = sact + (k0 + kk) * 12;
#pragma unroll
            for (int r = 0; r < 9; ++r) acc[r] += sa[r] * w; }
#pragma unroll
        for (int r = 0; r < 9; ++r) red[(wave * 9 + r) * 64 + lane] = acc[r];
        __syncthreads();
        for (int idx = tid; idx < 576; idx += NTHR) { const int r = idx >> 6, l = idx & 63; float s = 0.f;
#pragma unroll
            for (int w = 0; w < 8; ++w) s += red[(w * 9 + r) * 64 + l];
            const int nn = (chunk % 96) * 64 + l; modv_[(size_t)(layer * 9 + r) * 6144 + nn] = s + in_I_MODB[layer * 6144 + nn]; }
        __syncthreads();
    }
    __syncthreads();
    LAS float* scr = (LAS float*)(lds + wave * 16384);
    constexpr int NEXP = 4 * 16 * 3 * 512, NOTH = 1024 * 2 + 512 * 2 + 768 + 512 + 512 + 128;
    for (int it = gw; it < NEXP + NOTH; it += NGW) {
        if (it < NEXP) {
            const int mat = it >> 9, sub = it & 511, l = mat / 48, rem = mat % 48, e = rem / 3, which = rem % 3, k0 = (sub >> 5) * 64, n0 = (sub & 31) * 32;
            if (which < 2) { const float* W = (which == 0 ? in_I_WG : in_I_WU) + (size_t)(l * 16 + e) * 1024 * 1024;
                bf16_t* dst = wup_ + (size_t)l * 16 * 2048 * 1024 + (size_t)((e * 8 + (n0 >> 7)) * 256 + which * 128 + (n0 & 127)) * 1024;
                tr_item(W, 1024, k0, n0, dst, 1024, scr, lane); }
            else { const float* W = in_I_WD + (size_t)(l * 16 + e) * 1024 * 1024;
                bf16_t* dst = wdn_ + (size_t)l * 16 * 1024 * 1024 + (size_t)(e * 1024 + n0) * 1024;
                tr_item(W, 1024, k0, n0, dst, 1024, scr, lane); }
        } else {
            int r = it - NEXP;
            if (r < 2048) { const int j = r >> 10, sub = r & 1023, k0 = (sub >> 6) * 64, n0 = (sub & 63) * 32;
                tr_item(in_I_GWIN + (size_t)j * 1024 * 2048, 2048, k0, n0, wgin_ + (size_t)j * 2048 * 1024 + (size_t)n0 * 1024, 1024, scr, lane); continue; } r -= 2048;
            if (r < 1024) { const int j = r >> 9, sub = r & 511, k0 = (sub >> 5) * 64, n0 = (sub & 31) * 32;
                tr_item(in_I_GWOUT + (size_t)j * 1024 * 1024, 1024, k0, n0, wgout_ + (size_t)j * 1024 * 1024 + (size_t)n0 * 1024, 1024, scr, lane); continue; } r -= 1024;
            if (r < 768) { const int k0 = (r / 48) * 64, n0 = (r % 48) * 32;
                tr_item(in_I_AWIN, 1536, k0, n0, wain_ + (size_t)n0 * 1024, 1024, scr, lane); continue; } r -= 768;
            if (r < 512) { const int k0 = (r >> 5) * 64, n0 = (r & 31) * 32;
                tr_item(in_I_AWOUT, 1024, k0, n0, waout_ + (size_t)n0 * 1024, 1024, scr, lane); continue; } r -= 512;
            if (r < 512) { const int k0 = (r >> 5) * 64, n0 = (r & 31) * 32;
                tr_item(in_I_PWIN, 1024, k0, n0, wpin_ + (size_t)n0 * 1024, 1024, scr, lane); continue; } r -= 512;
            { const int g = r >> 5, sub = r & 31, k0 = (sub >> 3) * 64, n0 = (sub & 7) * 32;
                tr_item(in_I_PWG + (size_t)g * 256 * 256, 256, k0, n0, wpgrp_ + (size_t)g * 256 * 256 + (size_t)n0 * 256, 256, scr, lane); }
        }
    }
    for (int i4 = F.bx * NTHR + tid; i4 < 2 * 8 * 128 * 128 / 4; i4 += F.G * NTHR) { const f32x4 v = *(const f32x4*)(in_I_GSW + (size_t)i4 * 4);
        u32x2 o; o.x = cvt_pk_bf16(v[0], v[1]); o.y = cvt_pk_bf16(v[2], v[3]); *(u32x2*)(wsw_ + (size_t)i4 * 4) = o; }
}

template <int R>
__device__ __forceinline__ void norm_rows(const int r0, const bool isctx, const int lane, const int layer, const int which, const int comb, const int dry,
                                          const float* xsrc, float* xdst, const float* modv_, const float* ng, const int* slot_, const bf16_t* YEXP_, bf16_t* H_, float* aff_, int* slotw_, const LAS unsigned char* rwl) {
    const int rc0 = r0 - T; const int b = isctx ? (rc0 >> 8) : (r0 >> 11); const int mrow = isctx ? 8 : b;
    f32x4 v[R][4];
#pragma unroll
    for (int q = 0; q < R; ++q)
#pragma unroll
        for (int j = 0; j < 4; ++j) v[q][j] = *(const f32x4*)(xsrc + (size_t)q * D + lane * 4 + 256 * j);
#ifndef NO_NR_COMB
    if (comb >= 0) {
        int sl[R];
#pragma unroll
        for (int q = 0; q < R; ++q) sl[q] = slot_[(size_t)(r0 + q) * 16 + (lane & 15)];
        f32x4 a[R][4];
#pragma unroll
        for (int q = 0; q < R; ++q)
#pragma unroll
            for (int j = 0; j < 4; ++j) a[q][j] = (f32x4){0.f, 0.f, 0.f, 0.f};
#pragma nounroll
        for (int e = 0; e < 16; ++e) {
            u32x2 w[R][4];
#pragma unroll
            for (int q = 0; q < R; ++q) {
                const int s = __builtin_amdgcn_readlane(sl[q], e);
                if (s >= 0) {
                    const int tile = isctx ? 128 + e : e * 8 + b, rin = isctx ? (((rc0 + q) >> 8) * 32 + s) : s;
                    const bf16_t* yp = YEXP_ + ((size_t)tile * 256 + rin) * D + lane * 4;
#pragma unroll
                    for (int j = 0; j < 4; ++j) w[q][j] = *(const u32x2*)(yp + 256 * j);
                } else {
#pragma unroll
                    for (int j = 0; j < 4; ++j) w[q][j] = (u32x2){0u, 0u};
                }
            }
#pragma unroll
            for (int q = 0; q < R; ++q)
#pragma unroll
                for (int j = 0; j < 4; ++j) { a[q][j][0] += bf_lo(w[q][j].x); a[q][j][1] += bf_hi(w[q][j].x); a[q][j][2] += bf_lo(w[q][j].y); a[q][j][3] += bf_hi(w[q][j].y); }
        }
        const float* g2 = modv_ + (size_t)(comb * 9 + mrow) * 6144 + 5 * 1024 + lane * 4;
#pragma unroll
        for (int j = 0; j < 4; ++j) { const f32x4 gg = *(const f32x4*)(g2 + 256 * j);
#pragma unroll
            for (int q = 0; q < R; ++q) { v[q][j] = v[q][j] + gg * a[q][j]; if (!dry) *(f32x4*)(xdst + (size_t)q * D + lane * 4 + 256 * j) = v[q][j]; } }
    }
#endif
    if (which == 0) return;
    float rstd[R];
#pragma unroll
    for (int q = 0; q < R; ++q) { float ss = 0.f;
#pragma unroll
        for (int j = 0; j < 4; ++j) ss += (v[q][j][0] * v[q][j][0] + v[q][j][1] * v[q][j][1]) + (v[q][j][2] * v[q][j][2] + v[q][j][3] * v[q][j][3]);
        rstd[q] = ss; }
#pragma unroll
    for (int q = 0; q < R; ++q) rstd[q] = rsqrtf(wave_sum(rstd[q]) * (1.f / D) + EPS);
    const float* mv = modv_ + (size_t)(layer * 9 + mrow) * 6144 + (which == 2 ? 3 * 1024 : 0) + lane * 4;
#pragma unroll
    for (int j = 0; j < 4; ++j) { const f32x4 g = *(const f32x4*)(ng + lane * 4 + 256 * j), sh = *(const f32x4*)(mv + 256 * j), sc = *(const f32x4*)(mv + 1024 + 256 * j);
#pragma unroll
        for (int q = 0; q < R; ++q) { v[q][j] = (v[q][j] * rstd[q] * g) * (sc + 1.f) + sh;
            u32x2 o; o.x = cvt_pk_bf16(v[q][j][0], v[q][j][1]); o.y = cvt_pk_bf16(v[q][j][2], v[q][j][3]); *(u32x2*)(H_ + (size_t)(r0 + q) * D + lane * 4 + 256 * j) = o; } }
#ifndef NO_NR_ROUTER
    if (which == 2 && dry != 2) {
        float p[R][16];
#pragma unroll
        for (int q = 0; q < R; ++q)
#pragma unroll
            for (int e = 0; e < 16; ++e) p[q][e] = 0.f;
#pragma unroll
        for (int j = 0; j < 4; ++j)
#pragma unroll
            for (int i = 0; i < 4; ++i) { const int col = lane * 4 + 256 * j + i; const LAS unsigned char* rp = rwl + col * 64 + (col >> 2) * 16;
                const f32x4 w0 = *(const LAS f32x4*)(rp), w1 = *(const LAS f32x4*)(rp + 16), w2 = *(const LAS f32x4*)(rp + 32), w3 = *(const LAS f32x4*)(rp + 48);
#pragma unroll
                for (int q = 0; q < R; ++q) { const float hv = v[q][j][i];
                    p[q][0] += hv * w0[0]; p[q][1] += hv * w0[1]; p[q][2] += hv * w0[2]; p[q][3] += hv * w0[3]; p[q][4] += hv * w1[0]; p[q][5] += hv * w1[1]; p[q][6] += hv * w1[2]; p[q][7] += hv * w1[3];
                    p[q][8] += hv * w2[0]; p[q][9] += hv * w2[1]; p[q][10] += hv * w2[2]; p[q][11] += hv * w2[3]; p[q][12] += hv * w3[0]; p[q][13] += hv * w3[1]; p[q][14] += hv * w3[2]; p[q][15] += hv * w3[3]; }
                __builtin_amdgcn_sched_barrier(0); }
#pragma unroll
        for (int q = 0; q < R; ++q)
#pragma unroll
            for (int e = 0; e < 16; ++e) asm volatile("" : "+v"(p[q][e]));
#pragma unroll
        for (int q = 0; q < R; ++q) {
            const bool b5 = (lane & 32) != 0, b4 = (lane & 16) != 0, b3 = (lane & 8) != 0, b2 = (lane & 4) != 0;
            float k8[8], k4[4], k2[2];
#pragma unroll
            for (int e = 0; e < 8; ++e) { const float send = b5 ? p[q][e] : p[q][e + 8]; k8[e] = (b5 ? p[q][e + 8] : p[q][e]) + xor32(send, b5); }
#pragma unroll
            for (int e = 0; e < 4; ++e) { const float send = b4 ? k8[e] : k8[e + 4]; k4[e] = (b4 ? k8[e + 4] : k8[e]) + swz_xor<16>(send); }
#pragma unroll
            for (int e = 0; e < 2; ++e) { const float send = b3 ? k4[e] : k4[e + 2]; k2[e] = (b3 ? k4[e + 2] : k4[e]) + swz_xor<8>(send); }
            float lg; { const float send = b2 ? k2[0] : k2[1]; lg = (b2 ? k2[1] : k2[0]) + swz_xor<4>(send); }
            lg += swz_xor<2>(lg); lg += swz_xor<1>(lg);
            const float mx = wave_max(lg), ex = __expf(lg - mx), sum = wave_sum(ex) * 0.25f;
            const int eid = (lane >> 2) & 15;
            if ((lane & 3) == 0) aff_[(size_t)(r0 + q) * 16 + eid] = ex / sum;
            if (lane < 16) slotw_[(size_t)(r0 + q) * 16 + lane] = -1;
        }
    }
#endif
}
__device__ __forceinline__ void norm_phase(const Fr& F, LAS unsigned char* lds, int layer, int which, int nrows, int comb, const float* xlat, const float* xctx, float* xlat_d, float* xctx_d, int dry = 0) {
    const int tid = opaque_tid(), lane = tid & 63, wave = __builtin_amdgcn_readfirstlane(tid >> 6), gw = F.bx * NWAVES + wave, NGW = F.G * NWAVES;
    unsigned char* const ws_ = F.ws();
    float* const modv_ = (float*)(ws_ + WS_MODV); float* const aff_ = (float*)(ws_ + WS_AFF); int* const slot_ = (int*)(ws_ + WS_SLOT);
    bf16_t* const H_ = (bf16_t*)(ws_ + WS_H); bf16_t* const YEXP_ = (bf16_t*)(ws_ + WS_YEXP);
    LAS unsigned char* rwl = lds;
    if (which == 2) {
        const float* rw = F.in(I_RW) + (size_t)layer * 1024 * 16;
        for (int idx = tid; idx < 4096; idx += NTHR) { const int col = idx >> 2, e4 = idx & 3; *(LAS f32x4*)(rwl + col * 64 + (col >> 2) * 16 + e4 * 16) = *(const f32x4*)(rw + col * 16 + e4 * 4); }
        __syncthreads();
    }
    const float* ng = F.in(which == 2 ? I_N2G : I_N1G) + (size_t)layer * 1024;
#pragma nounroll
    for (int g4 = gw; g4 < T / 4; g4 += NGW) { const int r0 = g4 * 4;
        norm_rows<4>(r0, false, lane, layer, which, comb, dry, xlat + (size_t)r0 * D, xlat_d + (size_t)r0 * D, modv_, ng, slot_, YEXP_, H_, aff_, slot_, rwl); }
    if (nrows > T) {
#pragma nounroll
        for (int r = T + gw; r < nrows; r += NGW)
            norm_rows<1>(r, true, lane, layer, which, comb, dry, xctx + (size_t)(r - T) * D, xctx_d + (size_t)(r - T) * D, modv_, ng, slot_, YEXP_, H_, aff_, slot_, rwl);
    }
}

__device__ __forceinline__ void topk_phase(const Fr& F, LAS unsigned char* lds, bool with_ctx) {
    const int tid = opaque_tid();
    unsigned char* const ws_ = F.ws();
    float* const aff_ = (float*)(ws_ + WS_AFF); int* const slot_ = (int*)(ws_ + WS_SLOT); float* const gate_ = (float*)(ws_ + WS_GATE);
    int* const idx_ = (int*)(ws_ + WS_IDX);
    LAS unsigned* vals = (LAS unsigned*)lds;
    LAS int* hist = (LAS int*)(lds + 8192);
    LAS int* suf = (LAS int*)(lds + 9216);
    LAS int* scan = (LAS int*)(lds + 12288);
    volatile LAS unsigned* sv = (volatile LAS unsigned*)(lds + 16384);
    const int nunits = with_ctx ? 256 : 128;
    for (int u = F.bx; u < nunits; u += F.G) {
        const bool isctx = u >= 128; const int uu = isctx ? u - 128 : u, e = uu >> 3, b = uu & 7;
        const int N = isctx ? CL : SEQ, cap = isctx ? CCAP : CAP, row0 = isctx ? T + b * CL : b * SEQ;
        const int tile = isctx ? 128 + e : uu, rbase = isctx ? b * 32 : 0;
        unsigned v[4]; const bool act = tid * 4 < N;
#pragma unroll
        for (int k = 0; k < 4; ++k) v[k] = act ? __float_as_uint(aff_[(size_t)(row0 + tid * 4 + k) * 16 + e]) : 0u;
        if (tid == 0) { sv[0] = 0u; sv[1] = (unsigned)cap; }
        unsigned prefix = 0u, mask = 0u; int need = cap;
#pragma nounroll
        for (int shift = 24; shift >= 0; shift -= 8) {
            if (tid < 256) hist[tid] = 0;
            __syncthreads();
            if (act) {
#pragma unroll
                for (int k = 0; k < 4; ++k) if ((v[k] & mask) == prefix) __hip_atomic_fetch_add(&hist[(v[k] >> shift) & 255u], 1, __ATOMIC_RELAXED, __HIP_MEMORY_SCOPE_WORKGROUP);
            }
            __syncthreads();
            if (tid < 256) { int sacc = 0; for (int d = 255; d >= tid; --d) sacc += hist[d]; suf[tid] = sacc; }
            if (tid == 0) suf[256] = 0;
            __syncthreads();
            if (tid < 256) { const int s0 = suf[tid], s1 = suf[tid + 1]; if (s0 >= need && s1 < need) { sv[0] = prefix | ((unsigned)tid << shift); sv[1] = (unsigned)(need - s1); } }
            __syncthreads();
            prefix = sv[0]; need = (int)sv[1]; mask |= 255u << shift;
        }
        int cg = 0, ce = 0;
#pragma unroll
        for (int k = 0; k < 4; ++k) { cg += (act && v[k] > prefix) ? 1 : 0; ce += (act && v[k] == prefix) ? 1 : 0; }
        int cur = 0; scan[tid] = cg | (ce << 16);
        __syncthreads();
#pragma nounroll
        for (int off = 1; off < NTHR; off <<= 1) {
            const int x = scan[cur * NTHR + tid] + (tid >= off ? scan[cur * NTHR + tid - off] : 0);
            scan[(cur ^ 1) * NTHR + tid] = x; cur ^= 1;
            __syncthreads();
        }
        const int incl = scan[cur * NTHR + tid]; int gb = (incl & 0xffff) - cg, eb = (incl >> 16) - ce;
        if (act) {
#pragma unroll
            for (int k = 0; k < 4; ++k) {
                const bool isg = v[k] > prefix, ise = v[k] == prefix;
                if (isg || (ise && eb < need)) { const int sl = gb + (eb < need ? eb : need); const int row = row0 + tid * 4 + k;
                    idx_[(size_t)tile * 256 + rbase + sl] = row; gate_[(size_t)tile * 256 + rbase + sl] = __uint_as_float(v[k]); slot_[(size_t)row * 16 + e] = sl; }
                gb += isg ? 1 : 0; eb += ise ? 1 : 0;
            }
        }
        __syncthreads();
    }
}

template <int OFF> __device__ __forceinline__ s16x4 sp_tr_read(int vb) {
    s16x4 r; asm volatile("ds_read_b64_tr_b16 %0, %1 offset:%2" : "=&v"(r) : "v"(vb), "i"(OFF) : "memory"); return r;
}
template <int KS> __device__ __forceinline__ void sp_kstep(f32x16& acc0, f32x16& acc1, const LAS bf16_t* Ap, int vb) {
    constexpr int LDB2 = 320;
    const bf16x8 a = *(const LAS bf16x8*)(Ap + KS * 16);
    const s16x4 l0 = sp_tr_read<(16 * KS) * LDB2>(vb), h0 = sp_tr_read<(16 * KS + 4) * LDB2>(vb);
    const s16x4 l1 = sp_tr_read<(16 * KS) * LDB2 + 64>(vb), h1 = sp_tr_read<(16 * KS + 4) * LDB2 + 64>(vb);
    asm volatile("s_waitcnt lgkmcnt(0)" ::: "memory"); __builtin_amdgcn_sched_barrier(0);
    const bf16x8 b0 = (bf16x8){l0[0], l0[1], l0[2], l0[3], h0[0], h0[1], h0[2], h0[3]};
    const bf16x8 b1 = (bf16x8){l1[0], l1[1], l1[2], l1[3], h1[0], h1[1], h1[2], h1[3]};
    acc0 = __builtin_amdgcn_mfma_f32_32x32x16_bf16(b0, a, acc0, 0, 0, 0);
    acc1 = __builtin_amdgcn_mfma_f32_32x32x16_bf16(b1, a, acc1, 0, 0, 0);
}
__device__ __forceinline__ void spatial_phase(const Fr& F, LAS unsigned char* lds, int j, int nunits) {
    const int tid = opaque_tid(), lane = tid & 63, wave = __builtin_amdgcn_readfirstlane(tid >> 6);
    unsigned char* const ws_ = F.ws();
    const bf16_t* const wsw_ = (const bf16_t*)(ws_ + WS_WSW); const bf16_t* const S1_ = (const bf16_t*)(ws_ + WS_S1); bf16_t* const S2_ = (bf16_t*)(ws_ + WS_S2);
    constexpr int LDA = 136, LDB = 160;
    LAS float* stat = (LAS float*)lds;
    LAS bf16_t* As = (LAS bf16_t*)(lds + 1024);
    LAS bf16_t* Bs = (LAS bf16_t*)(lds + 1024 + 128 * LDA * 2);
    const float* vg = F.in(I_GVG) + (size_t)j * 1024; const float* sb = F.in(I_GSB) + (size_t)j * 8 * 128;
    const bf16_t* sw = wsw_ + (size_t)j * 8 * 128 * 128;
    const int r32 = lane & 31, hi = lane >> 5;
    const int pw = (wave >> 1) * 32, dw = (wave & 1) * 64;
    const LAS bf16_t* Ap = As + (pw + r32) * LDA + hi * 8;
    const int vb = (int)(unsigned)(uintptr_t)Bs + (8 * hi + ((lane & 15) >> 2)) * (LDB * 2) + (dw + 16 * ((lane >> 4) & 1) + 4 * (lane & 3)) * 2;
    for (int u = F.bx; u < nunits; u += F.G) {
        const int r0 = u * 128;
#pragma nounroll
        for (int rr = wave * 16; rr < wave * 16 + 16; rr += 4) {
            u32x4 w0[4], w1[4];
#pragma unroll
            for (int q = 0; q < 4; ++q) { const bf16_t* vp = S1_ + (size_t)(r0 + rr + q) * 2048 + 1024 + lane * 8; w0[q] = *(const u32x4*)vp; w1[q] = *(const u32x4*)(vp + 512); }
            float s1[4], s2[4];
#pragma unroll
            for (int q = 0; q < 4; ++q) { float a = 0.f, c = 0.f;
#pragma unroll
                for (int i = 0; i < 4; ++i) { const float x0 = bf_lo(w0[q][i]), x1 = bf_hi(w0[q][i]), x2 = bf_lo(w1[q][i]), x3 = bf_hi(w1[q][i]); a += (x0 + x1) + (x2 + x3); c += (x0 * x0 + x1 * x1) + (x2 * x2 + x3 * x3); }
                s1[q] = a; s2[q] = c; }
#pragma unroll
            for (int q = 0; q < 4; ++q) { s1[q] = wave_sum(s1[q]); s2[q] = wave_sum(s2[q]); }
#pragma unroll
            for (int q = 0; q < 4; ++q) { const float mean = s1[q] * (1.f / 1024.f), var = fmaxf(s2[q] * (1.f / 1024.f) - mean * mean, 0.f);
                if (lane == 0) { stat[(rr + q) * 2] = mean; stat[(rr + q) * 2 + 1] = rsqrtf(var + EPS); } }
        }
        __syncthreads();
        const int p = pw + r32; const size_t ro = (size_t)(r0 + p); const int c0 = dw + 4 * hi;
        u32x4 sa[4], wv[4]; u32x2 un[2][4];
#define SP_LOAD(g) do { _Pragma("unroll") for (int i = 0; i < 4; ++i) { const int id = tid + NTHR * i; \
            sa[i] = *(const u32x4*)(sw + (size_t)(g) * 128 * 128 + (id >> 4) * 128 + (id & 15) * 8); \
            wv[i] = *(const u32x4*)(S1_ + (size_t)(r0 + (id >> 4)) * 2048 + 1024 + (g) * 128 + (id & 15) * 8); } \
            _Pragma("unroll") for (int t = 0; t < 4; ++t) { un[0][t] = *(const u32x2*)(S1_ + ro * 2048 + (g) * 128 + c0 + 8 * t); un[1][t] = *(const u32x2*)(S1_ + ro * 2048 + (g) * 128 + c0 + 32 + 8 * t); } } while (0)
        SP_LOAD(0);
#pragma nounroll
        for (int g = 0; g < 8; ++g) {
#pragma unroll
            for (int i = 0; i < 4; ++i) { const int id = tid + NTHR * i; *(LAS u32x4*)(As + (id >> 4) * LDA + (id & 15) * 8) = sa[i]; }
            { const int dc = tid & 15; const f32x4 g0 = *(const f32x4*)(vg + g * 128 + dc * 8), g1 = *(const f32x4*)(vg + g * 128 + dc * 8 + 4);
#pragma unroll
              for (int i = 0; i < 4; ++i) { const int id = tid + NTHR * i, q = id >> 4; const float mean = stat[q * 2], rstd = stat[q * 2 + 1];
                float x[8];
#pragma unroll
                for (int k = 0; k < 4; ++k) { x[2 * k] = (bf_lo(wv[i][k]) - mean) * rstd; x[2 * k + 1] = (bf_hi(wv[i][k]) - mean) * rstd; }
                u32x4 o; o.x = cvt_pk_bf16(x[0] * g0[0], x[1] * g0[1]); o.y = cvt_pk_bf16(x[2] * g0[2], x[3] * g0[3]); o.z = cvt_pk_bf16(x[4] * g1[0], x[5] * g1[1]); o.w = cvt_pk_bf16(x[6] * g1[2], x[7] * g1[3]);
                *(LAS u32x4*)(Bs + q * LDB + dc * 8) = o; } }
            u32x2 uu[2][4];
#pragma unroll
            for (int t = 0; t < 4; ++t) { uu[0][t] = un[0][t]; uu[1][t] = un[1][t]; }
            const float bias = sb[g * 128 + p];
            __syncthreads();
            if (g < 7) SP_LOAD(g + 1);
            f32x16 acc0 = {}, acc1 = {};
            sp_kstep<0>(acc0, acc1, Ap, vb); sp_kstep<1>(acc0, acc1, Ap, vb); sp_kstep<2>(acc0, acc1, Ap, vb); sp_kstep<3>(acc0, acc1, Ap, vb);
            sp_kstep<4>(acc0, acc1, Ap, vb); sp_kstep<5>(acc0, acc1, Ap, vb); sp_kstep<6>(acc0, acc1, Ap, vb); sp_kstep<7>(acc0, acc1, Ap, vb);
#pragma unroll
            for (int t = 0; t < 4; ++t) {
                u32x2 o0, o1;
                o0.x = cvt_pk_bf16((acc0[4 * t] + bias) * bf_lo(uu[0][t].x), (acc0[4 * t + 1] + bias) * bf_hi(uu[0][t].x)); o0.y = cvt_pk_bf16((acc0[4 * t + 2] + bias) * bf_lo(uu[0][t].y), (acc0[4 * t + 3] + bias) * bf_hi(uu[0][t].y));
                o1.x = cvt_pk_bf16((acc1[4 * t] + bias) * bf_lo(uu[1][t].x), (acc1[4 * t + 1] + bias) * bf_hi(uu[1][t].x)); o1.y = cvt_pk_bf16((acc1[4 * t + 2] + bias) * bf_lo(uu[1][t].y), (acc1[4 * t + 3] + bias) * bf_hi(uu[1][t].y));
                *(u32x2*)(S2_ + ro * D + g * 128 + c0 + 8 * t) = o0; *(u32x2*)(S2_ + ro * D + g * 128 + c0 + 32 + 8 * t) = o1; }
            __syncthreads();
        }
#undef SP_LOAD
    }
}

__device__ __forceinline__ void qknorm_phase(const Fr& F) {
    const int tid = opaque_tid(), lane = tid & 63, wave = __builtin_amdgcn_readfirstlane(tid >> 6), gw = F.bx * NWAVES + wave, NGW = F.G * NWAVES;
    unsigned char* const ws_ = F.ws();
    const bf16_t* const S1_ = (const bf16_t*)(ws_ + WS_S1); bf16_t* const QB_ = (bf16_t*)(ws_ + WS_QB); bf16_t* const KB_ = (bf16_t*)(ws_ + WS_KB);
    const float* qg = F.in(I_AQG); const float* kg = F.in(I_AKG);
    const int hsel = lane >> 5, l5 = lane & 31;
    const f32x2 qg0 = *(const f32x2*)(qg + 2 * l5), qg1 = *(const f32x2*)(qg + 64 + 2 * l5), kg0 = *(const f32x2*)(kg + 2 * l5), kg1 = *(const f32x2*)(kg + 64 + 2 * l5);
    const float inv0 = exp2f(-(float)((2 * l5) & 31) * (13.287712379549449f / 32.f)), inv1 = exp2f(-(float)((2 * l5 + 1) & 31) * (13.287712379549449f / 32.f));
#pragma nounroll
    for (int g2 = gw; g2 < T / 2; g2 += NGW) {
        const int r0 = g2 * 2, b = r0 >> 11;
        unsigned u0[2][5], u1[2][5];
#pragma unroll
        for (int q = 0; q < 2; ++q)
#pragma unroll
            for (int ps = 0; ps < 5; ++ps) { const int hh = 2 * ps + hsel; const bf16_t* src = S1_ + (size_t)(r0 + q) * 2048 + (hh < 8 ? hh * 128 : 1024 + (hh - 8) * 128) + 2 * l5;
                u0[q][ps] = *(const unsigned*)src; u1[q][ps] = *(const unsigned*)(src + 64); }
#pragma unroll
        for (int q = 0; q < 2; ++q) {
            const int s = (r0 + q) & (SEQ - 1); const float pos = (float)(l5 < 16 ? (s >> 6) : (s & 63));
            float c0, s0, c1, s1; __sincosf(pos * inv0, &s0, &c0); __sincosf(pos * inv1, &s1, &c1);
            { c0 = cosf(pos * inv0); s0 = sinf(pos * inv0); c1 = cosf(pos * inv1); s1 = sinf(pos * inv1); }
#pragma unroll
            for (int ps = 0; ps < 5; ++ps) { const int hh = 2 * ps + hsel; const bool isk = ps == 4;
                float a0 = bf_lo(u0[q][ps]), a1 = bf_hi(u0[q][ps]), e0 = bf_lo(u1[q][ps]), e1 = bf_hi(u1[q][ps]);
                const float rs = rsqrtf(half_sum((a0 * a0 + a1 * a1) + (e0 * e0 + e1 * e1)) * (1.f / 128.f) + EPS);
                const f32x2 ga = isk ? kg0 : qg0, gb = isk ? kg1 : qg1;
                a0 *= rs * ga.x; a1 *= rs * ga.y; e0 *= rs * gb.x; e1 *= rs * gb.y;
                const float o10 = a0 * c0 - e0 * s0, o11 = a1 * c1 - e1 * s1, o20 = a0 * s0 + e0 * c0, o21 = a1 * s1 + e1 * c1;
                bf16_t* dst = isk ? KB_ + ((size_t)(b * 2 + (hh - 8)) * SKV + CL + s) * 128 + 2 * l5 : QB_ + (size_t)(r0 + q) * D + hh * 128 + 2 * l5;
                *(unsigned*)dst = cvt_pk_bf16(o10, o11); *(unsigned*)(dst + 64) = cvt_pk_bf16(o20, o21); }
        }
    }
#pragma nounroll
    for (int rc = gw; rc < TC; rc += NGW) {
        const int b = rc >> 8, s = rc & (CL - 1);
        const bf16_t* src = S1_ + (size_t)(T + rc) * 2048 + 1024 + hsel * 128 + 2 * l5;
        const unsigned u0 = *(const unsigned*)src, u1 = *(const unsigned*)(src + 64);
        float a0 = bf_lo(u0), a1 = bf_hi(u0), e0 = bf_lo(u1), e1 = bf_hi(u1);
        const float rs = rsqrtf(half_sum((a0 * a0 + a1 * a1) + (e0 * e0 + e1 * e1)) * (1.f / 128.f) + EPS);
        bf16_t* dst = KB_ + ((size_t)(b * 2 + hsel) * SKV + s) * 128 + 2 * l5;
        *(unsigned*)dst = cvt_pk_bf16(a0 * rs * kg0.x, a1 * rs * kg0.y); *(unsigned*)(dst + 64) = cvt_pk_bf16(e0 * rs * kg1.x, e1 * rs * kg1.y);
    }
}

template <int W> __device__ __forceinline__ void pool_item(const bf16_t* zb  , int s, bf16_t* dst) {
    constexpr int half = W / 2;
    u32x4 w[W];
#pragma unroll
    for (int k = 0; k < W; ++k) { int t = s - half + k; t = t < 0 ? 0 : (t > SEQ - 1 ? SEQ - 1 : t); w[k] = *(const u32x4*)(zb + (size_t)t * 2048); }
    float acc[8];
#pragma unroll
    for (int c = 0; c < 8; ++c) acc[c] = 0.f;
#pragma unroll
    for (int k = 0; k < W; ++k) { const int t = s - half + k; const float m = (t >= 0 && t < SEQ) ? 1.f : 0.f;
#pragma unroll
        for (int c = 0; c < 4; ++c) { acc[2 * c] += m * bf_lo(w[k][c]); acc[2 * c + 1] += m * bf_hi(w[k][c]); } }
    const int lo = s - half < 0 ? 0 : s - half, hi = s + half - 1 > SEQ - 1 ? SEQ - 1 : s + half - 1; const float ic = 1.f / (float)(hi - lo + 1);
    const u32x4 zc = w[half];
    float o[8];
#pragma unroll
    for (int c = 0; c < 4; ++c) { o[2 * c] = acc[2 * c] * ic - bf_lo(zc[c]); o[2 * c + 1] = acc[2 * c + 1] * ic - bf_hi(zc[c]); }
    u32x4 ov; ov.x = cvt_pk_bf16(o[0], o[1]); ov.y = cvt_pk_bf16(o[2], o[3]); ov.z = cvt_pk_bf16(o[4], o[5]); ov.w = cvt_pk_bf16(o[6], o[7]);
    *(u32x4*)dst = ov;
}
__device__ __forceinline__ void pool_phase(const Fr& F) {
    const int tid = opaque_tid(), lane = tid & 63, wave = __builtin_amdgcn_readfirstlane(tid >> 6);
    unsigned char* const ws_ = F.ws();
    const bf16_t* const S1_ = (const bf16_t*)(ws_ + WS_S1); bf16_t* const S2_ = (bf16_t*)(ws_ + WS_S2);
    const int gi = wave & 3, c8 = gi * 32 + (lane & 31), rsub = (wave >> 2) * 2 + (lane >> 5);
#pragma nounroll
    for (int r4 = F.bx; r4 < T / 4; r4 += F.G) {
        const int r = r4 * 4 + rsub, s = r & (SEQ - 1);
        const bf16_t* zb = S1_ + (size_t)(r - s) * 2048 + c8 * 8; bf16_t* dst = S2_ + (size_t)r * D + c8 * 8;
        if (gi == 0) pool_item<2>(zb, s, dst); else if (gi == 1) pool_item<4>(zb, s, dst); else if (gi == 2) pool_item<8>(zb, s, dst); else pool_item<16>(zb, s, dst);
    }
}

__global__ void __launch_bounds__(NTHR, 2) fwd_kernel(KArgs args) {
    extern __shared__ __attribute__((aligned(16))) unsigned char lds_raw[];
    LAS unsigned char* lds = (LAS unsigned char*)lds_raw;
    volatile LAS unsigned* MISC = (volatile LAS unsigned*)(lds + MISC_OFF);
    Fr F;
    F.PT = (volatile LAS unsigned long long*)(lds + MISC_OFF + 256);
    F.G = gridDim.x; F.bx = blockIdx.x; F.vcu = (F.G % 8 == 0) ? (F.bx % 8) * (F.G / 8) + F.bx / 8 : F.bx;
    { const int t0 = threadIdx.x;
      if (t0 < 64) MISC[t0] = 0u;
      if (t0 < 24) F.PT[t0] = (unsigned long long)args.in[t0];
      if (t0 == 24) F.PT[24] = (unsigned long long)args.out;
      if (t0 == 25) F.PT[25] = (unsigned long long)args.ws; }
    __syncthreads();
    XcdBarrier bar = xcd_barrier_post((unsigned*)(F.ws() + WS_CTL), MISC + 8);
    const int lo = args.ph_lo, hi = args.ph_hi;
    int p = 0;
#define RUN(...) RUNC(31, __VA_ARGS__)
#define RUNC(cls, ...) do { if (lo <= p && p < hi) { _Pragma("nounroll") for (int rep_ = 0; rep_ < 1 + (int)((REPEAT_MASK >> (cls)) & 1u); ++rep_) { __VA_ARGS__; if (REPEAT_MASK) __syncthreads(); } if (p + 1 < hi) xcd_barrier(bar); } ++p; } while (0)

#ifndef NO_P0
    RUNC(0, p0_phase(F, lds));
#endif
#pragma nounroll
    for (int L = 0; L < 4; ++L) {
        const int kind = L % 3, jm = L / 3;
        const bool with_ctx = (L == 0);
        RUNC(1, {
            float* xo = F.out(); float* xc = WSP(F, float, WS_XC);
#ifndef NO_NORM
            norm_phase(F, lds, L, 1, (L <= 1) ? TT : T, L - 1, (L == 0) ? F.in(I_X) : xo, (L == 0) ? F.in(I_CTX) : xc, xo, xc, (REPEAT_MASK >> 1) & 1u ? (rep_ == 0) : 0);
#endif
        });
        RUNC(2, {
            unsigned char* ws = F.ws();
            pg8::SchedDense S; S.A = (bf16_t*)(ws + WS_H); S.G = F.G; S.c = F.bx; S.a_pn_stride = 0; S.a_pm_stride = 256 * D; S.b_pn_stride = 256 * D; S.extra = 0;
            pg8::EpiA E; E.O = (bf16_t*)(ws + WS_S1); E.ldc = 2048; E.act = 0; E.VB = nullptr;
            if (kind == 0) { S.Bt = (bf16_t*)(ws + WS_WGIN) + (size_t)jm * 2048 * 1024; S.nM = with_ctx ? 72 : 64; S.nN = 8; E.act = 1; }
            else if (kind == 1) { S.Bt = (bf16_t*)(ws + WS_WAIN); S.nM = 64; S.nN = 6; S.extra = 16; E.VB = (bf16_t*)(ws + WS_VB); }
            else { S.Bt = (bf16_t*)(ws + WS_WPIN); S.nM = 64; S.nN = 4; }
            S.nwg = S.nM * S.nN;
            #ifndef NO_GA
            pg8::gemm_phase<pg8::EpiA, pg8::SchedDense>(lds, D, D, D, S, E);
#endif
        });
        if (kind == 0) {
#ifndef NO_SPAT
            RUNC(3, spatial_phase(F, lds, jm, with_ctx ? 144 : 128));
#endif
        }
        else if (kind == 1) {
#ifndef NO_QKN
            RUNC(4, qknorm_phase(F));
#endif
            RUNC(5, {
                unsigned char* ws = F.ws();
                const bf16_t* QB = (const bf16_t*)(ws + WS_QB); const bf16_t* KB = (const bf16_t*)(ws + WS_KB); const bf16_t* VB = (const bf16_t*)(ws + WS_VB); bf16_t* S2 = (bf16_t*)(ws + WS_S2);
                for (int i = 0; i * F.G + F.vcu < 512; ++i) { const int Lu = i * F.G + F.vcu, bk = Lu >> 5, w = Lu & 31, b = bk >> 1, kvh = bk & 1, h = kvh * 4 + (w >> 3), qb = w & 7;
#ifndef NO_ATT
                    att::attn_body<D, D>(QB + ((size_t)(b * SEQ + qb * 256)) * D + h * 128, KB + (size_t)bk * SKV * 128, VB + (size_t)bk * SKV * 128,
                                         S2 + ((size_t)(b * SEQ + qb * 256)) * D + h * 128, SKV, lds);
#endif
                    __syncthreads(); }
            });
        } else {
#ifndef NO_POOL
            RUNC(6, pool_phase(F));
#endif
        }
        RUNC(7, {
            unsigned char* ws = F.ws();
            pg8::SchedDense S; S.A = (bf16_t*)(ws + WS_S2); S.G = F.G; S.c = F.bx; S.a_pm_stride = 256 * D; S.a_pn_stride = 0; S.b_pn_stride = 256 * D; S.extra = 0; S.nN = 4; S.nM = 64;
            pg8::EpiB E; E.xd_lat = F.out(); E.xd_ctx = (float*)(ws + WS_XC); E.xs_lat = (L == 0) ? F.in(I_X) : E.xd_lat; E.xs_ctx = (L == 0) ? F.in(I_CTX) : E.xd_ctx;
            E.gt = (const float*)(ws + WS_MODV) + (size_t)L * 9 * 6144 + 2 * 1024; E.colscale = nullptr; E.dry = (REPEAT_MASK >> 7) & 1u ? (rep_ == 0) : 0;
            int K = D, ldb = D;
            if (kind == 0) { S.Bt = (bf16_t*)(ws + WS_WGOUT) + (size_t)jm * 1024 * 1024; S.nM = with_ctx ? 72 : 64; }
            else if (kind == 1) { S.Bt = (bf16_t*)(ws + WS_WAOUT); }
            else { S.Bt = (bf16_t*)(ws + WS_WPGRP); S.a_pn_stride = 256; S.b_pn_stride = 256 * 256; K = 256; ldb = 256; E.colscale = F.in(I_PSC); }
            S.nwg = S.nM * S.nN;
            #ifndef NO_GB
            pg8::gemm_phase<pg8::EpiB, pg8::SchedDense>(lds, K, D, ldb, S, E);
#endif
        });
        RUNC(8, {
            float* xo = F.out(); float* xc = WSP(F, float, WS_XC);
#ifndef NO_NORM
            norm_phase(F, lds, L, 2, with_ctx ? TT : T, -1, xo, xc, xo, xc, ((REPEAT_MASK >> 13) & 1u) && rep_ == 0 ? 2 : 0);
#endif
        });
#ifndef NO_TOPK
        RUNC(9, topk_phase(F, lds, with_ctx));
#endif
        RUNC(10, {
            unsigned char* ws = F.ws();
            pg8::SchedMoE<true> S; S.A = (bf16_t*)(ws + WS_H); S.IDX = (const int*)(ws + WS_IDX); S.Bt = (bf16_t*)(ws + WS_WUP) + (size_t)L * 16 * 2048 * 1024; S.nbt = with_ctx ? 9 : 8; S.nn = 8; S.G = F.G; S.vcu = F.vcu;
            pg8::EpiC E; E.HID = (bf16_t*)(ws + WS_HID);
            #ifndef NO_GC
            pg8::gemm_phase<pg8::EpiC, pg8::SchedMoE<true>>(lds, D, D, D, S, E);
#endif
        });
        RUNC(11, {
            unsigned char* ws = F.ws();
            pg8::SchedMoE<false> S; S.A = (bf16_t*)(ws + WS_HID); S.IDX = nullptr; S.Bt = (bf16_t*)(ws + WS_WDN) + (size_t)L * 16 * 1024 * 1024; S.nbt = with_ctx ? 9 : 8; S.nn = 4; S.G = F.G; S.vcu = F.vcu;
            pg8::EpiD E; E.Y = (bf16_t*)(ws + WS_YEXP); E.gate = (const float*)(ws + WS_GATE);
            #ifndef NO_GD
            pg8::gemm_phase<pg8::EpiD, pg8::SchedMoE<false>>(lds, D, D, D, S, E);
#endif
        });
    }
    RUN({
        float* xo = F.out(); float* xc = WSP(F, float, WS_XC);
#ifndef NO_NORM
        norm_phase(F, lds, 3, 0, T, 3, xo, xc, xo, xc);
#endif
    });
#undef RUN
#undef RUNC
}

constexpr int N_PHASES = 1 + 8 + 9 + 8 + 8 + 1;

extern "C" void kernel_launch(void* const* d_in, const int* in_sizes, int n_in, void* d_out, int out_size, void* d_ws, size_t ws_size, hipStream_t stream) {
    static int grid = 0;
    if (grid == 0) {
        if (n_in != 24 || out_size != T * D || ws_size < WS_END) { fprintf(stderr, "kernel_launch: unexpected shapes (n_in %d out %d ws %zu need %zu)\n", n_in, out_size, ws_size, (size_t)WS_END); grid = -1; return; }
        int dev = 0, cus = 0;
        if (hipGetDevice(&dev) != hipSuccess || hipDeviceGetAttribute(&cus, hipDeviceAttributeMultiprocessorCount, dev) != hipSuccess) { grid = -1; return; }
        if (hipFuncSetAttribute((const void*)fwd_kernel, hipFuncAttributeMaxDynamicSharedMemorySize, LDS_BYTES) != hipSuccess) { fprintf(stderr, "kernel_launch: hipFuncSetAttribute failed\n"); grid = -1; return; }
        (void)hipGetLastError();
        grid = cus;
    }
    if (grid < 0) return;
    (void)hipMemsetAsync((char*)d_ws + WS_CTL, 0, CTL_BYTES, stream);
    KArgs a{};
    for (int i = 0; i < 24; ++i) a.in[i] = (const float*)d_in[i];
    a.out = (float*)d_out; a.ws = (unsigned char*)d_ws;
#if MK_PER_PHASE
    for (int k = 0; k < N_PHASES; ++k) { a.ph_lo = k; a.ph_hi = k + 1; hipLaunchKernelGGL(fwd_kernel, dim3(grid), dim3(NTHR), LDS_BYTES, stream, a); }
#else
    a.ph_lo = 0; a.ph_hi = N_PHASES;
    hipLaunchKernelGGL(fwd_kernel, dim3(grid), dim3(NTHR), LDS_BYTES, stream, a);
#endif
    const hipError_t le = hipPeekAtLastError();
    if (le != hipSuccess) fprintf(stderr, "kernel_launch: launch failed: %s\n", hipGetErrorName(le));
}
```

```cpp
#include <hip/hip_runtime.h>
#include <cstdio>
#include <cstdint>

#ifndef REPEAT_MASK
#define REPEAT_MASK 0u
#endif
#ifndef MK_PER_PHASE
#define MK_PER_PHASE 0
#endif

#define LAS __attribute__((address_space(3)))
#define GAS __attribute__((address_space(1)))
typedef unsigned short bf16_t;
typedef short bf16x8 __attribute__((ext_vector_type(8)));
typedef short s16x4 __attribute__((ext_vector_type(4)));
typedef float f32x2 __attribute__((ext_vector_type(2)));
typedef float f32x4 __attribute__((ext_vector_type(4)));
typedef float f32x16 __attribute__((ext_vector_type(16)));
typedef unsigned u32x2 __attribute__((ext_vector_type(2)));
typedef unsigned u32x4 __attribute__((ext_vector_type(4)));

constexpr int D = 1024, NB = 8, SEQ = 2048, T = NB * SEQ, CL = 256, TC = NB * CL, TT = T + TC, NE = 16, CAP = 256, CCAP = 32, NTILE = 144;
constexpr int SKV = CL + SEQ;
constexpr float EPS = 1e-6f;
constexpr int NWAVES = 8, NTHR = 512;

constexpr size_t al256(size_t x) { return (x + 255) / 256 * 256; }
constexpr size_t WS_CTL   = 0;
constexpr size_t CTL_BYTES = 65536;
constexpr size_t WS_MODV  = WS_CTL + CTL_BYTES;
constexpr size_t WS_AFF   = WS_MODV + al256((size_t)4 * 9 * 6144 * 4);
constexpr size_t WS_SLOT  = WS_AFF + (size_t)TT * 16 * 4;
constexpr size_t WS_GATE  = WS_SLOT + (size_t)TT * 16 * 4;
constexpr size_t WS_VST   = WS_GATE + (size_t)NTILE * 256 * 4;
constexpr size_t WS_WSW   = WS_VST + (size_t)TT * 16 * 2 * 4;
constexpr size_t WS_WGIN  = WS_WSW + (size_t)2 * 8 * 128 * 128 * 2;
constexpr size_t WS_WGOUT = WS_WGIN + (size_t)2 * 2048 * 1024 * 2;
constexpr size_t WS_WAIN  = WS_WGOUT + (size_t)2 * 1024 * 1024 * 2;
constexpr size_t WS_WAOUT = WS_WAIN + (size_t)1536 * 1024 * 2;
constexpr size_t WS_WPIN  = WS_WAOUT + (size_t)1024 * 1024 * 2;
constexpr size_t WS_WPGRP = WS_WPIN + (size_t)1024 * 1024 * 2;
constexpr size_t WS_WUP   = WS_WPGRP + (size_t)4 * 256 * 256 * 2;
constexpr size_t WS_WDN   = WS_WUP + (size_t)4 * 16 * 2048 * 1024 * 2;
constexpr size_t WS_XC    = WS_WDN + (size_t)4 * 16 * 1024 * 1024 * 2;
constexpr size_t WS_H     = WS_XC + (size_t)TC * D * 4;
constexpr size_t WS_S1    = WS_H + (size_t)TT * D * 2;
constexpr size_t WS_S2    = WS_S1 + (size_t)TT * 2048 * 2;
constexpr size_t WS_QB    = WS_S2 + (size_t)TT * D * 2;
constexpr size_t WS_KB    = WS_QB + (size_t)T * D * 2;
constexpr size_t WS_VB    = WS_KB + (size_t)NB * 2 * SKV * 128 * 2;
constexpr size_t WS_IDX   = WS_VB + (size_t)NB * 2 * SKV * 128 * 2;
constexpr size_t WS_HID   = WS_IDX + (size_t)NTILE * 256 * 4;
constexpr size_t WS_YEXP  = WS_HID + (size_t)NTILE * 256 * D * 2;
constexpr size_t WS_END   = WS_YEXP + (size_t)NTILE * 256 * D * 2;

constexpr int RING_BYTES = 131072, MISC_OFF = RING_BYTES, LDS_BYTES = RING_BYTES + 1024;

__device__ __forceinline__ unsigned cvt_pk_bf16(float lo, float hi) { unsigned r; asm volatile("v_cvt_pk_bf16_f32 %0, %1, %2" : "=v"(r) : "v"(lo), "v"(hi)); return r; }
__device__ __forceinline__ float bf_lo(unsigned u) { return __uint_as_float(u << 16); }
__device__ __forceinline__ float bf_hi(unsigned u) { return __uint_as_float(u & 0xffff0000u); }
__device__ __forceinline__ float bf2f(bf16_t b) { return __uint_as_float(((unsigned)b) << 16); }
__device__ __forceinline__ bf16_t f2bf(float f) { return (bf16_t)(cvt_pk_bf16(f, 0.f) & 0xffffu); }
template <int K> __device__ __forceinline__ float swz_xor(float v) { return __int_as_float(__builtin_amdgcn_ds_swizzle(__float_as_int(v), 0x1F | (K << 10))); }
__device__ __forceinline__ float half_sum(float v) { v += swz_xor<1>(v); v += swz_xor<2>(v); v += swz_xor<4>(v); v += swz_xor<8>(v); v += swz_xor<16>(v); return v; }
__device__ __forceinline__ float half_max(float v) { v = fmaxf(v, swz_xor<1>(v)); v = fmaxf(v, swz_xor<2>(v)); v = fmaxf(v, swz_xor<4>(v)); v = fmaxf(v, swz_xor<8>(v)); v = fmaxf(v, swz_xor<16>(v)); return v; }
__device__ __forceinline__ float wave_sum(float v) { v = half_sum(v); auto rr = __builtin_amdgcn_permlane32_swap(__float_as_uint(v), __float_as_uint(v), false, false); return __uint_as_float(rr[0]) + __uint_as_float(rr[1]); }
__device__ __forceinline__ float wave_max(float v) { v = half_max(v); auto rr = __builtin_amdgcn_permlane32_swap(__float_as_uint(v), __float_as_uint(v), false, false); return fmaxf(__uint_as_float(rr[0]), __uint_as_float(rr[1])); }
__device__ __forceinline__ float xor32(float v, bool hi) { auto rr = __builtin_amdgcn_permlane32_swap(__float_as_uint(v), __float_as_uint(v), false, false); return __uint_as_float(hi ? rr[0] : rr[1]); }
__device__ __forceinline__ int opaque_tid() { int t = threadIdx.x; asm volatile("" : "+v"(t)); return t; }
__device__ __forceinline__ float silu_f(float x) { return x / (1.f + __expf(-x)); }
__device__ __forceinline__ float gelu_tanh_f(float x) {
    const float z = 0.7978845608028654f * (x + 0.044715f * x * x * x);
    return x / (1.f + __expf(-2.f * z));
}
#define LDS_WAIT() asm volatile("s_waitcnt lgkmcnt(0)" ::: "memory")

#define XB_TMO      128
#define XB_XCNT(j)  (256  + 64 * (j))
#define XB_XSUB(j)  (1280 + 64 * (j))
#define XB_XGEN(j)  (2304 + 64 * (j))
#define XB_TOP      3328
#define XB_TOPGEN   3392
#define XCD_BAR_WORDS 3456
#define XB_SPIN_CAP (1u << 22)
__device__ __forceinline__ unsigned xb_ld(unsigned* p)              { return __hip_atomic_load(p, __ATOMIC_RELAXED, __HIP_MEMORY_SCOPE_AGENT); }
__device__ __forceinline__ unsigned xb_add(unsigned* p, unsigned v) { return __hip_atomic_fetch_add(p, v, __ATOMIC_RELAXED, __HIP_MEMORY_SCOPE_AGENT); }
__device__ __forceinline__ unsigned xb_xcc_id() { return (unsigned)__builtin_amdgcn_s_getreg((3 << 11) | 20) & 0xFu; }
#define XB_SPIN(cond, bar) do { unsigned _sp = 0; while (cond) { __builtin_amdgcn_s_sleep(1); \
    if ((++_sp & 255u) == 0u) { if (xb_ld(&(bar)[XB_TMO])) break; if (_sp > XB_SPIN_CAP) { atomicAdd(&(bar)[XB_TMO], 1u); break; } } } } while (0)
struct XcdBarrier { unsigned* bar; unsigned x; volatile LAS unsigned* st; };
__device__ __forceinline__ XcdBarrier xcd_barrier_post(unsigned* bar, volatile LAS unsigned* st) {
    XcdBarrier b; b.bar = bar; b.x = xb_xcc_id(); b.st = st;
    if (threadIdx.x == 0) (void)xb_add(&bar[XB_XCNT(b.x)], 1u);
    return b;
}
__device__ __forceinline__ void xcd_barrier_complete(unsigned* bar, unsigned x, unsigned& nloc, unsigned& nx) {
    const unsigned G = gridDim.x * gridDim.y * gridDim.z;
    unsigned sum, cnt, mine, sp = 0u;
    for (;;) {
        sum = 0u; cnt = 0u; mine = 0u;
#pragma unroll
        for (unsigned j = 0; j < 16; ++j) { const unsigned c = xb_ld(&bar[XB_XCNT(j)]); sum += c; cnt += (c > 0u) ? 1u : 0u; }
        mine = xb_ld(&bar[XB_XCNT(x)]);
        if (sum == G) break;
        __builtin_amdgcn_s_sleep(1);
        if ((++sp & 255u) == 0u) { if (xb_ld(&bar[XB_TMO])) break; if (sp > XB_SPIN_CAP) { atomicAdd(&bar[XB_TMO], 1u); break; } }
    }
    nloc = mine > 0u ? mine : 1u; nx = cnt > 0u ? cnt : 1u;
}
__device__ __forceinline__ void xcd_barrier(const XcdBarrier& b) {
    asm volatile("s_waitcnt vmcnt(0)" ::: "memory");
    __syncthreads();
    if (threadIdx.x == 0) {
        unsigned* bar = b.bar;
        __builtin_amdgcn_s_waitcnt(0);
        unsigned nloc = b.st[0], nx = b.st[1];
        if (nloc == 0u) { xcd_barrier_complete(bar, b.x, nloc, nx); b.st[0] = nloc; b.st[1] = nx; }
        const unsigned old = xb_add(&bar[XB_XSUB(b.x)], 1u);
        const unsigned gen = old / nloc;
        if (old + 1u == (gen + 1u) * nloc) {
            __builtin_amdgcn_fence(__ATOMIC_RELEASE, "agent");
            asm volatile("s_waitcnt vmcnt(0)" ::: "memory");
            const unsigned og = xb_add(&bar[XB_TOP], 1u);
            const unsigned tg = og / nx;
            if (og + 1u == (tg + 1u) * nx) xb_add(&bar[XB_TOPGEN], 1u);
            else XB_SPIN(xb_ld(&bar[XB_TOPGEN]) == tg, bar);
            __builtin_amdgcn_fence(__ATOMIC_ACQUIRE, "agent");
            xb_add(&bar[XB_XGEN(b.x)], 1u);
            asm volatile("s_waitcnt vmcnt(0)" ::: "memory");
        } else {
            XB_SPIN(xb_ld(&bar[XB_XGEN(b.x)]) == gen, bar);
            __builtin_amdgcn_fence(__ATOMIC_ACQUIRE, "agent");
            asm volatile("s_waitcnt vmcnt(0)" ::: "memory");
        }
    }
    __syncthreads();
}

namespace pg8 {
constexpr int BM = 256, BK = 64, HALF = 128, HTB = HALF * BK * 2, NXCD = 8, WGM = 8;
__host__ __device__ __forceinline__ int lds_byte(int r, int c) { const int st = (r >> 4) * 2 + (c >> 5), rr = r & 15, cc = c & 31, ob = rr * 64 + cc * 2; return st * 1024 + (ob ^ (((ob >> 9) & 1) << 5)); }
__host__ __device__ __forceinline__ void stage_rc(int b, int& R, int& C) { const int st = b / 1024, sb = b % 1024, swz = sb ^ (((sb >> 9) & 1) << 5); R = (st >> 1) * 16 + swz / 64; C = (st & 1) * 32 + (swz % 64) / 2; }
__host__ __device__ __forceinline__ int perm32(int rho) { const int n = rho >> 4, i = rho & 15; return 8 * (i >> 2) + 4 * n + (i & 3); }
struct Unit { int pm, pn; };

template <class Epi, class Sched>
__device__ __forceinline__ void gemm_phase(LAS unsigned char* lds, const int K, const int lda, const int ldb, const Sched& S, const Epi& E) {
    const int tid = opaque_tid(), wid = __builtin_amdgcn_readfirstlane(tid >> 6), lane = tid & 63, wr = wid >> 2, wc = wid & 3, fr = lane & 15, fq = lane >> 4;
    const int nt = K / BK;
    constexpr bool GATHER = Sched::GATHER;
    unsigned voffA[2], voffB[2]; int rowA[2];
#pragma unroll
    for (int i = 0; i < 2; ++i) { int R, C; stage_rc(tid * 16 + i * 8192, R, C); const int Rb = Epi::PERM ? ((R & ~31) + perm32(R & 31)) : R;
        voffA[i] = GATHER ? (unsigned)C * 2u : (unsigned)(R * lda + C) * 2u; voffB[i] = (unsigned)(Rb * ldb + C) * 2u; rowA[i] = R; }
    unsigned gA[2][2], gN[2][2];
    const size_t kstep = (size_t)(BK * 2);
    const size_t hstepA = (size_t)HALF * lda * 2, hstepB = (size_t)HALF * ldb * 2;
    const unsigned ldsw = (unsigned)wid * 1024u;
    const int aoff = lds_byte(wr * 64 + fr, fq * 8), boff = lds_byte(wc * 32 + fr, fq * 8);
#define PG8_SA(b, h) (((b) * 2 + (h)) * HTB)
#define PG8_SB(b, h) ((4 + (b) * 2 + (h)) * HTB)
#define PG8_STAGE(bufoff, gbase, voff) do { _Pragma("unroll") for (int _i = 0; _i < 2; ++_i) \
        __builtin_amdgcn_global_load_lds((const unsigned*)((const char*)(gbase) + (voff)[_i]), (LAS unsigned*)(lds + (bufoff) + ldsw + _i * 8192), 16, 0, 0); } while (0)
#define PG8_STAGE_A(bufoff, ubase, kb, h, nx) do { if constexpr (GATHER) { unsigned _v[2]; _v[0] = ((nx) ? gN[h][0] : gA[h][0]) + voffA[0]; _v[1] = ((nx) ? gN[h][1] : gA[h][1]) + voffA[1]; \
        PG8_STAGE(bufoff, (const char*)S.abase() + (kb), _v); } else { PG8_STAGE(bufoff, (ubase) + (size_t)(h) * hstepA + (kb), voffA); } } while (0)
#define PG8_LOADG(u, g) do { if constexpr (GATHER) { const int* _ip = S.idx(u); _Pragma("unroll") for (int _h = 0; _h < 2; ++_h) _Pragma("unroll") for (int _i = 0; _i < 2; ++_i) \
        g[_h][_i] = (unsigned)_ip[_h * HALF + rowA[_i]] * (unsigned)(lda * 2); } } while (0)
#define PG8_LDA(dst, b, h) do { _Pragma("unroll") for (int m = 0; m < 4; ++m) _Pragma("unroll") for (int k = 0; k < 2; ++k) dst[m][k] = *(const LAS bf16x8*)(lds + PG8_SA(b, h) + aoff + m * 2048 + k * 1024); } while (0)
#define PG8_LDB(dst, b, h) do { _Pragma("unroll") for (int n = 0; n < 2; ++n) _Pragma("unroll") for (int k = 0; k < 2; ++k) dst[n][k] = *(const LAS bf16x8*)(lds + PG8_SB(b, h) + boff + n * 2048 + k * 1024); } while (0)
#define PG8_MMA(ai, bj, At, Bt) do { __builtin_amdgcn_s_setprio(1); _Pragma("unroll") for (int m = 0; m < 4; ++m) _Pragma("unroll") for (int n = 0; n < 2; ++n) _Pragma("unroll") for (int k = 0; k < 2; ++k) \
        acc[ai][bj][m][n] = __builtin_amdgcn_mfma_f32_16x16x32_bf16(Bt[n][k], At[m][k], acc[ai][bj][m][n], 0, 0, 0); __builtin_amdgcn_s_setprio(0); } while (0)
#define PG8_WAIT_V(n) asm volatile("s_waitcnt vmcnt(" #n ")" ::: "memory")
#define PG8_WAIT_L(n) asm volatile("s_waitcnt lgkmcnt(" #n ")" ::: "memory")
#define PG8_BAR __builtin_amdgcn_s_barrier()
#define PG8_SCHED __builtin_amdgcn_sched_barrier(0)
    Unit cur, nxt; int ui = 0;
    if (!S.next(0, cur)) return;
    f32x4 acc[2][2][4][2];
#pragma unroll
    for (int a = 0; a < 2; ++a)
#pragma unroll
        for (int b = 0; b < 2; ++b)
#pragma unroll
            for (int m = 0; m < 4; ++m)
#pragma unroll
                for (int n = 0; n < 2; ++n) acc[a][b][m][n] = (f32x4){0.f, 0.f, 0.f, 0.f};
    bf16x8 At[4][2], B0[2][2], B1[2][2];
    const char* cA = GATHER ? (const char*)nullptr : S.aptr(cur); const char* cB = S.bptr(cur);
    PG8_LOADG(cur, gA);
    PG8_STAGE(PG8_SB(0, 0), cB, voffB); PG8_STAGE(PG8_SB(0, 1), cB + hstepB, voffB); PG8_STAGE_A(PG8_SA(0, 0), cA, 0, 0, false); PG8_STAGE_A(PG8_SA(0, 1), cA, 0, 1, false);
    if (wr == 1) PG8_BAR;
    PG8_WAIT_V(2); PG8_BAR;
    PG8_STAGE(PG8_SB(1, 0), cB + kstep, voffB); PG8_STAGE_A(PG8_SA(1, 0), cA, kstep, 0, false); PG8_STAGE(PG8_SB(1, 1), cB + hstepB + kstep, voffB);
    PG8_WAIT_V(6); PG8_BAR;
    for (;;) {
        const bool has_next = S.next(ui + 1, nxt);
        const char* nA = (has_next && !GATHER) ? S.aptr(nxt) : cA; const char* nB = has_next ? S.bptr(nxt) : cB;
        if (has_next) PG8_LOADG(nxt, gN); else { if constexpr (GATHER) {
#pragma unroll
            for (int h_ = 0; h_ < 2; ++h_) { gN[h_][0] = gA[h_][0]; gN[h_][1] = gA[h_][1]; } } }
        for (int t = 0; t < nt; t += 2) {
            const bool last = (t == nt - 2);
            const size_t k1 = (size_t)(t + 1) * kstep, k2 = last ? 0 : (size_t)(t + 2) * kstep, k3 = k2 + kstep;
            const char* a2 = last ? nA : cA; const char* b2 = last ? nB : cB + (size_t)(t + 2) * kstep;
            const char* b3 = b2 + kstep;
            PG8_LDB(B0, 0, 0); PG8_LDB(B1, 0, 1); PG8_SCHED; PG8_LDA(At, 0, 0); PG8_STAGE_A(PG8_SA(1, 1), cA, k1, 1, false);
            PG8_WAIT_V(8); PG8_WAIT_L(0); PG8_BAR; PG8_MMA(0, 0, At, B0); PG8_MMA(0, 1, At, B1); PG8_BAR; PG8_SCHED;
            PG8_LDA(At, 0, 1); PG8_STAGE(PG8_SB(0, 0), b2, voffB); PG8_STAGE(PG8_SB(0, 1), b2 + hstepB, voffB); PG8_STAGE_A(PG8_SA(0, 0), a2, k2, 0, last);
            PG8_WAIT_V(8); PG8_WAIT_L(0); PG8_BAR; PG8_MMA(1, 0, At, B0); PG8_MMA(1, 1, At, B1); PG8_BAR; PG8_SCHED;
            PG8_LDB(B0, 1, 0); PG8_LDB(B1, 1, 1); PG8_SCHED; PG8_LDA(At, 1, 0); PG8_STAGE_A(PG8_SA(0, 1), a2, k2, 1, last);
            PG8_WAIT_V(8); PG8_WAIT_L(0); PG8_BAR; PG8_MMA(0, 0, At, B0); PG8_MMA(0, 1, At, B1); PG8_BAR; PG8_SCHED;
            PG8_LDA(At, 1, 1); PG8_STAGE(PG8_SB(1, 0), b3, voffB); PG8_STAGE(PG8_SB(1, 1), b3 + hstepB, voffB); PG8_STAGE_A(PG8_SA(1, 0), a2, k3, 0, last);
            PG8_WAIT_V(8); PG8_WAIT_L(0); PG8_BAR; PG8_MMA(1, 0, At, B0); PG8_MMA(1, 1, At, B1); PG8_BAR; PG8_SCHED;
        }
        if (wr == 0) PG8_BAR;
        E(acc, cur, wr, wc, fr, fq);
        if (!has_next) break;
#pragma unroll
        for (int a = 0; a < 2; ++a)
#pragma unroll
            for (int b = 0; b < 2; ++b)
#pragma unroll
                for (int m = 0; m < 4; ++m)
#pragma unroll
                    for (int n = 0; n < 2; ++n) acc[a][b][m][n] = (f32x4){0.f, 0.f, 0.f, 0.f};
        cur = nxt; cA = nA; cB = nB; ++ui;
        if constexpr (GATHER) {
#pragma unroll
            for (int h_ = 0; h_ < 2; ++h_) { gA[h_][0] = gN[h_][0]; gA[h_][1] = gN[h_][1]; } }
        if (wr == 1) PG8_BAR;
    }
    PG8_WAIT_V(0);
    PG8_BAR;
#undef PG8_SA
#undef PG8_SB
#undef PG8_STAGE
#undef PG8_STAGE_A
#undef PG8_LOADG
#undef PG8_LDA
#undef PG8_LDB
#undef PG8_MMA
#undef PG8_WAIT_V
#undef PG8_WAIT_L
#undef PG8_BAR
#undef PG8_SCHED
}

struct SchedDense {
    static constexpr bool GATHER = false;
    __device__ __forceinline__ const char* abase() const { return nullptr; }
    __device__ __forceinline__ const int* idx(const Unit&) const { return nullptr; }
    const bf16_t* A; const bf16_t* Bt; int a_pm_stride, a_pn_stride, b_pn_stride;
    int nM, nN, nwg, extra, G, c;
    __device__ __forceinline__ bool next(int i, Unit& u) const {
        const int L = i * G + c; if (L >= nwg + extra) return false;
        if (L >= nwg) { const int x = L - nwg; u.pm = nM + (x >> 1); u.pn = 4 + (x & 1); return true; }
        int wgid = L; { const int q = nwg / NXCD, r = nwg % NXCD, xcd = wgid % NXCD, off = wgid / NXCD; wgid = (xcd < r ? xcd * (q + 1) : r * (q + 1) + (xcd - r) * q) + off; }
        const int nig = WGM * nN, gid = wgid / nig, fm = gid * WGM, gsz = (nM - fm) < WGM ? (nM - fm) : WGM;
        u.pm = fm + ((wgid % nig) % gsz); u.pn = (wgid % nig) / gsz; return true;
    }
    __device__ __forceinline__ const char* aptr(const Unit& u) const { return (const char*)(A + (size_t)u.pm * a_pm_stride + (size_t)u.pn * a_pn_stride); }
    __device__ __forceinline__ const char* bptr(const Unit& u) const { return (const char*)(Bt + (size_t)u.pn * b_pn_stride); }
};
template <bool GATHER_>
struct SchedMoE {
    static constexpr bool GATHER = GATHER_;
    const bf16_t* A; const bf16_t* Bt; const int* IDX; int nbt, nn, G, vcu;
    __device__ __forceinline__ bool next(int i, Unit& u) const {
        const int L = i * G + vcu, per_e = nbt * nn; if (L >= NE * per_e) return false;
        const int e = L / per_e, rem = L - e * per_e, bt = rem / nn, j = rem - bt * nn;
        u.pm = bt < 8 ? e * 8 + bt : 128 + e; u.pn = e * nn + j; return true;
    }
    __device__ __forceinline__ const char* aptr(const Unit& u) const { return (const char*)(A + (size_t)u.pm * 256 * D); }
    __device__ __forceinline__ const char* abase() const { return (const char*)A; }
    __device__ __forceinline__ const int* idx(const Unit& u) const { return IDX + (size_t)u.pm * 256; }
    __device__ __forceinline__ const char* bptr(const Unit& u) const { return (const char*)(Bt + (size_t)u.pn * 256 * D); }
};

struct EpiA {
    static constexpr bool PERM = true;
    bf16_t* O; int ldc; int act; bf16_t* VB; float* stats;
    __device__ __forceinline__ void operator()(const f32x4 (&acc)[2][2][4][2], const Unit& u, int wr, int wc, int fr, int fq) const {
        const int row0 = u.pm * BM + wr * 64 + fr, cl = wc * 32 + 8 * fq;
        const bool vtile = (VB != nullptr) && (u.pn == 5);
        const bool dostat = (stats != nullptr) && (u.pn >= 4);
#pragma unroll
        for (int ai = 0; ai < 2; ++ai)
#pragma unroll
            for (int m = 0; m < 4; ++m) {
                const int r = row0 + ai * HALF + m * 16;
                float s1 = 0.f, s2 = 0.f;
#pragma unroll
                for (int bj = 0; bj < 2; ++bj) {
                    f32x4 v0 = acc[ai][bj][m][0], v1 = acc[ai][bj][m][1];
                    if (act) {
#pragma unroll
                        for (int j = 0; j < 4; ++j) { v0[j] = gelu_tanh_f(v0[j]); v1[j] = gelu_tanh_f(v1[j]); } }
#pragma unroll
                    for (int j = 0; j < 4; ++j) { s1 += v0[j] + v1[j]; s2 += v0[j] * v0[j] + v1[j] * v1[j]; }
                    u32x4 w; w.x = cvt_pk_bf16(v0[0], v0[1]); w.y = cvt_pk_bf16(v0[2], v0[3]); w.z = cvt_pk_bf16(v1[0], v1[1]); w.w = cvt_pk_bf16(v1[2], v1[3]);
                    bf16_t* dst;
                    if (vtile) { int b, pos; if (r < T) { b = r >> 11; pos = CL + (r & (SEQ - 1)); } else { const int rc = r - T; b = rc >> 8; pos = rc & (CL - 1); }
                        dst = VB + ((size_t)(b * 2 + bj) * SKV + pos) * 128 + cl; }
                    else dst = O + (size_t)r * ldc + u.pn * BM + bj * HALF + cl;
                    *(u32x4*)dst = w; }
                if (dostat) {
                    s1 += swz_xor<16>(s1); s2 += swz_xor<16>(s2);
                    { auto rr = __builtin_amdgcn_permlane32_swap(__float_as_uint(s1), __float_as_uint(s1), false, false); s1 = __uint_as_float(rr[0]) + __uint_as_float(rr[1]); }
                    { auto rr = __builtin_amdgcn_permlane32_swap(__float_as_uint(s2), __float_as_uint(s2), false, false); s2 = __uint_as_float(rr[0]) + __uint_as_float(rr[1]); }
                    if (fq == 0) *(f32x2*)(stats + ((size_t)r * 16 + (u.pn - 4) * 4 + wc) * 2) = (f32x2){s1, s2}; } }
    }
};
struct EpiB {
    static constexpr bool PERM = false;
    const float* xs_lat; const float* xs_ctx; float* xd_lat; float* xd_ctx; const float* gt; const float* colscale; int dry;
    __device__ __forceinline__ void operator()(const f32x4 (&acc)[2][2][4][2], const Unit& u, int wr, int wc, int fr, int fq) const {
        const int row0 = u.pm * BM + wr * 64 + fr, col0 = u.pn * BM + wc * 32 + 4 * fq;
        const bool isctx = row0 >= T;
        const int mrow = isctx ? 8 : (row0 >> 11);
        const float* xs = isctx ? xs_ctx - (size_t)T * D : xs_lat; float* xd = isctx ? xd_ctx - (size_t)T * D : xd_lat;
        f32x4 gv[2][2];
#pragma unroll
        for (int bj = 0; bj < 2; ++bj)
#pragma unroll
            for (int n = 0; n < 2; ++n) { const int c = col0 + bj * HALF + n * 16; gv[bj][n] = *(const f32x4*)(gt + (size_t)mrow * 6144 + c);
                if (colscale) gv[bj][n] = gv[bj][n] * *(const f32x4*)(colscale + c); }
#pragma unroll
        for (int ai = 0; ai < 2; ++ai)
#pragma unroll
            for (int m = 0; m < 4; ++m) { const size_t off = (size_t)(row0 + ai * HALF + m * 16) * D + col0;
#pragma unroll
                for (int bj = 0; bj < 2; ++bj)
#pragma unroll
                    for (int n = 0; n < 2; ++n) { const f32x4 xo = *(const f32x4*)(xs + off + bj * HALF + n * 16);
                        const f32x4 xn = xo + gv[bj][n] * acc[ai][bj][m][n]; if (!dry) *(f32x4*)(xd + off + bj * HALF + n * 16) = xn; } }
    }
};
struct EpiC {
    static constexpr bool PERM = true;
    bf16_t* HID;
    __device__ __forceinline__ void operator()(const f32x4 (&acc)[2][2][4][2], const Unit& u, int wr, int wc, int fr, int fq) const {
        const int n8 = u.pn & 7, rl = wr * 64 + fr, cl = n8 * 128 + wc * 32 + 8 * fq;
        bf16_t* base = HID + (size_t)u.pm * 256 * D;
#pragma unroll
        for (int ai = 0; ai < 2; ++ai)
#pragma unroll
            for (int m = 0; m < 4; ++m) {
                float h[8];
#pragma unroll
                for (int n = 0; n < 2; ++n)
#pragma unroll
                    for (int j = 0; j < 4; ++j) { const float g = acc[ai][0][m][n][j], up = acc[ai][1][m][n][j]; h[n * 4 + j] = silu_f(g) * up; }
                u32x4 w; w.x = cvt_pk_bf16(h[0], h[1]); w.y = cvt_pk_bf16(h[2], h[3]); w.z = cvt_pk_bf16(h[4], h[5]); w.w = cvt_pk_bf16(h[6], h[7]);
                *(u32x4*)(base + (size_t)(rl + ai * HALF + m * 16) * D + cl) = w; }
    }
};
struct EpiD {
    static constexpr bool PERM = true;
    bf16_t* Y; const float* gate;
    __device__ __forceinline__ void operator()(const f32x4 (&acc)[2][2][4][2], const Unit& u, int wr, int wc, int fr, int fq) const {
        const int n4 = u.pn & 3, rl = wr * 64 + fr, cl = n4 * 256 + wc * 32 + 8 * fq;
        bf16_t* base = Y + (size_t)u.pm * 256 * D; const float* gp = gate + (size_t)u.pm * 256;
#pragma unroll
        for (int ai = 0; ai < 2; ++ai)
#pragma unroll
            for (int m = 0; m < 4; ++m) { const int r = rl + ai * HALF + m * 16; const float g = gp[r];
#pragma unroll
                for (int bj = 0; bj < 2; ++bj) { const f32x4 v0 = acc[ai][bj][m][0] * g, v1 = acc[ai][bj][m][1] * g;
                    u32x4 w; w.x = cvt_pk_bf16(v0[0], v0[1]); w.y = cvt_pk_bf16(v0[2], v0[3]); w.z = cvt_pk_bf16(v1[0], v1[1]); w.w = cvt_pk_bf16(v1[2], v1[3]);
                    *(u32x4*)(base + (size_t)r * D + bj * HALF + cl) = w; } }
    }
};
}

namespace att {
constexpr int QBLK = 32, KVBLK = 64;
constexpr float SCALE = 0.088388347648318440f;
constexpr float THR = 8.f;
constexpr int SHM_V = KVBLK * 128 * 2, SHM_K = KVBLK * 128 * 2;
#define KSWZ(row, colB) ((row) * 256 + ((colB) ^ (((row) & 7) << 4)))
#define SBAR() __builtin_amdgcn_sched_barrier(0)
__device__ __forceinline__ int crow(int r, int hi) { return (r & 3) + 8 * (r >> 2) + 4 * hi; }
__device__ __forceinline__ void partialSM(f32x16& p0, f32x16& p1, float& m_reg, float& mn, float& alpha) {
    constexpr float C = SCALE * 1.4426950408889634f;
    float pmax = p0[0];
#pragma unroll
    for (int r = 1; r < 16; ++r) pmax = fmaxf(pmax, p0[r]);
#pragma unroll
    for (int r = 0; r < 16; ++r) pmax = fmaxf(pmax, p1[r]);
    { auto rr = __builtin_amdgcn_permlane32_swap(__float_as_uint(pmax), __float_as_uint(pmax), false, false);
      pmax = fmaxf(__uint_as_float(rr[0]), __uint_as_float(rr[1])); }
    if (__builtin_expect(__all(pmax - m_reg <= THR / SCALE), 1)) { mn = m_reg; alpha = 1.f; }
    else { mn = fmaxf(m_reg, pmax); alpha = __builtin_amdgcn_exp2f((m_reg - mn) * C); m_reg = mn; }
    float mnC = -mn * C;
#pragma unroll
    for (int r = 0; r < 16; ++r) p0[r] = fmaf(p0[r], C, mnC);
#pragma unroll
    for (int r = 0; r < 16; ++r) p1[r] = fmaf(p1[r], C, mnC);
#pragma unroll
    for (int r = 0; r < 16; ++r) p0[r] = __builtin_amdgcn_exp2f(p0[r]);
}
__device__ __forceinline__ void finishSM(f32x16& p0, f32x16& p1, float alpha, float& l_reg, bf16x8& pa0, bf16x8& pa1, bf16x8& pa2, bf16x8& pa3) {
#pragma unroll
    for (int r = 0; r < 16; ++r) p1[r] = __builtin_amdgcn_exp2f(p1[r]);
    float ps = 0;
#pragma unroll
    for (int r = 0; r < 16; ++r) ps += p0[r];
#pragma unroll
    for (int r = 0; r < 16; ++r) ps += p1[r];
    { auto rr = __builtin_amdgcn_permlane32_swap(__float_as_uint(ps), __float_as_uint(ps), false, false);
      ps = __uint_as_float(rr[0]) + __uint_as_float(rr[1]); }
    l_reg = l_reg * alpha + ps;
#define PK4(P, BASE, OUT) do { unsigned a0 = cvt_pk_bf16(P[BASE + 0], P[BASE + 1]), a1 = cvt_pk_bf16(P[BASE + 2], P[BASE + 3]);   \
    unsigned b0 = cvt_pk_bf16(P[BASE + 4], P[BASE + 5]), b1 = cvt_pk_bf16(P[BASE + 6], P[BASE + 7]);                              \
    auto r0 = __builtin_amdgcn_permlane32_swap(a0, b0, false, false); auto r1 = __builtin_amdgcn_permlane32_swap(a1, b1, false, false); \
    u32x4 w = {r0[0], r1[0], r0[1], r1[1]}; OUT = *reinterpret_cast<bf16x8*>(&w); } while (0)
    PK4(p0, 0, pa0); PK4(p0, 8, pa1); PK4(p1, 0, pa2); PK4(p1, 8, pa3);
#undef PK4
}
__device__ __forceinline__ void qkt(f32x16& p0, f32x16& p1, const LAS unsigned char* Ks, const bf16x8* qr, int r32, int hi) {
    p0 = f32x16{}; p1 = f32x16{};
#pragma unroll
    for (int d0 = 0; d0 < 8; ++d0) { int cb = (d0 * 16 + hi * 8) * 2;
        bf16x8 b0 = *reinterpret_cast<const LAS bf16x8*>(Ks + KSWZ(r32, cb));
        bf16x8 b1 = *reinterpret_cast<const LAS bf16x8*>(Ks + KSWZ(32 + r32, cb));
        p0 = __builtin_amdgcn_mfma_f32_32x32x16_bf16(b0, qr[d0], p0, 0, 0, 0);
        p1 = __builtin_amdgcn_mfma_f32_32x32x16_bf16(b1, qr[d0], p1, 0, 0, 0); }
}
__device__ __forceinline__ int v_st(int k, int c) { const int kk = (k & ~0xC) | ((k & 4) << 1) | ((k & 8) >> 1); return ((kk >> 3) * 4 + (c >> 5)) * 512 + ((kk & 7) * 32 + (c & 31)) * 2; }
__device__ __forceinline__ int v_rd_base(int lane) { return ((lane & 3) << 3) | (((lane >> 2) & 3) << 6) | (((lane >> 4) & 1) << 5) | (((lane >> 5) & 1) << 8); }
constexpr int v_rd_off(int d0, int ks, int half) { return d0 * 512 + ks * 4096 + half * 2048; }
template <int OFF> __device__ __forceinline__ s16x4 tr_read(int vb) {
    s16x4 r; asm volatile("ds_read_b64_tr_b16 %0, %1 offset:%2" : "=&v"(r) : "v"(vb), "i"(OFF) : "memory"); return r;
}
template <int D0> __device__ __forceinline__ void pv_one(f32x16& od, int vb, bf16x8 pa0, bf16x8 pa1, bf16x8 pa2, bf16x8 pa3) {
    const s16x4 l0 = tr_read<v_rd_off(D0, 0, 0)>(vb), h0 = tr_read<v_rd_off(D0, 0, 1)>(vb), l1 = tr_read<v_rd_off(D0, 1, 0)>(vb), h1 = tr_read<v_rd_off(D0, 1, 1)>(vb);
    const s16x4 l2 = tr_read<v_rd_off(D0, 2, 0)>(vb), h2 = tr_read<v_rd_off(D0, 2, 1)>(vb), l3 = tr_read<v_rd_off(D0, 3, 0)>(vb), h3 = tr_read<v_rd_off(D0, 3, 1)>(vb);
    asm volatile("s_waitcnt lgkmcnt(0)" ::: "memory"); SBAR();
#define PK(L, H) (bf16x8){L[0], L[1], L[2], L[3], H[0], H[1], H[2], H[3]}
    od = __builtin_amdgcn_mfma_f32_32x32x16_bf16(pa0, PK(l0, h0), od, 0, 0, 0);
    od = __builtin_amdgcn_mfma_f32_32x32x16_bf16(pa1, PK(l1, h1), od, 0, 0, 0);
    od = __builtin_amdgcn_mfma_f32_32x32x16_bf16(pa2, PK(l2, h2), od, 0, 0, 0);
    od = __builtin_amdgcn_mfma_f32_32x32x16_bf16(pa3, PK(l3, h3), od, 0, 0, 0);
#undef PK
}
__device__ __forceinline__ void pv_d0(f32x16* o, int vb, bf16x8 pa0, bf16x8 pa1, bf16x8 pa2, bf16x8 pa3) {
    pv_one<0>(o[0], vb, pa0, pa1, pa2, pa3); pv_one<1>(o[1], vb, pa0, pa1, pa2, pa3); pv_one<2>(o[2], vb, pa0, pa1, pa2, pa3); pv_one<3>(o[3], vb, pa0, pa1, pa2, pa3);
}
template <int LDQ, int LDO>
__device__ __forceinline__ void attn_body(const bf16_t* __restrict__ Qb, const bf16_t* __restrict__ Kh, const bf16_t* __restrict__ Vh, bf16_t* __restrict__ Ob, int seq, LAS unsigned char* lds) {
    constexpr int LDK = 128;
    const int tid = opaque_tid(), wid = tid >> 6, lane = tid & 63, r32 = lane & 31, hi = lane >> 5;
    LAS unsigned char* V_lds = lds; LAS unsigned char* K_lds = lds + 2 * SHM_V;
    LAS float* ws = (LAS float*)(lds + 2 * SHM_V + 2 * SHM_K) + wid * 64; LAS float* li_l = ws; LAS float* al_l = ws + 32;
    float m_reg = -1e30f, l_reg = 0; f32x16 o[4] = {}; bf16x8 qr[8];
    const bf16_t* Qw = Qb + (long)(wid * QBLK + r32) * LDQ + hi * 8;
#pragma unroll
    for (int d0 = 0; d0 < 8; ++d0) qr[d0] = *reinterpret_cast<const bf16x8*>(Qw + d0 * 16);
    const int sr = tid >> 4, sc = (tid & 15) * 8, vst0 = v_st(sr, sc), vst1 = v_st(32 + sr, sc);
    const int vb0 = (int)(unsigned)(uintptr_t)V_lds + v_rd_base(lane);
    struct { bf16x8 vs0, vs1, ks0, ks1; } sr_[2];
#define SLOAD(i, k0) do { sr_[i].vs0 = *reinterpret_cast<const bf16x8*>(&Vh[(long)((k0) + sr) * LDK + sc]); sr_[i].vs1 = *reinterpret_cast<const bf16x8*>(&Vh[(long)((k0) + 32 + sr) * LDK + sc]); \
    sr_[i].ks0 = *reinterpret_cast<const bf16x8*>(&Kh[(long)((k0) + sr) * LDK + sc]); sr_[i].ks1 = *reinterpret_cast<const bf16x8*>(&Kh[(long)((k0) + 32 + sr) * LDK + sc]); } while (0)
#define SWRITE(b, i) do { *(LAS bf16x8*)(V_lds + (b) * SHM_V + vst0) = sr_[i].vs0;          \
    *(LAS bf16x8*)(V_lds + (b) * SHM_V + vst1) = sr_[i].vs1; int kc = sc * 2;               \
    *(LAS bf16x8*)(K_lds + (b) * SHM_K + KSWZ(sr, kc)) = sr_[i].ks0;                       \
    *(LAS bf16x8*)(K_lds + (b) * SHM_K + KSWZ(32 + sr, kc)) = sr_[i].ks1; } while (0)
#define SWAIT() asm volatile("s_waitcnt vmcnt(4)" ::: "memory")
#define RESC(a) do { if (__any((a) < 1.f)) { if (hi == 0) al_l[r32] = (a); asm volatile("s_waitcnt lgkmcnt(0)" ::: "memory"); \
    for (int d = 0; d < 4; ++d) for (int r = 0; r < 16; ++r) o[d][r] *= al_l[crow(r, hi)]; } } while (0)
    f32x16 pA0, pA1, pB0, pB1; float mnA, mnB, alA, alB; bf16x8 pa0, pa1, pa2, pa3; const int NT = seq / KVBLK;
    constexpr int SE = 0, SO = 1;
    SLOAD(SE, 0); asm volatile("s_waitcnt vmcnt(0)" ::: "memory"); SWRITE(0, SE); __syncthreads();
    qkt(pA0, pA1, K_lds, qr, r32, hi); partialSM(pA0, pA1, m_reg, mnA, alA);
    SLOAD(SO, KVBLK); if (2 < NT) SLOAD(SE, 2 * KVBLK);
    SWAIT(); SWRITE(1, SO); __syncthreads();
    for (int j = 1; j + 1 < NT; j += 2) {
        SBAR(); qkt(pB0, pB1, K_lds + SHM_K, qr, r32, hi);
        finishSM(pA0, pA1, alA, l_reg, pa0, pa1, pa2, pa3); SBAR();
        SLOAD(SO, (j + 2) * KVBLK); SBAR();
        pv_d0(o, vb0, pa0, pa1, pa2, pa3); partialSM(pB0, pB1, m_reg, mnB, alB);
        __syncthreads(); SWAIT(); SWRITE(0, SE);
        RESC(alB); __syncthreads();
        SBAR(); qkt(pA0, pA1, K_lds, qr, r32, hi);
        finishSM(pB0, pB1, alB, l_reg, pa0, pa1, pa2, pa3); SBAR();
        if (j + 3 < NT) SLOAD(SE, (j + 3) * KVBLK); SBAR();
        pv_d0(o, vb0 + (int)SHM_V, pa0, pa1, pa2, pa3); partialSM(pA0, pA1, m_reg, mnA, alA);
        __syncthreads(); SWAIT(); SWRITE(1, SO);
        RESC(alA); __syncthreads();
    }
    SBAR(); qkt(pB0, pB1, K_lds + SHM_K, qr, r32, hi);
    finishSM(pA0, pA1, alA, l_reg, pa0, pa1, pa2, pa3); SBAR();
    pv_d0(o, vb0, pa0, pa1, pa2, pa3); partialSM(pB0, pB1, m_reg, mnB, alB);
    __syncthreads(); RESC(alB);
    finishSM(pB0, pB1, alB, l_reg, pa0, pa1, pa2, pa3); SBAR();
    pv_d0(o, vb0 + (int)SHM_V, pa0, pa1, pa2, pa3);
    if (hi == 0) li_l[r32] = l_reg; asm volatile("s_waitcnt lgkmcnt(0)" ::: "memory");
    float rli[16];
#pragma unroll
    for (int r = 0; r < 16; ++r) rli[r] = __builtin_amdgcn_rcpf(li_l[crow(r, hi)]);
    bf16_t* Ow = Ob + (long)(wid * QBLK) * LDO;
#pragma unroll
    for (int r = 0; r < 16; ++r) { int orow = crow(r, hi);
#pragma unroll
        for (int d0 = 0; d0 < 4; ++d0) Ow[(long)orow * LDO + d0 * 32 + r32] = f2bf(o[d0][r] * rli[r]); }
#undef SLOAD
#undef SWRITE
#undef SWAIT
#undef RESC
}
}

struct KArgs { const float* in[24]; float* out; unsigned char* ws; int ph_lo, ph_hi; };
enum { I_X = 0, I_C, I_CTX, I_CCTX, I_MODW, I_MODB, I_N1G, I_N2G, I_RW, I_WG, I_WU, I_WD, I_GWIN, I_GVG, I_GSW, I_GSB, I_GWOUT, I_AWIN, I_AQG, I_AKG, I_AWOUT, I_PWIN, I_PWG, I_PSC };

struct Fr {
    volatile LAS unsigned long long* PT;
    int G, bx, vcu;
    __device__ __forceinline__ unsigned long long ldp(int i) const { const unsigned long long v = PT[i];
        const unsigned lo = __builtin_amdgcn_readfirstlane((unsigned)v), hi = __builtin_amdgcn_readfirstlane((unsigned)(v >> 32)); return ((unsigned long long)hi << 32) | lo; }
    __device__ __forceinline__ const float* in(int i) const { return (const float*)(GAS const float*)ldp(i); }
    __device__ __forceinline__ float* out() const { return (float*)(GAS float*)ldp(24); }
    __device__ __forceinline__ unsigned char* ws() const { return (unsigned char*)(GAS unsigned char*)ldp(25); }
};
#define WSP(F, T_, OFF) ((T_*)((F).ws() + (OFF)))

__device__ __forceinline__ void tr_item(const float* W, int N, int k0, int n0, bf16_t* dst, int ldt, LAS float* scr, int lane) {
#pragma unroll 8
    for (int i = 0; i < 32; ++i) { const int kk = 2 * i + (lane >> 5); scr[kk * 33 + (lane & 31)] = W[(size_t)(k0 + kk) * N + n0 + (lane & 31)]; }
    LDS_WAIT(); asm volatile("" ::: "memory");
    const int c = lane & 7;
#pragma unroll
    for (int j = 0; j < 4; ++j) { const int n = (lane >> 3) + 8 * j; const LAS float* s = scr + (8 * c) * 33 + n;
        u32x4 o; o.x = cvt_pk_bf16(s[0 * 33], s[1 * 33]); o.y = cvt_pk_bf16(s[2 * 33], s[3 * 33]); o.z = cvt_pk_bf16(s[4 * 33], s[5 * 33]); o.w = cvt_pk_bf16(s[6 * 33], s[7 * 33]);
        *(u32x4*)(dst + (size_t)n * ldt + k0 + 8 * c) = o; }
    LDS_WAIT(); asm volatile("" ::: "memory");
}

__device__ __forceinline__ void p0_phase(const Fr& F, LAS unsigned char* lds) {
    const int tid = opaque_tid(), lane = tid & 63, wave = __builtin_amdgcn_readfirstlane(tid >> 6), gw = F.bx * NWAVES + wave, NGW = F.G * NWAVES; (void)gw; (void)NGW; (void)lane; (void)wave;
    unsigned char* const ws_ = F.ws();
    float* const modv_ = (float*)(ws_ + WS_MODV);
    bf16_t* const wsw_ = (bf16_t*)(ws_ + WS_WSW);
    bf16_t* const wgin_ = (bf16_t*)(ws_ + WS_WGIN);
    bf16_t* const wgout_ = (bf16_t*)(ws_ + WS_WGOUT);
    bf16_t* const wain_ = (bf16_t*)(ws_ + WS_WAIN);
    bf16_t* const waout_ = (bf16_t*)(ws_ + WS_WAOUT);
    bf16_t* const wpin_ = (bf16_t*)(ws_ + WS_WPIN);
    bf16_t* const wpgrp_ = (bf16_t*)(ws_ + WS_WPGRP);
    bf16_t* const wup_ = (bf16_t*)(ws_ + WS_WUP);
    bf16_t* const wdn_ = (bf16_t*)(ws_ + WS_WDN);
    const float* const in_I_AWIN = F.in(I_AWIN);
    const float* const in_I_AWOUT = F.in(I_AWOUT);
    const float* const in_I_C = F.in(I_C);
    const float* const in_I_CCTX = F.in(I_CCTX);
    const float* const in_I_GSW = F.in(I_GSW);
    const float* const in_I_GWIN = F.in(I_GWIN);
    const float* const in_I_GWOUT = F.in(I_GWOUT);
    const float* const in_I_MODB = F.in(I_MODB);
    const float* const in_I_MODW = F.in(I_MODW);
    const float* const in_I_PWG = F.in(I_PWG);
    const float* const in_I_PWIN = F.in(I_PWIN);
    const float* const in_I_WD = F.in(I_WD);
    const float* const in_I_WG = F.in(I_WG);
    const float* const in_I_WU = F.in(I_WU);

    LAS float* sact = (LAS float*)lds;
    LAS float* red = (LAS float*)(lds + 49152);
    for (int idx = tid; idx < 9 * 1024; idx += NTHR) { const int r = idx >> 10, k = idx & 1023; const float v = r < 8 ? in_I_C[r * 1024 + k] : in_I_CCTX[k]; sact[k * 12 + r] = silu_f(v); }
    __syncthreads();
    for (int chunk = F.bx; chunk < 384; chunk += F.G) {
        const int layer = chunk / 96, n = (chunk % 96) * 64 + lane, k0 = wave * 128;
        const float* wp = in_I_MODW + (size_t)layer * 1024 * 6144 + (size_t)k0 * 6144 + n;
        float acc[9];
#pragma unroll
        for (int r = 0; r < 9; ++r) acc[r] = 0.f;
#pragma unroll 8
        for (int kk = 0; kk < 128; ++kk) { const float w = wp[(size_t)kk * 6144]; const LAS float* sa = sact + (k0 + kk) * 12;
#pragma unroll
            for (int r = 0; r < 9; ++r) acc[r] += sa[r] * w; }
#pragma unroll
        for (int r = 0; r < 9; ++r) red[(wave * 9 + r) * 64 + lane] = acc[r];
        __syncthreads();
        for (int idx = tid; idx < 576; idx += NTHR) { const int r = idx >> 6, l = idx & 63; float s = 0.f;
#pragma unroll
            for (int w = 0; w < 8; ++w) s += red[(w * 9 + r) * 64 + l];
            const int nn = (chunk % 96) * 64 + l; modv_[(size_t)(layer * 9 + r) * 6144 + nn] = s + in_I_MODB[layer * 6144 + nn]; }
        __syncthreads();
    }
    __syncthreads();
    LAS float* scr = (LAS float*)(lds + wave * 16384);
    constexpr int NEXP = 4 * 16 * 3 * 512, NOTH = 1024 * 2 + 512 * 2 + 768 + 512 + 512 + 128;
    for (int it = gw; it < NEXP + NOTH; it += NGW) {
        if (it < NEXP) {
            const int mat = it >> 9, sub = it & 511, l = mat / 48, rem = mat % 48, e = rem / 3, which = rem % 3, k0 = (sub >> 5) * 64, n0 = (sub & 31) * 32;
            if (which < 2) { const float* W = (which == 0 ? in_I_WG : in_I_WU) + (size_t)(l * 16 + e) * 1024 * 1024;
                bf16_t* dst = wup_ + (size_t)l * 16 * 2048 * 1024 + (size_t)((e * 8 + (n0 >> 7)) * 256 + which * 128 + (n0 & 127)) * 1024;
                tr_item(W, 1024, k0, n0, dst, 1024, scr, lane); }
            else { const float* W = in_I_WD + (size_t)(l * 16 + e) * 1024 * 1024;
                bf16_t* dst = wdn_ + (size_t)l * 16 * 1024 * 1024 + (size_t)(e * 1024 + n0) * 1024;
                tr_item(W, 1024, k0, n0, dst, 1024, scr, lane); }
        } else {
            int r = it - NEXP;
            if (r < 2048) { const int j = r >> 10, sub = r & 1023, k0 = (sub >> 6) * 64, n0 = (sub & 63) * 32;
                tr_item(in_I_GWIN + (size_t)j * 1024 * 2048, 2048, k0, n0, wgin_ + (size_t)j * 2048 * 1024 + (size_t)n0 * 1024, 1024, scr, lane); continue; } r -= 2048;
            if (r < 1024) { const int j = r >> 9, sub = r & 511, k0 = (sub >> 5) * 64, n0 = (sub & 31) * 32;
                tr_item(in_I_GWOUT + (size_t)j * 1024 * 1024, 1024, k0, n0, wgout_ + (size_t)j * 1024 * 1024 + (size_t)n0 * 1024, 1024, scr, lane); continue; } r -= 1024;
            if (r < 768) { const int k0 = (r / 48) * 64, n0 = (r % 48) * 32;
                tr_item(in_I_AWIN, 1536, k0, n0, wain_ + (size_t)n0 * 1024, 1024, scr, lane); continue; } r -= 768;
            if (r < 512) { const int k0 = (r >> 5) * 64, n0 = (r & 31) * 32;
                tr_item(in_I_AWOUT, 1024, k0, n0, waout_ + (size_t)n0 * 1024, 1024, scr, lane); continue; } r -= 512;
            if (r < 512) { const int k0 = (r >> 5) * 64, n0 = (r & 31) * 32;
                tr_item(in_I_PWIN, 1024, k0, n0, wpin_ + (size_t)n0 * 1024, 1024, scr, lane); continue; } r -= 512;
            { const int g = r >> 5, sub = r & 31, k0 = (sub >> 3) * 64, n0 = (sub & 7) * 32;
                tr_item(in_I_PWG + (size_t)g * 256 * 256, 256, k0, n0, wpgrp_ + (size_t)g * 256 * 256 + (size_t)n0 * 256, 256, scr, lane); }
        }
    }
    for (int i4 = F.bx * NTHR + tid; i4 < 2 * 8 * 128 * 128 / 4; i4 += F.G * NTHR) { const f32x4 v = *(const f32x4*)(in_I_GSW + (size_t)i4 * 4);
        u32x2 o; o.x = cvt_pk_bf16(v[0], v[1]); o.y = cvt_pk_bf16(v[2], v[3]); *(u32x2*)(wsw_ + (size_t)i4 * 4) = o; }
}

template <int R>
__device__ __forceinline__ void norm_rows(const int r0, const bool isctx, const int lane, const int layer, const int which, const int comb, const int dry, float* vst,
                                          const float* xsrc, float* xdst, const float* modv_, const float* ng, const int* slot_, const bf16_t* YEXP_, bf16_t* H_, float* aff_, int* slotw_, const LAS unsigned char* rwl) {
    const int rc0 = r0 - T; const int b = isctx ? (rc0 >> 8) : (r0 >> 11); const int mrow = isctx ? 8 : b;
    f32x4 v[R][4];
#pragma unroll
    for (int q = 0; q < R; ++q)
#pragma unroll
        for (int j = 0; j < 4; ++j) v[q][j] = *(const f32x4*)(xsrc + (size_t)q * D + lane * 4 + 256 * j);
#ifndef NO_NR_COMB
    if (comb >= 0) {
        int sl[R];
#pragma unroll
        for (int q = 0; q < R; ++q) sl[q] = slot_[(size_t)(r0 + q) * 16 + (lane & 15)];
        f32x4 a[R][4];
#pragma unroll
        for (int q = 0; q < R; ++q)
#pragma unroll
            for (int j = 0; j < 4; ++j) a[q][j] = (f32x4){0.f, 0.f, 0.f, 0.f};
#pragma nounroll
        for (int e = 0; e < 16; ++e) {
            u32x2 w[R][4];
#pragma unroll
            for (int q = 0; q < R; ++q) {
                const int s = __builtin_amdgcn_readlane(sl[q], e);
                if (s >= 0) {
                    const int tile = isctx ? 128 + e : e * 8 + b, rin = isctx ? (((rc0 + q) >> 8) * 32 + s) : s;
                    const bf16_t* yp = YEXP_ + ((size_t)tile * 256 + rin) * D + lane * 4;
#pragma unroll
                    for (int j = 0; j < 4; ++j) w[q][j] = *(const u32x2*)(yp + 256 * j);
                } else {
#pragma unroll
                    for (int j = 0; j < 4; ++j) w[q][j] = (u32x2){0u, 0u};
                }
            }
#pragma unroll
            for (int q = 0; q < R; ++q)
#pragma unroll
                for (int j = 0; j < 4; ++j) { a[q][j][0] += bf_lo(w[q][j].x); a[q][j][1] += bf_hi(w[q][j].x); a[q][j][2] += bf_lo(w[q][j].y); a[q][j][3] += bf_hi(w[q][j].y); }
        }
        const float* g2 = modv_ + (size_t)(comb * 9 + mrow) * 6144 + 5 * 1024 + lane * 4;
#pragma unroll
        for (int j = 0; j < 4; ++j) { const f32x4 gg = *(const f32x4*)(g2 + 256 * j);
#pragma unroll
            for (int q = 0; q < R; ++q) { v[q][j] = v[q][j] + gg * a[q][j]; if (!dry) *(f32x4*)(xdst + (size_t)q * D + lane * 4 + 256 * j) = v[q][j]; } }
    }
#endif
    if (which == 0) return;
    float rstd[R];
#pragma unroll
    for (int q = 0; q < R; ++q) { float ss = 0.f;
#pragma unroll
        for (int j = 0; j < 4; ++j) ss += (v[q][j][0] * v[q][j][0] + v[q][j][1] * v[q][j][1]) + (v[q][j][2] * v[q][j][2] + v[q][j][3] * v[q][j][3]);
        rstd[q] = ss; }
#pragma unroll
    for (int q = 0; q < R; ++q) rstd[q] = rsqrtf(wave_sum(rstd[q]) * (1.f / D) + EPS);
    const float* mv = modv_ + (size_t)(layer * 9 + mrow) * 6144 + (which == 2 ? 3 * 1024 : 0) + lane * 4;
#pragma unroll
    for (int j = 0; j < 4; ++j) { const f32x4 g = *(const f32x4*)(ng + lane * 4 + 256 * j), sh = *(const f32x4*)(mv + 256 * j), sc = *(const f32x4*)(mv + 1024 + 256 * j);
#pragma unroll
        for (int q = 0; q < R; ++q) { v[q][j] = (v[q][j] * rstd[q] * g) * (sc + 1.f) + sh;
            u32x2 o; o.x = cvt_pk_bf16(v[q][j][0], v[q][j][1]); o.y = cvt_pk_bf16(v[q][j][2], v[q][j][3]); *(u32x2*)(H_ + (size_t)(r0 + q) * D + lane * 4 + 256 * j) = o; } }
#ifndef NO_NR_ROUTER
    if (which == 2 && dry != 2) {
        float p[R][16];
#pragma unroll
        for (int q = 0; q < R; ++q)
#pragma unroll
            for (int e = 0; e < 16; ++e) p[q][e] = 0.f;
#pragma unroll
        for (int j = 0; j < 4; ++j)
#pragma unroll
            for (int i = 0; i < 4; ++i) { const int col = lane * 4 + 256 * j + i; const LAS unsigned char* rp = rwl + col * 64 + (col >> 2) * 16;
                const f32x4 w0 = *(const LAS f32x4*)(rp), w1 = *(const LAS f32x4*)(rp + 16), w2 = *(const LAS f32x4*)(rp + 32), w3 = *(const LAS f32x4*)(rp + 48);
#pragma unroll
                for (int q = 0; q < R; ++q) { const float hv = v[q][j][i];
                    p[q][0] += hv * w0[0]; p[q][1] += hv * w0[1]; p[q][2] += hv * w0[2]; p[q][3] += hv * w0[3]; p[q][4] += hv * w1[0]; p[q][5] += hv * w1[1]; p[q][6] += hv * w1[2]; p[q][7] += hv * w1[3];
                    p[q][8] += hv * w2[0]; p[q][9] += hv * w2[1]; p[q][10] += hv * w2[2]; p[q][11] += hv * w2[3]; p[q][12] += hv * w3[0]; p[q][13] += hv * w3[1]; p[q][14] += hv * w3[2]; p[q][15] += hv * w3[3]; }
                __builtin_amdgcn_sched_barrier(0); }
#pragma unroll
        for (int q = 0; q < R; ++q)
#pragma unroll
            for (int e = 0; e < 16; ++e) asm volatile("" : "+v"(p[q][e]));
#pragma unroll
        for (int q = 0; q < R; ++q) {
            const bool b5 = (lane & 32) != 0, b4 = (lane & 16) != 0, b3 = (lane & 8) != 0, b2 = (lane & 4) != 0;
            float k8[8], k4[4], k2[2];
#pragma unroll
            for (int e = 0; e < 8; ++e) { const float send = b5 ? p[q][e] : p[q][e + 8]; k8[e] = (b5 ? p[q][e + 8] : p[q][e]) + xor32(send, b5); }
#pragma unroll
            for (int e = 0; e < 4; ++e) { const float send = b4 ? k8[e] : k8[e + 4]; k4[e] = (b4 ? k8[e + 4] : k8[e]) + swz_xor<16>(send); }
#pragma unroll
            for (int e = 0; e < 2; ++e) { const float send = b3 ? k4[e] : k4[e + 2]; k2[e] = (b3 ? k4[e + 2] : k4[e]) + swz_xor<8>(send); }
            float lg; { const float send = b2 ? k2[0] : k2[1]; lg = (b2 ? k2[1] : k2[0]) + swz_xor<4>(send); }
            lg += swz_xor<2>(lg); lg += swz_xor<1>(lg);
            const float mx = wave_max(lg), ex = __expf(lg - mx), sum = wave_sum(ex) * 0.25f;
            const int eid = (lane >> 2) & 15;
            if ((lane & 3) == 0) aff_[(size_t)(r0 + q) * 16 + eid] = ex / sum;
            if (lane < 16) slotw_[(size_t)(r0 + q) * 16 + lane] = -1;
        }
    }
#endif
}
__device__ __forceinline__ void norm_phase(const Fr& F, LAS unsigned char* lds, int layer, int which, int nrows, int comb, const float* xlat, const float* xctx, float* xlat_d, float* xctx_d, int dry = 0, bool zero_vst = false) {
    const int tid = opaque_tid(), lane = tid & 63, wave = __builtin_amdgcn_readfirstlane(tid >> 6), gw = F.bx * NWAVES + wave, NGW = F.G * NWAVES;
    unsigned char* const ws_ = F.ws();
    float* const modv_ = (float*)(ws_ + WS_MODV); float* const aff_ = (float*)(ws_ + WS_AFF); int* const slot_ = (int*)(ws_ + WS_SLOT);
    bf16_t* const H_ = (bf16_t*)(ws_ + WS_H); bf16_t* const YEXP_ = (bf16_t*)(ws_ + WS_YEXP);
    float* const vst = zero_vst ? (float*)(ws_ + WS_VST) : nullptr;
    LAS unsigned char* rwl = lds;
    if (which == 2) {
        const float* rw = F.in(I_RW) + (size_t)layer * 1024 * 16;
        for (int idx = tid; idx < 4096; idx += NTHR) { const int col = idx >> 2, e4 = idx & 3; *(LAS f32x4*)(rwl + col * 64 + (col >> 2) * 16 + e4 * 16) = *(const f32x4*)(rw + col * 16 + e4 * 4); }
        __syncthreads();
    }
    const float* ng = F.in(which == 2 ? I_N2G : I_N1G) + (size_t)layer * 1024;
#pragma nounroll
    for (int g4 = gw; g4 < T / 4; g4 += NGW) { const int r0 = g4 * 4;
        norm_rows<4>(r0, false, lane, layer, which, comb, dry, vst, xlat + (size_t)r0 * D, xlat_d + (size_t)r0 * D, modv_, ng, slot_, YEXP_, H_, aff_, slot_, rwl); }
    if (nrows > T) {
#pragma nounroll
        for (int r = T + gw; r < nrows; r += NGW)
            norm_rows<1>(r, true, lane, layer, which, comb, dry, vst, xctx + (size_t)(r - T) * D, xctx_d + (size_t)(r - T) * D, modv_, ng, slot_, YEXP_, H_, aff_, slot_, rwl);
    }
}

__device__ __forceinline__ void topk_phase(const Fr& F, LAS unsigned char* lds, bool with_ctx) {
    const int tid = opaque_tid();
    unsigned char* const ws_ = F.ws();
    float* const aff_ = (float*)(ws_ + WS_AFF); int* const slot_ = (int*)(ws_ + WS_SLOT); float* const gate_ = (float*)(ws_ + WS_GATE);
    int* const idx_ = (int*)(ws_ + WS_IDX);
    LAS unsigned* vals = (LAS unsigned*)lds;
    LAS int* hist = (LAS int*)(lds + 8192);
    LAS int* suf = (LAS int*)(lds + 9216);
    LAS int* scan = (LAS int*)(lds + 12288);
    volatile LAS unsigned* sv = (volatile LAS unsigned*)(lds + 16384);
    const int nunits = with_ctx ? 256 : 128;
    for (int u = F.bx; u < nunits; u += F.G) {
        const bool isctx = u >= 128; const int uu = isctx ? u - 128 : u, e = uu >> 3, b = uu & 7;
        const int N = isctx ? CL : SEQ, cap = isctx ? CCAP : CAP, row0 = isctx ? T + b * CL : b * SEQ;
        const int tile = isctx ? 128 + e : uu, rbase = isctx ? b * 32 : 0;
        unsigned v[4]; const bool act = tid * 4 < N;
#pragma unroll
        for (int k = 0; k < 4; ++k) v[k] = act ? __float_as_uint(aff_[(size_t)(row0 + tid * 4 + k) * 16 + e]) : 0u;
        if (tid == 0) { sv[0] = 0u; sv[1] = (unsigned)cap; }
        unsigned prefix = 0u, mask = 0u; int need = cap;
#pragma nounroll
        for (int shift = 24; shift >= 0; shift -= 8) {
            if (tid < 256) hist[tid] = 0;
            __syncthreads();
            if (act) {
#pragma unroll
                for (int k = 0; k < 4; ++k) if ((v[k] & mask) == prefix) __hip_atomic_fetch_add(&hist[(v[k] >> shift) & 255u], 1, __ATOMIC_RELAXED, __HIP_MEMORY_SCOPE_WORKGROUP);
            }
            __syncthreads();
            if (tid < 256) { int sacc = 0; for (int d = 255; d >= tid; --d) sacc += hist[d]; suf[tid] = sacc; }
            if (tid == 0) suf[256] = 0;
            __syncthreads();
            if (tid < 256) { const int s0 = suf[tid], s1 = suf[tid + 1]; if (s0 >= need && s1 < need) { sv[0] = prefix | ((unsigned)tid << shift); sv[1] = (unsigned)(need - s1); } }
            __syncthreads();
            prefix = sv[0]; need = (int)sv[1]; mask |= 255u << shift;
        }
        int cg = 0, ce = 0;
#pragma unroll
        for (int k = 0; k < 4; ++k) { cg += (act && v[k] > prefix) ? 1 : 0; ce += (act && v[k] == prefix) ? 1 : 0; }
        int cur = 0; scan[tid] = cg | (ce << 16);
        __syncthreads();
#pragma nounroll
        for (int off = 1; off < NTHR; off <<= 1) {
            const int x = scan[cur * NTHR + tid] + (tid >= off ? scan[cur * NTHR + tid - off] : 0);
            scan[(cur ^ 1) * NTHR + tid] = x; cur ^= 1;
            __syncthreads();
        }
        const int incl = scan[cur * NTHR + tid]; int gb = (incl & 0xffff) - cg, eb = (incl >> 16) - ce;
        if (act) {
#pragma unroll
            for (int k = 0; k < 4; ++k) {
                const bool isg = v[k] > prefix, ise = v[k] == prefix;
                if (isg || (ise && eb < need)) { const int sl = gb + (eb < need ? eb : need); const int row = row0 + tid * 4 + k;
                    idx_[(size_t)tile * 256 + rbase + sl] = row; gate_[(size_t)tile * 256 + rbase + sl] = __uint_as_float(v[k]); slot_[(size_t)row * 16 + e] = sl; }
                gb += isg ? 1 : 0; eb += ise ? 1 : 0;
            }
        }
        __syncthreads();
    }
}

template <int OFF> __device__ __forceinline__ s16x4 sp_tr_read(int vb) {
    s16x4 r; asm volatile("ds_read_b64_tr_b16 %0, %1 offset:%2" : "=&v"(r) : "v"(vb), "i"(OFF) : "memory"); return r;
}
template <int KS> __device__ __forceinline__ void sp_kstep(f32x16& acc0, f32x16& acc1, const LAS bf16_t* Ap, int vb) {
    constexpr int LDB2 = 320;
    const bf16x8 a = *(const LAS bf16x8*)(Ap + KS * 16);
    const s16x4 l0 = sp_tr_read<(16 * KS) * LDB2>(vb), h0 = sp_tr_read<(16 * KS + 4) * LDB2>(vb);
    const s16x4 l1 = sp_tr_read<(16 * KS) * LDB2 + 64>(vb), h1 = sp_tr_read<(16 * KS + 4) * LDB2 + 64>(vb);
    asm volatile("s_waitcnt lgkmcnt(0)" ::: "memory"); __builtin_amdgcn_sched_barrier(0);
    const bf16x8 b0 = (bf16x8){l0[0], l0[1], l0[2], l0[3], h0[0], h0[1], h0[2], h0[3]};
    const bf16x8 b1 = (bf16x8){l1[0], l1[1], l1[2], l1[3], h1[0], h1[1], h1[2], h1[3]};
    acc0 = __builtin_amdgcn_mfma_f32_32x32x16_bf16(b0, a, acc0, 0, 0, 0);
    acc1 = __builtin_amdgcn_mfma_f32_32x32x16_bf16(b1, a, acc1, 0, 0, 0);
}
__device__ __forceinline__ void spatial_phase(const Fr& F, LAS unsigned char* lds, int j, int nchunks) {
    const int tid = opaque_tid(), lane = tid & 63, wave = __builtin_amdgcn_readfirstlane(tid >> 6);
    unsigned char* const ws_ = F.ws();
    const bf16_t* const wsw_ = (const bf16_t*)(ws_ + WS_WSW); const bf16_t* const S1_ = (const bf16_t*)(ws_ + WS_S1); bf16_t* const S2_ = (bf16_t*)(ws_ + WS_S2);
    const float* const vst_ = (const float*)(ws_ + WS_VST);
    constexpr int LDA = 136, LDB = 160;
    LAS bf16_t* As = (LAS bf16_t*)(lds + 1024);
    LAS bf16_t* Bs = (LAS bf16_t*)(lds + 1024 + 128 * LDA * 2);
    const float* vg = F.in(I_GVG) + (size_t)j * 1024; const float* sb = F.in(I_GSB) + (size_t)j * 8 * 128;
    const bf16_t* sw = wsw_ + (size_t)j * 8 * 128 * 128;
    const int r32 = lane & 31, hi = lane >> 5;
    const int pw = (wave >> 1) * 32, dw = (wave & 1) * 64;
    const LAS bf16_t* Ap = As + (pw + r32) * LDA + hi * 8;
    const int vb = (int)(unsigned)(uintptr_t)Bs + (8 * hi + ((lane & 15) >> 2)) * (LDB * 2) + (dw + 16 * ((lane >> 4) & 1) + 4 * (lane & 3)) * 2;
    const int p = pw + r32, c0 = dw + 4 * hi, nunits = nchunks * 8;
    u32x4 sa[4], wv[4]; u32x2 un[2][4]; f32x2 st[4];
#define SP_LOAD(U) do { const int _r0 = ((U) >> 3) * 128, _g = (U) & 7; _Pragma("unroll") for (int i = 0; i < 4; ++i) { const int id = tid + NTHR * i; \
            sa[i] = *(const u32x4*)(sw + (size_t)_g * 128 * 128 + (id >> 4) * 128 + (id & 15) * 8); \
            wv[i] = *(const u32x4*)(S1_ + (size_t)(_r0 + (id >> 4)) * 2048 + 1024 + _g * 128 + (id & 15) * 8); \
            st[i] = *(const f32x2*)(vst_ + ((size_t)(_r0 + (id >> 4)) * 16 + (id & 15)) * 2); } \
            _Pragma("unroll") for (int t = 0; t < 4; ++t) { un[0][t] = *(const u32x2*)(S1_ + (size_t)(_r0 + p) * 2048 + _g * 128 + c0 + 8 * t); un[1][t] = *(const u32x2*)(S1_ + (size_t)(_r0 + p) * 2048 + _g * 128 + c0 + 32 + 8 * t); } } while (0)
    int U = F.vcu;
    if (U < nunits) SP_LOAD(U);
#pragma nounroll
    for (; U < nunits; U += F.G) {
        const int r0 = (U >> 3) * 128, g = U & 7;
#pragma unroll
        for (int i = 0; i < 4; ++i) { const int id = tid + NTHR * i; *(LAS u32x4*)(As + (id >> 4) * LDA + (id & 15) * 8) = sa[i]; }
        { const int dc = tid & 15; const f32x4 g0 = *(const f32x4*)(vg + g * 128 + dc * 8), g1 = *(const f32x4*)(vg + g * 128 + dc * 8 + 4);
#pragma unroll
          for (int i = 0; i < 4; ++i) { const int id = tid + NTHR * i, q = id >> 4;
            float s1 = st[i].x, s2 = st[i].y;
            s1 += swz_xor<1>(s1); s2 += swz_xor<1>(s2); s1 += swz_xor<2>(s1); s2 += swz_xor<2>(s2); s1 += swz_xor<4>(s1); s2 += swz_xor<4>(s2); s1 += swz_xor<8>(s1); s2 += swz_xor<8>(s2);
            const float mean = s1 * (1.f / 1024.f), rstd = rsqrtf(fmaxf(s2 * (1.f / 1024.f) - mean * mean, 0.f) + EPS);
            float x[8];
#pragma unroll
            for (int k = 0; k < 4; ++k) { x[2 * k] = (bf_lo(wv[i][k]) - mean) * rstd; x[2 * k + 1] = (bf_hi(wv[i][k]) - mean) * rstd; }
            u32x4 o; o.x = cvt_pk_bf16(x[0] * g0[0], x[1] * g0[1]); o.y = cvt_pk_bf16(x[2] * g0[2], x[3] * g0[3]); o.z = cvt_pk_bf16(x[4] * g1[0], x[5] * g1[1]); o.w = cvt_pk_bf16(x[6] * g1[2], x[7] * g1[3]);
            *(LAS u32x4*)(Bs + q * LDB + dc * 8) = o; } }
        u32x2 uu[2][4];
#pragma unroll
        for (int t = 0; t < 4; ++t) { uu[0][t] = un[0][t]; uu[1][t] = un[1][t]; }
        const float bias = sb[g * 128 + p];
        __syncthreads();
        if (U + F.G < nunits) SP_LOAD(U + F.G);
        f32x16 acc0 = {}, acc1 = {};
        sp_kstep<0>(acc0, acc1, Ap, vb); sp_kstep<1>(acc0, acc1, Ap, vb); sp_kstep<2>(acc0, acc1, Ap, vb); sp_kstep<3>(acc0, acc1, Ap, vb);
        sp_kstep<4>(acc0, acc1, Ap, vb); sp_kstep<5>(acc0, acc1, Ap, vb); sp_kstep<6>(acc0, acc1, Ap, vb); sp_kstep<7>(acc0, acc1, Ap, vb);
        const size_t ro = (size_t)(r0 + p);
#pragma unroll
        for (int t = 0; t < 4; ++t) {
            u32x2 o0, o1;
            o0.x = cvt_pk_bf16((acc0[4 * t] + bias) * bf_lo(uu[0][t].x), (acc0[4 * t + 1] + bias) * bf_hi(uu[0][t].x)); o0.y = cvt_pk_bf16((acc0[4 * t + 2] + bias) * bf_lo(uu[0][t].y), (acc0[4 * t + 3] + bias) * bf_hi(uu[0][t].y));
            o1.x = cvt_pk_bf16((acc1[4 * t] + bias) * bf_lo(uu[1][t].x), (acc1[4 * t + 1] + bias) * bf_hi(uu[1][t].x)); o1.y = cvt_pk_bf16((acc1[4 * t + 2] + bias) * bf_lo(uu[1][t].y), (acc1[4 * t + 3] + bias) * bf_hi(uu[1][t].y));
            *(u32x2*)(S2_ + ro * D + g * 128 + c0 + 8 * t) = o0; *(u32x2*)(S2_ + ro * D + g * 128 + c0 + 32 + 8 * t) = o1; }
        __syncthreads();
    }
#undef SP_LOAD
}

__device__ __forceinline__ void qknorm_phase(const Fr& F) {
    const int tid = opaque_tid(), lane = tid & 63, wave = __builtin_amdgcn_readfirstlane(tid >> 6), gw = F.bx * NWAVES + wave, NGW = F.G * NWAVES;
    unsigned char* const ws_ = F.ws();
    const bf16_t* const S1_ = (const bf16_t*)(ws_ + WS_S1); bf16_t* const QB_ = (bf16_t*)(ws_ + WS_QB); bf16_t* const KB_ = (bf16_t*)(ws_ + WS_KB);
    const float* qg = F.in(I_AQG); const float* kg = F.in(I_AKG);
    const int hsel = lane >> 5, l5 = lane & 31;
    const f32x2 qg0 = *(const f32x2*)(qg + 2 * l5), qg1 = *(const f32x2*)(qg + 64 + 2 * l5), kg0 = *(const f32x2*)(kg + 2 * l5), kg1 = *(const f32x2*)(kg + 64 + 2 * l5);
    const float inv0 = exp2f(-(float)((2 * l5) & 31) * (13.287712379549449f / 32.f)), inv1 = exp2f(-(float)((2 * l5 + 1) & 31) * (13.287712379549449f / 32.f));
#pragma nounroll
    for (int g2 = gw; g2 < T / 2; g2 += NGW) {
        const int r0 = g2 * 2, b = r0 >> 11;
        unsigned u0[2][5], u1[2][5];
#pragma unroll
        for (int q = 0; q < 2; ++q)
#pragma unroll
            for (int ps = 0; ps < 5; ++ps) { const int hh = 2 * ps + hsel; const bf16_t* src = S1_ + (size_t)(r0 + q) * 2048 + (hh < 8 ? hh * 128 : 1024 + (hh - 8) * 128) + 2 * l5;
                u0[q][ps] = *(const unsigned*)src; u1[q][ps] = *(const unsigned*)(src + 64); }
#pragma unroll
        for (int q = 0; q < 2; ++q) {
            const int s = (r0 + q) & (SEQ - 1); const float pos = (float)(l5 < 16 ? (s >> 6) : (s & 63));
            float c0, s0, c1, s1; __sincosf(pos * inv0, &s0, &c0); __sincosf(pos * inv1, &s1, &c1);
            { c0 = cosf(pos * inv0); s0 = sinf(pos * inv0); c1 = cosf(pos * inv1); s1 = sinf(pos * inv1); }
#pragma unroll
            for (int ps = 0; ps < 5; ++ps) { const int hh = 2 * ps + hsel; const bool isk = ps == 4;
                float a0 = bf_lo(u0[q][ps]), a1 = bf_hi(u0[q][ps]), e0 = bf_lo(u1[q][ps]), e1 = bf_hi(u1[q][ps]);
                const float rs = rsqrtf(half_sum((a0 * a0 + a1 * a1) + (e0 * e0 + e1 * e1)) * (1.f / 128.f) + EPS);
                const f32x2 ga = isk ? kg0 : qg0, gb = isk ? kg1 : qg1;
                a0 *= rs * ga.x; a1 *= rs * ga.y; e0 *= rs * gb.x; e1 *= rs * gb.y;
                const float o10 = a0 * c0 - e0 * s0, o11 = a1 * c1 - e1 * s1, o20 = a0 * s0 + e0 * c0, o21 = a1 * s1 + e1 * c1;
                bf16_t* dst = isk ? KB_ + ((size_t)(b * 2 + (hh - 8)) * SKV + CL + s) * 128 + 2 * l5 : QB_ + (size_t)(r0 + q) * D + hh * 128 + 2 * l5;
                *(unsigned*)dst = cvt_pk_bf16(o10, o11); *(unsigned*)(dst + 64) = cvt_pk_bf16(o20, o21); }
        }
    }
#pragma nounroll
    for (int rc = gw; rc < TC; rc += NGW) {
        const int b = rc >> 8, s = rc & (CL - 1);
        const bf16_t* src = S1_ + (size_t)(T + rc) * 2048 + 1024 + hsel * 128 + 2 * l5;
        const unsigned u0 = *(const unsigned*)src, u1 = *(const unsigned*)(src + 64);
        float a0 = bf_lo(u0), a1 = bf_hi(u0), e0 = bf_lo(u1), e1 = bf_hi(u1);
        const float rs = rsqrtf(half_sum((a0 * a0 + a1 * a1) + (e0 * e0 + e1 * e1)) * (1.f / 128.f) + EPS);
        bf16_t* dst = KB_ + ((size_t)(b * 2 + hsel) * SKV + s) * 128 + 2 * l5;
        *(unsigned*)dst = cvt_pk_bf16(a0 * rs * kg0.x, a1 * rs * kg0.y); *(unsigned*)(dst + 64) = cvt_pk_bf16(e0 * rs * kg1.x, e1 * rs * kg1.y);
    }
}

template <int W> __device__ __forceinline__ void pool_item(const bf16_t* zb  , int s, bf16_t* dst) {
    constexpr int half = W / 2;
    u32x4 w[W];
#pragma unroll
    for (int k = 0; k < W; ++k) { int t = s - half + k; t = t < 0 ? 0 : (t > SEQ - 1 ? SEQ - 1 : t); w[k] = *(const u32x4*)(zb + (size_t)t * 2048); }
    float acc[8];
#pragma unroll
    for (int c = 0; c < 8; ++c) acc[c] = 0.f;
#pragma unroll
    for (int k = 0; k < W; ++k) { const int t = s - half + k; const float m = (t >= 0 && t < SEQ) ? 1.f : 0.f;
#pragma unroll
        for (int c = 0; c < 4; ++c) { acc[2 * c] += m * bf_lo(w[k][c]); acc[2 * c + 1] += m * bf_hi(w[k][c]); } }
    const int lo = s - half < 0 ? 0 : s - half, hi = s + half - 1 > SEQ - 1 ? SEQ - 1 : s + half - 1; const float ic = 1.f / (float)(hi - lo + 1);
    const u32x4 zc = w[half];
    float o[8];
#pragma unroll
    for (int c = 0; c < 4; ++c) { o[2 * c] = acc[2 * c] * ic - bf_lo(zc[c]); o[2 * c + 1] = acc[2 * c + 1] * ic - bf_hi(zc[c]); }
    u32x4 ov; ov.x = cvt_pk_bf16(o[0], o[1]); ov.y = cvt_pk_bf16(o[2], o[3]); ov.z = cvt_pk_bf16(o[4], o[5]); ov.w = cvt_pk_bf16(o[6], o[7]);
    *(u32x4*)dst = ov;
}
__device__ __forceinline__ void pool_phase(const Fr& F) {
    const int tid = opaque_tid(), lane = tid & 63, wave = __builtin_amdgcn_readfirstlane(tid >> 6);
    unsigned char* const ws_ = F.ws();
    const bf16_t* const S1_ = (const bf16_t*)(ws_ + WS_S1); bf16_t* const S2_ = (bf16_t*)(ws_ + WS_S2);
    const int gi = wave & 3, c8 = gi * 32 + (lane & 31), rsub = (wave >> 2) * 2 + (lane >> 5);
#pragma nounroll
    for (int r4 = F.bx; r4 < T / 4; r4 += F.G) {
        const int r = r4 * 4 + rsub, s = r & (SEQ - 1);
        const bf16_t* zb = S1_ + (size_t)(r - s) * 2048 + c8 * 8; bf16_t* dst = S2_ + (size_t)r * D + c8 * 8;
        if (gi == 0) pool_item<2>(zb, s, dst); else if (gi == 1) pool_item<4>(zb, s, dst); else if (gi == 2) pool_item<8>(zb, s, dst); else pool_item<16>(zb, s, dst);
    }
}

__global__ void __launch_bounds__(NTHR, 2) fwd_kernel(KArgs args) {
    extern __shared__ __attribute__((aligned(16))) unsigned char lds_raw[];
    LAS unsigned char* lds = (LAS unsigned char*)lds_raw;
    volatile LAS unsigned* MISC = (volatile LAS unsigned*)(lds + MISC_OFF);
    Fr F;
    F.PT = (volatile LAS unsigned long long*)(lds + MISC_OFF + 256);
    F.G = gridDim.x; F.bx = blockIdx.x; F.vcu = (F.G % 8 == 0) ? (F.bx % 8) * (F.G / 8) + F.bx / 8 : F.bx;
    { const int t0 = threadIdx.x;
      if (t0 < 64) MISC[t0] = 0u;
      if (t0 < 24) F.PT[t0] = (unsigned long long)args.in[t0];
      if (t0 == 24) F.PT[24] = (unsigned long long)args.out;
      if (t0 == 25) F.PT[25] = (unsigned long long)args.ws; }
    __syncthreads();
    XcdBarrier bar = xcd_barrier_post((unsigned*)(F.ws() + WS_CTL), MISC + 8);
    const int lo = args.ph_lo, hi = args.ph_hi;
    int p = 0;
#define RUN(...) RUNC(31, __VA_ARGS__)
#define RUNC(cls, ...) do { if (lo <= p && p < hi) { _Pragma("nounroll") for (int rep_ = 0; rep_ < 1 + (int)((REPEAT_MASK >> (cls)) & 1u); ++rep_) { __VA_ARGS__; if (REPEAT_MASK) __syncthreads(); } if (p + 1 < hi) xcd_barrier(bar); } ++p; } while (0)

#ifndef NO_P0
    RUNC(0, p0_phase(F, lds));
#endif
#pragma nounroll
    for (int L = 0; L < 4; ++L) {
        const int kind = L % 3, jm = L / 3;
        const bool with_ctx = (L == 0);
        RUNC(1, {
            float* xo = F.out(); float* xc = WSP(F, float, WS_XC);
#ifndef NO_NORM
            norm_phase(F, lds, L, 1, (L <= 1) ? TT : T, L - 1, (L == 0) ? F.in(I_X) : xo, (L == 0) ? F.in(I_CTX) : xc, xo, xc, (REPEAT_MASK >> 1) & 1u ? (rep_ == 0) : 0, kind == 0);
#endif
        });
        RUNC(2, {
            unsigned char* ws = F.ws();
            pg8::SchedDense S; S.A = (bf16_t*)(ws + WS_H); S.G = F.G; S.c = F.bx; S.a_pn_stride = 0; S.a_pm_stride = 256 * D; S.b_pn_stride = 256 * D; S.extra = 0;
            pg8::EpiA E; E.O = (bf16_t*)(ws + WS_S1); E.ldc = 2048; E.act = 0; E.VB = nullptr; E.stats = nullptr;
            if (kind == 0) { S.Bt = (bf16_t*)(ws + WS_WGIN) + (size_t)jm * 2048 * 1024; S.nM = with_ctx ? 72 : 64; S.nN = 8; E.act = 1; E.stats = (float*)(ws + WS_VST); }
            else if (kind == 1) { S.Bt = (bf16_t*)(ws + WS_WAIN); S.nM = 64; S.nN = 6; S.extra = 16; E.VB = (bf16_t*)(ws + WS_VB); }
            else { S.Bt = (bf16_t*)(ws + WS_WPIN); S.nM = 64; S.nN = 4; }
            S.nwg = S.nM * S.nN;
            #ifndef NO_GA
            pg8::gemm_phase<pg8::EpiA, pg8::SchedDense>(lds, D, D, D, S, E);
#endif
        });
        if (kind == 0) {
#ifndef NO_SPAT
            RUNC(3, spatial_phase(F, lds, jm, with_ctx ? 144 : 128));
#endif
        }
        else if (kind == 1) {
#ifndef NO_QKN
            RUNC(4, qknorm_phase(F));
#endif
            RUNC(5, {
                unsigned char* ws = F.ws();
                const bf16_t* QB = (const bf16_t*)(ws + WS_QB); const bf16_t* KB = (const bf16_t*)(ws + WS_KB); const bf16_t* VB = (const bf16_t*)(ws + WS_VB); bf16_t* S2 = (bf16_t*)(ws + WS_S2);
                for (int i = 0; i * F.G + F.vcu < 512; ++i) { const int Lu = i * F.G + F.vcu, bk = Lu >> 5, w = Lu & 31, b = bk >> 1, kvh = bk & 1, h = kvh * 4 + (w >> 3), qb = w & 7;
#ifndef NO_ATT
                    att::attn_body<D, D>(QB + ((size_t)(b * SEQ + qb * 256)) * D + h * 128, KB + (size_t)bk * SKV * 128, VB + (size_t)bk * SKV * 128,
                                         S2 + ((size_t)(b * SEQ + qb * 256)) * D + h * 128, SKV, lds);
#endif
                    __syncthreads(); }
            });
        } else {
#ifndef NO_POOL
            RUNC(6, pool_phase(F));
#endif
        }
        RUNC(7, {
            unsigned char* ws = F.ws();
            pg8::SchedDense S; S.A = (bf16_t*)(ws + WS_S2); S.G = F.G; S.c = F.bx; S.a_pm_stride = 256 * D; S.a_pn_stride = 0; S.b_pn_stride = 256 * D; S.extra = 0; S.nN = 4; S.nM = 64;
            pg8::EpiB E; E.xd_lat = F.out(); E.xd_ctx = (float*)(ws + WS_XC); E.xs_lat = (L == 0) ? F.in(I_X) : E.xd_lat; E.xs_ctx = (L == 0) ? F.in(I_CTX) : E.xd_ctx;
            E.gt = (const float*)(ws + WS_MODV) + (size_t)L * 9 * 6144 + 2 * 1024; E.colscale = nullptr; E.dry = (REPEAT_MASK >> 7) & 1u ? (rep_ == 0) : 0;
            int K = D, ldb = D;
            if (kind == 0) { S.Bt = (bf16_t*)(ws + WS_WGOUT) + (size_t)jm * 1024 * 1024; S.nM = with_ctx ? 72 : 64; }
            else if (kind == 1) { S.Bt = (bf16_t*)(ws + WS_WAOUT); }
            else { S.Bt = (bf16_t*)(ws + WS_WPGRP); S.a_pn_stride = 256; S.b_pn_stride = 256 * 256; K = 256; ldb = 256; E.colscale = F.in(I_PSC); }
            S.nwg = S.nM * S.nN;
            #ifndef NO_GB
            pg8::gemm_phase<pg8::EpiB, pg8::SchedDense>(lds, K, D, ldb, S, E);
#endif
        });
        RUNC(8, {
            float* xo = F.out(); float* xc = WSP(F, float, WS_XC);
#ifndef NO_NORM
            norm_phase(F, lds, L, 2, with_ctx ? TT : T, -1, xo, xc, xo, xc, ((REPEAT_MASK >> 13) & 1u) && rep_ == 0 ? 2 : 0);
#endif
        });
#ifndef NO_TOPK
        RUNC(9, topk_phase(F, lds, with_ctx));
#endif
        RUNC(10, {
            unsigned char* ws = F.ws();
            pg8::SchedMoE<true> S; S.A = (bf16_t*)(ws + WS_H); S.IDX = (const int*)(ws + WS_IDX); S.Bt = (bf16_t*)(ws + WS_WUP) + (size_t)L * 16 * 2048 * 1024; S.nbt = with_ctx ? 9 : 8; S.nn = 8; S.G = F.G; S.vcu = F.vcu;
            pg8::EpiC E; E.HID = (bf16_t*)(ws + WS_HID);
            #ifndef NO_GC
            pg8::gemm_phase<pg8::EpiC, pg8::SchedMoE<true>>(lds, D, D, D, S, E);
#endif
        });
        RUNC(11, {
            unsigned char* ws = F.ws();
            pg8::SchedMoE<false> S; S.A = (bf16_t*)(ws + WS_HID); S.IDX = nullptr; S.Bt = (bf16_t*)(ws + WS_WDN) + (size_t)L * 16 * 1024 * 1024; S.nbt = with_ctx ? 9 : 8; S.nn = 4; S.G = F.G; S.vcu = F.vcu;
            pg8::EpiD E; E.Y = (bf16_t*)(ws + WS_YEXP); E.gate = (const float*)(ws + WS_GATE);
            #ifndef NO_GD
            pg8::gemm_phase<pg8::EpiD, pg8::SchedMoE<false>>(lds, D, D, D, S, E);
#endif
        });
    }
    RUN({
        float* xo = F.out(); float* xc = WSP(F, float, WS_XC);
#ifndef NO_NORM
        norm_phase(F, lds, 3, 0, T, 3, xo, xc, xo, xc);
#endif
    });
#undef RUN
#undef RUNC
}

constexpr int N_PHASES = 1 + 8 + 9 + 8 + 8 + 1;

extern "C" void kernel_launch(void* const* d_in, const int* in_sizes, int n_in, void* d_out, int out_size, void* d_ws, size_t ws_size, hipStream_t stream) {
    static int grid = 0;
    if (grid == 0) {
        if (n_in != 24 || out_size != T * D || ws_size < WS_END) { fprintf(stderr, "kernel_launch: unexpected shapes (n_in %d out %d ws %zu need %zu)\n", n_in, out_size, ws_size, (size_t)WS_END); grid = -1; return; }
        int dev = 0, cus = 0;
        if (hipGetDevice(&dev) != hipSuccess || hipDeviceGetAttribute(&cus, hipDeviceAttributeMultiprocessorCount, dev) != hipSuccess) { grid = -1; return; }
        if (hipFuncSetAttribute((const void*)fwd_kernel, hipFuncAttributeMaxDynamicSharedMemorySize, LDS_BYTES) != hipSuccess) { fprintf(stderr, "kernel_launch: hipFuncSetAttribute failed\n"); grid = -1; return; }
        (void)hipGetLastError();
        grid = cus;
    }
    if (grid < 0) return;
    (void)hipMemsetAsync((char*)d_ws + WS_CTL, 0, CTL_BYTES, stream);
    KArgs a{};
    for (int i = 0; i < 24; ++i) a.in[i] = (const float*)d_in[i];
    a.out = (float*)d_out; a.ws = (unsigned char*)d_ws;
#if MK_PER_PHASE
    for (int k = 0; k < N_PHASES; ++k) { a.ph_lo = k; a.ph_hi = k + 1; hipLaunchKernelGGL(fwd_kernel, dim3(grid), dim3(NTHR), LDS_BYTES, stream, a); }
#else
    a.ph_lo = 0; a.ph_hi = N_PHASES;
    hipLaunchKernelGGL(fwd_kernel, dim3(grid), dim3(NTHR), LDS_BYTES, stream, a);
#endif
    const hipError_t le = hipPeekAtLastError();
    if (le != hipSuccess) fprintf(stderr, "kernel_launch: launch failed: %s\n", hipGetErrorName(le));
}
```

```cpp
#include <hip/hip_runtime.h>
#include <cstdio>
#include <cstdint>

#ifndef REPEAT_MASK
#define REPEAT_MASK 0u
#endif
#ifndef MK_PER_PHASE
#define MK_PER_PHASE 0
#endif

#define LAS __attribute__((address_space(3)))
#define GAS __attribute__((address_space(1)))
typedef unsigned short bf16_t;
typedef short bf16x8 __attribute__((ext_vector_type(8)));
typedef short s16x4 __attribute__((ext_vector_type(4)));
typedef float f32x2 __attribute__((ext_vector_type(2)));
typedef float f32x4 __attribute__((ext_vector_type(4)));
typedef float f32x16 __attribute__((ext_vector_type(16)));
typedef unsigned u32x2 __attribute__((ext_vector_type(2)));
typedef unsigned u32x4 __attribute__((ext_vector_type(4)));

constexpr int D = 1024, NB = 8, SEQ = 2048, T = NB * SEQ, CL = 256, TC = NB * CL, TT = T + TC, NE = 16, CAP = 256, CCAP = 32, NTILE = 144;
constexpr int SKV = CL + SEQ;
constexpr float EPS = 1e-6f;
constexpr int NWAVES = 8, NTHR = 512;

constexpr size_t al256(size_t x) { return (x + 255) / 256 * 256; }
constexpr size_t WS_CTL   = 0;
constexpr size_t CTL_BYTES = 65536;
constexpr size_t WS_MODV  = WS_CTL + CTL_BYTES;
constexpr size_t WS_AFF   = WS_MODV + al256((size_t)4 * 9 * 6144 * 4);
constexpr size_t WS_SLOT  = WS_AFF + (size_t)TT * 16 * 4;
constexpr size_t WS_GATE  = WS_SLOT + (size_t)TT * 16 * 4;
constexpr size_t WS_VST   = WS_GATE + (size_t)NTILE * 256 * 4;
constexpr size_t WS_WSW   = WS_VST + (size_t)TT * 16 * 2 * 4;
constexpr size_t WS_WGIN  = WS_WSW + (size_t)2 * 8 * 128 * 128 * 2;
constexpr size_t WS_WGOUT = WS_WGIN + (size_t)2 * 2048 * 1024 * 2;
constexpr size_t WS_WAIN  = WS_WGOUT + (size_t)2 * 1024 * 1024 * 2;
constexpr size_t WS_WAOUT = WS_WAIN + (size_t)1536 * 1024 * 2;
constexpr size_t WS_WPIN  = WS_WAOUT + (size_t)1024 * 1024 * 2;
constexpr size_t WS_WPGRP = WS_WPIN + (size_t)1024 * 1024 * 2;
constexpr size_t WS_WUP   = WS_WPGRP + (size_t)4 * 256 * 256 * 2;
constexpr size_t WS_WDN   = WS_WUP + (size_t)4 * 16 * 2048 * 1024 * 2;
constexpr size_t WS_XC    = WS_WDN + (size_t)4 * 16 * 1024 * 1024 * 2;
constexpr size_t WS_H     = WS_XC + (size_t)TC * D * 4;
constexpr size_t WS_S1    = WS_H + (size_t)TT * D * 2;
constexpr size_t WS_S2    = WS_S1 + (size_t)TT * 2048 * 2;
constexpr size_t WS_QB    = WS_S2 + (size_t)TT * D * 2;
constexpr size_t WS_KB    = WS_QB + (size_t)T * D * 2;
constexpr size_t WS_VB    = WS_KB + (size_t)NB * 2 * SKV * 128 * 2;
constexpr size_t WS_IDX   = WS_VB + (size_t)NB * 2 * SKV * 128 * 2;
constexpr size_t WS_HID   = WS_IDX + (size_t)NTILE * 256 * 4;
constexpr size_t WS_YEXP  = WS_HID + (size_t)NTILE * 256 * D * 2;
constexpr size_t WS_END   = WS_YEXP + (size_t)NTILE * 256 * D * 2;

constexpr int RING_BYTES = 131072, MISC_OFF = RING_BYTES, LDS_BYTES = RING_BYTES + 1024;

__device__ __forceinline__ unsigned cvt_pk_bf16(float lo, float hi) { unsigned r; asm volatile("v_cvt_pk_bf16_f32 %0, %1, %2" : "=v"(r) : "v"(lo), "v"(hi)); return r; }
__device__ __forceinline__ float bf_lo(unsigned u) { return __uint_as_float(u << 16); }
__device__ __forceinline__ float bf_hi(unsigned u) { return __uint_as_float(u & 0xffff0000u); }
__device__ __forceinline__ float bf2f(bf16_t b) { return __uint_as_float(((unsigned)b) << 16); }
__device__ __forceinline__ bf16_t f2bf(float f) { return (bf16_t)(cvt_pk_bf16(f, 0.f) & 0xffffu); }
template <int K> __device__ __forceinline__ float swz_xor(float v) { return __int_as_float(__builtin_amdgcn_ds_swizzle(__float_as_int(v), 0x1F | (K << 10))); }
__device__ __forceinline__ float half_sum(float v) { v += swz_xor<1>(v); v += swz_xor<2>(v); v += swz_xor<4>(v); v += swz_xor<8>(v); v += swz_xor<16>(v); return v; }
__device__ __forceinline__ float half_max(float v) { v = fmaxf(v, swz_xor<1>(v)); v = fmaxf(v, swz_xor<2>(v)); v = fmaxf(v, swz_xor<4>(v)); v = fmaxf(v, swz_xor<8>(v)); v = fmaxf(v, swz_xor<16>(v)); return v; }
__device__ __forceinline__ float wave_sum(float v) { v = half_sum(v); auto rr = __builtin_amdgcn_permlane32_swap(__float_as_uint(v), __float_as_uint(v), false, false); return __uint_as_float(rr[0]) + __uint_as_float(rr[1]); }
__device__ __forceinline__ float wave_max(float v) { v = half_max(v); auto rr = __builtin_amdgcn_permlane32_swap(__float_as_uint(v), __float_as_uint(v), false, false); return fmaxf(__uint_as_float(rr[0]), __uint_as_float(rr[1])); }
__device__ __forceinline__ float xor32(float v, bool hi) { auto rr = __builtin_amdgcn_permlane32_swap(__float_as_uint(v), __float_as_uint(v), false, false); return __uint_as_float(hi ? rr[0] : rr[1]); }
__device__ __forceinline__ int opaque_tid() { int t = threadIdx.x; asm volatile("" : "+v"(t)); return t; }
__device__ __forceinline__ float silu_f(float x) { return x / (1.f + __expf(-x)); }
__device__ __forceinline__ float gelu_tanh_f(float x) {
    const float z = 0.7978845608028654f * (x + 0.044715f * x * x * x);
    return x / (1.f + __expf(-2.f * z));
}
#define LDS_WAIT() asm volatile("s_waitcnt lgkmcnt(0)" ::: "memory")

#define XB_TMO      128
#define XB_XCNT(j)  (256  + 64 * (j))
#define XB_XSUB(j)  (1280 + 64 * (j))
#define XB_XGEN(j)  (2304 + 64 * (j))
#define XB_TOP      3328
#define XB_TOPGEN   3392
#define XCD_BAR_WORDS 3456
#define XB_SPIN_CAP (1u << 22)
__device__ __forceinline__ unsigned xb_ld(unsigned* p)              { return __hip_atomic_load(p, __ATOMIC_RELAXED, __HIP_MEMORY_SCOPE_AGENT); }
__device__ __forceinline__ unsigned xb_add(unsigned* p, unsigned v) { return __hip_atomic_fetch_add(p, v, __ATOMIC_RELAXED, __HIP_MEMORY_SCOPE_AGENT); }
__device__ __forceinline__ unsigned xb_xcc_id() { return (unsigned)__builtin_amdgcn_s_getreg((3 << 11) | 20) & 0xFu; }
#define XB_SPIN(cond, bar) do { unsigned _sp = 0; while (cond) { __builtin_amdgcn_s_sleep(1); \
    if ((++_sp & 255u) == 0u) { if (xb_ld(&(bar)[XB_TMO])) break; if (_sp > XB_SPIN_CAP) { atomicAdd(&(bar)[XB_TMO], 1u); break; } } } } while (0)
struct XcdBarrier { unsigned* bar; unsigned x; volatile LAS unsigned* st; };
__device__ __forceinline__ XcdBarrier xcd_barrier_post(unsigned* bar, volatile LAS unsigned* st) {
    XcdBarrier b; b.bar = bar; b.x = xb_xcc_id(); b.st = st;
    if (threadIdx.x == 0) (void)xb_add(&bar[XB_XCNT(b.x)], 1u);
    return b;
}
__device__ __forceinline__ void xcd_barrier_complete(unsigned* bar, unsigned x, unsigned& nloc, unsigned& nx) {
    const unsigned G = gridDim.x * gridDim.y * gridDim.z;
    unsigned sum, cnt, mine, sp = 0u;
    for (;;) {
        sum = 0u; cnt = 0u; mine = 0u;
#pragma unroll
        for (unsigned j = 0; j < 16; ++j) { const unsigned c = xb_ld(&bar[XB_XCNT(j)]); sum += c; cnt += (c > 0u) ? 1u : 0u; }
        mine = xb_ld(&bar[XB_XCNT(x)]);
        if (sum == G) break;
        __builtin_amdgcn_s_sleep(1);
        if ((++sp & 255u) == 0u) { if (xb_ld(&bar[XB_TMO])) break; if (sp > XB_SPIN_CAP) { atomicAdd(&bar[XB_TMO], 1u); break; } }
    }
    nloc = mine > 0u ? mine : 1u; nx = cnt > 0u ? cnt : 1u;
}
__device__ __forceinline__ void xcd_barrier(const XcdBarrier& b) {
    asm volatile("s_waitcnt vmcnt(0)" ::: "memory");
    __syncthreads();
    if (threadIdx.x == 0) {
        unsigned* bar = b.bar;
        __builtin_amdgcn_s_waitcnt(0);
        unsigned nloc = b.st[0], nx = b.st[1];
        if (nloc == 0u) { xcd_barrier_complete(bar, b.x, nloc, nx); b.st[0] = nloc; b.st[1] = nx; }
        const unsigned old = xb_add(&bar[XB_XSUB(b.x)], 1u);
        const unsigned gen = old / nloc;
        if (old + 1u == (gen + 1u) * nloc) {
            __builtin_amdgcn_fence(__ATOMIC_RELEASE, "agent");
            asm volatile("s_waitcnt vmcnt(0)" ::: "memory");
            const unsigned og = xb_add(&bar[XB_TOP], 1u);
            const unsigned tg = og / nx;
            if (og + 1u == (tg + 1u) * nx) xb_add(&bar[XB_TOPGEN], 1u);
            else XB_SPIN(xb_ld(&bar[XB_TOPGEN]) == tg, bar);
            __builtin_amdgcn_fence(__ATOMIC_ACQUIRE, "agent");
            xb_add(&bar[XB_XGEN(b.x)], 1u);
            asm volatile("s_waitcnt vmcnt(0)" ::: "memory");
        } else {
            XB_SPIN(xb_ld(&bar[XB_XGEN(b.x)]) == gen, bar);
            __builtin_amdgcn_fence(__ATOMIC_ACQUIRE, "agent");
            asm volatile("s_waitcnt vmcnt(0)" ::: "memory");
        }
    }
    __syncthreads();
}

namespace pg8 {
constexpr int BM = 256, BK = 64, HALF = 128, HTB = HALF * BK * 2, NXCD = 8, WGM = 8;
__host__ __device__ __forceinline__ int lds_byte(int r, int c) { const int st = (r >> 4) * 2 + (c >> 5), rr = r & 15, cc = c & 31, ob = rr * 64 + cc * 2; return st * 1024 + (ob ^ (((ob >> 9) & 1) << 5)); }
__host__ __device__ __forceinline__ void stage_rc(int b, int& R, int& C) { const int st = b / 1024, sb = b % 1024, swz = sb ^ (((sb >> 9) & 1) << 5); R = (st >> 1) * 16 + swz / 64; C = (st & 1) * 32 + (swz % 64) / 2; }
__host__ __device__ __forceinline__ int perm32(int rho) { const int n = rho >> 4, i = rho & 15; return 8 * (i >> 2) + 4 * n + (i & 3); }
struct Unit { int pm, pn; };

template <class Epi, class Sched>
__device__ __forceinline__ void gemm_phase(LAS unsigned char* lds, const int K, const int lda, const int ldb, const Sched& S, const Epi& E) {
    const int tid = opaque_tid(), wid = __builtin_amdgcn_readfirstlane(tid >> 6), lane = tid & 63, wr = wid >> 2, wc = wid & 3, fr = lane & 15, fq = lane >> 4;
    const int nt = K / BK;
    constexpr bool GATHER = Sched::GATHER;
    unsigned voffA[2], voffB[2]; int rowA[2];
#pragma unroll
    for (int i = 0; i < 2; ++i) { int R, C; stage_rc(tid * 16 + i * 8192, R, C); const int Rb = Epi::PERM ? ((R & ~31) + perm32(R & 31)) : R;
        voffA[i] = GATHER ? (unsigned)C * 2u : (unsigned)(R * lda + C) * 2u; voffB[i] = (unsigned)(Rb * ldb + C) * 2u; rowA[i] = R; }
    unsigned gA[2][2], gN[2][2];
    const size_t kstep = (size_t)(BK * 2);
    const size_t hstepA = (size_t)HALF * lda * 2, hstepB = (size_t)HALF * ldb * 2;
    const unsigned ldsw = (unsigned)wid * 1024u;
    const int aoff = lds_byte(wr * 64 + fr, fq * 8), boff = lds_byte(wc * 32 + fr, fq * 8);
#define PG8_SA(b, h) (((b) * 2 + (h)) * HTB)
#define PG8_SB(b, h) ((4 + (b) * 2 + (h)) * HTB)
#define PG8_STAGE(bufoff, gbase, voff) do { _Pragma("unroll") for (int _i = 0; _i < 2; ++_i) \
        __builtin_amdgcn_global_load_lds((const unsigned*)((const char*)(gbase) + (voff)[_i]), (LAS unsigned*)(lds + (bufoff) + ldsw + _i * 8192), 16, 0, 0); } while (0)
#define PG8_STAGE_A(bufoff, ubase, kb, h, nx) do { if constexpr (GATHER) { unsigned _v[2]; _v[0] = ((nx) ? gN[h][0] : gA[h][0]) + voffA[0]; _v[1] = ((nx) ? gN[h][1] : gA[h][1]) + voffA[1]; \
        PG8_STAGE(bufoff, (const char*)S.abase() + (kb), _v); } else { PG8_STAGE(bufoff, (ubase) + (size_t)(h) * hstepA + (kb), voffA); } } while (0)
#define PG8_LOADG(u, g) do { if constexpr (GATHER) { const int* _ip = S.idx(u); _Pragma("unroll") for (int _h = 0; _h < 2; ++_h) _Pragma("unroll") for (int _i = 0; _i < 2; ++_i) \
        g[_h][_i] = (unsigned)_ip[_h * HALF + rowA[_i]] * (unsigned)(lda * 2); } } while (0)
#define PG8_LDA(dst, b, h) do { _Pragma("unroll") for (int m = 0; m < 4; ++m) _Pragma("unroll") for (int k = 0; k < 2; ++k) dst[m][k] = *(const LAS bf16x8*)(lds + PG8_SA(b, h) + aoff + m * 2048 + k * 1024); } while (0)
#define PG8_LDB(dst, b, h) do { _Pragma("unroll") for (int n = 0; n < 2; ++n) _Pragma("unroll") for (int k = 0; k < 2; ++k) dst[n][k] = *(const LAS bf16x8*)(lds + PG8_SB(b, h) + boff + n * 2048 + k * 1024); } while (0)
#define PG8_MMA(ai, bj, At, Bt) do { __builtin_amdgcn_s_setprio(1); _Pragma("unroll") for (int m = 0; m < 4; ++m) _Pragma("unroll") for (int n = 0; n < 2; ++n) _Pragma("unroll") for (int k = 0; k < 2; ++k) \
        acc[ai][bj][m][n] = __builtin_amdgcn_mfma_f32_16x16x32_bf16(Bt[n][k], At[m][k], acc[ai][bj][m][n], 0, 0, 0); __builtin_amdgcn_s_setprio(0); } while (0)
#define PG8_WAIT_V(n) asm volatile("s_waitcnt vmcnt(" #n ")" ::: "memory")
#define PG8_WAIT_L(n) asm volatile("s_waitcnt lgkmcnt(" #n ")" ::: "memory")
#define PG8_BAR __builtin_amdgcn_s_barrier()
#define PG8_SCHED __builtin_amdgcn_sched_barrier(0)
    Unit cur, nxt; int ui = 0;
    if (!S.next(0, cur)) return;
    f32x4 acc[2][2][4][2];
#pragma unroll
    for (int a = 0; a < 2; ++a)
#pragma unroll
        for (int b = 0; b < 2; ++b)
#pragma unroll
            for (int m = 0; m < 4; ++m)
#pragma unroll
                for (int n = 0; n < 2; ++n) acc[a][b][m][n] = (f32x4){0.f, 0.f, 0.f, 0.f};
    bf16x8 At[4][2], B0[2][2], B1[2][2];
    const char* cA = GATHER ? (const char*)nullptr : S.aptr(cur); const char* cB = S.bptr(cur);
    PG8_LOADG(cur, gA);
    PG8_STAGE(PG8_SB(0, 0), cB, voffB); PG8_STAGE(PG8_SB(0, 1), cB + hstepB, voffB); PG8_STAGE_A(PG8_SA(0, 0), cA, 0, 0, false); PG8_STAGE_A(PG8_SA(0, 1), cA, 0, 1, false);
    if (wr == 1) PG8_BAR;
    PG8_WAIT_V(2); PG8_BAR;
    PG8_STAGE(PG8_SB(1, 0), cB + kstep, voffB); PG8_STAGE_A(PG8_SA(1, 0), cA, kstep, 0, false); PG8_STAGE(PG8_SB(1, 1), cB + hstepB + kstep, voffB);
    PG8_WAIT_V(6); PG8_BAR;
    for (;;) {
        const bool has_next = S.next(ui + 1, nxt);
        const char* nA = (has_next && !GATHER) ? S.aptr(nxt) : cA; const char* nB = has_next ? S.bptr(nxt) : cB;
        if (has_next) PG8_LOADG(nxt, gN); else { if constexpr (GATHER) {
#pragma unroll
            for (int h_ = 0; h_ < 2; ++h_) { gN[h_][0] = gA[h_][0]; gN[h_][1] = gA[h_][1]; } } }
        for (int t = 0; t < nt; t += 2) {
            const bool last = (t == nt - 2);
            const size_t k1 = (size_t)(t + 1) * kstep, k2 = last ? 0 : (size_t)(t + 2) * kstep, k3 = k2 + kstep;
            const char* a2 = last ? nA : cA; const char* b2 = last ? nB : cB + (size_t)(t + 2) * kstep;
            const char* b3 = b2 + kstep;
            PG8_LDB(B0, 0, 0); PG8_LDB(B1, 0, 1); PG8_SCHED; PG8_LDA(At, 0, 0); PG8_STAGE_A(PG8_SA(1, 1), cA, k1, 1, false);
            PG8_WAIT_V(8); PG8_WAIT_L(0); PG8_BAR; PG8_MMA(0, 0, At, B0); PG8_MMA(0, 1, At, B1); PG8_BAR; PG8_SCHED;
            PG8_LDA(At, 0, 1); PG8_STAGE(PG8_SB(0, 0), b2, voffB); PG8_STAGE(PG8_SB(0, 1), b2 + hstepB, voffB); PG8_STAGE_A(PG8_SA(0, 0), a2, k2, 0, last);
            PG8_WAIT_V(8); PG8_WAIT_L(0); PG8_BAR; PG8_MMA(1, 0, At, B0); PG8_MMA(1, 1, At, B1); PG8_BAR; PG8_SCHED;
            PG8_LDB(B0, 1, 0); PG8_LDB(B1, 1, 1); PG8_SCHED; PG8_LDA(At, 1, 0); PG8_STAGE_A(PG8_SA(0, 1), a2, k2, 1, last);
            PG8_WAIT_V(8); PG8_WAIT_L(0); PG8_BAR; PG8_MMA(0, 0, At, B0); PG8_MMA(0, 1, At, B1); PG8_BAR; PG8_SCHED;
            PG8_LDA(At, 1, 1); PG8_STAGE(PG8_SB(1, 0), b3, voffB); PG8_STAGE(PG8_SB(1, 1), b3 + hstepB, voffB); PG8_STAGE_A(PG8_SA(1, 0), a2, k3, 0, last);
            PG8_WAIT_V(8); PG8_WAIT_L(0); PG8_BAR; PG8_MMA(1, 0, At, B0); PG8_MMA(1, 1, At, B1); PG8_BAR; PG8_SCHED;
        }
        if (wr == 0) PG8_BAR;
        E(acc, cur, wr, wc, fr, fq);
        if (!has_next) break;
#pragma unroll
        for (int a = 0; a < 2; ++a)
#pragma unroll
            for (int b = 0; b < 2; ++b)
#pragma unroll
                for (int m = 0; m < 4; ++m)
#pragma unroll
                    for (int n = 0; n < 2; ++n) acc[a][b][m][n] = (f32x4){0.f, 0.f, 0.f, 0.f};
        cur = nxt; cA = nA; cB = nB; ++ui;
        if constexpr (GATHER) {
#pragma unroll
            for (int h_ = 0; h_ < 2; ++h_) { gA[h_][0] = gN[h_][0]; gA[h_][1] = gN[h_][1]; } }
        if (wr == 1) PG8_BAR;
    }
    PG8_WAIT_V(0);
    PG8_BAR;
#undef PG8_SA
#undef PG8_SB
#undef PG8_STAGE
#undef PG8_STAGE_A
#undef PG8_LOADG
#undef PG8_LDA
#undef PG8_LDB
#undef PG8_MMA
#undef PG8_WAIT_V
#undef PG8_WAIT_L
#undef PG8_BAR
#undef PG8_SCHED
}

struct SchedDense {
    static constexpr bool GATHER = false;
    __device__ __forceinline__ const char* abase() const { return nullptr; }
    __device__ __forceinline__ const int* idx(const Unit&) const { return nullptr; }
    const bf16_t* A; const bf16_t* Bt; int a_pm_stride, a_pn_stride, b_pn_stride;
    int nM, nN, nwg, extra, G, c;
    __device__ __forceinline__ bool next(int i, Unit& u) const {
        const int L = i * G + c; if (L >= nwg + extra) return false;
        if (L >= nwg) { const int x = L - nwg; u.pm = nM + (x >> 1); u.pn = 4 + (x & 1); return true; }
        int wgid = L; { const int q = nwg / NXCD, r = nwg % NXCD, xcd = wgid % NXCD, off = wgid / NXCD; wgid = (xcd < r ? xcd * (q + 1) : r * (q + 1) + (xcd - r) * q) + off; }
        const int nig = WGM * nN, gid = wgid / nig, fm = gid * WGM, gsz = (nM - fm) < WGM ? (nM - fm) : WGM;
        u.pm = fm + ((wgid % nig) % gsz); u.pn = (wgid % nig) / gsz; return true;
    }
    __device__ __forceinline__ const char* aptr(const Unit& u) const { return (const char*)(A + (size_t)u.pm * a_pm_stride + (size_t)u.pn * a_pn_stride); }
    __device__ __forceinline__ const char* bptr(const Unit& u) const { return (const char*)(Bt + (size_t)u.pn * b_pn_stride); }
};
template <bool GATHER_>
struct SchedMoE {
    static constexpr bool GATHER = GATHER_;
    const bf16_t* A; const bf16_t* Bt; const int* IDX; int nbt, nn, G, vcu;
    __device__ __forceinline__ bool next(int i, Unit& u) const {
        const int L = i * G + vcu, per_e = nbt * nn; if (L >= NE * per_e) return false;
        const int e = L / per_e, rem = L - e * per_e, bt = rem / nn, j = rem - bt * nn;
        u.pm = bt < 8 ? e * 8 + bt : 128 + e; u.pn = e * nn + j; return true;
    }
    __device__ __forceinline__ const char* aptr(const Unit& u) const { return (const char*)(A + (size_t)u.pm * 256 * D); }
    __device__ __forceinline__ const char* abase() const { return (const char*)A; }
    __device__ __forceinline__ const int* idx(const Unit& u) const { return IDX + (size_t)u.pm * 256; }
    __device__ __forceinline__ const char* bptr(const Unit& u) const { return (const char*)(Bt + (size_t)u.pn * 256 * D); }
};

struct EpiA {
    static constexpr bool PERM = true;
    bf16_t* O; int ldc; int act; bf16_t* VB; float* stats;
    __device__ __forceinline__ void operator()(const f32x4 (&acc)[2][2][4][2], const Unit& u, int wr, int wc, int fr, int fq) const {
        const int row0 = u.pm * BM + wr * 64 + fr, cl = wc * 32 + 8 * fq;
        const bool vtile = (VB != nullptr) && (u.pn == 5);
        const bool dostat = (stats != nullptr) && (u.pn >= 4);
#pragma unroll
        for (int ai = 0; ai < 2; ++ai)
#pragma unroll
            for (int m = 0; m < 4; ++m) {
                const int r = row0 + ai * HALF + m * 16;
                float s1 = 0.f, s2 = 0.f;
#pragma unroll
                for (int bj = 0; bj < 2; ++bj) {
                    f32x4 v0 = acc[ai][bj][m][0], v1 = acc[ai][bj][m][1];
                    if (act) {
#pragma unroll
                        for (int j = 0; j < 4; ++j) { v0[j] = gelu_tanh_f(v0[j]); v1[j] = gelu_tanh_f(v1[j]); } }
#pragma unroll
                    for (int j = 0; j < 4; ++j) { s1 += v0[j] + v1[j]; s2 += v0[j] * v0[j] + v1[j] * v1[j]; }
                    u32x4 w; w.x = cvt_pk_bf16(v0[0], v0[1]); w.y = cvt_pk_bf16(v0[2], v0[3]); w.z = cvt_pk_bf16(v1[0], v1[1]); w.w = cvt_pk_bf16(v1[2], v1[3]);
                    bf16_t* dst;
                    if (vtile) { int b, pos; if (r < T) { b = r >> 11; pos = CL + (r & (SEQ - 1)); } else { const int rc = r - T; b = rc >> 8; pos = rc & (CL - 1); }
                        dst = VB + ((size_t)(b * 2 + bj) * SKV + pos) * 128 + cl; }
                    else dst = O + (size_t)r * ldc + u.pn * BM + bj * HALF + cl;
                    *(u32x4*)dst = w; }
                if (dostat) {
                    s1 += swz_xor<16>(s1); s2 += swz_xor<16>(s2);
                    { auto rr = __builtin_amdgcn_permlane32_swap(__float_as_uint(s1), __float_as_uint(s1), false, false); s1 = __uint_as_float(rr[0]) + __uint_as_float(rr[1]); }
                    { auto rr = __builtin_amdgcn_permlane32_swap(__float_as_uint(s2), __float_as_uint(s2), false, false); s2 = __uint_as_float(rr[0]) + __uint_as_float(rr[1]); }
                    if (fq == 0) *(f32x2*)(stats + ((size_t)r * 16 + (u.pn - 4) * 4 + wc) * 2) = (f32x2){s1, s2}; } }
    }
};
struct EpiB {
    static constexpr bool PERM = false;
    const float* xs_lat; const float* xs_ctx; float* xd_lat; float* xd_ctx; const float* gt; const float* colscale; int dry;
    __device__ __forceinline__ void operator()(const f32x4 (&acc)[2][2][4][2], const Unit& u, int wr, int wc, int fr, int fq) const {
        const int row0 = u.pm * BM + wr * 64 + fr, col0 = u.pn * BM + wc * 32 + 4 * fq;
        const bool isctx = row0 >= T;
        const int mrow = isctx ? 8 : (row0 >> 11);
        const float* xs = isctx ? xs_ctx - (size_t)T * D : xs_lat; float* xd = isctx ? xd_ctx - (size_t)T * D : xd_lat;
        f32x4 gv[2][2];
#pragma unroll
        for (int bj = 0; bj < 2; ++bj)
#pragma unroll
            for (int n = 0; n < 2; ++n) { const int c = col0 + bj * HALF + n * 16; gv[bj][n] = *(const f32x4*)(gt + (size_t)mrow * 6144 + c);
                if (colscale) gv[bj][n] = gv[bj][n] * *(const f32x4*)(colscale + c); }
#pragma unroll
        for (int ai = 0; ai < 2; ++ai)
#pragma unroll
            for (int m = 0; m < 4; ++m) { const size_t off = (size_t)(row0 + ai * HALF + m * 16) * D + col0;
#pragma unroll
                for (int bj = 0; bj < 2; ++bj)
#pragma unroll
                    for (int n = 0; n < 2; ++n) { const f32x4 xo = *(const f32x4*)(xs + off + bj * HALF + n * 16);
                        const f32x4 xn = xo + gv[bj][n] * acc[ai][bj][m][n]; if (!dry) *(f32x4*)(xd + off + bj * HALF + n * 16) = xn; } }
    }
};
struct EpiC {
    static constexpr bool PERM = true;
    bf16_t* HID;
    __device__ __forceinline__ void operator()(const f32x4 (&acc)[2][2][4][2], const Unit& u, int wr, int wc, int fr, int fq) const {
        const int n8 = u.pn & 7, rl = wr * 64 + fr, cl = n8 * 128 + wc * 32 + 8 * fq;
        bf16_t* base = HID + (size_t)u.pm * 256 * D;
#pragma unroll
        for (int ai = 0; ai < 2; ++ai)
#pragma unroll
            for (int m = 0; m < 4; ++m) {
                float h[8];
#pragma unroll
                for (int n = 0; n < 2; ++n)
#pragma unroll
                    for (int j = 0; j < 4; ++j) { const float g = acc[ai][0][m][n][j], up = acc[ai][1][m][n][j]; h[n * 4 + j] = silu_f(g) * up; }
                u32x4 w; w.x = cvt_pk_bf16(h[0], h[1]); w.y = cvt_pk_bf16(h[2], h[3]); w.z = cvt_pk_bf16(h[4], h[5]); w.w = cvt_pk_bf16(h[6], h[7]);
                *(u32x4*)(base + (size_t)(rl + ai * HALF + m * 16) * D + cl) = w; }
    }
};
struct EpiD {
    static constexpr bool PERM = true;
    bf16_t* Y; const float* gate;
    __device__ __forceinline__ void operator()(const f32x4 (&acc)[2][2][4][2], const Unit& u, int wr, int wc, int fr, int fq) const {
        const int n4 = u.pn & 3, rl = wr * 64 + fr, cl = n4 * 256 + wc * 32 + 8 * fq;
        bf16_t* base = Y + (size_t)u.pm * 256 * D; const float* gp = gate + (size_t)u.pm * 256;
#pragma unroll
        for (int ai = 0; ai < 2; ++ai)
#pragma unroll
            for (int m = 0; m < 4; ++m) { const int r = rl + ai * HALF + m * 16; const float g = gp[r];
#pragma unroll
                for (int bj = 0; bj < 2; ++bj) { const f32x4 v0 = acc[ai][bj][m][0] * g, v1 = acc[ai][bj][m][1] * g;
                    u32x4 w; w.x = cvt_pk_bf16(v0[0], v0[1]); w.y = cvt_pk_bf16(v0[2], v0[3]); w.z = cvt_pk_bf16(v1[0], v1[1]); w.w = cvt_pk_bf16(v1[2], v1[3]);
                    *(u32x4*)(base + (size_t)r * D + bj * HALF + cl) = w; } }
    }
};
}

namespace att {
constexpr int QBLK = 32, KVBLK = 64;
constexpr float SCALE = 0.088388347648318440f;
constexpr float THR = 8.f;
constexpr int SHM_V = KVBLK * 128 * 2, SHM_K = KVBLK * 128 * 2;
#define KSWZ(row, colB) ((row) * 256 + ((colB) ^ (((row) & 7) << 4)))
#define SBAR() __builtin_amdgcn_sched_barrier(0)
__device__ __forceinline__ int crow(int r, int hi) { return (r & 3) + 8 * (r >> 2) + 4 * hi; }
__device__ __forceinline__ void partialSM(f32x16& p0, f32x16& p1, float& m_reg, float& mn, float& alpha) {
    constexpr float C = SCALE * 1.4426950408889634f;
    float pmax = p0[0];
#pragma unroll
    for (int r = 1; r < 16; ++r) pmax = fmaxf(pmax, p0[r]);
#pragma unroll
    for (int r = 0; r < 16; ++r) pmax = fmaxf(pmax, p1[r]);
    { auto rr = __builtin_amdgcn_permlane32_swap(__float_as_uint(pmax), __float_as_uint(pmax), false, false);
      pmax = fmaxf(__uint_as_float(rr[0]), __uint_as_float(rr[1])); }
    if (__builtin_expect(__all(pmax - m_reg <= THR / SCALE), 1)) { mn = m_reg; alpha = 1.f; }
    else { mn = fmaxf(m_reg, pmax); alpha = __builtin_amdgcn_exp2f((m_reg - mn) * C); m_reg = mn; }
    float mnC = -mn * C;
#pragma unroll
    for (int r = 0; r < 16; ++r) p0[r] = fmaf(p0[r], C, mnC);
#pragma unroll
    for (int r = 0; r < 16; ++r) p1[r] = fmaf(p1[r], C, mnC);
#pragma unroll
    for (int r = 0; r < 16; ++r) p0[r] = __builtin_amdgcn_exp2f(p0[r]);
}
__device__ __forceinline__ void finishSM(f32x16& p0, f32x16& p1, float alpha, float& l_reg, bf16x8& pa0, bf16x8& pa1, bf16x8& pa2, bf16x8& pa3) {
#pragma unroll
    for (int r = 0; r < 16; ++r) p1[r] = __builtin_amdgcn_exp2f(p1[r]);
    float ps = 0;
#pragma unroll
    for (int r = 0; r < 16; ++r) ps += p0[r];
#pragma unroll
    for (int r = 0; r < 16; ++r) ps += p1[r];
    { auto rr = __builtin_amdgcn_permlane32_swap(__float_as_uint(ps), __float_as_uint(ps), false, false);
      ps = __uint_as_float(rr[0]) + __uint_as_float(rr[1]); }
    l_reg = l_reg * alpha + ps;
#define PK4(P, BASE, OUT) do { unsigned a0 = cvt_pk_bf16(P[BASE + 0], P[BASE + 1]), a1 = cvt_pk_bf16(P[BASE + 2], P[BASE + 3]);   \
    unsigned b0 = cvt_pk_bf16(P[BASE + 4], P[BASE + 5]), b1 = cvt_pk_bf16(P[BASE + 6], P[BASE + 7]);                              \
    auto r0 = __builtin_amdgcn_permlane32_swap(a0, b0, false, false); auto r1 = __builtin_amdgcn_permlane32_swap(a1, b1, false, false); \
    u32x4 w = {r0[0], r1[0], r0[1], r1[1]}; OUT = *reinterpret_cast<bf16x8*>(&w); } while (0)
    PK4(p0, 0, pa0); PK4(p0, 8, pa1); PK4(p1, 0, pa2); PK4(p1, 8, pa3);
#undef PK4
}
__device__ __forceinline__ void qkt(f32x16& p0, f32x16& p1, const LAS unsigned char* Ks, const bf16x8* qr, int r32, int hi) {
    p0 = f32x16{}; p1 = f32x16{};
#pragma unroll
    for (int d0 = 0; d0 < 8; ++d0) { int cb = (d0 * 16 + hi * 8) * 2;
        bf16x8 b0 = *reinterpret_cast<const LAS bf16x8*>(Ks + KSWZ(r32, cb));
        bf16x8 b1 = *reinterpret_cast<const LAS bf16x8*>(Ks + KSWZ(32 + r32, cb));
        p0 = __builtin_amdgcn_mfma_f32_32x32x16_bf16(b0, qr[d0], p0, 0, 0, 0);
        p1 = __builtin_amdgcn_mfma_f32_32x32x16_bf16(b1, qr[d0], p1, 0, 0, 0); }
}
__device__ __forceinline__ int v_st(int k, int c) { const int kk = (k & ~0xC) | ((k & 4) << 1) | ((k & 8) >> 1); return ((kk >> 3) * 4 + (c >> 5)) * 512 + ((kk & 7) * 32 + (c & 31)) * 2; }
__device__ __forceinline__ int v_rd_base(int lane) { return ((lane & 3) << 3) | (((lane >> 2) & 3) << 6) | (((lane >> 4) & 1) << 5) | (((lane >> 5) & 1) << 8); }
constexpr int v_rd_off(int d0, int ks, int half) { return d0 * 512 + ks * 4096 + half * 2048; }
template <int OFF> __device__ __forceinline__ s16x4 tr_read(int vb) {
    s16x4 r; asm volatile("ds_read_b64_tr_b16 %0, %1 offset:%2" : "=&v"(r) : "v"(vb), "i"(OFF) : "memory"); return r;
}
template <int D0> __device__ __forceinline__ void pv_one(f32x16& od, int vb, bf16x8 pa0, bf16x8 pa1, bf16x8 pa2, bf16x8 pa3) {
    const s16x4 l0 = tr_read<v_rd_off(D0, 0, 0)>(vb), h0 = tr_read<v_rd_off(D0, 0, 1)>(vb), l1 = tr_read<v_rd_off(D0, 1, 0)>(vb), h1 = tr_read<v_rd_off(D0, 1, 1)>(vb);
    const s16x4 l2 = tr_read<v_rd_off(D0, 2, 0)>(vb), h2 = tr_read<v_rd_off(D0, 2, 1)>(vb), l3 = tr_read<v_rd_off(D0, 3, 0)>(vb), h3 = tr_read<v_rd_off(D0, 3, 1)>(vb);
    asm volatile("s_waitcnt lgkmcnt(0)" ::: "memory"); SBAR();
#define PK(L, H) (bf16x8){L[0], L[1], L[2], L[3], H[0], H[1], H[2], H[3]}
    od = __builtin_amdgcn_mfma_f32_32x32x16_bf16(pa0, PK(l0, h0), od, 0, 0, 0);
    od = __builtin_amdgcn_mfma_f32_32x32x16_bf16(pa1, PK(l1, h1), od, 0, 0, 0);
    od = __builtin_amdgcn_mfma_f32_32x32x16_bf16(pa2, PK(l2, h2), od, 0, 0, 0);
    od = __builtin_amdgcn_mfma_f32_32x32x16_bf16(pa3, PK(l3, h3), od, 0, 0, 0);
#undef PK
}
__device__ __forceinline__ void pv_d0(f32x16* o, int vb, bf16x8 pa0, bf16x8 pa1, bf16x8 pa2, bf16x8 pa3) {
    pv_one<0>(o[0], vb, pa0, pa1, pa2, pa3); pv_one<1>(o[1], vb, pa0, pa1, pa2, pa3); pv_one<2>(o[2], vb, pa0, pa1, pa2, pa3); pv_one<3>(o[3], vb, pa0, pa1, pa2, pa3);
}
template <int LDQ, int LDO>
__device__ __forceinline__ void attn_body(const bf16_t* __restrict__ Qb, const bf16_t* __restrict__ Kh, const bf16_t* __restrict__ Vh, bf16_t* __restrict__ Ob, int seq, LAS unsigned char* lds) {
    constexpr int LDK = 128;
    const int tid = opaque_tid(), wid = tid >> 6, lane = tid & 63, r32 = lane & 31, hi = lane >> 5;
    LAS unsigned char* V_lds = lds; LAS unsigned char* K_lds = lds + 2 * SHM_V;
    LAS float* ws = (LAS float*)(lds + 2 * SHM_V + 2 * SHM_K) + wid * 64; LAS float* li_l = ws; LAS float* al_l = ws + 32;
    float m_reg = -1e30f, l_reg = 0; f32x16 o[4] = {}; bf16x8 qr[8];
    const bf16_t* Qw = Qb + (long)(wid * QBLK + r32) * LDQ + hi * 8;
#pragma unroll
    for (int d0 = 0; d0 < 8; ++d0) qr[d0] = *reinterpret_cast<const bf16x8*>(Qw + d0 * 16);
    const int sr = tid >> 4, sc = (tid & 15) * 8, vst0 = v_st(sr, sc), vst1 = v_st(32 + sr, sc);
    const int vb0 = (int)(unsigned)(uintptr_t)V_lds + v_rd_base(lane);
    struct { bf16x8 vs0, vs1, ks0, ks1; } sr_[2];
#define SLOAD(i, k0) do { sr_[i].vs0 = *reinterpret_cast<const bf16x8*>(&Vh[(long)((k0) + sr) * LDK + sc]); sr_[i].vs1 = *reinterpret_cast<const bf16x8*>(&Vh[(long)((k0) + 32 + sr) * LDK + sc]); \
    sr_[i].ks0 = *reinterpret_cast<const bf16x8*>(&Kh[(long)((k0) + sr) * LDK + sc]); sr_[i].ks1 = *reinterpret_cast<const bf16x8*>(&Kh[(long)((k0) + 32 + sr) * LDK + sc]); } while (0)
#define SWRITE(b, i) do { *(LAS bf16x8*)(V_lds + (b) * SHM_V + vst0) = sr_[i].vs0;          \
    *(LAS bf16x8*)(V_lds + (b) * SHM_V + vst1) = sr_[i].vs1; int kc = sc * 2;               \
    *(LAS bf16x8*)(K_lds + (b) * SHM_K + KSWZ(sr, kc)) = sr_[i].ks0;                       \
    *(LAS bf16x8*)(K_lds + (b) * SHM_K + KSWZ(32 + sr, kc)) = sr_[i].ks1; } while (0)
#define SWAIT() asm volatile("s_waitcnt vmcnt(4)" ::: "memory")
#define RESC(a) do { if (__any((a) < 1.f)) { if (hi == 0) al_l[r32] = (a); asm volatile("s_waitcnt lgkmcnt(0)" ::: "memory"); \
    for (int d = 0; d < 4; ++d) for (int r = 0; r < 16; ++r) o[d][r] *= al_l[crow(r, hi)]; } } while (0)
    f32x16 pA0, pA1, pB0, pB1; float mnA, mnB, alA, alB; bf16x8 pa0, pa1, pa2, pa3; const int NT = seq / KVBLK;
    constexpr int SE = 0, SO = 1;
    SLOAD(SE, 0); asm volatile("s_waitcnt vmcnt(0)" ::: "memory"); SWRITE(0, SE); __syncthreads();
    qkt(pA0, pA1, K_lds, qr, r32, hi); partialSM(pA0, pA1, m_reg, mnA, alA);
    SLOAD(SO, KVBLK); if (2 < NT) SLOAD(SE, 2 * KVBLK);
    SWAIT(); SWRITE(1, SO); __syncthreads();
    for (int j = 1; j + 1 < NT; j += 2) {
        SBAR(); qkt(pB0, pB1, K_lds + SHM_K, qr, r32, hi);
        finishSM(pA0, pA1, alA, l_reg, pa0, pa1, pa2, pa3); SBAR();
        SLOAD(SO, (j + 2) * KVBLK); SBAR();
        pv_d0(o, vb0, pa0, pa1, pa2, pa3); partialSM(pB0, pB1, m_reg, mnB, alB);
        __syncthreads(); SWAIT(); SWRITE(0, SE);
        RESC(alB); __syncthreads();
        SBAR(); qkt(pA0, pA1, K_lds, qr, r32, hi);
        finishSM(pB0, pB1, alB, l_reg, pa0, pa1, pa2, pa3); SBAR();
        if (j + 3 < NT) SLOAD(SE, (j + 3) * KVBLK); SBAR();
        pv_d0(o, vb0 + (int)SHM_V, pa0, pa1, pa2, pa3); partialSM(pA0, pA1, m_reg, mnA, alA);
        __syncthreads(); SWAIT(); SWRITE(1, SO);
        RESC(alA); __syncthreads();
    }
    SBAR(); qkt(pB0, pB1, K_lds + SHM_K, qr, r32, hi);
    finishSM(pA0, pA1, alA, l_reg, pa0, pa1, pa2, pa3); SBAR();
    pv_d0(o, vb0, pa0, pa1, pa2, pa3); partialSM(pB0, pB1, m_reg, mnB, alB);
    __syncthreads(); RESC(alB);
    finishSM(pB0, pB1, alB, l_reg, pa0, pa1, pa2, pa3); SBAR();
    pv_d0(o, vb0 + (int)SHM_V, pa0, pa1, pa2, pa3);
    if (hi == 0) li_l[r32] = l_reg; asm volatile("s_waitcnt lgkmcnt(0)" ::: "memory");
    float rli[16];
#pragma unroll
    for (int r = 0; r < 16; ++r) rli[r] = __builtin_amdgcn_rcpf(li_l[crow(r, hi)]);
    bf16_t* Ow = Ob + (long)(wid * QBLK) * LDO;
#pragma unroll
    for (int r = 0; r < 16; ++r) { int orow = crow(r, hi);
#pragma unroll
        for (int d0 = 0; d0 < 4; ++d0) Ow[(long)orow * LDO + d0 * 32 + r32] = f2bf(o[d0][r] * rli[r]); }
#undef SLOAD
#undef SWRITE
#undef SWAIT
#undef RESC
}
}

struct KArgs { const float* in[24]; float* out; unsigned char* ws; int ph_lo, ph_hi; };
enum { I_X = 0, I_C, I_CTX, I_CCTX, I_MODW, I_MODB, I_N1G, I_N2G, I_RW, I_WG, I_WU, I_WD, I_GWIN, I_GVG, I_GSW, I_GSB, I_GWOUT, I_AWIN, I_AQG, I_AKG, I_AWOUT, I_PWIN, I_PWG, I_PSC };

struct Fr {
    volatile LAS unsigned long long* PT;
    int G, bx, vcu;
    __device__ __forceinline__ unsigned long long ldp(int i) const { const unsigned long long v = PT[i];
        const unsigned lo = __builtin_amdgcn_readfirstlane((unsigned)v), hi = __builtin_amdgcn_readfirstlane((unsigned)(v >> 32)); return ((unsigned long long)hi << 32) | lo; }
    __device__ __forceinline__ const float* in(int i) const { return (const float*)(GAS const float*)ldp(i); }
    __device__ __forceinline__ float* out() const { return (float*)(GAS float*)ldp(24); }
    __device__ __forceinline__ unsigned char* ws() const { return (unsigned char*)(GAS unsigned char*)ldp(25); }
};
#define WSP(F, T_, OFF) ((T_*)((F).ws() + (OFF)))

__device__ __forceinline__ void p0_phase(const Fr& F, LAS unsigned char* lds, const int part) {
    const int tid = opaque_tid(), lane = tid & 63, wave = __builtin_amdgcn_readfirstlane(tid >> 6), gw = F.bx * NWAVES + wave, NGW = F.G * NWAVES; (void)gw; (void)NGW; (void)lane; (void)wave;
    unsigned char* const ws_ = F.ws();
    float* const modv_ = (float*)(ws_ + WS_MODV);
    bf16_t* const wsw_ = (bf16_t*)(ws_ + WS_WSW);
    bf16_t* const wgin_ = (bf16_t*)(ws_ + WS_WGIN);
    bf16_t* const wgout_ = (bf16_t*)(ws_ + WS_WGOUT);
    bf16_t* const wain_ = (bf16_t*)(ws_ + WS_WAIN);
    bf16_t* const waout_ = (bf16_t*)(ws_ + WS_WAOUT);
    bf16_t* const wpin_ = (bf16_t*)(ws_ + WS_WPIN);
    bf16_t* const wpgrp_ = (bf16_t*)(ws_ + WS_WPGRP);
    bf16_t* const wup_ = (bf16_t*)(ws_ + WS_WUP);
    bf16_t* const wdn_ = (bf16_t*)(ws_ + WS_WDN);
    const float* const in_I_AWIN = F.in(I_AWIN);
    const float* const in_I_AWOUT = F.in(I_AWOUT);
    const float* const in_I_C = F.in(I_C);
    const float* const in_I_CCTX = F.in(I_CCTX);
    const float* const in_I_GSW = F.in(I_GSW);
    const float* const in_I_GWIN = F.in(I_GWIN);
    const float* const in_I_GWOUT = F.in(I_GWOUT);
    const float* const in_I_MODB = F.in(I_MODB);
    const float* const in_I_MODW = F.in(I_MODW);
    const float* const in_I_PWG = F.in(I_PWG);
    const float* const in_I_PWIN = F.in(I_PWIN);
    const float* const in_I_WD = F.in(I_WD);
    const float* const in_I_WG = F.in(I_WG);
    const float* const in_I_WU = F.in(I_WU);

    if (part == 0) {
    LAS float* sact = (LAS float*)lds;
    LAS float* red = (LAS float*)(lds + 49152);
    for (int idx = tid; idx < 9 * 1024; idx += NTHR) { const int r = idx >> 10, k = idx & 1023; const float v = r < 8 ? in_I_C[r * 1024 + k] : in_I_CCTX[k]; sact[k * 12 + r] = silu_f(v); }
    __syncthreads();
    for (int chunk = F.bx; chunk < 768; chunk += F.G) {
        const int layer = chunk / 192, n0 = (chunk % 192) * 32, k0 = wave * 128 + (lane >> 5);
        const float* wp = in_I_MODW + (size_t)layer * 1024 * 6144 + (size_t)k0 * 6144 + n0 + (lane & 31);
        float acc[9];
#pragma unroll
        for (int r = 0; r < 9; ++r) acc[r] = 0.f;
#pragma nounroll
        for (int hb = 0; hb < 4; ++hb) {
            float w[16];
#pragma unroll
            for (int i = 0; i < 16; ++i) w[i] = wp[(size_t)(2 * (hb * 16 + i)) * 6144];
#pragma unroll
            for (int i = 0; i < 16; ++i) { const LAS float* sa = sact + (k0 + 2 * (hb * 16 + i)) * 12;
                const f32x4 s0 = *(const LAS f32x4*)sa, s1 = *(const LAS f32x4*)(sa + 4); const float s8 = sa[8];
                acc[0] += s0[0] * w[i]; acc[1] += s0[1] * w[i]; acc[2] += s0[2] * w[i]; acc[3] += s0[3] * w[i];
                acc[4] += s1[0] * w[i]; acc[5] += s1[1] * w[i]; acc[6] += s1[2] * w[i]; acc[7] += s1[3] * w[i]; acc[8] += s8 * w[i];
                __builtin_amdgcn_sched_barrier(0); }
        }
#pragma unroll
        for (int r = 0; r < 9; ++r) { acc[r] += xor32(acc[r], lane >= 32); if (lane < 32) red[(wave * 9 + r) * 32 + lane] = acc[r]; }
        __syncthreads();
        for (int idx = tid; idx < 288; idx += NTHR) { const int r = idx >> 5, l = idx & 31; float sacc = 0.f;
#pragma unroll
            for (int w = 0; w < 8; ++w) sacc += red[(w * 9 + r) * 32 + l];
            const int nn = n0 + l; modv_[(size_t)(layer * 9 + r) * 6144 + nn] = sacc + in_I_MODB[layer * 6144 + nn]; }
        __syncthreads();
    }
    return;
    }
    {
        constexpr int NT_EXP = 4 * 16 * 3 * 64, NT_ALL = NT_EXP + 256 + 128 + 96 + 64 + 64 + 16;
        const int c4 = tid & 63, rr = tid >> 3, ch = tid & 7;
        f32x4 ld[8];
        const float* W = nullptr; int N = 0, k0 = 0, n0 = 0, ldt = 0, gu = 0; bf16_t* dst = nullptr;
#define P0_DECODE(it) do { int r_ = (it); \
            if (r_ < NT_EXP) { const int mat = r_ >> 6, sub = r_ & 63, l = mat / 48, rem = mat % 48, e = rem / 3, which = rem % 3; k0 = (sub >> 2) * 64; n0 = (sub & 3) * 256; N = 1024; ldt = 1024; \
                if (which < 2) { W = (which == 0 ? in_I_WG : in_I_WU) + (size_t)(l * 16 + e) * 1024 * 1024; dst = wup_ + (size_t)l * 16 * 2048 * 1024 + (size_t)(e * 8 * 256 + which * 128) * 1024; gu = 1; } \
                else { W = in_I_WD + (size_t)(l * 16 + e) * 1024 * 1024; dst = wdn_ + (size_t)l * 16 * 1024 * 1024 + (size_t)(e * 1024) * 1024; gu = 0; } } \
            else { r_ -= NT_EXP; gu = 0; \
                if (r_ < 256) { const int j = r_ >> 7, sub = r_ & 127; k0 = (sub >> 3) * 64; n0 = (sub & 7) * 256; N = 2048; ldt = 1024; W = in_I_GWIN + (size_t)j * 1024 * 2048; dst = wgin_ + (size_t)j * 2048 * 1024; } \
                else if ((r_ -= 256) < 128) { const int j = r_ >> 6, sub = r_ & 63; k0 = (sub >> 2) * 64; n0 = (sub & 3) * 256; N = 1024; ldt = 1024; W = in_I_GWOUT + (size_t)j * 1024 * 1024; dst = wgout_ + (size_t)j * 1024 * 1024; } \
                else if ((r_ -= 128) < 96) { k0 = (r_ / 6) * 64; n0 = (r_ % 6) * 256; N = 1536; ldt = 1024; W = in_I_AWIN; dst = wain_; } \
                else if ((r_ -= 96) < 64) { k0 = (r_ >> 2) * 64; n0 = (r_ & 3) * 256; N = 1024; ldt = 1024; W = in_I_AWOUT; dst = waout_; } \
                else if ((r_ -= 64) < 64) { k0 = (r_ >> 2) * 64; n0 = (r_ & 3) * 256; N = 1024; ldt = 1024; W = in_I_PWIN; dst = wpin_; } \
                else { r_ -= 64; const int g = r_ >> 2; k0 = (r_ & 3) * 64; n0 = 0; N = 256; ldt = 256; W = in_I_PWG + (size_t)g * 256 * 256; dst = wpgrp_ + (size_t)g * 256 * 256; } } } while (0)
#define P0_LOAD() do { const float* wp_ = W + (size_t)(k0 + wave * 8) * N + n0 + c4 * 4; _Pragma("unroll") for (int s_ = 0; s_ < 8; ++s_) ld[s_] = *(const f32x4*)(wp_ + (size_t)s_ * N); } while (0)
        int it = F.bx, buf = 0;
        if (it < NT_ALL) { P0_DECODE(it); P0_LOAD(); }
#pragma nounroll
        for (; it < NT_ALL; it += F.G) {
            LAS unsigned char* Lt = lds + buf * 32768;
#pragma unroll
            for (int j = 0; j < 4; ++j) { const int n = c4 * 4 + j;
                u32x4 o; o.x = cvt_pk_bf16(ld[0][j], ld[1][j]); o.y = cvt_pk_bf16(ld[2][j], ld[3][j]); o.z = cvt_pk_bf16(ld[4][j], ld[5][j]); o.w = cvt_pk_bf16(ld[6][j], ld[7][j]);
                *(LAS u32x4*)(Lt + n * 128 + ((wave ^ ((n >> 2) & 7)) << 4)) = o; }
            bf16_t* const cdst = dst; const int ck0 = k0, cn0 = n0, cldt = ldt, cgu = gu;
            __syncthreads();
            if (it + F.G < NT_ALL) { P0_DECODE(it + F.G); P0_LOAD(); }
#pragma unroll
            for (int s_ = 0; s_ < 4; ++s_) { const int n = s_ * 64 + rr; const u32x4 o = *(const LAS u32x4*)(Lt + n * 128 + ((ch ^ ((n >> 2) & 7)) << 4));
                const int nn = cn0 + n; const size_t row = cgu ? (size_t)((nn >> 7) * 256 + (nn & 127)) : (size_t)nn;
                *(u32x4*)(cdst + row * cldt + ck0 + ch * 8) = o; }
            buf ^= 1;
        }
#undef P0_DECODE
#undef P0_LOAD
    }
    __syncthreads();
    for (int i4 = F.bx * NTHR + tid; i4 < 2 * 8 * 128 * 128 / 4; i4 += F.G * NTHR) { const f32x4 v = *(const f32x4*)(in_I_GSW + (size_t)i4 * 4);
        u32x2 o; o.x = cvt_pk_bf16(v[0], v[1]); o.y = cvt_pk_bf16(v[2], v[3]); *(u32x2*)(wsw_ + (size_t)i4 * 4) = o; }
}

template <int R>
__device__ __forceinline__ void norm_rows(const int r0, const bool isctx, const int lane, const int layer, const int which, const int comb, const int dry, float* vst,
                                          const float* xsrc, float* xdst, const float* modv_, const float* ng, const int* slot_, const bf16_t* YEXP_, bf16_t* H_, float* aff_, int* slotw_, const LAS unsigned char* rwl) {
    const int rc0 = r0 - T; const int b = isctx ? (rc0 >> 8) : (r0 >> 11); const int mrow = isctx ? 8 : b;
    f32x4 v[R][4];
#pragma unroll
    for (int q = 0; q < R; ++q)
#pragma unroll
        for (int j = 0; j < 4; ++j) v[q][j] = *(const f32x4*)(xsrc + (size_t)q * D + lane * 4 + 256 * j);
#ifndef NO_NR_COMB
    if (comb >= 0) {
        int sl[R];
#pragma unroll
        for (int q = 0; q < R; ++q) sl[q] = slot_[(size_t)(r0 + q) * 16 + (lane & 15)];
        f32x4 a[R][4];
#pragma unroll
        for (int q = 0; q < R; ++q)
#pragma unroll
            for (int j = 0; j < 4; ++j) a[q][j] = (f32x4){0.f, 0.f, 0.f, 0.f};
#pragma nounroll
        for (int e = 0; e < 16; ++e) {
            u32x2 w[R][4];
#pragma unroll
            for (int q = 0; q < R; ++q) {
                const int s = __builtin_amdgcn_readlane(sl[q], e);
                if (s >= 0) {
                    const int tile = isctx ? 128 + e : e * 8 + b, rin = isctx ? (((rc0 + q) >> 8) * 32 + s) : s;
                    const bf16_t* yp = YEXP_ + ((size_t)tile * 256 + rin) * D + lane * 4;
#pragma unroll
                    for (int j = 0; j < 4; ++j) w[q][j] = *(const u32x2*)(yp + 256 * j);
                } else {
#pragma unroll
                    for (int j = 0; j < 4; ++j) w[q][j] = (u32x2){0u, 0u};
                }
            }
#pragma unroll
            for (int q = 0; q < R; ++q)
#pragma unroll
                for (int j = 0; j < 4; ++j) { a[q][j][0] += bf_lo(w[q][j].x); a[q][j][1] += bf_hi(w[q][j].x); a[q][j][2] += bf_lo(w[q][j].y); a[q][j][3] += bf_hi(w[q][j].y); }
        }
        const float* g2 = modv_ + (size_t)(comb * 9 + mrow) * 6144 + 5 * 1024 + lane * 4;
#pragma unroll
        for (int j = 0; j < 4; ++j) { const f32x4 gg = *(const f32x4*)(g2 + 256 * j);
#pragma unroll
            for (int q = 0; q < R; ++q) { v[q][j] = v[q][j] + gg * a[q][j]; if (!dry) *(f32x4*)(xdst + (size_t)q * D + lane * 4 + 256 * j) = v[q][j]; } }
    }
#endif
    if (which == 0) return;
    float rstd[R];
#pragma unroll
    for (int q = 0; q < R; ++q) { float ss = 0.f;
#pragma unroll
        for (int j = 0; j < 4; ++j) ss += (v[q][j][0] * v[q][j][0] + v[q][j][1] * v[q][j][1]) + (v[q][j][2] * v[q][j][2] + v[q][j][3] * v[q][j][3]);
        rstd[q] = ss; }
#pragma unroll
    for (int q = 0; q < R; ++q) rstd[q] = rsqrtf(wave_sum(rstd[q]) * (1.f / D) + EPS);
    const float* mv = modv_ + (size_t)(layer * 9 + mrow) * 6144 + (which == 2 ? 3 * 1024 : 0) + lane * 4;
#pragma unroll
    for (int j = 0; j < 4; ++j) { const f32x4 g = *(const f32x4*)(ng + lane * 4 + 256 * j), sh = *(const f32x4*)(mv + 256 * j), sc = *(const f32x4*)(mv + 1024 + 256 * j);
#pragma unroll
        for (int q = 0; q < R; ++q) { v[q][j] = (v[q][j] * rstd[q] * g) * (sc + 1.f) + sh;
            u32x2 o; o.x = cvt_pk_bf16(v[q][j][0], v[q][j][1]); o.y = cvt_pk_bf16(v[q][j][2], v[q][j][3]); *(u32x2*)(H_ + (size_t)(r0 + q) * D + lane * 4 + 256 * j) = o; } }
#ifndef NO_NR_ROUTER
    if (which == 2 && dry != 2) {
        float p[R][16];
#pragma unroll
        for (int q = 0; q < R; ++q)
#pragma unroll
            for (int e = 0; e < 16; ++e) p[q][e] = 0.f;
#pragma unroll
        for (int j = 0; j < 4; ++j)
#pragma unroll
            for (int i = 0; i < 4; ++i) { const int col = lane * 4 + 256 * j + i; const LAS unsigned char* rp = rwl + col * 64 + (col >> 2) * 16;
                const f32x4 w0 = *(const LAS f32x4*)(rp), w1 = *(const LAS f32x4*)(rp + 16), w2 = *(const LAS f32x4*)(rp + 32), w3 = *(const LAS f32x4*)(rp + 48);
#pragma unroll
                for (int q = 0; q < R; ++q) { const float hv = v[q][j][i];
                    p[q][0] += hv * w0[0]; p[q][1] += hv * w0[1]; p[q][2] += hv * w0[2]; p[q][3] += hv * w0[3]; p[q][4] += hv * w1[0]; p[q][5] += hv * w1[1]; p[q][6] += hv * w1[2]; p[q][7] += hv * w1[3];
                    p[q][8] += hv * w2[0]; p[q][9] += hv * w2[1]; p[q][10] += hv * w2[2]; p[q][11] += hv * w2[3]; p[q][12] += hv * w3[0]; p[q][13] += hv * w3[1]; p[q][14] += hv * w3[2]; p[q][15] += hv * w3[3]; }
                __builtin_amdgcn_sched_barrier(0); }
#pragma unroll
        for (int q = 0; q < R; ++q)
#pragma unroll
            for (int e = 0; e < 16; ++e) asm volatile("" : "+v"(p[q][e]));
#pragma unroll
        for (int q = 0; q < R; ++q) {
            const bool b5 = (lane & 32) != 0, b4 = (lane & 16) != 0, b3 = (lane & 8) != 0, b2 = (lane & 4) != 0;
            float k8[8], k4[4], k2[2];
#pragma unroll
            for (int e = 0; e < 8; ++e) { const float send = b5 ? p[q][e] : p[q][e + 8]; k8[e] = (b5 ? p[q][e + 8] : p[q][e]) + xor32(send, b5); }
#pragma unroll
            for (int e = 0; e < 4; ++e) { const float send = b4 ? k8[e] : k8[e + 4]; k4[e] = (b4 ? k8[e + 4] : k8[e]) + swz_xor<16>(send); }
#pragma unroll
            for (int e = 0; e < 2; ++e) { const float send = b3 ? k4[e] : k4[e + 2]; k2[e] = (b3 ? k4[e + 2] : k4[e]) + swz_xor<8>(send); }
            float lg; { const float send = b2 ? k2[0] : k2[1]; lg = (b2 ? k2[1] : k2[0]) + swz_xor<4>(send); }
            lg += swz_xor<2>(lg); lg += swz_xor<1>(lg);
            const float mx = wave_max(lg), ex = __expf(lg - mx), sum = wave_sum(ex) * 0.25f;
            const int eid = (lane >> 2) & 15;
            if ((lane & 3) == 0) aff_[(size_t)(r0 + q) * 16 + eid] = ex / sum;
            if (lane < 16) slotw_[(size_t)(r0 + q) * 16 + lane] = -1;
        }
    }
#endif
}
__device__ __forceinline__ void norm_phase(const Fr& F, LAS unsigned char* lds, int layer, int which, int nrows, int comb, const float* xlat, const float* xctx, float* xlat_d, float* xctx_d, int dry = 0, bool zero_vst = false) {
    const int tid = opaque_tid(), lane = tid & 63, wave = __builtin_amdgcn_readfirstlane(tid >> 6), gw = F.bx * NWAVES + wave, NGW = F.G * NWAVES;
    unsigned char* const ws_ = F.ws();
    float* const modv_ = (float*)(ws_ + WS_MODV); float* const aff_ = (float*)(ws_ + WS_AFF); int* const slot_ = (int*)(ws_ + WS_SLOT);
    bf16_t* const H_ = (bf16_t*)(ws_ + WS_H); bf16_t* const YEXP_ = (bf16_t*)(ws_ + WS_YEXP);
    float* const vst = zero_vst ? (float*)(ws_ + WS_VST) : nullptr;
    LAS unsigned char* rwl = lds;
    if (which == 2) {
        const float* rw = F.in(I_RW) + (size_t)layer * 1024 * 16;
        for (int idx = tid; idx < 4096; idx += NTHR) { const int col = idx >> 2, e4 = idx & 3; *(LAS f32x4*)(rwl + col * 64 + (col >> 2) * 16 + e4 * 16) = *(const f32x4*)(rw + col * 16 + e4 * 4); }
        __syncthreads();
    }
    const float* ng = F.in(which == 2 ? I_N2G : I_N1G) + (size_t)layer * 1024;
#pragma nounroll
    for (int g4 = gw; g4 < T / 4; g4 += NGW) { const int r0 = g4 * 4;
        norm_rows<4>(r0, false, lane, layer, which, comb, dry, vst, xlat + (size_t)r0 * D, xlat_d + (size_t)r0 * D, modv_, ng, slot_, YEXP_, H_, aff_, slot_, rwl); }
    if (nrows > T) {
#pragma nounroll
        for (int r = T + gw; r < nrows; r += NGW)
            norm_rows<1>(r, true, lane, layer, which, comb, dry, vst, xctx + (size_t)(r - T) * D, xctx_d + (size_t)(r - T) * D, modv_, ng, slot_, YEXP_, H_, aff_, slot_, rwl);
    }
}

__device__ __forceinline__ void topk_phase(const Fr& F, LAS unsigned char* lds, bool with_ctx) {
    const int tid = opaque_tid();
    unsigned char* const ws_ = F.ws();
    float* const aff_ = (float*)(ws_ + WS_AFF); int* const slot_ = (int*)(ws_ + WS_SLOT); float* const gate_ = (float*)(ws_ + WS_GATE);
    int* const idx_ = (int*)(ws_ + WS_IDX);
    LAS unsigned* vals = (LAS unsigned*)lds;
    LAS int* hist = (LAS int*)(lds + 8192);
    LAS int* suf = (LAS int*)(lds + 9216);
    LAS int* scan = (LAS int*)(lds + 12288);
    volatile LAS unsigned* sv = (volatile LAS unsigned*)(lds + 16384);
    const int nunits = with_ctx ? 256 : 128;
    for (int u = F.bx; u < nunits; u += F.G) {
        const bool isctx = u >= 128; const int uu = isctx ? u - 128 : u, e = uu >> 3, b = uu & 7;
        const int N = isctx ? CL : SEQ, cap = isctx ? CCAP : CAP, row0 = isctx ? T + b * CL : b * SEQ;
        const int tile = isctx ? 128 + e : uu, rbase = isctx ? b * 32 : 0;
        unsigned v[4]; const bool act = tid * 4 < N;
#pragma unroll
        for (int k = 0; k < 4; ++k) v[k] = act ? __float_as_uint(aff_[(size_t)(row0 + tid * 4 + k) * 16 + e]) : 0u;
        if (tid == 0) { sv[0] = 0u; sv[1] = (unsigned)cap; }
        unsigned prefix = 0u, mask = 0u; int need = cap;
#pragma nounroll
        for (int shift = 24; shift >= 0; shift -= 8) {
            if (tid < 256) hist[tid] = 0;
            __syncthreads();
            if (act) {
#pragma unroll
                for (int k = 0; k < 4; ++k) if ((v[k] & mask) == prefix) __hip_atomic_fetch_add(&hist[(v[k] >> shift) & 255u], 1, __ATOMIC_RELAXED, __HIP_MEMORY_SCOPE_WORKGROUP);
            }
            __syncthreads();
            if (tid < 256) { int sacc = 0; for (int d = 255; d >= tid; --d) sacc += hist[d]; suf[tid] = sacc; }
            if (tid == 0) suf[256] = 0;
            __syncthreads();
            if (tid < 256) { const int s0 = suf[tid], s1 = suf[tid + 1]; if (s0 >= need && s1 < need) { sv[0] = prefix | ((unsigned)tid << shift); sv[1] = (unsigned)(need - s1); } }
            __syncthreads();
            prefix = sv[0]; need = (int)sv[1]; mask |= 255u << shift;
        }
        int cg = 0, ce = 0;
#pragma unroll
        for (int k = 0; k < 4; ++k) { cg += (act && v[k] > prefix) ? 1 : 0; ce += (act && v[k] == prefix) ? 1 : 0; }
        int cur = 0; scan[tid] = cg | (ce << 16);
        __syncthreads();
#pragma nounroll
        for (int off = 1; off < NTHR; off <<= 1) {
            const int x = scan[cur * NTHR + tid] + (tid >= off ? scan[cur * NTHR + tid - off] : 0);
            scan[(cur ^ 1) * NTHR + tid] = x; cur ^= 1;
            __syncthreads();
        }
        const int incl = scan[cur * NTHR + tid]; int gb = (incl & 0xffff) - cg, eb = (incl >> 16) - ce;
        if (act) {
#pragma unroll
            for (int k = 0; k < 4; ++k) {
                const bool isg = v[k] > prefix, ise = v[k] == prefix;
                if (isg || (ise && eb < need)) { const int sl = gb + (eb < need ? eb : need); const int row = row0 + tid * 4 + k;
                    idx_[(size_t)tile * 256 + rbase + sl] = row; gate_[(size_t)tile * 256 + rbase + sl] = __uint_as_float(v[k]); slot_[(size_t)row * 16 + e] = sl; }
                gb += isg ? 1 : 0; eb += ise ? 1 : 0;
            }
        }
        __syncthreads();
    }
}

template <int OFF> __device__ __forceinline__ s16x4 sp_tr_read(int vb) {
    s16x4 r; asm volatile("ds_read_b64_tr_b16 %0, %1 offset:%2" : "=&v"(r) : "v"(vb), "i"(OFF) : "memory"); return r;
}
template <int KS> __device__ __forceinline__ void sp_kstep(f32x16& acc0, f32x16& acc1, const LAS bf16_t* Ap, int vb) {
    constexpr int LDB2 = 320;
    const bf16x8 a = *(const LAS bf16x8*)(Ap + KS * 16);
    const s16x4 l0 = sp_tr_read<(16 * KS) * LDB2>(vb), h0 = sp_tr_read<(16 * KS + 4) * LDB2>(vb);
    const s16x4 l1 = sp_tr_read<(16 * KS) * LDB2 + 64>(vb), h1 = sp_tr_read<(16 * KS + 4) * LDB2 + 64>(vb);
    asm volatile("s_waitcnt lgkmcnt(0)" ::: "memory"); __builtin_amdgcn_sched_barrier(0);
    const bf16x8 b0 = (bf16x8){l0[0], l0[1], l0[2], l0[3], h0[0], h0[1], h0[2], h0[3]};
    const bf16x8 b1 = (bf16x8){l1[0], l1[1], l1[2], l1[3], h1[0], h1[1], h1[2], h1[3]};
    acc0 = __builtin_amdgcn_mfma_f32_32x32x16_bf16(b0, a, acc0, 0, 0, 0);
    acc1 = __builtin_amdgcn_mfma_f32_32x32x16_bf16(b1, a, acc1, 0, 0, 0);
}
__device__ __forceinline__ void spatial_phase(const Fr& F, LAS unsigned char* lds, int j, int nchunks) {
    const int tid = opaque_tid(), lane = tid & 63, wave = __builtin_amdgcn_readfirstlane(tid >> 6);
    unsigned char* const ws_ = F.ws();
    const bf16_t* const wsw_ = (const bf16_t*)(ws_ + WS_WSW); const bf16_t* const S1_ = (const bf16_t*)(ws_ + WS_S1); bf16_t* const S2_ = (bf16_t*)(ws_ + WS_S2);
    const float* const vst_ = (const float*)(ws_ + WS_VST);
    constexpr int LDA = 136, LDB = 160;
    LAS bf16_t* As = (LAS bf16_t*)(lds + 1024);
    LAS bf16_t* Bs = (LAS bf16_t*)(lds + 1024 + 128 * LDA * 2);
    const float* vg = F.in(I_GVG) + (size_t)j * 1024; const float* sb = F.in(I_GSB) + (size_t)j * 8 * 128;
    const bf16_t* sw = wsw_ + (size_t)j * 8 * 128 * 128;
    const int r32 = lane & 31, hi = lane >> 5;
    const int pw = (wave >> 1) * 32, dw = (wave & 1) * 64;
    const LAS bf16_t* Ap = As + (pw + r32) * LDA + hi * 8;
    const int vb = (int)(unsigned)(uintptr_t)Bs + (8 * hi + ((lane & 15) >> 2)) * (LDB * 2) + (dw + 16 * ((lane >> 4) & 1) + 4 * (lane & 3)) * 2;
    const int p = pw + r32, c0 = dw + 4 * hi, nunits = nchunks * 8;
    u32x4 sa[4], wv[4]; u32x2 un[2][4]; f32x2 st[4];
#define SP_LOAD(U) do { const int _r0 = ((U) >> 3) * 128, _g = (U) & 7; _Pragma("unroll") for (int i = 0; i < 4; ++i) { const int id = tid + NTHR * i; \
            sa[i] = *(const u32x4*)(sw + (size_t)_g * 128 * 128 + (id >> 4) * 128 + (id & 15) * 8); \
            wv[i] = *(const u32x4*)(S1_ + (size_t)(_r0 + (id >> 4)) * 2048 + 1024 + _g * 128 + (id & 15) * 8); \
            st[i] = *(const f32x2*)(vst_ + ((size_t)(_r0 + (id >> 4)) * 16 + (id & 15)) * 2); } \
            _Pragma("unroll") for (int t = 0; t < 4; ++t) { un[0][t] = *(const u32x2*)(S1_ + (size_t)(_r0 + p) * 2048 + _g * 128 + c0 + 8 * t); un[1][t] = *(const u32x2*)(S1_ + (size_t)(_r0 + p) * 2048 + _g * 128 + c0 + 32 + 8 * t); } } while (0)
    int U = F.vcu;
    if (U < nunits) SP_LOAD(U);
#pragma nounroll
    for (; U < nunits; U += F.G) {
        const int r0 = (U >> 3) * 128, g = U & 7;
#pragma unroll
        for (int i = 0; i < 4; ++i) { const int id = tid + NTHR * i; *(LAS u32x4*)(As + (id >> 4) * LDA + (id & 15) * 8) = sa[i]; }
        { const int dc = tid & 15; const f32x4 g0 = *(const f32x4*)(vg + g * 128 + dc * 8), g1 = *(const f32x4*)(vg + g * 128 + dc * 8 + 4);
#pragma unroll
          for (int i = 0; i < 4; ++i) { const int id = tid + NTHR * i, q = id >> 4;
            float s1 = st[i].x, s2 = st[i].y;
            s1 += swz_xor<1>(s1); s2 += swz_xor<1>(s2); s1 += swz_xor<2>(s1); s2 += swz_xor<2>(s2); s1 += swz_xor<4>(s1); s2 += swz_xor<4>(s2); s1 += swz_xor<8>(s1); s2 += swz_xor<8>(s2);
            const float mean = s1 * (1.f / 1024.f), rstd = rsqrtf(fmaxf(s2 * (1.f / 1024.f) - mean * mean, 0.f) + EPS);
            float x[8];
#pragma unroll
            for (int k = 0; k < 4; ++k) { x[2 * k] = (bf_lo(wv[i][k]) - mean) * rstd; x[2 * k + 1] = (bf_hi(wv[i][k]) - mean) * rstd; }
            u32x4 o; o.x = cvt_pk_bf16(x[0] * g0[0], x[1] * g0[1]); o.y = cvt_pk_bf16(x[2] * g0[2], x[3] * g0[3]); o.z = cvt_pk_bf16(x[4] * g1[0], x[5] * g1[1]); o.w = cvt_pk_bf16(x[6] * g1[2], x[7] * g1[3]);
            *(LAS u32x4*)(Bs + q * LDB + dc * 8) = o; } }
        u32x2 uu[2][4];
#pragma unroll
        for (int t = 0; t < 4; ++t) { uu[0][t] = un[0][t]; uu[1][t] = un[1][t]; }
        const float bias = sb[g * 128 + p];
        __syncthreads();
        if (U + F.G < nunits) SP_LOAD(U + F.G);
        f32x16 acc0 = {}, acc1 = {};
        sp_kstep<0>(acc0, acc1, Ap, vb); sp_kstep<1>(acc0, acc1, Ap, vb); sp_kstep<2>(acc0, acc1, Ap, vb); sp_kstep<3>(acc0, acc1, Ap, vb);
        sp_kstep<4>(acc0, acc1, Ap, vb); sp_kstep<5>(acc0, acc1, Ap, vb); sp_kstep<6>(acc0, acc1, Ap, vb); sp_kstep<7>(acc0, acc1, Ap, vb);
        const size_t ro = (size_t)(r0 + p);
#pragma unroll
        for (int t = 0; t < 4; ++t) {
            u32x2 o0, o1;
            o0.x = cvt_pk_bf16((acc0[4 * t] + bias) * bf_lo(uu[0][t].x), (acc0[4 * t + 1] + bias) * bf_hi(uu[0][t].x)); o0.y = cvt_pk_bf16((acc0[4 * t + 2] + bias) * bf_lo(uu[0][t].y), (acc0[4 * t + 3] + bias) * bf_hi(uu[0][t].y));
            o1.x = cvt_pk_bf16((acc1[4 * t] + bias) * bf_lo(uu[1][t].x), (acc1[4 * t + 1] + bias) * bf_hi(uu[1][t].x)); o1.y = cvt_pk_bf16((acc1[4 * t + 2] + bias) * bf_lo(uu[1][t].y), (acc1[4 * t + 3] + bias) * bf_hi(uu[1][t].y));
            *(u32x2*)(S2_ + ro * D + g * 128 + c0 + 8 * t) = o0; *(u32x2*)(S2_ + ro * D + g * 128 + c0 + 32 + 8 * t) = o1; }
        __syncthreads();
    }
#undef SP_LOAD
}

__device__ __forceinline__ void qknorm_phase(const Fr& F) {
    const int tid = opaque_tid(), lane = tid & 63, wave = __builtin_amdgcn_readfirstlane(tid >> 6), gw = F.bx * NWAVES + wave, NGW = F.G * NWAVES;
    unsigned char* const ws_ = F.ws();
    const bf16_t* const S1_ = (const bf16_t*)(ws_ + WS_S1); bf16_t* const QB_ = (bf16_t*)(ws_ + WS_QB); bf16_t* const KB_ = (bf16_t*)(ws_ + WS_KB);
    const float* qg = F.in(I_AQG); const float* kg = F.in(I_AKG);
    const int hsel = lane >> 5, l5 = lane & 31;
    const f32x2 qg0 = *(const f32x2*)(qg + 2 * l5), qg1 = *(const f32x2*)(qg + 64 + 2 * l5), kg0 = *(const f32x2*)(kg + 2 * l5), kg1 = *(const f32x2*)(kg + 64 + 2 * l5);
    const float inv0 = exp2f(-(float)((2 * l5) & 31) * (13.287712379549449f / 32.f)), inv1 = exp2f(-(float)((2 * l5 + 1) & 31) * (13.287712379549449f / 32.f));
#pragma nounroll
    for (int g2 = gw; g2 < T / 2; g2 += NGW) {
        const int r0 = g2 * 2, b = r0 >> 11;
        unsigned u0[2][5], u1[2][5];
#pragma unroll
        for (int q = 0; q < 2; ++q)
#pragma unroll
            for (int ps = 0; ps < 5; ++ps) { const int hh = 2 * ps + hsel; const bf16_t* src = S1_ + (size_t)(r0 + q) * 2048 + (hh < 8 ? hh * 128 : 1024 + (hh - 8) * 128) + 2 * l5;
                u0[q][ps] = *(const unsigned*)src; u1[q][ps] = *(const unsigned*)(src + 64); }
#pragma unroll
        for (int q = 0; q < 2; ++q) {
            const int s = (r0 + q) & (SEQ - 1); const float pos = (float)(l5 < 16 ? (s >> 6) : (s & 63));
            float c0, s0, c1, s1; __sincosf(pos * inv0, &s0, &c0); __sincosf(pos * inv1, &s1, &c1);
            { c0 = cosf(pos * inv0); s0 = sinf(pos * inv0); c1 = cosf(pos * inv1); s1 = sinf(pos * inv1); }
#pragma unroll
            for (int ps = 0; ps < 5; ++ps) { const int hh = 2 * ps + hsel; const bool isk = ps == 4;
                float a0 = bf_lo(u0[q][ps]), a1 = bf_hi(u0[q][ps]), e0 = bf_lo(u1[q][ps]), e1 = bf_hi(u1[q][ps]);
                const float rs = rsqrtf(half_sum((a0 * a0 + a1 * a1) + (e0 * e0 + e1 * e1)) * (1.f / 128.f) + EPS);
                const f32x2 ga = isk ? kg0 : qg0, gb = isk ? kg1 : qg1;
                a0 *= rs * ga.x; a1 *= rs * ga.y; e0 *= rs * gb.x; e1 *= rs * gb.y;
                const float o10 = a0 * c0 - e0 * s0, o11 = a1 * c1 - e1 * s1, o20 = a0 * s0 + e0 * c0, o21 = a1 * s1 + e1 * c1;
                bf16_t* dst = isk ? KB_ + ((size_t)(b * 2 + (hh - 8)) * SKV + CL + s) * 128 + 2 * l5 : QB_ + (size_t)(r0 + q) * D + hh * 128 + 2 * l5;
                *(unsigned*)dst = cvt_pk_bf16(o10, o11); *(unsigned*)(dst + 64) = cvt_pk_bf16(o20, o21); }
        }
    }
#pragma nounroll
    for (int rc = gw; rc < TC; rc += NGW) {
        const int b = rc >> 8, s = rc & (CL - 1);
        const bf16_t* src = S1_ + (size_t)(T + rc) * 2048 + 1024 + hsel * 128 + 2 * l5;
        const unsigned u0 = *(const unsigned*)src, u1 = *(const unsigned*)(src + 64);
        float a0 = bf_lo(u0), a1 = bf_hi(u0), e0 = bf_lo(u1), e1 = bf_hi(u1);
        const float rs = rsqrtf(half_sum((a0 * a0 + a1 * a1) + (e0 * e0 + e1 * e1)) * (1.f / 128.f) + EPS);
        bf16_t* dst = KB_ + ((size_t)(b * 2 + hsel) * SKV + s) * 128 + 2 * l5;
        *(unsigned*)dst = cvt_pk_bf16(a0 * rs * kg0.x, a1 * rs * kg0.y); *(unsigned*)(dst + 64) = cvt_pk_bf16(e0 * rs * kg1.x, e1 * rs * kg1.y);
    }
}

template <int W> __device__ __forceinline__ void pool_item(const bf16_t* zb  , int s, bf16_t* dst) {
    constexpr int half = W / 2;
    u32x4 w[W];
#pragma unroll
    for (int k = 0; k < W; ++k) { int t = s - half + k; t = t < 0 ? 0 : (t > SEQ - 1 ? SEQ - 1 : t); w[k] = *(const u32x4*)(zb + (size_t)t * 2048); }
    float acc[8];
#pragma unroll
    for (int c = 0; c < 8; ++c) acc[c] = 0.f;
#pragma unroll
    for (int k = 0; k < W; ++k) { const int t = s - half + k; const float m = (t >= 0 && t < SEQ) ? 1.f : 0.f;
#pragma unroll
        for (int c = 0; c < 4; ++c) { acc[2 * c] += m * bf_lo(w[k][c]); acc[2 * c + 1] += m * bf_hi(w[k][c]); } }
    const int lo = s - half < 0 ? 0 : s - half, hi = s + half - 1 > SEQ - 1 ? SEQ - 1 : s + half - 1; const float ic = 1.f / (float)(hi - lo + 1);
    const u32x4 zc = w[half];
    float o[8];
#pragma unroll
    for (int c = 0; c < 4; ++c) { o[2 * c] = acc[2 * c] * ic - bf_lo(zc[c]); o[2 * c + 1] = acc[2 * c + 1] * ic - bf_hi(zc[c]); }
    u32x4 ov; ov.x = cvt_pk_bf16(o[0], o[1]); ov.y = cvt_pk_bf16(o[2], o[3]); ov.z = cvt_pk_bf16(o[4], o[5]); ov.w = cvt_pk_bf16(o[6], o[7]);
    *(u32x4*)dst = ov;
}
__device__ __forceinline__ void pool_phase(const Fr& F) {
    const int tid = opaque_tid(), lane = tid & 63, wave = __builtin_amdgcn_readfirstlane(tid >> 6);
    unsigned char* const ws_ = F.ws();
    const bf16_t* const S1_ = (const bf16_t*)(ws_ + WS_S1); bf16_t* const S2_ = (bf16_t*)(ws_ + WS_S2);
    const int gi = wave & 3, c8 = gi * 32 + (lane & 31), rsub = (wave >> 2) * 2 + (lane >> 5);
#pragma nounroll
    for (int r4 = F.bx; r4 < T / 4; r4 += F.G) {
        const int r = r4 * 4 + rsub, s = r & (SEQ - 1);
        const bf16_t* zb = S1_ + (size_t)(r - s) * 2048 + c8 * 8; bf16_t* dst = S2_ + (size_t)r * D + c8 * 8;
        if (gi == 0) pool_item<2>(zb, s, dst); else if (gi == 1) pool_item<4>(zb, s, dst); else if (gi == 2) pool_item<8>(zb, s, dst); else pool_item<16>(zb, s, dst);
    }
}

__global__ void __launch_bounds__(NTHR, 2) fwd_kernel(KArgs args) {
    extern __shared__ __attribute__((aligned(16))) unsigned char lds_raw[];
    LAS unsigned char* lds = (LAS unsigned char*)lds_raw;
    volatile LAS unsigned* MISC = (volatile LAS unsigned*)(lds + MISC_OFF);
    Fr F;
    F.PT = (volatile LAS unsigned long long*)(lds + MISC_OFF + 256);
    F.G = gridDim.x; F.bx = blockIdx.x; F.vcu = (F.G % 8 == 0) ? (F.bx % 8) * (F.G / 8) + F.bx / 8 : F.bx;
    { const int t0 = threadIdx.x;
      if (t0 < 64) MISC[t0] = 0u;
      if (t0 < 24) F.PT[t0] = (unsigned long long)args.in[t0];
      if (t0 == 24) F.PT[24] = (unsigned long long)args.out;
      if (t0 == 25) F.PT[25] = (unsigned long long)args.ws; }
    __syncthreads();
    XcdBarrier bar = xcd_barrier_post((unsigned*)(F.ws() + WS_CTL), MISC + 8);
    const int lo = args.ph_lo, hi = args.ph_hi;
    int p = 0;
#define RUN(...) RUNC(31, __VA_ARGS__)
#define RUNC(cls, ...) do { if (lo <= p && p < hi) { _Pragma("nounroll") for (int rep_ = 0; rep_ < 1 + (int)((REPEAT_MASK >> (cls)) & 1u); ++rep_) { __VA_ARGS__; if (REPEAT_MASK) __syncthreads(); } if (p + 1 < hi) xcd_barrier(bar); } ++p; } while (0)

#ifndef NO_P0
    RUNC(0, p0_phase(F, lds, 0));
    RUN({
        float* xo = F.out(); float* xc = WSP(F, float, WS_XC);
        norm_phase(F, lds, 0, 1, TT, -1, F.in(I_X), F.in(I_CTX), xo, xc, 0, true);
        __syncthreads();
        p0_phase(F, lds, 1);
    });
#endif
#pragma nounroll
    for (int L = 0; L < 4; ++L) {
        const int kind = L % 3, jm = L / 3;
        const bool with_ctx = (L == 0);
        if (L > 0) RUNC(1, {
            float* xo = F.out(); float* xc = WSP(F, float, WS_XC);
#ifndef NO_NORM
            norm_phase(F, lds, L, 1, (L <= 1) ? TT : T, L - 1, (L == 0) ? F.in(I_X) : xo, (L == 0) ? F.in(I_CTX) : xc, xo, xc, (REPEAT_MASK >> 1) & 1u ? (rep_ == 0) : 0, kind == 0);
#endif
        });
        RUNC(2, {
            unsigned char* ws = F.ws();
            pg8::SchedDense S; S.A = (bf16_t*)(ws + WS_H); S.G = F.G; S.c = F.bx; S.a_pn_stride = 0; S.a_pm_stride = 256 * D; S.b_pn_stride = 256 * D; S.extra = 0;
            pg8::EpiA E; E.O = (bf16_t*)(ws + WS_S1); E.ldc = 2048; E.act = 0; E.VB = nullptr; E.stats = nullptr;
            if (kind == 0) { S.Bt = (bf16_t*)(ws + WS_WGIN) + (size_t)jm * 2048 * 1024; S.nM = with_ctx ? 72 : 64; S.nN = 8; E.act = 1; E.stats = (float*)(ws + WS_VST); }
            else if (kind == 1) { S.Bt = (bf16_t*)(ws + WS_WAIN); S.nM = 64; S.nN = 6; S.extra = 16; E.VB = (bf16_t*)(ws + WS_VB); }
            else { S.Bt = (bf16_t*)(ws + WS_WPIN); S.nM = 64; S.nN = 4; }
            S.nwg = S.nM * S.nN;
            #ifndef NO_GA
            pg8::gemm_phase<pg8::EpiA, pg8::SchedDense>(lds, D, D, D, S, E);
#endif
        });
        if (kind == 0) {
#ifndef NO_SPAT
            RUNC(3, spatial_phase(F, lds, jm, with_ctx ? 144 : 128));
#endif
        }
        else if (kind == 1) {
#ifndef NO_QKN
            RUNC(4, qknorm_phase(F));
#endif
            RUNC(5, {
                unsigned char* ws = F.ws();
                const bf16_t* QB = (const bf16_t*)(ws + WS_QB); const bf16_t* KB = (const bf16_t*)(ws + WS_KB); const bf16_t* VB = (const bf16_t*)(ws + WS_VB); bf16_t* S2 = (bf16_t*)(ws + WS_S2);
                for (int i = 0; i * F.G + F.vcu < 512; ++i) { const int Lu = i * F.G + F.vcu, bk = Lu >> 5, w = Lu & 31, b = bk >> 1, kvh = bk & 1, h = kvh * 4 + (w >> 3), qb = w & 7;
#ifndef NO_ATT
                    att::attn_body<D, D>(QB + ((size_t)(b * SEQ + qb * 256)) * D + h * 128, KB + (size_t)bk * SKV * 128, VB + (size_t)bk * SKV * 128,
                                         S2 + ((size_t)(b * SEQ + qb * 256)) * D + h * 128, SKV, lds);
#endif
                    __syncthreads(); }
            });
        } else {
#ifndef NO_POOL
            RUNC(6, pool_phase(F));
#endif
        }
        RUNC(7, {
            unsigned char* ws = F.ws();
            pg8::SchedDense S; S.A = (bf16_t*)(ws + WS_S2); S.G = F.G; S.c = F.bx; S.a_pm_stride = 256 * D; S.a_pn_stride = 0; S.b_pn_stride = 256 * D; S.extra = 0; S.nN = 4; S.nM = 64;
            pg8::EpiB E; E.xd_lat = F.out(); E.xd_ctx = (float*)(ws + WS_XC); E.xs_lat = (L == 0) ? F.in(I_X) : E.xd_lat; E.xs_ctx = (L == 0) ? F.in(I_CTX) : E.xd_ctx;
            E.gt = (const float*)(ws + WS_MODV) + (size_t)L * 9 * 6144 + 2 * 1024; E.colscale = nullptr; E.dry = (REPEAT_MASK >> 7) & 1u ? (rep_ == 0) : 0;
            int K = D, ldb = D;
            if (kind == 0) { S.Bt = (bf16_t*)(ws + WS_WGOUT) + (size_t)jm * 1024 * 1024; S.nM = with_ctx ? 72 : 64; }
            else if (kind == 1) { S.Bt = (bf16_t*)(ws + WS_WAOUT); }
            else { S.Bt = (bf16_t*)(ws + WS_WPGRP); S.a_pn_stride = 256; S.b_pn_stride = 256 * 256; K = 256; ldb = 256; E.colscale = F.in(I_PSC); }
            S.nwg = S.nM * S.nN;
            #ifndef NO_GB
            pg8::gemm_phase<pg8::EpiB, pg8::SchedDense>(lds, K, D, ldb, S, E);
#endif
        });
        RUNC(8, {
            float* xo = F.out(); float* xc = WSP(F, float, WS_XC);
#ifndef NO_NORM
            norm_phase(F, lds, L, 2, with_ctx ? TT : T, -1, xo, xc, xo, xc, ((REPEAT_MASK >> 13) & 1u) && rep_ == 0 ? 2 : 0);
#endif
        });
#ifndef NO_TOPK
        RUNC(9, topk_phase(F, lds, with_ctx));
#endif
        RUNC(10, {
            unsigned char* ws = F.ws();
            pg8::SchedMoE<true> S; S.A = (bf16_t*)(ws + WS_H); S.IDX = (const int*)(ws + WS_IDX); S.Bt = (bf16_t*)(ws + WS_WUP) + (size_t)L * 16 * 2048 * 1024; S.nbt = with_ctx ? 9 : 8; S.nn = 8; S.G = F.G; S.vcu = F.vcu;
            pg8::EpiC E; E.HID = (bf16_t*)(ws + WS_HID);
            #ifndef NO_GC
            pg8::gemm_phase<pg8::EpiC, pg8::SchedMoE<true>>(lds, D, D, D, S, E);
#endif
        });
        RUNC(11, {
            unsigned char* ws = F.ws();
            pg8::SchedMoE<false> S; S.A = (bf16_t*)(ws + WS_HID); S.IDX = nullptr; S.Bt = (bf16_t*)(ws + WS_WDN) + (size_t)L * 16 * 1024 * 1024; S.nbt = with_ctx ? 9 : 8; S.nn = 4; S.G = F.G; S.vcu = F.vcu;
            pg8::EpiD E; E.Y = (bf16_t*)(ws + WS_YEXP); E.gate = (const float*)(ws + WS_GATE);
            #ifndef NO_GD
            pg8::gemm_phase<pg8::EpiD, pg8::SchedMoE<false>>(lds, D, D, D, S, E);
#endif
        });
    }
    RUN({
        float* xo = F.out(); float* xc = WSP(F, float, WS_XC);
#ifndef NO_NORM
        norm_phase(F, lds, 3, 0, T, 3, xo, xc, xo, xc);
#endif
    });
#undef RUN
#undef RUNC
}

constexpr int N_PHASES = 1 + 8 + 9 + 8 + 8 + 1;

extern "C" void kernel_launch(void* const* d_in, const int* in_sizes, int n_in, void* d_out, int out_size, void* d_ws, size_t ws_size, hipStream_t stream) {
    static int grid = 0;
    if (grid == 0) {
        if (n_in != 24 || out_size != T * D || ws_size < WS_END) { fprintf(stderr, "kernel_launch: unexpected shapes (n_in %d out %d ws %zu need %zu)\n", n_in, out_size, ws_size, (size_t)WS_END); grid = -1; return; }
        int dev = 0, cus = 0;
        if (hipGetDevice(&dev) != hipSuccess || hipDeviceGetAttribute(&cus, hipDeviceAttributeMultiprocessorCount, dev) != hipSuccess) { grid = -1; return; }
        if (hipFuncSetAttribute((const void*)fwd_kernel, hipFuncAttributeMaxDynamicSharedMemorySize, LDS_BYTES) != hipSuccess) { fprintf(stderr, "kernel_launch: hipFuncSetAttribute failed\n"); grid = -1; return; }
        (void)hipGetLastError();
        grid = cus;
    }
    if (grid < 0) return;
    (void)hipMemsetAsync((char*)d_ws + WS_CTL, 0, CTL_BYTES, stream);
    KArgs a{};
    for (int i = 0; i < 24; ++i) a.in[i] = (const float*)d_in[i];
    a.out = (float*)d_out; a.ws = (unsigned char*)d_ws;
#if MK_PER_PHASE
    for (int k = 0; k < N_PHASES; ++k) { a.ph_lo = k; a.ph_hi = k + 1; hipLaunchKernelGGL(fwd_kernel, dim3(grid), dim3(NTHR), LDS_BYTES, stream, a); }
#else
    a.ph_lo = 0; a.ph_hi = N_PHASES;
    hipLaunchKernelGGL(fwd_kernel, dim3(grid), dim3(NTHR), LDS_BYTES, stream, a);
#endif
    const hipError_t le = hipPeekAtLastError();
    if (le != hipSuccess) fprintf(stderr, "kernel_launch: launch failed: %s\n", hipGetErrorName(le));
}
```

```cpp
#include <hip/hip_runtime.h>
#include <cstdio>
#include <cstdint>

#ifndef REPEAT_MASK
#define REPEAT_MASK 0u
#endif
#ifndef MK_PER_PHASE
#define MK_PER_PHASE 0
#endif

#define LAS __attribute__((address_space(3)))
#define GAS __attribute__((address_space(1)))
typedef unsigned short bf16_t;
typedef short bf16x8 __attribute__((ext_vector_type(8)));
typedef short s16x4 __attribute__((ext_vector_type(4)));
typedef float f32x2 __attribute__((ext_vector_type(2)));
typedef float f32x4 __attribute__((ext_vector_type(4)));
typedef float f32x16 __attribute__((ext_vector_type(16)));
typedef unsigned u32x2 __attribute__((ext_vector_type(2)));
typedef unsigned u32x4 __attribute__((ext_vector_type(4)));

constexpr int D = 1024, NB = 8, SEQ = 2048, T = NB * SEQ, CL = 256, TC = NB * CL, TT = T + TC, NE = 16, CAP = 256, CCAP = 32, NTILE = 144;
constexpr int SKV = CL + SEQ;
constexpr float EPS = 1e-6f;
constexpr int NWAVES = 8, NTHR = 512;

constexpr size_t al256(size_t x) { return (x + 255) / 256 * 256; }
constexpr size_t WS_CTL   = 0;
constexpr size_t CTL_BYTES = 65536;
constexpr size_t WS_MODV  = WS_CTL + CTL_BYTES;
constexpr size_t WS_AFF   = WS_MODV + al256((size_t)4 * 9 * 6144 * 4);
constexpr size_t WS_SLOT  = WS_AFF + (size_t)TT * 16 * 4;
constexpr size_t WS_GATE  = WS_SLOT + (size_t)TT * 16 * 4;
constexpr size_t WS_VST   = WS_GATE + (size_t)NTILE * 256 * 4;
constexpr size_t WS_WSW   = WS_VST + (size_t)TT * 16 * 2 * 4;
constexpr size_t WS_WGIN  = WS_WSW + (size_t)2 * 8 * 128 * 128 * 2;
constexpr size_t WS_WGOUT = WS_WGIN + (size_t)2 * 2048 * 1024 * 2;
constexpr size_t WS_WAIN  = WS_WGOUT + (size_t)2 * 1024 * 1024 * 2;
constexpr size_t WS_WAOUT = WS_WAIN + (size_t)1536 * 1024 * 2;
constexpr size_t WS_WPIN  = WS_WAOUT + (size_t)1024 * 1024 * 2;
constexpr size_t WS_WPGRP = WS_WPIN + (size_t)1024 * 1024 * 2;
constexpr size_t WS_WUP   = WS_WPGRP + (size_t)4 * 256 * 256 * 2;
constexpr size_t WS_WDN   = WS_WUP + (size_t)4 * 16 * 2048 * 1024 * 2;
constexpr size_t WS_XC    = WS_WDN + (size_t)4 * 16 * 1024 * 1024 * 2;
constexpr size_t WS_XB    = WS_XC + (size_t)TC * D * 2;
constexpr size_t WS_H     = WS_XB + (size_t)T * D * 2;
constexpr size_t WS_S1    = WS_H + (size_t)TT * D * 2;
constexpr size_t WS_S2    = WS_S1 + (size_t)TT * 2048 * 2;
constexpr size_t WS_QB    = WS_S2 + (size_t)TT * D * 2;
constexpr size_t WS_KB    = WS_QB + (size_t)T * D * 2;
constexpr size_t WS_VB    = WS_KB + (size_t)NB * 2 * SKV * 128 * 2;
constexpr size_t WS_IDX   = WS_VB + (size_t)NB * 2 * SKV * 128 * 2;
constexpr size_t WS_HID   = WS_IDX + (size_t)NTILE * 256 * 4;
constexpr size_t WS_YEXP  = WS_HID + (size_t)NTILE * 256 * D * 2;
constexpr size_t WS_END   = WS_YEXP + (size_t)NTILE * 256 * D * 2;

constexpr int RING_BYTES = 131072, MISC_OFF = RING_BYTES, LDS_BYTES = RING_BYTES + 1024;

__device__ __forceinline__ unsigned cvt_pk_bf16(float lo, float hi) { unsigned r; asm volatile("v_cvt_pk_bf16_f32 %0, %1, %2" : "=v"(r) : "v"(lo), "v"(hi)); return r; }
__device__ __forceinline__ float bf_lo(unsigned u) { return __uint_as_float(u << 16); }
__device__ __forceinline__ float bf_hi(unsigned u) { return __uint_as_float(u & 0xffff0000u); }
__device__ __forceinline__ float bf2f(bf16_t b) { return __uint_as_float(((unsigned)b) << 16); }
__device__ __forceinline__ bf16_t f2bf(float f) { return (bf16_t)(cvt_pk_bf16(f, 0.f) & 0xffffu); }
template <int K> __device__ __forceinline__ float swz_xor(float v) { return __int_as_float(__builtin_amdgcn_ds_swizzle(__float_as_int(v), 0x1F | (K << 10))); }
__device__ __forceinline__ float half_sum(float v) { v += swz_xor<1>(v); v += swz_xor<2>(v); v += swz_xor<4>(v); v += swz_xor<8>(v); v += swz_xor<16>(v); return v; }
__device__ __forceinline__ float half_max(float v) { v = fmaxf(v, swz_xor<1>(v)); v = fmaxf(v, swz_xor<2>(v)); v = fmaxf(v, swz_xor<4>(v)); v = fmaxf(v, swz_xor<8>(v)); v = fmaxf(v, swz_xor<16>(v)); return v; }
__device__ __forceinline__ float wave_sum(float v) { v = half_sum(v); auto rr = __builtin_amdgcn_permlane32_swap(__float_as_uint(v), __float_as_uint(v), false, false); return __uint_as_float(rr[0]) + __uint_as_float(rr[1]); }
__device__ __forceinline__ float wave_max(float v) { v = half_max(v); auto rr = __builtin_amdgcn_permlane32_swap(__float_as_uint(v), __float_as_uint(v), false, false); return fmaxf(__uint_as_float(rr[0]), __uint_as_float(rr[1])); }
__device__ __forceinline__ float xor32(float v, bool hi) { auto rr = __builtin_amdgcn_permlane32_swap(__float_as_uint(v), __float_as_uint(v), false, false); return __uint_as_float(hi ? rr[0] : rr[1]); }
__device__ __forceinline__ int opaque_tid() { int t = threadIdx.x; asm volatile("" : "+v"(t)); return t; }
__device__ __forceinline__ float silu_f(float x) { return x / (1.f + __expf(-x)); }
__device__ __forceinline__ float gelu_tanh_f(float x) {
    const float z = 0.7978845608028654f * (x + 0.044715f * x * x * x);
    return x / (1.f + __expf(-2.f * z));
}
#define LDS_WAIT() asm volatile("s_waitcnt lgkmcnt(0)" ::: "memory")

#define XB_TMO      128
#define XB_XCNT(j)  (256  + 64 * (j))
#define XB_XSUB(j)  (1280 + 64 * (j))
#define XB_XGEN(j)  (2304 + 64 * (j))
#define XB_TOP      3328
#define XB_TOPGEN   3392
#define XCD_BAR_WORDS 3456
#define XB_SPIN_CAP (1u << 22)
__device__ __forceinline__ unsigned xb_ld(unsigned* p)              { return __hip_atomic_load(p, __ATOMIC_RELAXED, __HIP_MEMORY_SCOPE_AGENT); }
__device__ __forceinline__ unsigned xb_add(unsigned* p, unsigned v) { return __hip_atomic_fetch_add(p, v, __ATOMIC_RELAXED, __HIP_MEMORY_SCOPE_AGENT); }
__device__ __forceinline__ unsigned xb_xcc_id() { return (unsigned)__builtin_amdgcn_s_getreg((3 << 11) | 20) & 0xFu; }
#define XB_SPIN(cond, bar) do { unsigned _sp = 0; while (cond) { __builtin_amdgcn_s_sleep(1); \
    if ((++_sp & 255u) == 0u) { if (xb_ld(&(bar)[XB_TMO])) break; if (_sp > XB_SPIN_CAP) { atomicAdd(&(bar)[XB_TMO], 1u); break; } } } } while (0)
struct XcdBarrier { unsigned* bar; unsigned x; volatile LAS unsigned* st; };
__device__ __forceinline__ XcdBarrier xcd_barrier_post(unsigned* bar, volatile LAS unsigned* st) {
    XcdBarrier b; b.bar = bar; b.x = xb_xcc_id(); b.st = st;
    if (threadIdx.x == 0) (void)xb_add(&bar[XB_XCNT(b.x)], 1u);
    return b;
}
__device__ __forceinline__ void xcd_barrier_complete(unsigned* bar, unsigned x, unsigned& nloc, unsigned& nx) {
    const unsigned G = gridDim.x * gridDim.y * gridDim.z;
    unsigned sum, cnt, mine, sp = 0u;
    for (;;) {
        sum = 0u; cnt = 0u; mine = 0u;
#pragma unroll
        for (unsigned j = 0; j < 16; ++j) { const unsigned c = xb_ld(&bar[XB_XCNT(j)]); sum += c; cnt += (c > 0u) ? 1u : 0u; }
        mine = xb_ld(&bar[XB_XCNT(x)]);
        if (sum == G) break;
        __builtin_amdgcn_s_sleep(1);
        if ((++sp & 255u) == 0u) { if (xb_ld(&bar[XB_TMO])) break; if (sp > XB_SPIN_CAP) { atomicAdd(&bar[XB_TMO], 1u); break; } }
    }
    nloc = mine > 0u ? mine : 1u; nx = cnt > 0u ? cnt : 1u;
}
__device__ __forceinline__ void xcd_barrier(const XcdBarrier& b) {
    asm volatile("s_waitcnt vmcnt(0)" ::: "memory");
    __syncthreads();
    if (threadIdx.x == 0) {
        unsigned* bar = b.bar;
        __builtin_amdgcn_s_waitcnt(0);
        unsigned nloc = b.st[0], nx = b.st[1];
        if (nloc == 0u) { xcd_barrier_complete(bar, b.x, nloc, nx); b.st[0] = nloc; b.st[1] = nx; }
        const unsigned old = xb_add(&bar[XB_XSUB(b.x)], 1u);
        const unsigned gen = old / nloc;
        if (old + 1u == (gen + 1u) * nloc) {
            __builtin_amdgcn_fence(__ATOMIC_RELEASE, "agent");
            asm volatile("s_waitcnt vmcnt(0)" ::: "memory");
            const unsigned og = xb_add(&bar[XB_TOP], 1u);
            const unsigned tg = og / nx;
            if (og + 1u == (tg + 1u) * nx) xb_add(&bar[XB_TOPGEN], 1u);
            else XB_SPIN(xb_ld(&bar[XB_TOPGEN]) == tg, bar);
            __builtin_amdgcn_fence(__ATOMIC_ACQUIRE, "agent");
            xb_add(&bar[XB_XGEN(b.x)], 1u);
            asm volatile("s_waitcnt vmcnt(0)" ::: "memory");
        } else {
            XB_SPIN(xb_ld(&bar[XB_XGEN(b.x)]) == gen, bar);
            __builtin_amdgcn_fence(__ATOMIC_ACQUIRE, "agent");
            asm volatile("s_waitcnt vmcnt(0)" ::: "memory");
        }
    }
    __syncthreads();
}

namespace pg8 {
constexpr int BM = 256, BK = 64, HALF = 128, HTB = HALF * BK * 2, NXCD = 8, WGM = 8;
__host__ __device__ __forceinline__ int lds_byte(int r, int c) { const int st = (r >> 4) * 2 + (c >> 5), rr = r & 15, cc = c & 31, ob = rr * 64 + cc * 2; return st * 1024 + (ob ^ (((ob >> 9) & 1) << 5)); }
__host__ __device__ __forceinline__ void stage_rc(int b, int& R, int& C) { const int st = b / 1024, sb = b % 1024, swz = sb ^ (((sb >> 9) & 1) << 5); R = (st >> 1) * 16 + swz / 64; C = (st & 1) * 32 + (swz % 64) / 2; }
__host__ __device__ __forceinline__ int perm32(int rho) { const int n = rho >> 4, i = rho & 15; return 8 * (i >> 2) + 4 * n + (i & 3); }
struct Unit { int pm, pn; };

template <class Epi, class Sched>
__device__ __forceinline__ void gemm_phase(LAS unsigned char* lds, const int K, const int lda, const int ldb, const Sched& S, const Epi& E) {
    const int tid = opaque_tid(), wid = __builtin_amdgcn_readfirstlane(tid >> 6), lane = tid & 63, wr = wid >> 2, wc = wid & 3, fr = lane & 15, fq = lane >> 4;
    const int nt = K / BK;
    constexpr bool GATHER = Sched::GATHER;
    unsigned voffA[2], voffB[2]; int rowA[2];
#pragma unroll
    for (int i = 0; i < 2; ++i) { int R, C; stage_rc(tid * 16 + i * 8192, R, C); const int Rb = Epi::PERM ? ((R & ~31) + perm32(R & 31)) : R;
        voffA[i] = GATHER ? (unsigned)C * 2u : (unsigned)(R * lda + C) * 2u; voffB[i] = (unsigned)(Rb * ldb + C) * 2u; rowA[i] = R; }
    unsigned gA[2][2], gN[2][2];
    const size_t kstep = (size_t)(BK * 2);
    const size_t hstepA = (size_t)HALF * lda * 2, hstepB = (size_t)HALF * ldb * 2;
    const unsigned ldsw = (unsigned)wid * 1024u;
    const int aoff = lds_byte(wr * 64 + fr, fq * 8), boff = lds_byte(wc * 32 + fr, fq * 8);
#define PG8_SA(b, h) (((b) * 2 + (h)) * HTB)
#define PG8_SB(b, h) ((4 + (b) * 2 + (h)) * HTB)
#define PG8_STAGE(bufoff, gbase, voff) do { _Pragma("unroll") for (int _i = 0; _i < 2; ++_i) \
        __builtin_amdgcn_global_load_lds((const unsigned*)((const char*)(gbase) + (voff)[_i]), (LAS unsigned*)(lds + (bufoff) + ldsw + _i * 8192), 16, 0, 0); } while (0)
#define PG8_STAGE_A(bufoff, ubase, kb, h, nx) do { if constexpr (GATHER) { unsigned _v[2]; _v[0] = ((nx) ? gN[h][0] : gA[h][0]) + voffA[0]; _v[1] = ((nx) ? gN[h][1] : gA[h][1]) + voffA[1]; \
        PG8_STAGE(bufoff, (const char*)S.abase() + (kb), _v); } else { PG8_STAGE(bufoff, (ubase) + (size_t)(h) * hstepA + (kb), voffA); } } while (0)
#define PG8_LOADG(u, g) do { if constexpr (GATHER) { const int* _ip = S.idx(u); _Pragma("unroll") for (int _h = 0; _h < 2; ++_h) _Pragma("unroll") for (int _i = 0; _i < 2; ++_i) \
        g[_h][_i] = (unsigned)_ip[_h * HALF + rowA[_i]] * (unsigned)(lda * 2); } } while (0)
#define PG8_LDA(dst, b, h) do { _Pragma("unroll") for (int m = 0; m < 4; ++m) _Pragma("unroll") for (int k = 0; k < 2; ++k) dst[m][k] = *(const LAS bf16x8*)(lds + PG8_SA(b, h) + aoff + m * 2048 + k * 1024); } while (0)
#define PG8_LDB(dst, b, h) do { _Pragma("unroll") for (int n = 0; n < 2; ++n) _Pragma("unroll") for (int k = 0; k < 2; ++k) dst[n][k] = *(const LAS bf16x8*)(lds + PG8_SB(b, h) + boff + n * 2048 + k * 1024); } while (0)
#define PG8_MMA(ai, bj, At, Bt) do { __builtin_amdgcn_s_setprio(1); _Pragma("unroll") for (int m = 0; m < 4; ++m) _Pragma("unroll") for (int n = 0; n < 2; ++n) _Pragma("unroll") for (int k = 0; k < 2; ++k) \
        acc[ai][bj][m][n] = __builtin_amdgcn_mfma_f32_16x16x32_bf16(Bt[n][k], At[m][k], acc[ai][bj][m][n], 0, 0, 0); __builtin_amdgcn_s_setprio(0); } while (0)
#define PG8_WAIT_V(n) asm volatile("s_waitcnt vmcnt(" #n ")" ::: "memory")
#define PG8_WAIT_L(n) asm volatile("s_waitcnt lgkmcnt(" #n ")" ::: "memory")
#define PG8_BAR __builtin_amdgcn_s_barrier()
#define PG8_SCHED __builtin_amdgcn_sched_barrier(0)
    Unit cur, nxt; int ui = 0;
    if (!S.next(0, cur)) return;
    f32x4 acc[2][2][4][2];
#pragma unroll
    for (int a = 0; a < 2; ++a)
#pragma unroll
        for (int b = 0; b < 2; ++b)
#pragma unroll
            for (int m = 0; m < 4; ++m)
#pragma unroll
                for (int n = 0; n < 2; ++n) acc[a][b][m][n] = (f32x4){0.f, 0.f, 0.f, 0.f};
    bf16x8 At[4][2], B0[2][2], B1[2][2];
    const char* cA = GATHER ? (const char*)nullptr : S.aptr(cur); const char* cB = S.bptr(cur);
    PG8_LOADG(cur, gA);
    PG8_STAGE(PG8_SB(0, 0), cB, voffB); PG8_STAGE(PG8_SB(0, 1), cB + hstepB, voffB); PG8_STAGE_A(PG8_SA(0, 0), cA, 0, 0, false); PG8_STAGE_A(PG8_SA(0, 1), cA, 0, 1, false);
    if (wr == 1) PG8_BAR;
    PG8_WAIT_V(2); PG8_BAR;
    PG8_STAGE(PG8_SB(1, 0), cB + kstep, voffB); PG8_STAGE_A(PG8_SA(1, 0), cA, kstep, 0, false); PG8_STAGE(PG8_SB(1, 1), cB + hstepB + kstep, voffB);
    PG8_WAIT_V(6); PG8_BAR;
    for (;;) {
        const bool has_next = S.next(ui + 1, nxt);
        const char* nA = (has_next && !GATHER) ? S.aptr(nxt) : cA; const char* nB = has_next ? S.bptr(nxt) : cB;
        if (has_next) PG8_LOADG(nxt, gN); else { if constexpr (GATHER) {
#pragma unroll
            for (int h_ = 0; h_ < 2; ++h_) { gN[h_][0] = gA[h_][0]; gN[h_][1] = gA[h_][1]; } } }
        for (int t = 0; t < nt; t += 2) {
            const bool last = (t == nt - 2);
            const size_t k1 = (size_t)(t + 1) * kstep, k2 = last ? 0 : (size_t)(t + 2) * kstep, k3 = k2 + kstep;
            const char* a2 = last ? nA : cA; const char* b2 = last ? nB : cB + (size_t)(t + 2) * kstep;
            const char* b3 = b2 + kstep;
            PG8_LDB(B0, 0, 0); PG8_LDB(B1, 0, 1); PG8_SCHED; PG8_LDA(At, 0, 0); PG8_STAGE_A(PG8_SA(1, 1), cA, k1, 1, false);
            PG8_WAIT_V(8); PG8_WAIT_L(0); PG8_BAR; PG8_MMA(0, 0, At, B0); PG8_MMA(0, 1, At, B1); PG8_BAR; PG8_SCHED;
            PG8_LDA(At, 0, 1); PG8_STAGE(PG8_SB(0, 0), b2, voffB); PG8_STAGE(PG8_SB(0, 1), b2 + hstepB, voffB); PG8_STAGE_A(PG8_SA(0, 0), a2, k2, 0, last);
            PG8_WAIT_V(8); PG8_WAIT_L(0); PG8_BAR; PG8_MMA(1, 0, At, B0); PG8_MMA(1, 1, At, B1); PG8_BAR; PG8_SCHED;
            PG8_LDB(B0, 1, 0); PG8_LDB(B1, 1, 1); PG8_SCHED; PG8_LDA(At, 1, 0); PG8_STAGE_A(PG8_SA(0, 1), a2, k2, 1, last);
            PG8_WAIT_V(8); PG8_WAIT_L(0); PG8_BAR; PG8_MMA(0, 0, At, B0); PG8_MMA(0, 1, At, B1); PG8_BAR; PG8_SCHED;
            PG8_LDA(At, 1, 1); PG8_STAGE(PG8_SB(1, 0), b3, voffB); PG8_STAGE(PG8_SB(1, 1), b3 + hstepB, voffB); PG8_STAGE_A(PG8_SA(1, 0), a2, k3, 0, last);
            PG8_WAIT_V(8); PG8_WAIT_L(0); PG8_BAR; PG8_MMA(1, 0, At, B0); PG8_MMA(1, 1, At, B1); PG8_BAR; PG8_SCHED;
        }
        if (wr == 0) PG8_BAR;
        E(acc, cur, wr, wc, fr, fq);
        if (!has_next) break;
#pragma unroll
        for (int a = 0; a < 2; ++a)
#pragma unroll
            for (int b = 0; b < 2; ++b)
#pragma unroll
                for (int m = 0; m < 4; ++m)
#pragma unroll
                    for (int n = 0; n < 2; ++n) acc[a][b][m][n] = (f32x4){0.f, 0.f, 0.f, 0.f};
        cur = nxt; cA = nA; cB = nB; ++ui;
        if constexpr (GATHER) {
#pragma unroll
            for (int h_ = 0; h_ < 2; ++h_) { gA[h_][0] = gN[h_][0]; gA[h_][1] = gN[h_][1]; } }
        if (wr == 1) PG8_BAR;
    }
    PG8_WAIT_V(0);
    PG8_BAR;
#undef PG8_SA
#undef PG8_SB
#undef PG8_STAGE
#undef PG8_STAGE_A
#undef PG8_LOADG
#undef PG8_LDA
#undef PG8_LDB
#undef PG8_MMA
#undef PG8_WAIT_V
#undef PG8_WAIT_L
#undef PG8_BAR
#undef PG8_SCHED
}

struct SchedDense {
    static constexpr bool GATHER = false;
    __device__ __forceinline__ const char* abase() const { return nullptr; }
    __device__ __forceinline__ const int* idx(const Unit&) const { return nullptr; }
    const bf16_t* A; const bf16_t* Bt; int a_pm_stride, a_pn_stride, b_pn_stride;
    int nM, nN, nwg, extra, G, c;
    __device__ __forceinline__ bool next(int i, Unit& u) const {
        const int L = i * G + c; if (L >= nwg + extra) return false;
        if (L >= nwg) { const int x = L - nwg; u.pm = nM + (x >> 1); u.pn = 4 + (x & 1); return true; }
        int wgid = L; { const int q = nwg / NXCD, r = nwg % NXCD, xcd = wgid % NXCD, off = wgid / NXCD; wgid = (xcd < r ? xcd * (q + 1) : r * (q + 1) + (xcd - r) * q) + off; }
        const int nig = WGM * nN, gid = wgid / nig, fm = gid * WGM, gsz = (nM - fm) < WGM ? (nM - fm) : WGM;
        u.pm = fm + ((wgid % nig) % gsz); u.pn = (wgid % nig) / gsz; return true;
    }
    __device__ __forceinline__ const char* aptr(const Unit& u) const { return (const char*)(A + (size_t)u.pm * a_pm_stride + (size_t)u.pn * a_pn_stride); }
    __device__ __forceinline__ const char* bptr(const Unit& u) const { return (const char*)(Bt + (size_t)u.pn * b_pn_stride); }
};
template <bool GATHER_>
struct SchedMoE {
    static constexpr bool GATHER = GATHER_;
    const bf16_t* A; const bf16_t* Bt; const int* IDX; int nbt, nn, G, vcu;
    __device__ __forceinline__ bool next(int i, Unit& u) const {
        const int L = i * G + vcu, per_e = nbt * nn; if (L >= NE * per_e) return false;
        const int e = L / per_e, rem = L - e * per_e, bt = rem / nn, j = rem - bt * nn;
        u.pm = bt < 8 ? e * 8 + bt : 128 + e; u.pn = e * nn + j; return true;
    }
    __device__ __forceinline__ const char* aptr(const Unit& u) const { return (const char*)(A + (size_t)u.pm * 256 * D); }
    __device__ __forceinline__ const char* abase() const { return (const char*)A; }
    __device__ __forceinline__ const int* idx(const Unit& u) const { return IDX + (size_t)u.pm * 256; }
    __device__ __forceinline__ const char* bptr(const Unit& u) const { return (const char*)(Bt + (size_t)u.pn * 256 * D); }
};

struct EpiA {
    static constexpr bool PERM = true;
    bf16_t* O; int ldc; int act; bf16_t* VB; float* stats;
    __device__ __forceinline__ void operator()(const f32x4 (&acc)[2][2][4][2], const Unit& u, int wr, int wc, int fr, int fq) const {
        const int row0 = u.pm * BM + wr * 64 + fr, cl = wc * 32 + 8 * fq;
        const bool vtile = (VB != nullptr) && (u.pn == 5);
        const bool dostat = (stats != nullptr) && (u.pn >= 4);
#pragma unroll
        for (int ai = 0; ai < 2; ++ai)
#pragma unroll
            for (int m = 0; m < 4; ++m) {
                const int r = row0 + ai * HALF + m * 16;
                float s1 = 0.f, s2 = 0.f;
#pragma unroll
                for (int bj = 0; bj < 2; ++bj) {
                    f32x4 v0 = acc[ai][bj][m][0], v1 = acc[ai][bj][m][1];
                    if (act) {
#pragma unroll
                        for (int j = 0; j < 4; ++j) { v0[j] = gelu_tanh_f(v0[j]); v1[j] = gelu_tanh_f(v1[j]); } }
#pragma unroll
                    for (int j = 0; j < 4; ++j) { s1 += v0[j] + v1[j]; s2 += v0[j] * v0[j] + v1[j] * v1[j]; }
                    u32x4 w; w.x = cvt_pk_bf16(v0[0], v0[1]); w.y = cvt_pk_bf16(v0[2], v0[3]); w.z = cvt_pk_bf16(v1[0], v1[1]); w.w = cvt_pk_bf16(v1[2], v1[3]);
                    bf16_t* dst;
                    if (vtile) { int b, pos; if (r < T) { b = r >> 11; pos = CL + (r & (SEQ - 1)); } else { const int rc = r - T; b = rc >> 8; pos = rc & (CL - 1); }
                        dst = VB + ((size_t)(b * 2 + bj) * SKV + pos) * 128 + cl; }
                    else dst = O + (size_t)r * ldc + u.pn * BM + bj * HALF + cl;
                    *(u32x4*)dst = w; }
                if (dostat) {
                    s1 += swz_xor<16>(s1); s2 += swz_xor<16>(s2);
                    { auto rr = __builtin_amdgcn_permlane32_swap(__float_as_uint(s1), __float_as_uint(s1), false, false); s1 = __uint_as_float(rr[0]) + __uint_as_float(rr[1]); }
                    { auto rr = __builtin_amdgcn_permlane32_swap(__float_as_uint(s2), __float_as_uint(s2), false, false); s2 = __uint_as_float(rr[0]) + __uint_as_float(rr[1]); }
                    if (fq == 0) *(f32x2*)(stats + ((size_t)r * 16 + (u.pn - 4) * 4 + wc) * 2) = (f32x2){s1, s2}; } }
    }
};
struct EpiB {
    static constexpr bool PERM = true;
    const void* xs_lat; const void* xs_ctx; bf16_t* xd_lat; bf16_t* xd_ctx; const float* gt; const float* colscale; int src_f32; int dry;
    __device__ __forceinline__ void operator()(const f32x4 (&acc)[2][2][4][2], const Unit& u, int wr, int wc, int fr, int fq) const {
        const int row0 = u.pm * BM + wr * 64 + fr, col0 = u.pn * BM + wc * 32 + 8 * fq;
        const bool isctx = row0 >= T;
        const int mrow = isctx ? 8 : (row0 >> 11);
        const size_t rbase = isctx ? (size_t)T : 0;
        const void* xs = isctx ? xs_ctx : xs_lat; bf16_t* xd = isctx ? xd_ctx : xd_lat;
        f32x4 gv[2][2];
#pragma unroll
        for (int bj = 0; bj < 2; ++bj)
#pragma unroll
            for (int n = 0; n < 2; ++n) { const int c = col0 + bj * HALF + n * 4; gv[bj][n] = *(const f32x4*)(gt + (size_t)mrow * 6144 + c);
                if (colscale) gv[bj][n] = gv[bj][n] * *(const f32x4*)(colscale + c); }
#pragma unroll
        for (int ai = 0; ai < 2; ++ai)
#pragma unroll
            for (int m = 0; m < 4; ++m) { const size_t off = ((size_t)(row0 + ai * HALF + m * 16) - rbase) * D + col0;
#pragma unroll
                for (int bj = 0; bj < 2; ++bj) { f32x4 x0, x1;
                    if (src_f32) { x0 = *(const f32x4*)((const float*)xs + off + bj * HALF); x1 = *(const f32x4*)((const float*)xs + off + bj * HALF + 4); }
                    else { const u32x4 w = *(const u32x4*)((const bf16_t*)xs + off + bj * HALF); x0 = (f32x4){bf_lo(w.x), bf_hi(w.x), bf_lo(w.y), bf_hi(w.y)}; x1 = (f32x4){bf_lo(w.z), bf_hi(w.z), bf_lo(w.w), bf_hi(w.w)}; }
                    x0 = x0 + gv[bj][0] * acc[ai][bj][m][0]; x1 = x1 + gv[bj][1] * acc[ai][bj][m][1];
                    u32x4 o; o.x = cvt_pk_bf16(x0[0], x0[1]); o.y = cvt_pk_bf16(x0[2], x0[3]); o.z = cvt_pk_bf16(x1[0], x1[1]); o.w = cvt_pk_bf16(x1[2], x1[3]);
                    if (!dry) *(u32x4*)(xd + off + bj * HALF) = o; } }
    }
};
struct EpiC {
    static constexpr bool PERM = true;
    bf16_t* HID;
    __device__ __forceinline__ void operator()(const f32x4 (&acc)[2][2][4][2], const Unit& u, int wr, int wc, int fr, int fq) const {
        const int n8 = u.pn & 7, rl = wr * 64 + fr, cl = n8 * 128 + wc * 32 + 8 * fq;
        bf16_t* base = HID + (size_t)u.pm * 256 * D;
#pragma unroll
        for (int ai = 0; ai < 2; ++ai)
#pragma unroll
            for (int m = 0; m < 4; ++m) {
                float h[8];
#pragma unroll
                for (int n = 0; n < 2; ++n)
#pragma unroll
                    for (int j = 0; j < 4; ++j) { const float g = acc[ai][0][m][n][j], up = acc[ai][1][m][n][j]; h[n * 4 + j] = silu_f(g) * up; }
                u32x4 w; w.x = cvt_pk_bf16(h[0], h[1]); w.y = cvt_pk_bf16(h[2], h[3]); w.z = cvt_pk_bf16(h[4], h[5]); w.w = cvt_pk_bf16(h[6], h[7]);
                *(u32x4*)(base + (size_t)(rl + ai * HALF + m * 16) * D + cl) = w; }
    }
};
struct EpiD {
    static constexpr bool PERM = true;
    bf16_t* Y; const float* gate;
    __device__ __forceinline__ void operator()(const f32x4 (&acc)[2][2][4][2], const Unit& u, int wr, int wc, int fr, int fq) const {
        const int n4 = u.pn & 3, rl = wr * 64 + fr, cl = n4 * 256 + wc * 32 + 8 * fq;
        bf16_t* base = Y + (size_t)u.pm * 256 * D; const float* gp = gate + (size_t)u.pm * 256;
#pragma unroll
        for (int ai = 0; ai < 2; ++ai)
#pragma unroll
            for (int m = 0; m < 4; ++m) { const int r = rl + ai * HALF + m * 16; const float g = gp[r];
#pragma unroll
                for (int bj = 0; bj < 2; ++bj) { const f32x4 v0 = acc[ai][bj][m][0] * g, v1 = acc[ai][bj][m][1] * g;
                    u32x4 w; w.x = cvt_pk_bf16(v0[0], v0[1]); w.y = cvt_pk_bf16(v0[2], v0[3]); w.z = cvt_pk_bf16(v1[0], v1[1]); w.w = cvt_pk_bf16(v1[2], v1[3]);
                    *(u32x4*)(base + (size_t)r * D + bj * HALF + cl) = w; } }
    }
};
}

namespace att {
constexpr int QBLK = 32, KVBLK = 64;
constexpr float SCALE = 0.088388347648318440f;
constexpr float THR = 8.f;
constexpr int SHM_V = KVBLK * 128 * 2, SHM_K = KVBLK * 128 * 2;
#define KSWZ(row, colB) ((row) * 256 + ((colB) ^ (((row) & 7) << 4)))
#define SBAR() __builtin_amdgcn_sched_barrier(0)
__device__ __forceinline__ int crow(int r, int hi) { return (r & 3) + 8 * (r >> 2) + 4 * hi; }
__device__ __forceinline__ void partialSM(f32x16& p0, f32x16& p1, float& m_reg, float& mn, float& alpha) {
    constexpr float C = SCALE * 1.4426950408889634f;
    float pmax = p0[0];
#pragma unroll
    for (int r = 1; r < 16; ++r) pmax = fmaxf(pmax, p0[r]);
#pragma unroll
    for (int r = 0; r < 16; ++r) pmax = fmaxf(pmax, p1[r]);
    { auto rr = __builtin_amdgcn_permlane32_swap(__float_as_uint(pmax), __float_as_uint(pmax), false, false);
      pmax = fmaxf(__uint_as_float(rr[0]), __uint_as_float(rr[1])); }
    if (__builtin_expect(__all(pmax - m_reg <= THR / SCALE), 1)) { mn = m_reg; alpha = 1.f; }
    else { mn = fmaxf(m_reg, pmax); alpha = __builtin_amdgcn_exp2f((m_reg - mn) * C); m_reg = mn; }
    float mnC = -mn * C;
#pragma unroll
    for (int r = 0; r < 16; ++r) p0[r] = fmaf(p0[r], C, mnC);
#pragma unroll
    for (int r = 0; r < 16; ++r) p1[r] = fmaf(p1[r], C, mnC);
#pragma unroll
    for (int r = 0; r < 16; ++r) p0[r] = __builtin_amdgcn_exp2f(p0[r]);
}
__device__ __forceinline__ void finishSM(f32x16& p0, f32x16& p1, float alpha, float& l_reg, bf16x8& pa0, bf16x8& pa1, bf16x8& pa2, bf16x8& pa3) {
#pragma unroll
    for (int r = 0; r < 16; ++r) p1[r] = __builtin_amdgcn_exp2f(p1[r]);
    float ps = 0;
#pragma unroll
    for (int r = 0; r < 16; ++r) ps += p0[r];
#pragma unroll
    for (int r = 0; r < 16; ++r) ps += p1[r];
    { auto rr = __builtin_amdgcn_permlane32_swap(__float_as_uint(ps), __float_as_uint(ps), false, false);
      ps = __uint_as_float(rr[0]) + __uint_as_float(rr[1]); }
    l_reg = l_reg * alpha + ps;
#define PK4(P, BASE, OUT) do { unsigned a0 = cvt_pk_bf16(P[BASE + 0], P[BASE + 1]), a1 = cvt_pk_bf16(P[BASE + 2], P[BASE + 3]);   \
    unsigned b0 = cvt_pk_bf16(P[BASE + 4], P[BASE + 5]), b1 = cvt_pk_bf16(P[BASE + 6], P[BASE + 7]);                              \
    auto r0 = __builtin_amdgcn_permlane32_swap(a0, b0, false, false); auto r1 = __builtin_amdgcn_permlane32_swap(a1, b1, false, false); \
    u32x4 w = {r0[0], r1[0], r0[1], r1[1]}; OUT = *reinterpret_cast<bf16x8*>(&w); } while (0)
    PK4(p0, 0, pa0); PK4(p0, 8, pa1); PK4(p1, 0, pa2); PK4(p1, 8, pa3);
#undef PK4
}
__device__ __forceinline__ void qkt(f32x16& p0, f32x16& p1, const LAS unsigned char* Ks, const bf16x8* qr, int r32, int hi) {
    p0 = f32x16{}; p1 = f32x16{};
#pragma unroll
    for (int d0 = 0; d0 < 8; ++d0) { int cb = (d0 * 16 + hi * 8) * 2;
        bf16x8 b0 = *reinterpret_cast<const LAS bf16x8*>(Ks + KSWZ(r32, cb));
        bf16x8 b1 = *reinterpret_cast<const LAS bf16x8*>(Ks + KSWZ(32 + r32, cb));
        p0 = __builtin_amdgcn_mfma_f32_32x32x16_bf16(b0, qr[d0], p0, 0, 0, 0);
        p1 = __builtin_amdgcn_mfma_f32_32x32x16_bf16(b1, qr[d0], p1, 0, 0, 0); }
}
__device__ __forceinline__ int v_st(int k, int c) { const int kk = (k & ~0xC) | ((k & 4) << 1) | ((k & 8) >> 1); return ((kk >> 3) * 4 + (c >> 5)) * 512 + ((kk & 7) * 32 + (c & 31)) * 2; }
__device__ __forceinline__ int v_rd_base(int lane) { return ((lane & 3) << 3) | (((lane >> 2) & 3) << 6) | (((lane >> 4) & 1) << 5) | (((lane >> 5) & 1) << 8); }
constexpr int v_rd_off(int d0, int ks, int half) { return d0 * 512 + ks * 4096 + half * 2048; }
template <int OFF> __device__ __forceinline__ s16x4 tr_read(int vb) {
    s16x4 r; asm volatile("ds_read_b64_tr_b16 %0, %1 offset:%2" : "=&v"(r) : "v"(vb), "i"(OFF) : "memory"); return r;
}
template <int D0> __device__ __forceinline__ void pv_one(f32x16& od, int vb, bf16x8 pa0, bf16x8 pa1, bf16x8 pa2, bf16x8 pa3) {
    const s16x4 l0 = tr_read<v_rd_off(D0, 0, 0)>(vb), h0 = tr_read<v_rd_off(D0, 0, 1)>(vb), l1 = tr_read<v_rd_off(D0, 1, 0)>(vb), h1 = tr_read<v_rd_off(D0, 1, 1)>(vb);
    const s16x4 l2 = tr_read<v_rd_off(D0, 2, 0)>(vb), h2 = tr_read<v_rd_off(D0, 2, 1)>(vb), l3 = tr_read<v_rd_off(D0, 3, 0)>(vb), h3 = tr_read<v_rd_off(D0, 3, 1)>(vb);
    asm volatile("s_waitcnt lgkmcnt(0)" ::: "memory"); SBAR();
#define PK(L, H) (bf16x8){L[0], L[1], L[2], L[3], H[0], H[1], H[2], H[3]}
    od = __builtin_amdgcn_mfma_f32_32x32x16_bf16(pa0, PK(l0, h0), od, 0, 0, 0);
    od = __builtin_amdgcn_mfma_f32_32x32x16_bf16(pa1, PK(l1, h1), od, 0, 0, 0);
    od = __builtin_amdgcn_mfma_f32_32x32x16_bf16(pa2, PK(l2, h2), od, 0, 0, 0);
    od = __builtin_amdgcn_mfma_f32_32x32x16_bf16(pa3, PK(l3, h3), od, 0, 0, 0);
#undef PK
}
__device__ __forceinline__ void pv_d0(f32x16* o, int vb, bf16x8 pa0, bf16x8 pa1, bf16x8 pa2, bf16x8 pa3) {
    pv_one<0>(o[0], vb, pa0, pa1, pa2, pa3); pv_one<1>(o[1], vb, pa0, pa1, pa2, pa3); pv_one<2>(o[2], vb, pa0, pa1, pa2, pa3); pv_one<3>(o[3], vb, pa0, pa1, pa2, pa3);
}
template <int LDQ, int LDO>
__device__ __forceinline__ void attn_body(const bf16_t* __restrict__ Qb, const bf16_t* __restrict__ Kh, const bf16_t* __restrict__ Vh, bf16_t* __restrict__ Ob, int seq, LAS unsigned char* lds) {
    constexpr int LDK = 128;
    const int tid = opaque_tid(), wid = tid >> 6, lane = tid & 63, r32 = lane & 31, hi = lane >> 5;
    LAS unsigned char* V_lds = lds; LAS unsigned char* K_lds = lds + 2 * SHM_V;
    LAS float* ws = (LAS float*)(lds + 2 * SHM_V + 2 * SHM_K) + wid * 64; LAS float* li_l = ws; LAS float* al_l = ws + 32;
    float m_reg = -1e30f, l_reg = 0; f32x16 o[4] = {}; bf16x8 qr[8];
    const bf16_t* Qw = Qb + (long)(wid * QBLK + r32) * LDQ + hi * 8;
#pragma unroll
    for (int d0 = 0; d0 < 8; ++d0) qr[d0] = *reinterpret_cast<const bf16x8*>(Qw + d0 * 16);
    const int sr = tid >> 4, sc = (tid & 15) * 8, vst0 = v_st(sr, sc), vst1 = v_st(32 + sr, sc);
    const int vb0 = (int)(unsigned)(uintptr_t)V_lds + v_rd_base(lane);
    struct { bf16x8 vs0, vs1, ks0, ks1; } sr_[2];
#define SLOAD(i, k0) do { sr_[i].vs0 = *reinterpret_cast<const bf16x8*>(&Vh[(long)((k0) + sr) * LDK + sc]); sr_[i].vs1 = *reinterpret_cast<const bf16x8*>(&Vh[(long)((k0) + 32 + sr) * LDK + sc]); \
    sr_[i].ks0 = *reinterpret_cast<const bf16x8*>(&Kh[(long)((k0) + sr) * LDK + sc]); sr_[i].ks1 = *reinterpret_cast<const bf16x8*>(&Kh[(long)((k0) + 32 + sr) * LDK + sc]); } while (0)
#define SWRITE(b, i) do { *(LAS bf16x8*)(V_lds + (b) * SHM_V + vst0) = sr_[i].vs0;          \
    *(LAS bf16x8*)(V_lds + (b) * SHM_V + vst1) = sr_[i].vs1; int kc = sc * 2;               \
    *(LAS bf16x8*)(K_lds + (b) * SHM_K + KSWZ(sr, kc)) = sr_[i].ks0;                       \
    *(LAS bf16x8*)(K_lds + (b) * SHM_K + KSWZ(32 + sr, kc)) = sr_[i].ks1; } while (0)
#define SWAIT() asm volatile("s_waitcnt vmcnt(4)" ::: "memory")
#define RESC(a) do { if (__any((a) < 1.f)) { if (hi == 0) al_l[r32] = (a); asm volatile("s_waitcnt lgkmcnt(0)" ::: "memory"); \
    for (int d = 0; d < 4; ++d) for (int r = 0; r < 16; ++r) o[d][r] *= al_l[crow(r, hi)]; } } while (0)
    f32x16 pA0, pA1, pB0, pB1; float mnA, mnB, alA, alB; bf16x8 pa0, pa1, pa2, pa3; const int NT = seq / KVBLK;
    constexpr int SE = 0, SO = 1;
    SLOAD(SE, 0); asm volatile("s_waitcnt vmcnt(0)" ::: "memory"); SWRITE(0, SE); __syncthreads();
    qkt(pA0, pA1, K_lds, qr, r32, hi); partialSM(pA0, pA1, m_reg, mnA, alA);
    SLOAD(SO, KVBLK); if (2 < NT) SLOAD(SE, 2 * KVBLK);
    SWAIT(); SWRITE(1, SO); __syncthreads();
    for (int j = 1; j + 1 < NT; j += 2) {
        SBAR(); qkt(pB0, pB1, K_lds + SHM_K, qr, r32, hi);
        finishSM(pA0, pA1, alA, l_reg, pa0, pa1, pa2, pa3); SBAR();
        SLOAD(SO, (j + 2) * KVBLK); SBAR();
        pv_d0(o, vb0, pa0, pa1, pa2, pa3); partialSM(pB0, pB1, m_reg, mnB, alB);
        __syncthreads(); SWAIT(); SWRITE(0, SE);
        RESC(alB); __syncthreads();
        SBAR(); qkt(pA0, pA1, K_lds, qr, r32, hi);
        finishSM(pB0, pB1, alB, l_reg, pa0, pa1, pa2, pa3); SBAR();
        if (j + 3 < NT) SLOAD(SE, (j + 3) * KVBLK); SBAR();
        pv_d0(o, vb0 + (int)SHM_V, pa0, pa1, pa2, pa3); partialSM(pA0, pA1, m_reg, mnA, alA);
        __syncthreads(); SWAIT(); SWRITE(1, SO);
        RESC(alA); __syncthreads();
    }
    SBAR(); qkt(pB0, pB1, K_lds + SHM_K, qr, r32, hi);
    finishSM(pA0, pA1, alA, l_reg, pa0, pa1, pa2, pa3); SBAR();
    pv_d0(o, vb0, pa0, pa1, pa2, pa3); partialSM(pB0, pB1, m_reg, mnB, alB);
    __syncthreads(); RESC(alB);
    finishSM(pB0, pB1, alB, l_reg, pa0, pa1, pa2, pa3); SBAR();
    pv_d0(o, vb0 + (int)SHM_V, pa0, pa1, pa2, pa3);
    if (hi == 0) li_l[r32] = l_reg; asm volatile("s_waitcnt lgkmcnt(0)" ::: "memory");
    float rli[16];
#pragma unroll
    for (int r = 0; r < 16; ++r) rli[r] = __builtin_amdgcn_rcpf(li_l[crow(r, hi)]);
    bf16_t* Ow = Ob + (long)(wid * QBLK) * LDO;
#pragma unroll
    for (int r = 0; r < 16; ++r) { int orow = crow(r, hi);
#pragma unroll
        for (int d0 = 0; d0 < 4; ++d0) Ow[(long)orow * LDO + d0 * 32 + r32] = f2bf(o[d0][r] * rli[r]); }
#undef SLOAD
#undef SWRITE
#undef SWAIT
#undef RESC
}
}

struct KArgs { const float* in[24]; float* out; unsigned char* ws; int ph_lo, ph_hi; };
enum { I_X = 0, I_C, I_CTX, I_CCTX, I_MODW, I_MODB, I_N1G, I_N2G, I_RW, I_WG, I_WU, I_WD, I_GWIN, I_GVG, I_GSW, I_GSB, I_GWOUT, I_AWIN, I_AQG, I_AKG, I_AWOUT, I_PWIN, I_PWG, I_PSC };

struct Fr {
    volatile LAS unsigned long long* PT;
    int G, bx, vcu;
    __device__ __forceinline__ unsigned long long ldp(int i) const { const unsigned long long v = PT[i];
        const unsigned lo = __builtin_amdgcn_readfirstlane((unsigned)v), hi = __builtin_amdgcn_readfirstlane((unsigned)(v >> 32)); return ((unsigned long long)hi << 32) | lo; }
    __device__ __forceinline__ const float* in(int i) const { return (const float*)(GAS const float*)ldp(i); }
    __device__ __forceinline__ float* out() const { return (float*)(GAS float*)ldp(24); }
    __device__ __forceinline__ unsigned char* ws() const { return (unsigned char*)(GAS unsigned char*)ldp(25); }
};
#define WSP(F, T_, OFF) ((T_*)((F).ws() + (OFF)))

constexpr int CV_NT_EXP = 4 * 16 * 3 * 64, CV_NT_ALL = CV_NT_EXP + 256 + 128 + 96 + 64 + 64 + 16;
constexpr int CV_L1_FIRST = 3072;
constexpr int CV_Q_GA = 7, CV_N_GA = 192, CV_Q_GB = 5, CV_N_GB = 224, CV_Q_UP = 7, CV_N_UP = 128, CV_Q_DN = 7, CV_N_DN = 192;
constexpr int CV_B_GA = CV_L1_FIRST, CV_B_GB = CV_B_GA + CV_Q_GA * CV_N_GA, CV_B_UP = CV_B_GB + CV_Q_GB * CV_N_GB, CV_B_DN = CV_B_UP + CV_Q_UP * CV_N_UP;
constexpr int CV_DEFER = CV_Q_GA * CV_N_GA + CV_Q_GB * CV_N_GB + CV_Q_UP * CV_N_UP + CV_Q_DN * CV_N_DN;
static_assert(CV_L1_FIRST + CV_DEFER <= CV_NT_EXP, "deferred tiles must be expert tiles of layers 1-3");
__device__ __forceinline__ void convert_tiles(const Fr& F, LAS unsigned char* lds, const int j0, const int jstride, const int jend, const int skip_lo, const int skip_n) {
    const int tid = opaque_tid(), wave = __builtin_amdgcn_readfirstlane(tid >> 6);
    unsigned char* const ws_ = F.ws();
    const int c4 = tid & 63, rr = tid >> 3, ch = tid & 7;
    f32x4 ld[8];
    const float* W = nullptr; int N = 0, k0 = 0, n0 = 0, ldt = 0, gu = 0; bf16_t* dst = nullptr;
#define P0_DECODE(jj) do { int r_ = (jj); r_ = r_ < skip_lo ? r_ : r_ + skip_n; \
        if (r_ < CV_NT_EXP) { const int mat = r_ >> 6, sub = r_ & 63, l = mat / 48, rem = mat % 48, e = rem / 3, which = rem % 3; k0 = (sub >> 2) * 64; n0 = (sub & 3) * 256; N = 1024; ldt = 1024; \
            if (which < 2) { W = F.in(which == 0 ? I_WG : I_WU) + (size_t)(l * 16 + e) * 1024 * 1024; dst = (bf16_t*)(ws_ + WS_WUP) + (size_t)l * 16 * 2048 * 1024 + (size_t)(e * 8 * 256 + which * 128) * 1024; gu = 1; } \
            else { W = F.in(I_WD) + (size_t)(l * 16 + e) * 1024 * 1024; dst = (bf16_t*)(ws_ + WS_WDN) + (size_t)l * 16 * 1024 * 1024 + (size_t)(e * 1024) * 1024; gu = 0; } } \
        else { r_ -= CV_NT_EXP; gu = 0; \
            if (r_ < 256) { const int j = r_ >> 7, sub = r_ & 127; k0 = (sub >> 3) * 64; n0 = (sub & 7) * 256; N = 2048; ldt = 1024; W = F.in(I_GWIN) + (size_t)j * 1024 * 2048; dst = (bf16_t*)(ws_ + WS_WGIN) + (size_t)j * 2048 * 1024; } \
            else if ((r_ -= 256) < 128) { const int j = r_ >> 6, sub = r_ & 63; k0 = (sub >> 2) * 64; n0 = (sub & 3) * 256; N = 1024; ldt = 1024; W = F.in(I_GWOUT) + (size_t)j * 1024 * 1024; dst = (bf16_t*)(ws_ + WS_WGOUT) + (size_t)j * 1024 * 1024; } \
            else if ((r_ -= 128) < 96) { k0 = (r_ / 6) * 64; n0 = (r_ % 6) * 256; N = 1536; ldt = 1024; W = F.in(I_AWIN); dst = (bf16_t*)(ws_ + WS_WAIN); } \
            else if ((r_ -= 96) < 64) { k0 = (r_ >> 2) * 64; n0 = (r_ & 3) * 256; N = 1024; ldt = 1024; W = F.in(I_AWOUT); dst = (bf16_t*)(ws_ + WS_WAOUT); } \
            else if ((r_ -= 64) < 64) { k0 = (r_ >> 2) * 64; n0 = (r_ & 3) * 256; N = 1024; ldt = 1024; W = F.in(I_PWIN); dst = (bf16_t*)(ws_ + WS_WPIN); } \
            else { r_ -= 64; const int g = r_ >> 2; k0 = (r_ & 3) * 64; n0 = 0; N = 256; ldt = 256; W = F.in(I_PWG) + (size_t)g * 256 * 256; dst = (bf16_t*)(ws_ + WS_WPGRP) + (size_t)g * 256 * 256; } } } while (0)
#define P0_LOAD() do { const float* wp_ = W + (size_t)(k0 + wave * 8) * N + n0 + c4 * 4; _Pragma("unroll") for (int s_ = 0; s_ < 8; ++s_) ld[s_] = *(const f32x4*)(wp_ + (size_t)s_ * N); } while (0)
    int it = j0, buf = 0;
    if (it < jend) { P0_DECODE(it); P0_LOAD(); }
#pragma nounroll
    for (; it < jend; it += jstride) {
        LAS unsigned char* Lt = lds + buf * 32768;
#pragma unroll
        for (int j = 0; j < 4; ++j) { const int n = c4 * 4 + j;
            u32x4 o; o.x = cvt_pk_bf16(ld[0][j], ld[1][j]); o.y = cvt_pk_bf16(ld[2][j], ld[3][j]); o.z = cvt_pk_bf16(ld[4][j], ld[5][j]); o.w = cvt_pk_bf16(ld[6][j], ld[7][j]);
            *(LAS u32x4*)(Lt + n * 128 + ((wave ^ ((n >> 2) & 7)) << 4)) = o; }
        bf16_t* const cdst = dst; const int ck0 = k0, cn0 = n0, cldt = ldt, cgu = gu;
        __syncthreads();
        if (it + jstride < jend) { P0_DECODE(it + jstride); P0_LOAD(); }
#pragma unroll
        for (int s_ = 0; s_ < 4; ++s_) { const int n = s_ * 64 + rr; const u32x4 o = *(const LAS u32x4*)(Lt + n * 128 + ((ch ^ ((n >> 2) & 7)) << 4));
            const int nn = cn0 + n; const size_t row = cgu ? (size_t)((nn >> 7) * 256 + (nn & 127)) : (size_t)nn;
            *(u32x4*)(cdst + row * cldt + ck0 + ch * 8) = o; }
        buf ^= 1;
    }
#undef P0_DECODE
#undef P0_LOAD
}
__device__ __forceinline__ void convert_in_idle_slot(const Fr& F, LAS unsigned char* lds, const int c, const int total, const int base, const int quota, const int nidle) {
    const int rounds = (total + F.G - 1) / F.G, first_idle = total - (rounds - 1) * F.G;
    if (F.G != 256 || c < first_idle || c - first_idle >= nidle) return;
    __syncthreads();
    const int j0 = base + (c - first_idle) * quota;
    convert_tiles(F, lds, j0, 1, j0 + quota, 0x7fffffff, 0);
}

__device__ __forceinline__ void p0_phase(const Fr& F, LAS unsigned char* lds, const int part) {
    const int tid = opaque_tid(), lane = tid & 63, wave = __builtin_amdgcn_readfirstlane(tid >> 6), gw = F.bx * NWAVES + wave, NGW = F.G * NWAVES; (void)gw; (void)NGW; (void)lane; (void)wave;
    unsigned char* const ws_ = F.ws();
    float* const modv_ = (float*)(ws_ + WS_MODV);
    bf16_t* const wsw_ = (bf16_t*)(ws_ + WS_WSW);
    bf16_t* const wgin_ = (bf16_t*)(ws_ + WS_WGIN);
    bf16_t* const wgout_ = (bf16_t*)(ws_ + WS_WGOUT);
    bf16_t* const wain_ = (bf16_t*)(ws_ + WS_WAIN);
    bf16_t* const waout_ = (bf16_t*)(ws_ + WS_WAOUT);
    bf16_t* const wpin_ = (bf16_t*)(ws_ + WS_WPIN);
    bf16_t* const wpgrp_ = (bf16_t*)(ws_ + WS_WPGRP);
    bf16_t* const wup_ = (bf16_t*)(ws_ + WS_WUP);
    bf16_t* const wdn_ = (bf16_t*)(ws_ + WS_WDN);
    const float* const in_I_AWIN = F.in(I_AWIN);
    const float* const in_I_AWOUT = F.in(I_AWOUT);
    const float* const in_I_C = F.in(I_C);
    const float* const in_I_CCTX = F.in(I_CCTX);
    const float* const in_I_GSW = F.in(I_GSW);
    const float* const in_I_GWIN = F.in(I_GWIN);
    const float* const in_I_GWOUT = F.in(I_GWOUT);
    const float* const in_I_MODB = F.in(I_MODB);
    const float* const in_I_MODW = F.in(I_MODW);
    const float* const in_I_PWG = F.in(I_PWG);
    const float* const in_I_PWIN = F.in(I_PWIN);
    const float* const in_I_WD = F.in(I_WD);
    const float* const in_I_WG = F.in(I_WG);
    const float* const in_I_WU = F.in(I_WU);

    if (part == 0) {
    LAS float* sact = (LAS float*)lds;
    LAS float* red = (LAS float*)(lds + 49152);
    for (int idx = tid; idx < 9 * 1024; idx += NTHR) { const int r = idx >> 10, k = idx & 1023; const float v = r < 8 ? in_I_C[r * 1024 + k] : in_I_CCTX[k]; sact[k * 12 + r] = silu_f(v); }
    __syncthreads();
    for (int chunk = F.bx; chunk < 768; chunk += F.G) {
        const int layer = chunk / 192, n0 = (chunk % 192) * 32, k0 = wave * 128 + (lane >> 5);
        const float* wp = in_I_MODW + (size_t)layer * 1024 * 6144 + (size_t)k0 * 6144 + n0 + (lane & 31);
        float acc[9];
#pragma unroll
        for (int r = 0; r < 9; ++r) acc[r] = 0.f;
#pragma nounroll
        for (int hb = 0; hb < 4; ++hb) {
            float w[16];
#pragma unroll
            for (int i = 0; i < 16; ++i) w[i] = wp[(size_t)(2 * (hb * 16 + i)) * 6144];
#pragma unroll
            for (int i = 0; i < 16; ++i) { const LAS float* sa = sact + (k0 + 2 * (hb * 16 + i)) * 12;
                const f32x4 s0 = *(const LAS f32x4*)sa, s1 = *(const LAS f32x4*)(sa + 4); const float s8 = sa[8];
                acc[0] += s0[0] * w[i]; acc[1] += s0[1] * w[i]; acc[2] += s0[2] * w[i]; acc[3] += s0[3] * w[i];
                acc[4] += s1[0] * w[i]; acc[5] += s1[1] * w[i]; acc[6] += s1[2] * w[i]; acc[7] += s1[3] * w[i]; acc[8] += s8 * w[i];
                __builtin_amdgcn_sched_barrier(0); }
        }
#pragma unroll
        for (int r = 0; r < 9; ++r) { acc[r] += xor32(acc[r], lane >= 32); if (lane < 32) red[(wave * 9 + r) * 32 + lane] = acc[r]; }
        __syncthreads();
        for (int idx = tid; idx < 288; idx += NTHR) { const int r = idx >> 5, l = idx & 31; float sacc = 0.f;
#pragma unroll
            for (int w = 0; w < 8; ++w) sacc += red[(w * 9 + r) * 32 + l];
            const int nn = n0 + l; modv_[(size_t)(layer * 9 + r) * 6144 + nn] = sacc + in_I_MODB[layer * 6144 + nn]; }
        __syncthreads();
    }
    return;
    }
    { const int defer = (F.G == 256) ? CV_DEFER : 0; convert_tiles(F, lds, F.bx, F.G, CV_NT_ALL - defer, CV_L1_FIRST, defer); }
    __syncthreads();
    for (int i4 = F.bx * NTHR + tid; i4 < 2 * 8 * 128 * 128 / 4; i4 += F.G * NTHR) { const f32x4 v = *(const f32x4*)(in_I_GSW + (size_t)i4 * 4);
        u32x2 o; o.x = cvt_pk_bf16(v[0], v[1]); o.y = cvt_pk_bf16(v[2], v[3]); *(u32x2*)(wsw_ + (size_t)i4 * 4) = o; }
}

template <int R>
__device__ __forceinline__ void norm_rows(const int r0, const bool isctx, const int lane, const int layer, const int which, const int comb, const int dry, float* vst,
                                          const int xmode  , const void* xsrc, void* xdst, const float* modv_, const float* ng, const int* slot_, const bf16_t* YEXP_, bf16_t* H_, float* aff_, int* slotw_, const LAS unsigned char* rwl) {
    const int rc0 = r0 - T; const int b = isctx ? (rc0 >> 8) : (r0 >> 11); const int mrow = isctx ? 8 : b;
    f32x4 v[R][4];
#pragma unroll
    for (int q = 0; q < R; ++q)
#pragma unroll
        for (int j = 0; j < 4; ++j) {
            if (xmode == 0) v[q][j] = *(const f32x4*)((const float*)xsrc + (size_t)q * D + lane * 4 + 256 * j);
            else { const u32x2 w = *(const u32x2*)((const bf16_t*)xsrc + (size_t)q * D + lane * 4 + 256 * j); v[q][j] = (f32x4){bf_lo(w.x), bf_hi(w.x), bf_lo(w.y), bf_hi(w.y)}; } }
#ifndef NO_NR_COMB
    if (comb >= 0) {
        int sl[R];
#pragma unroll
        for (int q = 0; q < R; ++q) sl[q] = slot_[(size_t)(r0 + q) * 16 + (lane & 15)];
        f32x4 a[R][4];
#pragma unroll
        for (int q = 0; q < R; ++q)
#pragma unroll
            for (int j = 0; j < 4; ++j) a[q][j] = (f32x4){0.f, 0.f, 0.f, 0.f};
#pragma nounroll
        for (int e = 0; e < 16; ++e) {
            u32x2 w[R][4];
#pragma unroll
            for (int q = 0; q < R; ++q) {
                const int s = __builtin_amdgcn_readlane(sl[q], e);
                if (s >= 0) {
                    const int tile = isctx ? 128 + e : e * 8 + b, rin = isctx ? (((rc0 + q) >> 8) * 32 + s) : s;
                    const bf16_t* yp = YEXP_ + ((size_t)tile * 256 + rin) * D + lane * 4;
#pragma unroll
                    for (int j = 0; j < 4; ++j) w[q][j] = *(const u32x2*)(yp + 256 * j);
                } else {
#pragma unroll
                    for (int j = 0; j < 4; ++j) w[q][j] = (u32x2){0u, 0u};
                }
            }
#pragma unroll
            for (int q = 0; q < R; ++q)
#pragma unroll
                for (int j = 0; j < 4; ++j) { a[q][j][0] += bf_lo(w[q][j].x); a[q][j][1] += bf_hi(w[q][j].x); a[q][j][2] += bf_lo(w[q][j].y); a[q][j][3] += bf_hi(w[q][j].y); }
        }
        const float* g2 = modv_ + (size_t)(comb * 9 + mrow) * 6144 + 5 * 1024 + lane * 4;
#pragma unroll
        for (int j = 0; j < 4; ++j) { const f32x4 gg = *(const f32x4*)(g2 + 256 * j);
#pragma unroll
            for (int q = 0; q < R; ++q) { v[q][j] = v[q][j] + gg * a[q][j];
                if (!dry) { if (xmode == 2) *(f32x4*)((float*)xdst + (size_t)q * D + lane * 4 + 256 * j) = v[q][j];
                            else { u32x2 o; o.x = cvt_pk_bf16(v[q][j][0], v[q][j][1]); o.y = cvt_pk_bf16(v[q][j][2], v[q][j][3]); *(u32x2*)((bf16_t*)xdst + (size_t)q * D + lane * 4 + 256 * j) = o; } } } }
    }
#endif
    if (which == 0) return;
    float rstd[R];
#pragma unroll
    for (int q = 0; q < R; ++q) { float ss = 0.f;
#pragma unroll
        for (int j = 0; j < 4; ++j) ss += (v[q][j][0] * v[q][j][0] + v[q][j][1] * v[q][j][1]) + (v[q][j][2] * v[q][j][2] + v[q][j][3] * v[q][j][3]);
        rstd[q] = ss; }
#pragma unroll
    for (int q = 0; q < R; ++q) rstd[q] = rsqrtf(wave_sum(rstd[q]) * (1.f / D) + EPS);
    const float* mv = modv_ + (size_t)(layer * 9 + mrow) * 6144 + (which == 2 ? 3 * 1024 : 0) + lane * 4;
#pragma unroll
    for (int j = 0; j < 4; ++j) { const f32x4 g = *(const f32x4*)(ng + lane * 4 + 256 * j), sh = *(const f32x4*)(mv + 256 * j), sc = *(const f32x4*)(mv + 1024 + 256 * j);
#pragma unroll
        for (int q = 0; q < R; ++q) { v[q][j] = (v[q][j] * rstd[q] * g) * (sc + 1.f) + sh;
            u32x2 o; o.x = cvt_pk_bf16(v[q][j][0], v[q][j][1]); o.y = cvt_pk_bf16(v[q][j][2], v[q][j][3]); *(u32x2*)(H_ + (size_t)(r0 + q) * D + lane * 4 + 256 * j) = o; } }
#ifndef NO_NR_ROUTER
    if (which == 2 && dry != 2) {
        float p[R][16];
#pragma unroll
        for (int q = 0; q < R; ++q)
#pragma unroll
            for (int e = 0; e < 16; ++e) p[q][e] = 0.f;
#pragma unroll
        for (int j = 0; j < 4; ++j)
#pragma unroll
            for (int i = 0; i < 4; ++i) { const int col = lane * 4 + 256 * j + i; const LAS unsigned char* rp = rwl + col * 64 + (col >> 2) * 16;
                const f32x4 w0 = *(const LAS f32x4*)(rp), w1 = *(const LAS f32x4*)(rp + 16), w2 = *(const LAS f32x4*)(rp + 32), w3 = *(const LAS f32x4*)(rp + 48);
#pragma unroll
                for (int q = 0; q < R; ++q) { const float hv = v[q][j][i];
                    p[q][0] += hv * w0[0]; p[q][1] += hv * w0[1]; p[q][2] += hv * w0[2]; p[q][3] += hv * w0[3]; p[q][4] += hv * w1[0]; p[q][5] += hv * w1[1]; p[q][6] += hv * w1[2]; p[q][7] += hv * w1[3];
                    p[q][8] += hv * w2[0]; p[q][9] += hv * w2[1]; p[q][10] += hv * w2[2]; p[q][11] += hv * w2[3]; p[q][12] += hv * w3[0]; p[q][13] += hv * w3[1]; p[q][14] += hv * w3[2]; p[q][15] += hv * w3[3]; }
                __builtin_amdgcn_sched_barrier(0); }
#pragma unroll
        for (int q = 0; q < R; ++q)
#pragma unroll
            for (int e = 0; e < 16; ++e) asm volatile("" : "+v"(p[q][e]));
#pragma unroll
        for (int q = 0; q < R; ++q) {
            const bool b5 = (lane & 32) != 0, b4 = (lane & 16) != 0, b3 = (lane & 8) != 0, b2 = (lane & 4) != 0;
            float k8[8], k4[4], k2[2];
#pragma unroll
            for (int e = 0; e < 8; ++e) { const float send = b5 ? p[q][e] : p[q][e + 8]; k8[e] = (b5 ? p[q][e + 8] : p[q][e]) + xor32(send, b5); }
#pragma unroll
            for (int e = 0; e < 4; ++e) { const float send = b4 ? k8[e] : k8[e + 4]; k4[e] = (b4 ? k8[e + 4] : k8[e]) + swz_xor<16>(send); }
#pragma unroll
            for (int e = 0; e < 2; ++e) { const float send = b3 ? k4[e] : k4[e + 2]; k2[e] = (b3 ? k4[e + 2] : k4[e]) + swz_xor<8>(send); }
            float lg; { const float send = b2 ? k2[0] : k2[1]; lg = (b2 ? k2[1] : k2[0]) + swz_xor<4>(send); }
            lg += swz_xor<2>(lg); lg += swz_xor<1>(lg);
            const float mx = wave_max(lg), ex = __expf(lg - mx), sum = wave_sum(ex) * 0.25f;
            const int eid = (lane >> 2) & 15;
            if ((lane & 3) == 0) aff_[(size_t)(r0 + q) * 16 + eid] = ex / sum;
            if (lane < 16) slotw_[(size_t)(r0 + q) * 16 + lane] = -1;
        }
    }
#endif
}
__device__ __forceinline__ void norm_phase(const Fr& F, LAS unsigned char* lds, int layer, int which, int nrows, int comb, int xmode, const void* xlat, const void* xctx, void* xlat_d, void* xctx_d, int dry = 0, bool zero_vst = false) {
    const size_t esz_s = xmode == 0 ? 4 : 2, esz_d = xmode == 2 ? 4 : 2;
    const int tid = opaque_tid(), lane = tid & 63, wave = __builtin_amdgcn_readfirstlane(tid >> 6), gw = F.bx * NWAVES + wave, NGW = F.G * NWAVES;
    unsigned char* const ws_ = F.ws();
    float* const modv_ = (float*)(ws_ + WS_MODV); float* const aff_ = (float*)(ws_ + WS_AFF); int* const slot_ = (int*)(ws_ + WS_SLOT);
    bf16_t* const H_ = (bf16_t*)(ws_ + WS_H); bf16_t* const YEXP_ = (bf16_t*)(ws_ + WS_YEXP);
    float* const vst = zero_vst ? (float*)(ws_ + WS_VST) : nullptr;
    LAS unsigned char* rwl = lds;
    if (which == 2) {
        const float* rw = F.in(I_RW) + (size_t)layer * 1024 * 16;
        for (int idx = tid; idx < 4096; idx += NTHR) { const int col = idx >> 2, e4 = idx & 3; *(LAS f32x4*)(rwl + col * 64 + (col >> 2) * 16 + e4 * 16) = *(const f32x4*)(rw + col * 16 + e4 * 4); }
        __syncthreads();
    }
    const float* ng = F.in(which == 2 ? I_N2G : I_N1G) + (size_t)layer * 1024;
#pragma nounroll
    for (int g4 = gw; g4 < T / 4; g4 += NGW) { const int r0 = g4 * 4;
        norm_rows<4>(r0, false, lane, layer, which, comb, dry, vst, xmode, (const char*)xlat + (size_t)r0 * D * esz_s, (char*)xlat_d + (size_t)r0 * D * esz_d, modv_, ng, slot_, YEXP_, H_, aff_, slot_, rwl); }
    if (nrows > T) {
#pragma nounroll
        for (int r = T + gw; r < nrows; r += NGW)
            norm_rows<1>(r, true, lane, layer, which, comb, dry, vst, xmode, (const char*)xctx + (size_t)(r - T) * D * esz_s, (char*)xctx_d + (size_t)(r - T) * D * esz_d, modv_, ng, slot_, YEXP_, H_, aff_, slot_, rwl);
    }
}

__device__ __forceinline__ void topk_phase(const Fr& F, LAS unsigned char* lds, bool with_ctx) {
    const int tid = opaque_tid();
    unsigned char* const ws_ = F.ws();
    float* const aff_ = (float*)(ws_ + WS_AFF); int* const slot_ = (int*)(ws_ + WS_SLOT); float* const gate_ = (float*)(ws_ + WS_GATE);
    int* const idx_ = (int*)(ws_ + WS_IDX);
    LAS unsigned* vals = (LAS unsigned*)lds;
    LAS int* hist = (LAS int*)(lds + 8192);
    LAS int* suf = (LAS int*)(lds + 9216);
    LAS int* scan = (LAS int*)(lds + 12288);
    volatile LAS unsigned* sv = (volatile LAS unsigned*)(lds + 16384);
    const int nunits = with_ctx ? 256 : 128;
    for (int u = F.bx; u < nunits; u += F.G) {
        const bool isctx = u >= 128; const int uu = isctx ? u - 128 : u, e = uu >> 3, b = uu & 7;
        const int N = isctx ? CL : SEQ, cap = isctx ? CCAP : CAP, row0 = isctx ? T + b * CL : b * SEQ;
        const int tile = isctx ? 128 + e : uu, rbase = isctx ? b * 32 : 0;
        unsigned v[4]; const bool act = tid * 4 < N;
#pragma unroll
        for (int k = 0; k < 4; ++k) v[k] = act ? __float_as_uint(aff_[(size_t)(row0 + tid * 4 + k) * 16 + e]) : 0u;
        if (tid == 0) { sv[0] = 0u; sv[1] = (unsigned)cap; }
        unsigned prefix = 0u, mask = 0u; int need = cap;
#pragma nounroll
        for (int shift = 24; shift >= 0; shift -= 8) {
            if (tid < 256) hist[tid] = 0;
            __syncthreads();
            if (act) {
#pragma unroll
                for (int k = 0; k < 4; ++k) if ((v[k] & mask) == prefix) __hip_atomic_fetch_add(&hist[(v[k] >> shift) & 255u], 1, __ATOMIC_RELAXED, __HIP_MEMORY_SCOPE_WORKGROUP);
            }
            __syncthreads();
            if (tid < 256) { int sacc = 0; for (int d = 255; d >= tid; --d) sacc += hist[d]; suf[tid] = sacc; }
            if (tid == 0) suf[256] = 0;
            __syncthreads();
            if (tid < 256) { const int s0 = suf[tid], s1 = suf[tid + 1]; if (s0 >= need && s1 < need) { sv[0] = prefix | ((unsigned)tid << shift); sv[1] = (unsigned)(need - s1); } }
            __syncthreads();
            prefix = sv[0]; need = (int)sv[1]; mask |= 255u << shift;
        }
        int cg = 0, ce = 0;
#pragma unroll
        for (int k = 0; k < 4; ++k) { cg += (act && v[k] > prefix) ? 1 : 0; ce += (act && v[k] == prefix) ? 1 : 0; }
        int cur = 0; scan[tid] = cg | (ce << 16);
        __syncthreads();
#pragma nounroll
        for (int off = 1; off < NTHR; off <<= 1) {
            const int x = scan[cur * NTHR + tid] + (tid >= off ? scan[cur * NTHR + tid - off] : 0);
            scan[(cur ^ 1) * NTHR + tid] = x; cur ^= 1;
            __syncthreads();
        }
        const int incl = scan[cur * NTHR + tid]; int gb = (incl & 0xffff) - cg, eb = (incl >> 16) - ce;
        if (act) {
#pragma unroll
            for (int k = 0; k < 4; ++k) {
                const bool isg = v[k] > prefix, ise = v[k] == prefix;
                if (isg || (ise && eb < need)) { const int sl = gb + (eb < need ? eb : need); const int row = row0 + tid * 4 + k;
                    idx_[(size_t)tile * 256 + rbase + sl] = row; gate_[(size_t)tile * 256 + rbase + sl] = __uint_as_float(v[k]); slot_[(size_t)row * 16 + e] = sl; }
                gb += isg ? 1 : 0; eb += ise ? 1 : 0;
            }
        }
        __syncthreads();
    }
}

template <int OFF> __device__ __forceinline__ s16x4 sp_tr_read(int vb) {
    s16x4 r; asm volatile("ds_read_b64_tr_b16 %0, %1 offset:%2" : "=&v"(r) : "v"(vb), "i"(OFF) : "memory"); return r;
}
template <int KS> __device__ __forceinline__ void sp_kstep(f32x16& acc0, f32x16& acc1, const LAS bf16_t* Ap, int vb) {
    constexpr int LDB2 = 320;
    const bf16x8 a = *(const LAS bf16x8*)(Ap + KS * 16);
    const s16x4 l0 = sp_tr_read<(16 * KS) * LDB2>(vb), h0 = sp_tr_read<(16 * KS + 4) * LDB2>(vb);
    const s16x4 l1 = sp_tr_read<(16 * KS) * LDB2 + 64>(vb), h1 = sp_tr_read<(16 * KS + 4) * LDB2 + 64>(vb);
    asm volatile("s_waitcnt lgkmcnt(0)" ::: "memory"); __builtin_amdgcn_sched_barrier(0);
    const bf16x8 b0 = (bf16x8){l0[0], l0[1], l0[2], l0[3], h0[0], h0[1], h0[2], h0[3]};
    const bf16x8 b1 = (bf16x8){l1[0], l1[1], l1[2], l1[3], h1[0], h1[1], h1[2], h1[3]};
    acc0 = __builtin_amdgcn_mfma_f32_32x32x16_bf16(b0, a, acc0, 0, 0, 0);
    acc1 = __builtin_amdgcn_mfma_f32_32x32x16_bf16(b1, a, acc1, 0, 0, 0);
}
__device__ __forceinline__ void spatial_phase(const Fr& F, LAS unsigned char* lds, int j, int nchunks) {
    const int tid = opaque_tid(), lane = tid & 63, wave = __builtin_amdgcn_readfirstlane(tid >> 6);
    unsigned char* const ws_ = F.ws();
    const bf16_t* const wsw_ = (const bf16_t*)(ws_ + WS_WSW); const bf16_t* const S1_ = (const bf16_t*)(ws_ + WS_S1); bf16_t* const S2_ = (bf16_t*)(ws_ + WS_S2);
    const float* const vst_ = (const float*)(ws_ + WS_VST);
    constexpr int LDA = 136, LDB = 160;
    LAS bf16_t* As = (LAS bf16_t*)(lds + 1024);
    LAS bf16_t* Bs = (LAS bf16_t*)(lds + 1024 + 128 * LDA * 2);
    const float* vg = F.in(I_GVG) + (size_t)j * 1024; const float* sb = F.in(I_GSB) + (size_t)j * 8 * 128;
    const bf16_t* sw = wsw_ + (size_t)j * 8 * 128 * 128;
    const int r32 = lane & 31, hi = lane >> 5;
    const int pw = (wave >> 1) * 32, dw = (wave & 1) * 64;
    const LAS bf16_t* Ap = As + (pw + r32) * LDA + hi * 8;
    const int vb = (int)(unsigned)(uintptr_t)Bs + (8 * hi + ((lane & 15) >> 2)) * (LDB * 2) + (dw + 16 * ((lane >> 4) & 1) + 4 * (lane & 3)) * 2;
    const int p = pw + r32, c0 = dw + 4 * hi, nunits = nchunks * 8;
    u32x4 sa[4], wv[4]; u32x2 un[2][4]; f32x2 st[4];
#define SP_LOAD(U) do { const int _r0 = ((U) >> 3) * 128, _g = (U) & 7; _Pragma("unroll") for (int i = 0; i < 4; ++i) { const int id = tid + NTHR * i; \
            sa[i] = *(const u32x4*)(sw + (size_t)_g * 128 * 128 + (id >> 4) * 128 + (id & 15) * 8); \
            wv[i] = *(const u32x4*)(S1_ + (size_t)(_r0 + (id >> 4)) * 2048 + 1024 + _g * 128 + (id & 15) * 8); \
            st[i] = *(const f32x2*)(vst_ + ((size_t)(_r0 + (id >> 4)) * 16 + (id & 15)) * 2); } \
            _Pragma("unroll") for (int t = 0; t < 4; ++t) { un[0][t] = *(const u32x2*)(S1_ + (size_t)(_r0 + p) * 2048 + _g * 128 + c0 + 8 * t); un[1][t] = *(const u32x2*)(S1_ + (size_t)(_r0 + p) * 2048 + _g * 128 + c0 + 32 + 8 * t); } } while (0)
    int U = F.vcu;
    if (U < nunits) SP_LOAD(U);
#pragma nounroll
    for (; U < nunits; U += F.G) {
        const int r0 = (U >> 3) * 128, g = U & 7;
#pragma unroll
        for (int i = 0; i < 4; ++i) { const int id = tid + NTHR * i; *(LAS u32x4*)(As + (id >> 4) * LDA + (id & 15) * 8) = sa[i]; }
        { const int dc = tid & 15; const f32x4 g0 = *(const f32x4*)(vg + g * 128 + dc * 8), g1 = *(const f32x4*)(vg + g * 128 + dc * 8 + 4);
#pragma unroll
          for (int i = 0; i < 4; ++i) { const int id = tid + NTHR * i, q = id >> 4;
            float s1 = st[i].x, s2 = st[i].y;
            s1 += swz_xor<1>(s1); s2 += swz_xor<1>(s2); s1 += swz_xor<2>(s1); s2 += swz_xor<2>(s2); s1 += swz_xor<4>(s1); s2 += swz_xor<4>(s2); s1 += swz_xor<8>(s1); s2 += swz_xor<8>(s2);
            const float mean = s1 * (1.f / 1024.f), rstd = rsqrtf(fmaxf(s2 * (1.f / 1024.f) - mean * mean, 0.f) + EPS);
            float x[8];
#pragma unroll
            for (int k = 0; k < 4; ++k) { x[2 * k] = (bf_lo(wv[i][k]) - mean) * rstd; x[2 * k + 1] = (bf_hi(wv[i][k]) - mean) * rstd; }
            u32x4 o; o.x = cvt_pk_bf16(x[0] * g0[0], x[1] * g0[1]); o.y = cvt_pk_bf16(x[2] * g0[2], x[3] * g0[3]); o.z = cvt_pk_bf16(x[4] * g1[0], x[5] * g1[1]); o.w = cvt_pk_bf16(x[6] * g1[2], x[7] * g1[3]);
            *(LAS u32x4*)(Bs + q * LDB + dc * 8) = o; } }
        u32x2 uu[2][4];
#pragma unroll
        for (int t = 0; t < 4; ++t) { uu[0][t] = un[0][t]; uu[1][t] = un[1][t]; }
        const float bias = sb[g * 128 + p];
        __syncthreads();
        if (U + F.G < nunits) SP_LOAD(U + F.G);
        f32x16 acc0 = {}, acc1 = {};
        sp_kstep<0>(acc0, acc1, Ap, vb); sp_kstep<1>(acc0, acc1, Ap, vb); sp_kstep<2>(acc0, acc1, Ap, vb); sp_kstep<3>(acc0, acc1, Ap, vb);
        sp_kstep<4>(acc0, acc1, Ap, vb); sp_kstep<5>(acc0, acc1, Ap, vb); sp_kstep<6>(acc0, acc1, Ap, vb); sp_kstep<7>(acc0, acc1, Ap, vb);
        const size_t ro = (size_t)(r0 + p);
#pragma unroll
        for (int t = 0; t < 4; ++t) {
            u32x2 o0, o1;
            o0.x = cvt_pk_bf16((acc0[4 * t] + bias) * bf_lo(uu[0][t].x), (acc0[4 * t + 1] + bias) * bf_hi(uu[0][t].x)); o0.y = cvt_pk_bf16((acc0[4 * t + 2] + bias) * bf_lo(uu[0][t].y), (acc0[4 * t + 3] + bias) * bf_hi(uu[0][t].y));
            o1.x = cvt_pk_bf16((acc1[4 * t] + bias) * bf_lo(uu[1][t].x), (acc1[4 * t + 1] + bias) * bf_hi(uu[1][t].x)); o1.y = cvt_pk_bf16((acc1[4 * t + 2] + bias) * bf_lo(uu[1][t].y), (acc1[4 * t + 3] + bias) * bf_hi(uu[1][t].y));
            *(u32x2*)(S2_ + ro * D + g * 128 + c0 + 8 * t) = o0; *(u32x2*)(S2_ + ro * D + g * 128 + c0 + 32 + 8 * t) = o1; }
        __syncthreads();
    }
#undef SP_LOAD
}

__device__ __forceinline__ void qknorm_phase(const Fr& F) {
    const int tid = opaque_tid(), lane = tid & 63, wave = __builtin_amdgcn_readfirstlane(tid >> 6), gw = F.bx * NWAVES + wave, NGW = F.G * NWAVES;
    unsigned char* const ws_ = F.ws();
    const bf16_t* const S1_ = (const bf16_t*)(ws_ + WS_S1); bf16_t* const QB_ = (bf16_t*)(ws_ + WS_QB); bf16_t* const KB_ = (bf16_t*)(ws_ + WS_KB);
    const float* qg = F.in(I_AQG); const float* kg = F.in(I_AKG);
    const int hsel = lane >> 5, l5 = lane & 31;
    const f32x2 qg0 = *(const f32x2*)(qg + 2 * l5), qg1 = *(const f32x2*)(qg + 64 + 2 * l5), kg0 = *(const f32x2*)(kg + 2 * l5), kg1 = *(const f32x2*)(kg + 64 + 2 * l5);
    const float inv0 = exp2f(-(float)((2 * l5) & 31) * (13.287712379549449f / 32.f)), inv1 = exp2f(-(float)((2 * l5 + 1) & 31) * (13.287712379549449f / 32.f));
#pragma nounroll
    for (int g2 = gw; g2 < T / 2; g2 += NGW) {
        const int r0 = g2 * 2, b = r0 >> 11;
        unsigned u0[2][5], u1[2][5];
#pragma unroll
        for (int q = 0; q < 2; ++q)
#pragma unroll
            for (int ps = 0; ps < 5; ++ps) { const int hh = 2 * ps + hsel; const bf16_t* src = S1_ + (size_t)(r0 + q) * 2048 + (hh < 8 ? hh * 128 : 1024 + (hh - 8) * 128) + 2 * l5;
                u0[q][ps] = *(const unsigned*)src; u1[q][ps] = *(const unsigned*)(src + 64); }
#pragma unroll
        for (int q = 0; q < 2; ++q) {
            const int s = (r0 + q) & (SEQ - 1); const float pos = (float)(l5 < 16 ? (s >> 6) : (s & 63));
            float c0, s0, c1, s1; __sincosf(pos * inv0, &s0, &c0); __sincosf(pos * inv1, &s1, &c1);
            { c0 = cosf(pos * inv0); s0 = sinf(pos * inv0); c1 = cosf(pos * inv1); s1 = sinf(pos * inv1); }
#pragma unroll
            for (int ps = 0; ps < 5; ++ps) { const int hh = 2 * ps + hsel; const bool isk = ps == 4;
                float a0 = bf_lo(u0[q][ps]), a1 = bf_hi(u0[q][ps]), e0 = bf_lo(u1[q][ps]), e1 = bf_hi(u1[q][ps]);
                const float rs = rsqrtf(half_sum((a0 * a0 + a1 * a1) + (e0 * e0 + e1 * e1)) * (1.f / 128.f) + EPS);
                const f32x2 ga = isk ? kg0 : qg0, gb = isk ? kg1 : qg1;
                a0 *= rs * ga.x; a1 *= rs * ga.y; e0 *= rs * gb.x; e1 *= rs * gb.y;
                const float o10 = a0 * c0 - e0 * s0, o11 = a1 * c1 - e1 * s1, o20 = a0 * s0 + e0 * c0, o21 = a1 * s1 + e1 * c1;
                bf16_t* dst = isk ? KB_ + ((size_t)(b * 2 + (hh - 8)) * SKV + CL + s) * 128 + 2 * l5 : QB_ + (size_t)(r0 + q) * D + hh * 128 + 2 * l5;
                *(unsigned*)dst = cvt_pk_bf16(o10, o11); *(unsigned*)(dst + 64) = cvt_pk_bf16(o20, o21); }
        }
    }
#pragma nounroll
    for (int rc = gw; rc < TC; rc += NGW) {
        const int b = rc >> 8, s = rc & (CL - 1);
        const bf16_t* src = S1_ + (size_t)(T + rc) * 2048 + 1024 + hsel * 128 + 2 * l5;
        const unsigned u0 = *(const unsigned*)src, u1 = *(const unsigned*)(src + 64);
        float a0 = bf_lo(u0), a1 = bf_hi(u0), e0 = bf_lo(u1), e1 = bf_hi(u1);
        const float rs = rsqrtf(half_sum((a0 * a0 + a1 * a1) + (e0 * e0 + e1 * e1)) * (1.f / 128.f) + EPS);
        bf16_t* dst = KB_ + ((size_t)(b * 2 + hsel) * SKV + s) * 128 + 2 * l5;
        *(unsigned*)dst = cvt_pk_bf16(a0 * rs * kg0.x, a1 * rs * kg0.y); *(unsigned*)(dst + 64) = cvt_pk_bf16(e0 * rs * kg1.x, e1 * rs * kg1.y);
    }
}

template <int W> __device__ __forceinline__ void pool_item(const bf16_t* zb  , int s, bf16_t* dst) {
    constexpr int half = W / 2;
    u32x4 w[W];
#pragma unroll
    for (int k = 0; k < W; ++k) { int t = s - half + k; t = t < 0 ? 0 : (t > SEQ - 1 ? SEQ - 1 : t); w[k] = *(const u32x4*)(zb + (size_t)t * 2048); }
    float acc[8];
#pragma unroll
    for (int c = 0; c < 8; ++c) acc[c] = 0.f;
#pragma unroll
    for (int k = 0; k < W; ++k) { const int t = s - half + k; const float m = (t >= 0 && t < SEQ) ? 1.f : 0.f;
#pragma unroll
        for (int c = 0; c < 4; ++c) { acc[2 * c] += m * bf_lo(w[k][c]); acc[2 * c + 1] += m * bf_hi(w[k][c]); } }
    const int lo = s - half < 0 ? 0 : s - half, hi = s + half - 1 > SEQ - 1 ? SEQ - 1 : s + half - 1; const float ic = 1.f / (float)(hi - lo + 1);
    const u32x4 zc = w[half];
    float o[8];
#pragma unroll
    for (int c = 0; c < 4; ++c) { o[2 * c] = acc[2 * c] * ic - bf_lo(zc[c]); o[2 * c + 1] = acc[2 * c + 1] * ic - bf_hi(zc[c]); }
    u32x4 ov; ov.x = cvt_pk_bf16(o[0], o[1]); ov.y = cvt_pk_bf16(o[2], o[3]); ov.z = cvt_pk_bf16(o[4], o[5]); ov.w = cvt_pk_bf16(o[6], o[7]);
    *(u32x4*)dst = ov;
}
__device__ __forceinline__ void pool_phase(const Fr& F) {
    const int tid = opaque_tid(), lane = tid & 63, wave = __builtin_amdgcn_readfirstlane(tid >> 6);
    unsigned char* const ws_ = F.ws();
    const bf16_t* const S1_ = (const bf16_t*)(ws_ + WS_S1); bf16_t* const S2_ = (bf16_t*)(ws_ + WS_S2);
    const int gi = wave & 3, c8 = gi * 32 + (lane & 31), rsub = (wave >> 2) * 2 + (lane >> 5);
#pragma nounroll
    for (int r4 = F.bx; r4 < T / 4; r4 += F.G) {
        const int r = r4 * 4 + rsub, s = r & (SEQ - 1);
        const bf16_t* zb = S1_ + (size_t)(r - s) * 2048 + c8 * 8; bf16_t* dst = S2_ + (size_t)r * D + c8 * 8;
        if (gi == 0) pool_item<2>(zb, s, dst); else if (gi == 1) pool_item<4>(zb, s, dst); else if (gi == 2) pool_item<8>(zb, s, dst); else pool_item<16>(zb, s, dst);
    }
}

__global__ void __launch_bounds__(NTHR, 2) fwd_kernel(KArgs args) {
    extern __shared__ __attribute__((aligned(16))) unsigned char lds_raw[];
    LAS unsigned char* lds = (LAS unsigned char*)lds_raw;
    volatile LAS unsigned* MISC = (volatile LAS unsigned*)(lds + MISC_OFF);
    Fr F;
    F.PT = (volatile LAS unsigned long long*)(lds + MISC_OFF + 256);
    F.G = gridDim.x; F.bx = blockIdx.x; F.vcu = (F.G % 8 == 0) ? (F.bx % 8) * (F.G / 8) + F.bx / 8 : F.bx;
    { const int t0 = threadIdx.x;
      if (t0 < 64) MISC[t0] = 0u;
      if (t0 < 24) F.PT[t0] = (unsigned long long)args.in[t0];
      if (t0 == 24) F.PT[24] = (unsigned long long)args.out;
      if (t0 == 25) F.PT[25] = (unsigned long long)args.ws; }
    __syncthreads();
    XcdBarrier bar = xcd_barrier_post((unsigned*)(F.ws() + WS_CTL), MISC + 8);
    const int lo = args.ph_lo, hi = args.ph_hi;
    int p = 0;
#define RUN(...) RUNC(31, __VA_ARGS__)
#define RUNC(cls, ...) do { if (lo <= p && p < hi) { _Pragma("nounroll") for (int rep_ = 0; rep_ < 1 + (int)((REPEAT_MASK >> (cls)) & 1u); ++rep_) { __VA_ARGS__; if (REPEAT_MASK) __syncthreads(); } if (p + 1 < hi) xcd_barrier(bar); } ++p; } while (0)

#ifndef NO_P0
    RUNC(0, p0_phase(F, lds, 0));
    RUN({
        norm_phase(F, lds, 0, 1, TT, -1, 0, F.in(I_X), F.in(I_CTX), nullptr, nullptr, 0, true);
        __syncthreads();
        p0_phase(F, lds, 1);
    });
#endif
#pragma nounroll
    for (int L = 0; L < 4; ++L) {
        const int kind = L % 3, jm = L / 3;
        const bool with_ctx = (L == 0);
        if (L > 0) RUNC(1, {
            bf16_t* xo = WSP(F, bf16_t, WS_XB); bf16_t* xc = WSP(F, bf16_t, WS_XC);
#ifndef NO_NORM
            norm_phase(F, lds, L, 1, (L <= 1) ? TT : T, L - 1, 1, xo, xc, xo, xc, (REPEAT_MASK >> 1) & 1u ? (rep_ == 0) : 0, kind == 0);
#endif
        });
        RUNC(2, {
            unsigned char* ws = F.ws();
            pg8::SchedDense S; S.A = (bf16_t*)(ws + WS_H); S.G = F.G; S.c = F.bx; S.a_pn_stride = 0; S.a_pm_stride = 256 * D; S.b_pn_stride = 256 * D; S.extra = 0;
            pg8::EpiA E; E.O = (bf16_t*)(ws + WS_S1); E.ldc = 2048; E.act = 0; E.VB = nullptr; E.stats = nullptr;
            if (kind == 0) { S.Bt = (bf16_t*)(ws + WS_WGIN) + (size_t)jm * 2048 * 1024; S.nM = with_ctx ? 72 : 64; S.nN = 8; E.act = 1; E.stats = (float*)(ws + WS_VST); }
            else if (kind == 1) { S.Bt = (bf16_t*)(ws + WS_WAIN); S.nM = 64; S.nN = 6; S.extra = 16; E.VB = (bf16_t*)(ws + WS_VB); }
            else { S.Bt = (bf16_t*)(ws + WS_WPIN); S.nM = 64; S.nN = 4; }
            S.nwg = S.nM * S.nN;
            #ifndef NO_GA
            pg8::gemm_phase<pg8::EpiA, pg8::SchedDense>(lds, D, D, D, S, E);
#endif
            if (L == 0) convert_in_idle_slot(F, lds, F.bx, S.nwg + S.extra, CV_B_GA, CV_Q_GA, CV_N_GA);
        });
        if (kind == 0) {
#ifndef NO_SPAT
            RUNC(3, spatial_phase(F, lds, jm, with_ctx ? 144 : 128));
#endif
        }
        else if (kind == 1) {
#ifndef NO_QKN
            RUNC(4, qknorm_phase(F));
#endif
            RUNC(5, {
                unsigned char* ws = F.ws();
                const bf16_t* QB = (const bf16_t*)(ws + WS_QB); const bf16_t* KB = (const bf16_t*)(ws + WS_KB); const bf16_t* VB = (const bf16_t*)(ws + WS_VB); bf16_t* S2 = (bf16_t*)(ws + WS_S2);
                for (int i = 0; i * F.G + F.vcu < 512; ++i) { const int Lu = i * F.G + F.vcu, bk = Lu >> 5, w = Lu & 31, b = bk >> 1, kvh = bk & 1, h = kvh * 4 + (w >> 3), qb = w & 7;
#ifndef NO_ATT
                    att::attn_body<D, D>(QB + ((size_t)(b * SEQ + qb * 256)) * D + h * 128, KB + (size_t)bk * SKV * 128, VB + (size_t)bk * SKV * 128,
                                         S2 + ((size_t)(b * SEQ + qb * 256)) * D + h * 128, SKV, lds);
#endif
                    __syncthreads(); }
            });
        } else {
#ifndef NO_POOL
            RUNC(6, pool_phase(F));
#endif
        }
        RUNC(7, {
            unsigned char* ws = F.ws();
            pg8::SchedDense S; S.A = (bf16_t*)(ws + WS_S2); S.G = F.G; S.c = F.bx; S.a_pm_stride = 256 * D; S.a_pn_stride = 0; S.b_pn_stride = 256 * D; S.extra = 0; S.nN = 4; S.nM = 64;
            pg8::EpiB E; E.xd_lat = (bf16_t*)(ws + WS_XB); E.xd_ctx = (bf16_t*)(ws + WS_XC); E.src_f32 = (L == 0); E.xs_lat = (L == 0) ? (const void*)F.in(I_X) : (const void*)E.xd_lat; E.xs_ctx = (L == 0) ? (const void*)F.in(I_CTX) : (const void*)E.xd_ctx;
            E.gt = (const float*)(ws + WS_MODV) + (size_t)L * 9 * 6144 + 2 * 1024; E.colscale = nullptr; E.dry = (REPEAT_MASK >> 7) & 1u ? (rep_ == 0) : 0;
            int K = D, ldb = D;
            if (kind == 0) { S.Bt = (bf16_t*)(ws + WS_WGOUT) + (size_t)jm * 1024 * 1024; S.nM = with_ctx ? 72 : 64; }
            else if (kind == 1) { S.Bt = (bf16_t*)(ws + WS_WAOUT); }
            else { S.Bt = (bf16_t*)(ws + WS_WPGRP); S.a_pn_stride = 256; S.b_pn_stride = 256 * 256; K = 256; ldb = 256; E.colscale = F.in(I_PSC); }
            S.nwg = S.nM * S.nN;
            #ifndef NO_GB
            pg8::gemm_phase<pg8::EpiB, pg8::SchedDense>(lds, K, D, ldb, S, E);
#endif
            if (L == 0) convert_in_idle_slot(F, lds, F.bx, S.nwg + S.extra, CV_B_GB, CV_Q_GB, CV_N_GB);
        });
        RUNC(8, {
            bf16_t* xo = WSP(F, bf16_t, WS_XB); bf16_t* xc = WSP(F, bf16_t, WS_XC);
#ifndef NO_NORM
            norm_phase(F, lds, L, 2, with_ctx ? TT : T, -1, 1, xo, xc, xo, xc, ((REPEAT_MASK >> 13) & 1u) && rep_ == 0 ? 2 : 0);
#endif
        });
#ifndef NO_TOPK
        RUNC(9, topk_phase(F, lds, with_ctx));
#endif
        RUNC(10, {
            unsigned char* ws = F.ws();
            pg8::SchedMoE<true> S; S.A = (bf16_t*)(ws + WS_H); S.IDX = (const int*)(ws + WS_IDX); S.Bt = (bf16_t*)(ws + WS_WUP) + (size_t)L * 16 * 2048 * 1024; S.nbt = with_ctx ? 9 : 8; S.nn = 8; S.G = F.G; S.vcu = F.vcu;
            pg8::EpiC E; E.HID = (bf16_t*)(ws + WS_HID);
            #ifndef NO_GC
            pg8::gemm_phase<pg8::EpiC, pg8::SchedMoE<true>>(lds, D, D, D, S, E);
#endif
            if (L == 0) convert_in_idle_slot(F, lds, F.vcu, NE * S.nbt * S.nn, CV_B_UP, CV_Q_UP, CV_N_UP);
        });
        RUNC(11, {
            unsigned char* ws = F.ws();
            pg8::SchedMoE<false> S; S.A = (bf16_t*)(ws + WS_HID); S.IDX = nullptr; S.Bt = (bf16_t*)(ws + WS_WDN) + (size_t)L * 16 * 1024 * 1024; S.nbt = with_ctx ? 9 : 8; S.nn = 4; S.G = F.G; S.vcu = F.vcu;
            pg8::EpiD E; E.Y = (bf16_t*)(ws + WS_YEXP); E.gate = (const float*)(ws + WS_GATE);
            #ifndef NO_GD
            pg8::gemm_phase<pg8::EpiD, pg8::SchedMoE<false>>(lds, D, D, D, S, E);
#endif
            if (L == 0) convert_in_idle_slot(F, lds, F.vcu, NE * S.nbt * S.nn, CV_B_DN, CV_Q_DN, CV_N_DN);
        });
    }
    RUN({
        bf16_t* xb = WSP(F, bf16_t, WS_XB);
#ifndef NO_NORM
        norm_phase(F, lds, 3, 0, T, 3, 2, xb, nullptr, F.out(), nullptr);
#endif
    });
#undef RUN
#undef RUNC
}

constexpr int N_PHASES = 1 + 8 + 9 + 8 + 8 + 1;

extern "C" void kernel_launch(void* const* d_in, const int* in_sizes, int n_in, void* d_out, int out_size, void* d_ws, size_t ws_size, hipStream_t stream) {
    static int grid = 0;
    if (grid == 0) {
        if (n_in != 24 || out_size != T * D || ws_size < WS_END) { fprintf(stderr, "kernel_launch: unexpected shapes (n_in %d out %d ws %zu need %zu)\n", n_in, out_size, ws_size, (size_t)WS_END); grid = -1; return; }
        int dev = 0, cus = 0;
        if (hipGetDevice(&dev) != hipSuccess || hipDeviceGetAttribute(&cus, hipDeviceAttributeMultiprocessorCount, dev) != hipSuccess) { grid = -1; return; }
        if (hipFuncSetAttribute((const void*)fwd_kernel, hipFuncAttributeMaxDynamicSharedMemorySize, LDS_BYTES) != hipSuccess) { fprintf(stderr, "kernel_launch: hipFuncSetAttribute failed\n"); grid = -1; return; }
        (void)hipGetLastError();
        grid = cus;
    }
    if (grid < 0) return;
    (void)hipMemsetAsync((char*)d_ws + WS_CTL, 0, CTL_BYTES, stream);
    KArgs a{};
    for (int i = 0; i < 24; ++i) a.in[i] = (const float*)d_in[i];
    a.out = (float*)d_out; a.ws = (unsigned char*)d_ws;
#if MK_PER_PHASE
    for (int k = 0; k < N_PHASES; ++k) { a.ph_lo = k; a.ph_hi = k + 1; hipLaunchKernelGGL(fwd_kernel, dim3(grid), dim3(NTHR), LDS_BYTES, stream, a); }
#else
    a.ph_lo = 0; a.ph_hi = N_PHASES;
    hipLaunchKernelGGL(fwd_kernel, dim3(grid), dim3(NTHR), LDS_BYTES, stream, a);
#endif
    const hipError_t le = hipPeekAtLastError();
    if (le != hipSuccess) fprintf(stderr, "kernel_launch: launch failed: %s\n", hipGetErrorName(le));
}
```

```cpp
#include <hip/hip_runtime.h>
#include <cstdio>
#include <cstdint>

#ifndef REPEAT_MASK
#define REPEAT_MASK 0u
#endif
#ifndef MK_PER_PHASE
#define MK_PER_PHASE 0
#endif

#define LAS __attribute__((address_space(3)))
#define GAS __attribute__((address_space(1)))
typedef unsigned short bf16_t;
typedef short bf16x8 __attribute__((ext_vector_type(8)));
typedef short s16x4 __attribute__((ext_vector_type(4)));
typedef float f32x2 __attribute__((ext_vector_type(2)));
typedef float f32x4 __attribute__((ext_vector_type(4)));
typedef float f32x16 __attribute__((ext_vector_type(16)));
typedef unsigned u32x2 __attribute__((ext_vector_type(2)));
typedef unsigned u32x4 __attribute__((ext_vector_type(4)));

constexpr int D = 1024, NB = 8, SEQ = 2048, T = NB * SEQ, CL = 256, TC = NB * CL, TT = T + TC, NE = 16, CAP = 256, CCAP = 32, NTILE = 144;
constexpr int SKV = CL + SEQ;
constexpr float EPS = 1e-6f;
constexpr int NWAVES = 8, NTHR = 512;

constexpr size_t al256(size_t x) { return (x + 255) / 256 * 256; }
constexpr size_t WS_CTL   = 0;
constexpr size_t CTL_BYTES = 65536;
constexpr size_t WS_MODV  = WS_CTL + CTL_BYTES;
constexpr size_t WS_AFF   = WS_MODV + al256((size_t)4 * 9 * 6144 * 4);
constexpr size_t WS_SLOT  = WS_AFF + (size_t)TT * 16 * 4;
constexpr size_t WS_GATE  = WS_SLOT + (size_t)TT * 16 * 4;
constexpr size_t WS_VST   = WS_GATE + (size_t)NTILE * 256 * 4;
constexpr size_t WS_WSW   = WS_VST + (size_t)TT * 16 * 2 * 4;
constexpr size_t WS_WGIN  = WS_WSW + (size_t)2 * 8 * 128 * 128 * 2;
constexpr size_t WS_WGOUT = WS_WGIN + (size_t)2 * 2048 * 1024 * 2;
constexpr size_t WS_WAIN  = WS_WGOUT + (size_t)2 * 1024 * 1024 * 2;
constexpr size_t WS_WAOUT = WS_WAIN + (size_t)1536 * 1024 * 2;
constexpr size_t WS_WPIN  = WS_WAOUT + (size_t)1024 * 1024 * 2;
constexpr size_t WS_WPGRP = WS_WPIN + (size_t)1024 * 1024 * 2;
constexpr size_t WS_WUP   = WS_WPGRP + (size_t)4 * 256 * 256 * 2;
constexpr size_t WS_WDN   = WS_WUP + (size_t)4 * 16 * 2048 * 1024 * 2;
constexpr size_t WS_XC    = WS_WDN + (size_t)4 * 16 * 1024 * 1024 * 2;
constexpr size_t WS_XB    = WS_XC + (size_t)TC * D * 2;
constexpr size_t WS_H     = WS_XB + (size_t)T * D * 2;
constexpr size_t WS_S1    = WS_H + (size_t)TT * D * 2;
constexpr size_t WS_S2    = WS_S1 + (size_t)TT * 2048 * 2;
constexpr size_t WS_QB    = WS_S2 + (size_t)TT * D * 2;
constexpr size_t WS_KB    = WS_QB + (size_t)T * D * 2;
constexpr size_t WS_VB    = WS_KB + (size_t)NB * 2 * SKV * 128 * 2;
constexpr size_t WS_IDX   = WS_VB + (size_t)NB * 2 * SKV * 128 * 2;
constexpr size_t WS_HID   = WS_IDX + (size_t)NTILE * 256 * 4;
constexpr size_t WS_YEXP  = WS_HID + (size_t)NTILE * 256 * D * 2;
constexpr size_t WS_END   = WS_YEXP + (size_t)NTILE * 256 * D * 2;

constexpr int RING_BYTES = 131072, MISC_OFF = RING_BYTES, LDS_BYTES = RING_BYTES + 1024;

__device__ __forceinline__ unsigned cvt_pk_bf16(float lo, float hi) { unsigned r; asm volatile("v_cvt_pk_bf16_f32 %0, %1, %2" : "=v"(r) : "v"(lo), "v"(hi)); return r; }
__device__ __forceinline__ float bf_lo(unsigned u) { return __uint_as_float(u << 16); }
__device__ __forceinline__ float bf_hi(unsigned u) { return __uint_as_float(u & 0xffff0000u); }
__device__ __forceinline__ float bf2f(bf16_t b) { return __uint_as_float(((unsigned)b) << 16); }
__device__ __forceinline__ bf16_t f2bf(float f) { return (bf16_t)(cvt_pk_bf16(f, 0.f) & 0xffffu); }
template <int K> __device__ __forceinline__ float swz_xor(float v) { return __int_as_float(__builtin_amdgcn_ds_swizzle(__float_as_int(v), 0x1F | (K << 10))); }
__device__ __forceinline__ float half_sum(float v) { v += swz_xor<1>(v); v += swz_xor<2>(v); v += swz_xor<4>(v); v += swz_xor<8>(v); v += swz_xor<16>(v); return v; }
__device__ __forceinline__ float half_max(float v) { v = fmaxf(v, swz_xor<1>(v)); v = fmaxf(v, swz_xor<2>(v)); v = fmaxf(v, swz_xor<4>(v)); v = fmaxf(v, swz_xor<8>(v)); v = fmaxf(v, swz_xor<16>(v)); return v; }
__device__ __forceinline__ float wave_sum(float v) { v = half_sum(v); auto rr = __builtin_amdgcn_permlane32_swap(__float_as_uint(v), __float_as_uint(v), false, false); return __uint_as_float(rr[0]) + __uint_as_float(rr[1]); }
__device__ __forceinline__ float wave_max(float v) { v = half_max(v); auto rr = __builtin_amdgcn_permlane32_swap(__float_as_uint(v), __float_as_uint(v), false, false); return fmaxf(__uint_as_float(rr[0]), __uint_as_float(rr[1])); }
__device__ __forceinline__ float xor32(float v, bool hi) { auto rr = __builtin_amdgcn_permlane32_swap(__float_as_uint(v), __float_as_uint(v), false, false); return __uint_as_float(hi ? rr[0] : rr[1]); }
__device__ __forceinline__ int opaque_tid() { int t = threadIdx.x; asm volatile("" : "+v"(t)); return t; }
__device__ __forceinline__ float silu_f(float x) { return x / (1.f + __expf(-x)); }
__device__ __forceinline__ float gelu_tanh_f(float x) {
    const float z = 0.7978845608028654f * (x + 0.044715f * x * x * x);
    return x / (1.f + __expf(-2.f * z));
}
#define LDS_WAIT() asm volatile("s_waitcnt lgkmcnt(0)" ::: "memory")

#define XB_TMO      128
#define XB_XCNT(j)  (256  + 64 * (j))
#define XB_XSUB(j)  (1280 + 64 * (j))
#define XB_XGEN(j)  (2304 + 64 * (j))
#define XB_TOP      3328
#define XB_TOPGEN   3392
#define XCD_BAR_WORDS 3456
#define XB_SPIN_CAP (1u << 22)
__device__ __forceinline__ unsigned xb_ld(unsigned* p)              { return __hip_atomic_load(p, __ATOMIC_RELAXED, __HIP_MEMORY_SCOPE_AGENT); }
__device__ __forceinline__ unsigned xb_add(unsigned* p, unsigned v) { return __hip_atomic_fetch_add(p, v, __ATOMIC_RELAXED, __HIP_MEMORY_SCOPE_AGENT); }
__device__ __forceinline__ unsigned xb_xcc_id() { return (unsigned)__builtin_amdgcn_s_getreg((3 << 11) | 20) & 0xFu; }
#define XB_SPIN(cond, bar) do { unsigned _sp = 0; while (cond) { __builtin_amdgcn_s_sleep(1); \
    if ((++_sp & 255u) == 0u) { if (xb_ld(&(bar)[XB_TMO])) break; if (_sp > XB_SPIN_CAP) { atomicAdd(&(bar)[XB_TMO], 1u); break; } } } } while (0)
struct XcdBarrier { unsigned* bar; unsigned x; volatile LAS unsigned* st; };
__device__ __forceinline__ XcdBarrier xcd_barrier_post(unsigned* bar, volatile LAS unsigned* st) {
    XcdBarrier b; b.bar = bar; b.x = xb_xcc_id(); b.st = st;
    if (threadIdx.x == 0) (void)xb_add(&bar[XB_XCNT(b.x)], 1u);
    return b;
}
__device__ __forceinline__ void xcd_barrier_complete(unsigned* bar, unsigned x, unsigned& nloc, unsigned& nx) {
    const unsigned G = gridDim.x * gridDim.y * gridDim.z;
    unsigned sum, cnt, mine, sp = 0u;
    for (;;) {
        sum = 0u; cnt = 0u; mine = 0u;
#pragma unroll
        for (unsigned j = 0; j < 16; ++j) { const unsigned c = xb_ld(&bar[XB_XCNT(j)]); sum += c; cnt += (c > 0u) ? 1u : 0u; }
        mine = xb_ld(&bar[XB_XCNT(x)]);
        if (sum == G) break;
        __builtin_amdgcn_s_sleep(1);
        if ((++sp & 255u) == 0u) { if (xb_ld(&bar[XB_TMO])) break; if (sp > XB_SPIN_CAP) { atomicAdd(&bar[XB_TMO], 1u); break; } }
    }
    nloc = mine > 0u ? mine : 1u; nx = cnt > 0u ? cnt : 1u;
}
__device__ __forceinline__ void xcd_barrier(const XcdBarrier& b) {
    asm volatile("s_waitcnt vmcnt(0)" ::: "memory");
    __syncthreads();
    if (threadIdx.x == 0) {
        unsigned* bar = b.bar;
        __builtin_amdgcn_s_waitcnt(0);
        unsigned nloc = b.st[0], nx = b.st[1];
        if (nloc == 0u) { xcd_barrier_complete(bar, b.x, nloc, nx); b.st[0] = nloc; b.st[1] = nx; }
        const unsigned old = xb_add(&bar[XB_XSUB(b.x)], 1u);
        const unsigned gen = old / nloc;
        if (old + 1u == (gen + 1u) * nloc) {
            __builtin_amdgcn_fence(__ATOMIC_RELEASE, "agent");
            asm volatile("s_waitcnt vmcnt(0)" ::: "memory");
            const unsigned og = xb_add(&bar[XB_TOP], 1u);
            const unsigned tg = og / nx;
            if (og + 1u == (tg + 1u) * nx) xb_add(&bar[XB_TOPGEN], 1u);
            else XB_SPIN(xb_ld(&bar[XB_TOPGEN]) == tg, bar);
            __builtin_amdgcn_fence(__ATOMIC_ACQUIRE, "agent");
            xb_add(&bar[XB_XGEN(b.x)], 1u);
            asm volatile("s_waitcnt vmcnt(0)" ::: "memory");
        } else {
            XB_SPIN(xb_ld(&bar[XB_XGEN(b.x)]) == gen, bar);
            __builtin_amdgcn_fence(__ATOMIC_ACQUIRE, "agent");
            asm volatile("s_waitcnt vmcnt(0)" ::: "memory");
        }
    }
    __syncthreads();
}

namespace pg8 {
constexpr int BM = 256, BK = 64, HALF = 128, HTB = HALF * BK * 2, NXCD = 8, WGM = 8;
__host__ __device__ __forceinline__ int lds_byte(int r, int c) { const int st = (r >> 4) * 2 + (c >> 5), rr = r & 15, cc = c & 31, ob = rr * 64 + cc * 2; return st * 1024 + (ob ^ (((ob >> 9) & 1) << 5)); }
__host__ __device__ __forceinline__ void stage_rc(int b, int& R, int& C) { const int st = b / 1024, sb = b % 1024, swz = sb ^ (((sb >> 9) & 1) << 5); R = (st >> 1) * 16 + swz / 64; C = (st & 1) * 32 + (swz % 64) / 2; }
__host__ __device__ __forceinline__ int perm32(int rho) { const int n = rho >> 4, i = rho & 15; return 8 * (i >> 2) + 4 * n + (i & 3); }
struct Unit { int pm, pn; };

template <class Epi, class Sched>
__device__ __forceinline__ void gemm_phase(LAS unsigned char* lds, const int K, const int lda, const int ldb, const Sched& S, const Epi& E) {
    const int tid = opaque_tid(), wid = __builtin_amdgcn_readfirstlane(tid >> 6), lane = tid & 63, wr = wid >> 2, wc = wid & 3, fr = lane & 15, fq = lane >> 4;
    const int nt = K / BK;
    constexpr bool GATHER = Sched::GATHER;
    unsigned voffA[2], voffB[2]; int rowA[2];
#pragma unroll
    for (int i = 0; i < 2; ++i) { int R, C; stage_rc(tid * 16 + i * 8192, R, C); const int Rb = Epi::PERM ? ((R & ~31) + perm32(R & 31)) : R;
        voffA[i] = GATHER ? (unsigned)C * 2u : (unsigned)(R * lda + C) * 2u; voffB[i] = (unsigned)(Rb * ldb + C) * 2u; rowA[i] = R; }
    unsigned gA[2][2], gN[2][2];
    const size_t kstep = (size_t)(BK * 2);
    const size_t hstepA = (size_t)HALF * lda * 2, hstepB = (size_t)HALF * ldb * 2;
    const unsigned ldsw = (unsigned)wid * 1024u;
    const int aoff = lds_byte(wr * 64 + fr, fq * 8), boff = lds_byte(wc * 32 + fr, fq * 8);
#define PG8_SA(b, h) (((b) * 2 + (h)) * HTB)
#define PG8_SB(b, h) ((4 + (b) * 2 + (h)) * HTB)
#define PG8_STAGE(bufoff, gbase, voff) do { _Pragma("unroll") for (int _i = 0; _i < 2; ++_i) \
        __builtin_amdgcn_global_load_lds((const unsigned*)((const char*)(gbase) + (voff)[_i]), (LAS unsigned*)(lds + (bufoff) + ldsw + _i * 8192), 16, 0, 0); } while (0)
#define PG8_STAGE_A(bufoff, ubase, kb, h, nx) do { if constexpr (GATHER) { unsigned _v[2]; _v[0] = ((nx) ? gN[h][0] : gA[h][0]) + voffA[0]; _v[1] = ((nx) ? gN[h][1] : gA[h][1]) + voffA[1]; \
        PG8_STAGE(bufoff, (const char*)S.abase() + (kb), _v); } else { PG8_STAGE(bufoff, (ubase) + (size_t)(h) * hstepA + (kb), voffA); } } while (0)
#define PG8_LOADG(u, g) do { if constexpr (GATHER) { const int* _ip = S.idx(u); _Pragma("unroll") for (int _h = 0; _h < 2; ++_h) _Pragma("unroll") for (int _i = 0; _i < 2; ++_i) \
        g[_h][_i] = (unsigned)_ip[_h * HALF + rowA[_i]] * (unsigned)(lda * 2); } } while (0)
#define PG8_LDA(dst, b, h) do { _Pragma("unroll") for (int m = 0; m < 4; ++m) _Pragma("unroll") for (int k = 0; k < 2; ++k) dst[m][k] = *(const LAS bf16x8*)(lds + PG8_SA(b, h) + aoff + m * 2048 + k * 1024); } while (0)
#define PG8_LDB(dst, b, h) do { _Pragma("unroll") for (int n = 0; n < 2; ++n) _Pragma("unroll") for (int k = 0; k < 2; ++k) dst[n][k] = *(const LAS bf16x8*)(lds + PG8_SB(b, h) + boff + n * 2048 + k * 1024); } while (0)
#define PG8_MMA(ai, bj, At, Bt) do { __builtin_amdgcn_s_setprio(1); _Pragma("unroll") for (int m = 0; m < 4; ++m) _Pragma("unroll") for (int n = 0; n < 2; ++n) _Pragma("unroll") for (int k = 0; k < 2; ++k) \
        acc[ai][bj][m][n] = __builtin_amdgcn_mfma_f32_16x16x32_bf16(Bt[n][k], At[m][k], acc[ai][bj][m][n], 0, 0, 0); __builtin_amdgcn_s_setprio(0); } while (0)
#define PG8_WAIT_V(n) asm volatile("s_waitcnt vmcnt(" #n ")" ::: "memory")
#define PG8_WAIT_L(n) asm volatile("s_waitcnt lgkmcnt(" #n ")" ::: "memory")
#define PG8_BAR __builtin_amdgcn_s_barrier()
#define PG8_SCHED __builtin_amdgcn_sched_barrier(0)
    Unit cur, nxt; int ui = 0;
    if (!S.next(0, cur)) return;
    f32x4 acc[2][2][4][2];
#pragma unroll
    for (int a = 0; a < 2; ++a)
#pragma unroll
        for (int b = 0; b < 2; ++b)
#pragma unroll
            for (int m = 0; m < 4; ++m)
#pragma unroll
                for (int n = 0; n < 2; ++n) acc[a][b][m][n] = (f32x4){0.f, 0.f, 0.f, 0.f};
    bf16x8 At[4][2], B0[2][2], B1[2][2];
    const char* cA = GATHER ? (const char*)nullptr : S.aptr(cur); const char* cB = S.bptr(cur);
    PG8_LOADG(cur, gA);
    PG8_STAGE(PG8_SB(0, 0), cB, voffB); PG8_STAGE(PG8_SB(0, 1), cB + hstepB, voffB); PG8_STAGE_A(PG8_SA(0, 0), cA, 0, 0, false); PG8_STAGE_A(PG8_SA(0, 1), cA, 0, 1, false);
    if (wr == 1) PG8_BAR;
    PG8_WAIT_V(2); PG8_BAR;
    PG8_STAGE(PG8_SB(1, 0), cB + kstep, voffB); PG8_STAGE_A(PG8_SA(1, 0), cA, kstep, 0, false); PG8_STAGE(PG8_SB(1, 1), cB + hstepB + kstep, voffB);
    PG8_WAIT_V(6); PG8_BAR;
    for (;;) {
        const bool has_next = S.next(ui + 1, nxt);
        const char* nA = (has_next && !GATHER) ? S.aptr(nxt) : cA; const char* nB = has_next ? S.bptr(nxt) : cB;
        if (has_next) PG8_LOADG(nxt, gN); else { if constexpr (GATHER) {
#pragma unroll
            for (int h_ = 0; h_ < 2; ++h_) { gN[h_][0] = gA[h_][0]; gN[h_][1] = gA[h_][1]; } } }
        for (int t = 0; t < nt; t += 2) {
            const bool last = (t == nt - 2);
            const size_t k1 = (size_t)(t + 1) * kstep, k2 = last ? 0 : (size_t)(t + 2) * kstep, k3 = k2 + kstep;
            const char* a2 = last ? nA : cA; const char* b2 = last ? nB : cB + (size_t)(t + 2) * kstep;
            const char* b3 = b2 + kstep;
            PG8_LDB(B0, 0, 0); PG8_LDB(B1, 0, 1); PG8_SCHED; PG8_LDA(At, 0, 0); PG8_STAGE_A(PG8_SA(1, 1), cA, k1, 1, false);
            PG8_WAIT_V(8); PG8_WAIT_L(0); PG8_BAR; PG8_MMA(0, 0, At, B0); PG8_MMA(0, 1, At, B1); PG8_BAR; PG8_SCHED;
            PG8_LDA(At, 0, 1); PG8_STAGE(PG8_SB(0, 0), b2, voffB); PG8_STAGE(PG8_SB(0, 1), b2 + hstepB, voffB); PG8_STAGE_A(PG8_SA(0, 0), a2, k2, 0, last);
            PG8_WAIT_V(8); PG8_WAIT_L(0); PG8_BAR; PG8_MMA(1, 0, At, B0); PG8_MMA(1, 1, At, B1); PG8_BAR; PG8_SCHED;
            PG8_LDB(B0, 1, 0); PG8_LDB(B1, 1, 1); PG8_SCHED; PG8_LDA(At, 1, 0); PG8_STAGE_A(PG8_SA(0, 1), a2, k2, 1, last);
            PG8_WAIT_V(8); PG8_WAIT_L(0); PG8_BAR; PG8_MMA(0, 0, At, B0); PG8_MMA(0, 1, At, B1); PG8_BAR; PG8_SCHED;
            PG8_LDA(At, 1, 1); PG8_STAGE(PG8_SB(1, 0), b3, voffB); PG8_STAGE(PG8_SB(1, 1), b3 + hstepB, voffB); PG8_STAGE_A(PG8_SA(1, 0), a2, k3, 0, last);
            PG8_WAIT_V(8); PG8_WAIT_L(0); PG8_BAR; PG8_MMA(1, 0, At, B0); PG8_MMA(1, 1, At, B1); PG8_BAR; PG8_SCHED;
        }
        if (wr == 0) PG8_BAR;
        E(acc, cur, wr, wc, fr, fq);
        if (!has_next) break;
#pragma unroll
        for (int a = 0; a < 2; ++a)
#pragma unroll
            for (int b = 0; b < 2; ++b)
#pragma unroll
                for (int m = 0; m < 4; ++m)
#pragma unroll
                    for (int n = 0; n < 2; ++n) acc[a][b][m][n] = (f32x4){0.f, 0.f, 0.f, 0.f};
        cur = nxt; cA = nA; cB = nB; ++ui;
        if constexpr (GATHER) {
#pragma unroll
            for (int h_ = 0; h_ < 2; ++h_) { gA[h_][0] = gN[h_][0]; gA[h_][1] = gN[h_][1]; } }
        if (wr == 1) PG8_BAR;
    }
    PG8_WAIT_V(0);
    PG8_BAR;
#undef PG8_SA
#undef PG8_SB
#undef PG8_STAGE
#undef PG8_STAGE_A
#undef PG8_LOADG
#undef PG8_LDA
#undef PG8_LDB
#undef PG8_MMA
#undef PG8_WAIT_V
#undef PG8_WAIT_L
#undef PG8_BAR
#undef PG8_SCHED
}

struct SchedDense {
    static constexpr bool GATHER = false;
    __device__ __forceinline__ const char* abase() const { return nullptr; }
    __device__ __forceinline__ const int* idx(const Unit&) const { return nullptr; }
    const bf16_t* A; const bf16_t* Bt; int a_pm_stride, a_pn_stride, b_pn_stride;
    int nM, nN, nwg, extra, G, c;
    __device__ __forceinline__ bool next(int i, Unit& u) const {
        const int L = i * G + c; if (L >= nwg + extra) return false;
        if (L >= nwg) { const int x = L - nwg; u.pm = nM + (x >> 1); u.pn = 4 + (x & 1); return true; }
        int wgid = L; { const int q = nwg / NXCD, r = nwg % NXCD, xcd = wgid % NXCD, off = wgid / NXCD; wgid = (xcd < r ? xcd * (q + 1) : r * (q + 1) + (xcd - r) * q) + off; }
        const int nig = WGM * nN, gid = wgid / nig, fm = gid * WGM, gsz = (nM - fm) < WGM ? (nM - fm) : WGM;
        u.pm = fm + ((wgid % nig) % gsz); u.pn = (wgid % nig) / gsz; return true;
    }
    __device__ __forceinline__ const char* aptr(const Unit& u) const { return (const char*)(A + (size_t)u.pm * a_pm_stride + (size_t)u.pn * a_pn_stride); }
    __device__ __forceinline__ const char* bptr(const Unit& u) const { return (const char*)(Bt + (size_t)u.pn * b_pn_stride); }
};
template <bool GATHER_>
struct SchedMoE {
    static constexpr bool GATHER = GATHER_;
    const bf16_t* A; const bf16_t* Bt; const int* IDX; int nbt, nn, G, vcu;
    __device__ __forceinline__ bool next(int i, Unit& u) const {
        const int L = i * G + vcu, per_e = nbt * nn; if (L >= NE * per_e) return false;
        const int e = L / per_e, rem = L - e * per_e, bt = rem / nn, j = rem - bt * nn;
        u.pm = bt < 8 ? e * 8 + bt : 128 + e; u.pn = e * nn + j; return true;
    }
    __device__ __forceinline__ const char* aptr(const Unit& u) const { return (const char*)(A + (size_t)u.pm * 256 * D); }
    __device__ __forceinline__ const char* abase() const { return (const char*)A; }
    __device__ __forceinline__ const int* idx(const Unit& u) const { return IDX + (size_t)u.pm * 256; }
    __device__ __forceinline__ const char* bptr(const Unit& u) const { return (const char*)(Bt + (size_t)u.pn * 256 * D); }
};

struct EpiA {
    static constexpr bool PERM = true;
    bf16_t* O; int ldc; int act; bf16_t* VB; float* stats;
    __device__ __forceinline__ void operator()(const f32x4 (&acc)[2][2][4][2], const Unit& u, int wr, int wc, int fr, int fq) const {
        const int row0 = u.pm * BM + wr * 64 + fr, cl = wc * 32 + 8 * fq;
        const bool vtile = (VB != nullptr) && (u.pn == 5);
        const bool dostat = (stats != nullptr) && (u.pn >= 4);
#pragma unroll
        for (int ai = 0; ai < 2; ++ai)
#pragma unroll
            for (int m = 0; m < 4; ++m) {
                const int r = row0 + ai * HALF + m * 16;
                float s1 = 0.f, s2 = 0.f;
#pragma unroll
                for (int bj = 0; bj < 2; ++bj) {
                    f32x4 v0 = acc[ai][bj][m][0], v1 = acc[ai][bj][m][1];
                    if (act) {
#pragma unroll
                        for (int j = 0; j < 4; ++j) { v0[j] = gelu_tanh_f(v0[j]); v1[j] = gelu_tanh_f(v1[j]); } }
#pragma unroll
                    for (int j = 0; j < 4; ++j) { s1 += v0[j] + v1[j]; s2 += v0[j] * v0[j] + v1[j] * v1[j]; }
                    u32x4 w; w.x = cvt_pk_bf16(v0[0], v0[1]); w.y = cvt_pk_bf16(v0[2], v0[3]); w.z = cvt_pk_bf16(v1[0], v1[1]); w.w = cvt_pk_bf16(v1[2], v1[3]);
                    bf16_t* dst;
                    if (vtile) { int b, pos; if (r < T) { b = r >> 11; pos = CL + (r & (SEQ - 1)); } else { const int rc = r - T; b = rc >> 8; pos = rc & (CL - 1); }
                        dst = VB + ((size_t)(b * 2 + bj) * SKV + pos) * 128 + cl; }
                    else dst = O + (size_t)r * ldc + u.pn * BM + bj * HALF + cl;
                    *(u32x4*)dst = w; }
                if (dostat) {
                    s1 += swz_xor<16>(s1); s2 += swz_xor<16>(s2);
                    { auto rr = __builtin_amdgcn_permlane32_swap(__float_as_uint(s1), __float_as_uint(s1), false, false); s1 = __uint_as_float(rr[0]) + __uint_as_float(rr[1]); }
                    { auto rr = __builtin_amdgcn_permlane32_swap(__float_as_uint(s2), __float_as_uint(s2), false, false); s2 = __uint_as_float(rr[0]) + __uint_as_float(rr[1]); }
                    if (fq == 0) *(f32x2*)(stats + ((size_t)r * 16 + (u.pn - 4) * 4 + wc) * 2) = (f32x2){s1, s2}; } }
    }
};
struct EpiB {
    static constexpr bool PERM = true;
    const void* xs_lat; const void* xs_ctx; bf16_t* xd_lat; bf16_t* xd_ctx; const float* gt; const float* colscale; int src_f32; int dry;
    __device__ __forceinline__ void operator()(const f32x4 (&acc)[2][2][4][2], const Unit& u, int wr, int wc, int fr, int fq) const {
        const int row0 = u.pm * BM + wr * 64 + fr, col0 = u.pn * BM + wc * 32 + 8 * fq;
        const bool isctx = row0 >= T;
        const int mrow = isctx ? 8 : (row0 >> 11);
        const size_t rbase = isctx ? (size_t)T : 0;
        const void* xs = isctx ? xs_ctx : xs_lat; bf16_t* xd = isctx ? xd_ctx : xd_lat;
        f32x4 gv[2][2];
#pragma unroll
        for (int bj = 0; bj < 2; ++bj)
#pragma unroll
            for (int n = 0; n < 2; ++n) { const int c = col0 + bj * HALF + n * 4; gv[bj][n] = *(const f32x4*)(gt + (size_t)mrow * 6144 + c);
                if (colscale) gv[bj][n] = gv[bj][n] * *(const f32x4*)(colscale + c); }
#pragma unroll
        for (int ai = 0; ai < 2; ++ai)
#pragma unroll
            for (int m = 0; m < 4; ++m) { const size_t off = ((size_t)(row0 + ai * HALF + m * 16) - rbase) * D + col0;
#pragma unroll
                for (int bj = 0; bj < 2; ++bj) { f32x4 x0, x1;
                    if (src_f32) { x0 = *(const f32x4*)((const float*)xs + off + bj * HALF); x1 = *(const f32x4*)((const float*)xs + off + bj * HALF + 4); }
                    else { const u32x4 w = *(const u32x4*)((const bf16_t*)xs + off + bj * HALF); x0 = (f32x4){bf_lo(w.x), bf_hi(w.x), bf_lo(w.y), bf_hi(w.y)}; x1 = (f32x4){bf_lo(w.z), bf_hi(w.z), bf_lo(w.w), bf_hi(w.w)}; }
                    x0 = x0 + gv[bj][0] * acc[ai][bj][m][0]; x1 = x1 + gv[bj][1] * acc[ai][bj][m][1];
                    u32x4 o; o.x = cvt_pk_bf16(x0[0], x0[1]); o.y = cvt_pk_bf16(x0[2], x0[3]); o.z = cvt_pk_bf16(x1[0], x1[1]); o.w = cvt_pk_bf16(x1[2], x1[3]);
                    if (!dry) *(u32x4*)(xd + off + bj * HALF) = o; } }
    }
};
struct EpiC {
    static constexpr bool PERM = true;
    bf16_t* HID;
    __device__ __forceinline__ void operator()(const f32x4 (&acc)[2][2][4][2], const Unit& u, int wr, int wc, int fr, int fq) const {
        const int n8 = u.pn & 7, rl = wr * 64 + fr, cl = n8 * 128 + wc * 32 + 8 * fq;
        bf16_t* base = HID + (size_t)u.pm * 256 * D;
#pragma unroll
        for (int ai = 0; ai < 2; ++ai)
#pragma unroll
            for (int m = 0; m < 4; ++m) {
                float h[8];
#pragma unroll
                for (int n = 0; n < 2; ++n)
#pragma unroll
                    for (int j = 0; j < 4; ++j) { const float g = acc[ai][0][m][n][j], up = acc[ai][1][m][n][j]; h[n * 4 + j] = silu_f(g) * up; }
                u32x4 w; w.x = cvt_pk_bf16(h[0], h[1]); w.y = cvt_pk_bf16(h[2], h[3]); w.z = cvt_pk_bf16(h[4], h[5]); w.w = cvt_pk_bf16(h[6], h[7]);
                *(u32x4*)(base + (size_t)(rl + ai * HALF + m * 16) * D + cl) = w; }
    }
};
struct EpiD {
    static constexpr bool PERM = true;
    bf16_t* Y; const float* gate;
    __device__ __forceinline__ void operator()(const f32x4 (&acc)[2][2][4][2], const Unit& u, int wr, int wc, int fr, int fq) const {
        const int n4 = u.pn & 3, rl = wr * 64 + fr, cl = n4 * 256 + wc * 32 + 8 * fq;
        bf16_t* base = Y + (size_t)u.pm * 256 * D; const float* gp = gate + (size_t)u.pm * 256;
#pragma unroll
        for (int ai = 0; ai < 2; ++ai)
#pragma unroll
            for (int m = 0; m < 4; ++m) { const int r = rl + ai * HALF + m * 16; const float g = gp[r];
#pragma unroll
                for (int bj = 0; bj < 2; ++bj) { const f32x4 v0 = acc[ai][bj][m][0] * g, v1 = acc[ai][bj][m][1] * g;
                    u32x4 w; w.x = cvt_pk_bf16(v0[0], v0[1]); w.y = cvt_pk_bf16(v0[2], v0[3]); w.z = cvt_pk_bf16(v1[0], v1[1]); w.w = cvt_pk_bf16(v1[2], v1[3]);
                    *(u32x4*)(base + (size_t)r * D + bj * HALF + cl) = w; } }
    }
};
}

namespace att {
constexpr int QBLK = 32, KVBLK = 64;
constexpr float SCALE = 0.088388347648318440f;
constexpr float THR = 8.f;
constexpr int SHM_V = KVBLK * 128 * 2, SHM_K = KVBLK * 128 * 2;
#define KSWZ(row, colB) ((row) * 256 + ((colB) ^ (((row) & 7) << 4)))
#define SBAR() __builtin_amdgcn_sched_barrier(0)
__device__ __forceinline__ int crow(int r, int hi) { return (r & 3) + 8 * (r >> 2) + 4 * hi; }
__device__ __forceinline__ void partialSM(f32x16& p0, f32x16& p1, float& m_reg, float& mn, float& alpha) {
    constexpr float C = SCALE * 1.4426950408889634f;
    float pmax = p0[0];
#pragma unroll
    for (int r = 1; r < 16; ++r) pmax = fmaxf(pmax, p0[r]);
#pragma unroll
    for (int r = 0; r < 16; ++r) pmax = fmaxf(pmax, p1[r]);
    { auto rr = __builtin_amdgcn_permlane32_swap(__float_as_uint(pmax), __float_as_uint(pmax), false, false);
      pmax = fmaxf(__uint_as_float(rr[0]), __uint_as_float(rr[1])); }
    if (__builtin_expect(__all(pmax - m_reg <= THR / SCALE), 1)) { mn = m_reg; alpha = 1.f; }
    else { mn = fmaxf(m_reg, pmax); alpha = __builtin_amdgcn_exp2f((m_reg - mn) * C); m_reg = mn; }
    float mnC = -mn * C;
#pragma unroll
    for (int r = 0; r < 16; ++r) p0[r] = fmaf(p0[r], C, mnC);
#pragma unroll
    for (int r = 0; r < 16; ++r) p1[r] = fmaf(p1[r], C, mnC);
#pragma unroll
    for (int r = 0; r < 16; ++r) p0[r] = __builtin_amdgcn_exp2f(p0[r]);
}
__device__ __forceinline__ void finishSM(f32x16& p0, f32x16& p1, float alpha, float& l_reg, bf16x8& pa0, bf16x8& pa1, bf16x8& pa2, bf16x8& pa3) {
#pragma unroll
    for (int r = 0; r < 16; ++r) p1[r] = __builtin_amdgcn_exp2f(p1[r]);
    float ps = 0;
#pragma unroll
    for (int r = 0; r < 16; ++r) ps += p0[r];
#pragma unroll
    for (int r = 0; r < 16; ++r) ps += p1[r];
    { auto rr = __builtin_amdgcn_permlane32_swap(__float_as_uint(ps), __float_as_uint(ps), false, false);
      ps = __uint_as_float(rr[0]) + __uint_as_float(rr[1]); }
    l_reg = l_reg * alpha + ps;
#define PK4(P, BASE, OUT) do { unsigned a0 = cvt_pk_bf16(P[BASE + 0], P[BASE + 1]), a1 = cvt_pk_bf16(P[BASE + 2], P[BASE + 3]);   \
    unsigned b0 = cvt_pk_bf16(P[BASE + 4], P[BASE + 5]), b1 = cvt_pk_bf16(P[BASE + 6], P[BASE + 7]);                              \
    auto r0 = __builtin_amdgcn_permlane32_swap(a0, b0, false, false); auto r1 = __builtin_amdgcn_permlane32_swap(a1, b1, false, false); \
    u32x4 w = {r0[0], r1[0], r0[1], r1[1]}; OUT = *reinterpret_cast<bf16x8*>(&w); } while (0)
    PK4(p0, 0, pa0); PK4(p0, 8, pa1); PK4(p1, 0, pa2); PK4(p1, 8, pa3);
#undef PK4
}
__device__ __forceinline__ void qkt(f32x16& p0, f32x16& p1, const LAS unsigned char* Ks, const bf16x8* qr, int r32, int hi) {
    p0 = f32x16{}; p1 = f32x16{};
#pragma unroll
    for (int d0 = 0; d0 < 8; ++d0) { int cb = (d0 * 16 + hi * 8) * 2;
        bf16x8 b0 = *reinterpret_cast<const LAS bf16x8*>(Ks + KSWZ(r32, cb));
        bf16x8 b1 = *reinterpret_cast<const LAS bf16x8*>(Ks + KSWZ(32 + r32, cb));
        p0 = __builtin_amdgcn_mfma_f32_32x32x16_bf16(b0, qr[d0], p0, 0, 0, 0);
        p1 = __builtin_amdgcn_mfma_f32_32x32x16_bf16(b1, qr[d0], p1, 0, 0, 0); }
}
__device__ __forceinline__ int v_st(int k, int c) { const int kk = (k & ~0xC) | ((k & 4) << 1) | ((k & 8) >> 1); return ((kk >> 3) * 4 + (c >> 5)) * 512 + ((kk & 7) * 32 + (c & 31)) * 2; }
__device__ __forceinline__ int v_rd_base(int lane) { return ((lane & 3) << 3) | (((lane >> 2) & 3) << 6) | (((lane >> 4) & 1) << 5) | (((lane >> 5) & 1) << 8); }
constexpr int v_rd_off(int d0, int ks, int half) { return d0 * 512 + ks * 4096 + half * 2048; }
template <int OFF> __device__ __forceinline__ s16x4 tr_read(int vb) {
    s16x4 r; asm volatile("ds_read_b64_tr_b16 %0, %1 offset:%2" : "=&v"(r) : "v"(vb), "i"(OFF) : "memory"); return r;
}
template <int D0> __device__ __forceinline__ void pv_one(f32x16& od, int vb, bf16x8 pa0, bf16x8 pa1, bf16x8 pa2, bf16x8 pa3) {
    const s16x4 l0 = tr_read<v_rd_off(D0, 0, 0)>(vb), h0 = tr_read<v_rd_off(D0, 0, 1)>(vb), l1 = tr_read<v_rd_off(D0, 1, 0)>(vb), h1 = tr_read<v_rd_off(D0, 1, 1)>(vb);
    const s16x4 l2 = tr_read<v_rd_off(D0, 2, 0)>(vb), h2 = tr_read<v_rd_off(D0, 2, 1)>(vb), l3 = tr_read<v_rd_off(D0, 3, 0)>(vb), h3 = tr_read<v_rd_off(D0, 3, 1)>(vb);
    asm volatile("s_waitcnt lgkmcnt(0)" ::: "memory"); SBAR();
#define PK(L, H) (bf16x8){L[0], L[1], L[2], L[3], H[0], H[1], H[2], H[3]}
    od = __builtin_amdgcn_mfma_f32_32x32x16_bf16(pa0, PK(l0, h0), od, 0, 0, 0);
    od = __builtin_amdgcn_mfma_f32_32x32x16_bf16(pa1, PK(l1, h1), od, 0, 0, 0);
    od = __builtin_amdgcn_mfma_f32_32x32x16_bf16(pa2, PK(l2, h2), od, 0, 0, 0);
    od = __builtin_amdgcn_mfma_f32_32x32x16_bf16(pa3, PK(l3, h3), od, 0, 0, 0);
#undef PK
}
__device__ __forceinline__ void pv_d0(f32x16* o, int vb, bf16x8 pa0, bf16x8 pa1, bf16x8 pa2, bf16x8 pa3) {
    pv_one<0>(o[0], vb, pa0, pa1, pa2, pa3); pv_one<1>(o[1], vb, pa0, pa1, pa2, pa3); pv_one<2>(o[2], vb, pa0, pa1, pa2, pa3); pv_one<3>(o[3], vb, pa0, pa1, pa2, pa3);
}
template <int LDQ, int LDO>
__device__ __forceinline__ void attn_body(const bf16_t* __restrict__ Qb, const bf16_t* __restrict__ Kh, const bf16_t* __restrict__ Vh, bf16_t* __restrict__ Ob, int seq, LAS unsigned char* lds) {
    constexpr int LDK = 128;
    const int tid = opaque_tid(), wid = tid >> 6, lane = tid & 63, r32 = lane & 31, hi = lane >> 5;
    LAS unsigned char* V_lds = lds; LAS unsigned char* K_lds = lds + 2 * SHM_V;
    LAS float* ws = (LAS float*)(lds + 2 * SHM_V + 2 * SHM_K) + wid * 64; LAS float* li_l = ws; LAS float* al_l = ws + 32;
    float m_reg = -1e30f, l_reg = 0; f32x16 o[4] = {}; bf16x8 qr[8];
    const bf16_t* Qw = Qb + (long)(wid * QBLK + r32) * LDQ + hi * 8;
#pragma unroll
    for (int d0 = 0; d0 < 8; ++d0) qr[d0] = *reinterpret_cast<const bf16x8*>(Qw + d0 * 16);
    const int sr = tid >> 4, sc = (tid & 15) * 8, vst0 = v_st(sr, sc), vst1 = v_st(32 + sr, sc);
    const int vb0 = (int)(unsigned)(uintptr_t)V_lds + v_rd_base(lane);
    struct { bf16x8 vs0, vs1, ks0, ks1; } sr_[2];
#define SLOAD(i, k0) do { sr_[i].vs0 = *reinterpret_cast<const bf16x8*>(&Vh[(long)((k0) + sr) * LDK + sc]); sr_[i].vs1 = *reinterpret_cast<const bf16x8*>(&Vh[(long)((k0) + 32 + sr) * LDK + sc]); \
    sr_[i].ks0 = *reinterpret_cast<const bf16x8*>(&Kh[(long)((k0) + sr) * LDK + sc]); sr_[i].ks1 = *reinterpret_cast<const bf16x8*>(&Kh[(long)((k0) + 32 + sr) * LDK + sc]); } while (0)
#define SWRITE(b, i) do { *(LAS bf16x8*)(V_lds + (b) * SHM_V + vst0) = sr_[i].vs0;          \
    *(LAS bf16x8*)(V_lds + (b) * SHM_V + vst1) = sr_[i].vs1; int kc = sc * 2;               \
    *(LAS bf16x8*)(K_lds + (b) * SHM_K + KSWZ(sr, kc)) = sr_[i].ks0;                       \
    *(LAS bf16x8*)(K_lds + (b) * SHM_K + KSWZ(32 + sr, kc)) = sr_[i].ks1; } while (0)
#define SWAIT() asm volatile("s_waitcnt vmcnt(4)" ::: "memory")
#define RESC(a) do { if (__any((a) < 1.f)) { if (hi == 0) al_l[r32] = (a); asm volatile("s_waitcnt lgkmcnt(0)" ::: "memory"); \
    for (int d = 0; d < 4; ++d) for (int r = 0; r < 16; ++r) o[d][r] *= al_l[crow(r, hi)]; } } while (0)
    f32x16 pA0, pA1, pB0, pB1; float mnA, mnB, alA, alB; bf16x8 pa0, pa1, pa2, pa3; const int NT = seq / KVBLK;
    constexpr int SE = 0, SO = 1;
    SLOAD(SE, 0); asm volatile("s_waitcnt vmcnt(0)" ::: "memory"); SWRITE(0, SE); __syncthreads();
    qkt(pA0, pA1, K_lds, qr, r32, hi); partialSM(pA0, pA1, m_reg, mnA, alA);
    SLOAD(SO, KVBLK); if (2 < NT) SLOAD(SE, 2 * KVBLK);
    SWAIT(); SWRITE(1, SO); __syncthreads();
    for (int j = 1; j + 1 < NT; j += 2) {
        SBAR(); qkt(pB0, pB1, K_lds + SHM_K, qr, r32, hi);
        finishSM(pA0, pA1, alA, l_reg, pa0, pa1, pa2, pa3); SBAR();
        SLOAD(SO, (j + 2) * KVBLK); SBAR();
        pv_d0(o, vb0, pa0, pa1, pa2, pa3); partialSM(pB0, pB1, m_reg, mnB, alB);
        __syncthreads(); SWAIT(); SWRITE(0, SE);
        RESC(alB); __syncthreads();
        SBAR(); qkt(pA0, pA1, K_lds, qr, r32, hi);
        finishSM(pB0, pB1, alB, l_reg, pa0, pa1, pa2, pa3); SBAR();
        if (j + 3 < NT) SLOAD(SE, (j + 3) * KVBLK); SBAR();
        pv_d0(o, vb0 + (int)SHM_V, pa0, pa1, pa2, pa3); partialSM(pA0, pA1, m_reg, mnA, alA);
        __syncthreads(); SWAIT(); SWRITE(1, SO);
        RESC(alA); __syncthreads();
    }
    SBAR(); qkt(pB0, pB1, K_lds + SHM_K, qr, r32, hi);
    finishSM(pA0, pA1, alA, l_reg, pa0, pa1, pa2, pa3); SBAR();
    pv_d0(o, vb0, pa0, pa1, pa2, pa3); partialSM(pB0, pB1, m_reg, mnB, alB);
    __syncthreads(); RESC(alB);
    finishSM(pB0, pB1, alB, l_reg, pa0, pa1, pa2, pa3); SBAR();
    pv_d0(o, vb0 + (int)SHM_V, pa0, pa1, pa2, pa3);
    if (hi == 0) li_l[r32] = l_reg; asm volatile("s_waitcnt lgkmcnt(0)" ::: "memory");
    float rli[16];
#pragma unroll
    for (int r = 0; r < 16; ++r) rli[r] = __builtin_amdgcn_rcpf(li_l[crow(r, hi)]);
    bf16_t* Ow = Ob + (long)(wid * QBLK) * LDO;
#pragma unroll
    for (int r = 0; r < 16; ++r) { int orow = crow(r, hi);
#pragma unroll
        for (int d0 = 0; d0 < 4; ++d0) Ow[(long)orow * LDO + d0 * 32 + r32] = f2bf(o[d0][r] * rli[r]); }
#undef SLOAD
#undef SWRITE
#undef SWAIT
#undef RESC
}
}

struct KArgs { const float* in[24]; float* out; unsigned char* ws; int ph_lo, ph_hi; };
enum { I_X = 0, I_C, I_CTX, I_CCTX, I_MODW, I_MODB, I_N1G, I_N2G, I_RW, I_WG, I_WU, I_WD, I_GWIN, I_GVG, I_GSW, I_GSB, I_GWOUT, I_AWIN, I_AQG, I_AKG, I_AWOUT, I_PWIN, I_PWG, I_PSC };

struct Fr {
    volatile LAS unsigned long long* PT;
    int G, bx, vcu;
    __device__ __forceinline__ unsigned long long ldp(int i) const { const unsigned long long v = PT[i];
        const unsigned lo = __builtin_amdgcn_readfirstlane((unsigned)v), hi = __builtin_amdgcn_readfirstlane((unsigned)(v >> 32)); return ((unsigned long long)hi << 32) | lo; }
    __device__ __forceinline__ const float* in(int i) const { return (const float*)(GAS const float*)ldp(i); }
    __device__ __forceinline__ float* out() const { return (float*)(GAS float*)ldp(24); }
    __device__ __forceinline__ unsigned char* ws() const { return (unsigned char*)(GAS unsigned char*)ldp(25); }
};
#define WSP(F, T_, OFF) ((T_*)((F).ws() + (OFF)))

constexpr int CV_NT_EXP = 4 * 16 * 3 * 64, CV_NT_ALL = CV_NT_EXP + 256 + 128 + 96 + 64 + 64 + 16;
constexpr int CV_L1_FIRST = 3072;
constexpr int CV_Q_GA = 7, CV_N_GA = 192, CV_Q_GB = 5, CV_N_GB = 224, CV_Q_UP = 7, CV_N_UP = 128, CV_Q_DN = 7, CV_N_DN = 192;
constexpr int CV_B_GA = CV_L1_FIRST, CV_B_GB = CV_B_GA + CV_Q_GA * CV_N_GA, CV_B_UP = CV_B_GB + CV_Q_GB * CV_N_GB, CV_B_DN = CV_B_UP + CV_Q_UP * CV_N_UP;
constexpr int CV_DEFER = CV_Q_GA * CV_N_GA + CV_Q_GB * CV_N_GB + CV_Q_UP * CV_N_UP + CV_Q_DN * CV_N_DN;
constexpr int CV_Q_GA1 = 7, CV_N_GA1 = 112, CV_Q_TK = 3, CV_N_TK = 128;
constexpr int CV_DEFER2 = CV_Q_GA1 * CV_N_GA1 + 2 * CV_Q_TK * CV_N_TK;
constexpr int CV_B_GA1 = CV_NT_EXP - CV_DEFER2, CV_B_TK1 = CV_B_GA1 + CV_Q_GA1 * CV_N_GA1, CV_B_TK2 = CV_B_TK1 + CV_Q_TK * CV_N_TK;
static_assert(CV_L1_FIRST + CV_DEFER <= CV_B_GA1 && CV_B_GA1 >= 3 * 3072, "deferred tiles: layers 1-3 (first range), layer 3 only (second range)");
__device__ __forceinline__ void convert_tiles(const Fr& F, LAS unsigned char* lds, const int j0, const int jstride, const int jend, const int skip_lo, const int skip_n, const int skip2_lo = 0x7fffffff, const int skip2_n = 0) {
    const int tid = opaque_tid(), wave = __builtin_amdgcn_readfirstlane(tid >> 6);
    unsigned char* const ws_ = F.ws();
    const int c4 = tid & 63, rr = tid >> 3, ch = tid & 7;
    f32x4 ld[8];
    const float* W = nullptr; int N = 0, k0 = 0, n0 = 0, ldt = 0, gu = 0; bf16_t* dst = nullptr;
#define P0_DECODE(jj) do { int r_ = (jj); r_ = r_ < skip_lo ? r_ : r_ + skip_n; r_ = r_ < skip2_lo ? r_ : r_ + skip2_n; \
        if (r_ < CV_NT_EXP) { const int mat = r_ >> 6, sub = r_ & 63, l = mat / 48, rem = mat % 48, e = rem / 3, which = rem % 3; k0 = (sub >> 2) * 64; n0 = (sub & 3) * 256; N = 1024; ldt = 1024; \
            if (which < 2) { W = F.in(which == 0 ? I_WG : I_WU) + (size_t)(l * 16 + e) * 1024 * 1024; dst = (bf16_t*)(ws_ + WS_WUP) + (size_t)l * 16 * 2048 * 1024 + (size_t)(e * 8 * 256 + which * 128) * 1024; gu = 1; } \
            else { W = F.in(I_WD) + (size_t)(l * 16 + e) * 1024 * 1024; dst = (bf16_t*)(ws_ + WS_WDN) + (size_t)l * 16 * 1024 * 1024 + (size_t)(e * 1024) * 1024; gu = 0; } } \
        else { r_ -= CV_NT_EXP; gu = 0; \
            if (r_ < 256) { const int j = r_ >> 7, sub = r_ & 127; k0 = (sub >> 3) * 64; n0 = (sub & 7) * 256; N = 2048; ldt = 1024; W = F.in(I_GWIN) + (size_t)j * 1024 * 2048; dst = (bf16_t*)(ws_ + WS_WGIN) + (size_t)j * 2048 * 1024; } \
            else if ((r_ -= 256) < 128) { const int j = r_ >> 6, sub = r_ & 63; k0 = (sub >> 2) * 64; n0 = (sub & 3) * 256; N = 1024; ldt = 1024; W = F.in(I_GWOUT) + (size_t)j * 1024 * 1024; dst = (bf16_t*)(ws_ + WS_WGOUT) + (size_t)j * 1024 * 1024; } \
            else if ((r_ -= 128) < 96) { k0 = (r_ / 6) * 64; n0 = (r_ % 6) * 256; N = 1536; ldt = 1024; W = F.in(I_AWIN); dst = (bf16_t*)(ws_ + WS_WAIN); } \
            else if ((r_ -= 96) < 64) { k0 = (r_ >> 2) * 64; n0 = (r_ & 3) * 256; N = 1024; ldt = 1024; W = F.in(I_AWOUT); dst = (bf16_t*)(ws_ + WS_WAOUT); } \
            else if ((r_ -= 64) < 64) { k0 = (r_ >> 2) * 64; n0 = (r_ & 3) * 256; N = 1024; ldt = 1024; W = F.in(I_PWIN); dst = (bf16_t*)(ws_ + WS_WPIN); } \
            else { r_ -= 64; const int g = r_ >> 2; k0 = (r_ & 3) * 64; n0 = 0; N = 256; ldt = 256; W = F.in(I_PWG) + (size_t)g * 256 * 256; dst = (bf16_t*)(ws_ + WS_WPGRP) + (size_t)g * 256 * 256; } } } while (0)
#define P0_LOAD() do { const float* wp_ = W + (size_t)(k0 + wave * 8) * N + n0 + c4 * 4; _Pragma("unroll") for (int s_ = 0; s_ < 8; ++s_) ld[s_] = __builtin_nontemporal_load((const f32x4*)(wp_ + (size_t)s_ * N)); } while (0)
    int it = j0, buf = 0;
    if (it < jend) { P0_DECODE(it); P0_LOAD(); }
#pragma nounroll
    for (; it < jend; it += jstride) {
        LAS unsigned char* Lt = lds + buf * 32768;
#pragma unroll
        for (int j = 0; j < 4; ++j) { const int n = c4 * 4 + j;
            u32x4 o; o.x = cvt_pk_bf16(ld[0][j], ld[1][j]); o.y = cvt_pk_bf16(ld[2][j], ld[3][j]); o.z = cvt_pk_bf16(ld[4][j], ld[5][j]); o.w = cvt_pk_bf16(ld[6][j], ld[7][j]);
            *(LAS u32x4*)(Lt + n * 128 + ((wave ^ ((n >> 2) & 7)) << 4)) = o; }
        bf16_t* const cdst = dst; const int ck0 = k0, cn0 = n0, cldt = ldt, cgu = gu;
        __syncthreads();
        if (it + jstride < jend) { P0_DECODE(it + jstride); P0_LOAD(); }
#pragma unroll
        for (int s_ = 0; s_ < 4; ++s_) { const int n = s_ * 64 + rr; const u32x4 o = *(const LAS u32x4*)(Lt + n * 128 + ((ch ^ ((n >> 2) & 7)) << 4));
            const int nn = cn0 + n; const size_t row = cgu ? (size_t)((nn >> 7) * 256 + (nn & 127)) : (size_t)nn;
            __builtin_nontemporal_store(o, (u32x4*)(cdst + row * cldt + ck0 + ch * 8)); }
        buf ^= 1;
    }
#undef P0_DECODE
#undef P0_LOAD
}
__device__ __forceinline__ void convert_in_idle_slot(const Fr& F, LAS unsigned char* lds, const int c, const int total, const int base, const int quota, const int nidle) {
    const int rounds = (total + F.G - 1) / F.G, first_idle = total - (rounds - 1) * F.G;
    if (F.G != 256 || c < first_idle || c - first_idle >= nidle) return;
    __syncthreads();
    const int j0 = base + (c - first_idle) * quota;
    convert_tiles(F, lds, j0, 1, j0 + quota, 0x7fffffff, 0);
}

__device__ __forceinline__ void p0_phase(const Fr& F, LAS unsigned char* lds, const int part) {
    const int tid = opaque_tid(), lane = tid & 63, wave = __builtin_amdgcn_readfirstlane(tid >> 6), gw = F.bx * NWAVES + wave, NGW = F.G * NWAVES; (void)gw; (void)NGW; (void)lane; (void)wave;
    unsigned char* const ws_ = F.ws();
    float* const modv_ = (float*)(ws_ + WS_MODV);
    bf16_t* const wsw_ = (bf16_t*)(ws_ + WS_WSW);
    bf16_t* const wgin_ = (bf16_t*)(ws_ + WS_WGIN);
    bf16_t* const wgout_ = (bf16_t*)(ws_ + WS_WGOUT);
    bf16_t* const wain_ = (bf16_t*)(ws_ + WS_WAIN);
    bf16_t* const waout_ = (bf16_t*)(ws_ + WS_WAOUT);
    bf16_t* const wpin_ = (bf16_t*)(ws_ + WS_WPIN);
    bf16_t* const wpgrp_ = (bf16_t*)(ws_ + WS_WPGRP);
    bf16_t* const wup_ = (bf16_t*)(ws_ + WS_WUP);
    bf16_t* const wdn_ = (bf16_t*)(ws_ + WS_WDN);
    const float* const in_I_AWIN = F.in(I_AWIN);
    const float* const in_I_AWOUT = F.in(I_AWOUT);
    const float* const in_I_C = F.in(I_C);
    const float* const in_I_CCTX = F.in(I_CCTX);
    const float* const in_I_GSW = F.in(I_GSW);
    const float* const in_I_GWIN = F.in(I_GWIN);
    const float* const in_I_GWOUT = F.in(I_GWOUT);
    const float* const in_I_MODB = F.in(I_MODB);
    const float* const in_I_MODW = F.in(I_MODW);
    const float* const in_I_PWG = F.in(I_PWG);
    const float* const in_I_PWIN = F.in(I_PWIN);
    const float* const in_I_WD = F.in(I_WD);
    const float* const in_I_WG = F.in(I_WG);
    const float* const in_I_WU = F.in(I_WU);

    if (part == 0) {
    LAS float* sact = (LAS float*)lds;
    LAS float* red = (LAS float*)(lds + 49152);
    for (int idx = tid; idx < 9 * 1024; idx += NTHR) { const int r = idx >> 10, k = idx & 1023; const float v = r < 8 ? in_I_C[r * 1024 + k] : in_I_CCTX[k]; sact[k * 12 + r] = silu_f(v); }
    __syncthreads();
    for (int chunk = F.bx; chunk < 768; chunk += F.G) {
        const int layer = chunk / 192, n0 = (chunk % 192) * 32, k0 = wave * 128 + (lane >> 5);
        const float* wp = in_I_MODW + (size_t)layer * 1024 * 6144 + (size_t)k0 * 6144 + n0 + (lane & 31);
        float acc[9];
#pragma unroll
        for (int r = 0; r < 9; ++r) acc[r] = 0.f;
#pragma nounroll
        for (int hb = 0; hb < 4; ++hb) {
            float w[16];
#pragma unroll
            for (int i = 0; i < 16; ++i) w[i] = __builtin_nontemporal_load(wp + (size_t)(2 * (hb * 16 + i)) * 6144);
#pragma unroll
            for (int i = 0; i < 16; ++i) { const LAS float* sa = sact + (k0 + 2 * (hb * 16 + i)) * 12;
                const f32x4 s0 = *(const LAS f32x4*)sa, s1 = *(const LAS f32x4*)(sa + 4); const float s8 = sa[8];
                acc[0] += s0[0] * w[i]; acc[1] += s0[1] * w[i]; acc[2] += s0[2] * w[i]; acc[3] += s0[3] * w[i];
                acc[4] += s1[0] * w[i]; acc[5] += s1[1] * w[i]; acc[6] += s1[2] * w[i]; acc[7] += s1[3] * w[i]; acc[8] += s8 * w[i];
                __builtin_amdgcn_sched_barrier(0); }
        }
#pragma unroll
        for (int r = 0; r < 9; ++r) { acc[r] += xor32(acc[r], lane >= 32); if (lane < 32) red[(wave * 9 + r) * 32 + lane] = acc[r]; }
        __syncthreads();
        for (int idx = tid; idx < 288; idx += NTHR) { const int r = idx >> 5, l = idx & 31; float sacc = 0.f;
#pragma unroll
            for (int w = 0; w < 8; ++w) sacc += red[(w * 9 + r) * 32 + l];
            const int nn = n0 + l; modv_[(size_t)(layer * 9 + r) * 6144 + nn] = sacc + in_I_MODB[layer * 6144 + nn]; }
        __syncthreads();
    }
    return;
    }
    { const int defer = (F.G == 256) ? CV_DEFER : 0, defer2 = (F.G == 256) ? CV_DEFER2 : 0; convert_tiles(F, lds, F.bx, F.G, CV_NT_ALL - defer - defer2, CV_L1_FIRST, defer, CV_B_GA1, defer2); }
    __syncthreads();
    for (int i4 = F.bx * NTHR + tid; i4 < 2 * 8 * 128 * 128 / 4; i4 += F.G * NTHR) { const f32x4 v = *(const f32x4*)(in_I_GSW + (size_t)i4 * 4);
        u32x2 o; o.x = cvt_pk_bf16(v[0], v[1]); o.y = cvt_pk_bf16(v[2], v[3]); *(u32x2*)(wsw_ + (size_t)i4 * 4) = o; }
}

template <int R>
__device__ __forceinline__ void norm_rows(const int r0, const bool isctx, const int lane, const int layer, const int which, const int comb, const int dry, float* vst,
                                          const int xmode  , const void* xsrc, void* xdst, const float* modv_, const float* ng, const int* slot_, const bf16_t* YEXP_, bf16_t* H_, float* aff_, int* slotw_, const LAS unsigned char* rwl) {
    const int rc0 = r0 - T; const int b = isctx ? (rc0 >> 8) : (r0 >> 11); const int mrow = isctx ? 8 : b;
    f32x4 v[R][4];
#pragma unroll
    for (int q = 0; q < R; ++q)
#pragma unroll
        for (int j = 0; j < 4; ++j) {
            if (xmode == 0) v[q][j] = *(const f32x4*)((const float*)xsrc + (size_t)q * D + lane * 4 + 256 * j);
            else { const u32x2 w = *(const u32x2*)((const bf16_t*)xsrc + (size_t)q * D + lane * 4 + 256 * j); v[q][j] = (f32x4){bf_lo(w.x), bf_hi(w.x), bf_lo(w.y), bf_hi(w.y)}; } }
#ifndef NO_NR_COMB
    if (comb >= 0) {
        int sl[R];
#pragma unroll
        for (int q = 0; q < R; ++q) sl[q] = slot_[(size_t)(r0 + q) * 16 + (lane & 15)];
        f32x4 a[R][4];
#pragma unroll
        for (int q = 0; q < R; ++q)
#pragma unroll
            for (int j = 0; j < 4; ++j) a[q][j] = (f32x4){0.f, 0.f, 0.f, 0.f};
#pragma nounroll
        for (int e = 0; e < 16; ++e) {
            u32x2 w[R][4];
#pragma unroll
            for (int q = 0; q < R; ++q) {
                const int s = __builtin_amdgcn_readlane(sl[q], e);
                if (s >= 0) {
                    const int tile = isctx ? 128 + e : e * 8 + b, rin = isctx ? (((rc0 + q) >> 8) * 32 + s) : s;
                    const bf16_t* yp = YEXP_ + ((size_t)tile * 256 + rin) * D + lane * 4;
#pragma unroll
                    for (int j = 0; j < 4; ++j) w[q][j] = __builtin_nontemporal_load((const u32x2*)(yp + 256 * j));
                } else {
#pragma unroll
                    for (int j = 0; j < 4; ++j) w[q][j] = (u32x2){0u, 0u};
                }
            }
#pragma unroll
            for (int q = 0; q < R; ++q)
#pragma unroll
                for (int j = 0; j < 4; ++j) { a[q][j][0] += bf_lo(w[q][j].x); a[q][j][1] += bf_hi(w[q][j].x); a[q][j][2] += bf_lo(w[q][j].y); a[q][j][3] += bf_hi(w[q][j].y); }
        }
        const float* g2 = modv_ + (size_t)(comb * 9 + mrow) * 6144 + 5 * 1024 + lane * 4;
#pragma unroll
        for (int j = 0; j < 4; ++j) { const f32x4 gg = *(const f32x4*)(g2 + 256 * j);
#pragma unroll
            for (int q = 0; q < R; ++q) { v[q][j] = v[q][j] + gg * a[q][j];
                if (!dry) { if (xmode == 2) __builtin_nontemporal_store(v[q][j], (f32x4*)((float*)xdst + (size_t)q * D + lane * 4 + 256 * j));
                            else { u32x2 o; o.x = cvt_pk_bf16(v[q][j][0], v[q][j][1]); o.y = cvt_pk_bf16(v[q][j][2], v[q][j][3]); *(u32x2*)((bf16_t*)xdst + (size_t)q * D + lane * 4 + 256 * j) = o; } } } }
    }
#endif
    if (which == 0) return;
    float rstd[R];
#pragma unroll
    for (int q = 0; q < R; ++q) { float ss = 0.f;
#pragma unroll
        for (int j = 0; j < 4; ++j) ss += (v[q][j][0] * v[q][j][0] + v[q][j][1] * v[q][j][1]) + (v[q][j][2] * v[q][j][2] + v[q][j][3] * v[q][j][3]);
        rstd[q] = ss; }
#pragma unroll
    for (int q = 0; q < R; ++q) rstd[q] = rsqrtf(wave_sum(rstd[q]) * (1.f / D) + EPS);
    const float* mv = modv_ + (size_t)(layer * 9 + mrow) * 6144 + (which == 2 ? 3 * 1024 : 0) + lane * 4;
#pragma unroll
    for (int j = 0; j < 4; ++j) { const f32x4 g = *(const f32x4*)(ng + lane * 4 + 256 * j), sh = *(const f32x4*)(mv + 256 * j), sc = *(const f32x4*)(mv + 1024 + 256 * j);
#pragma unroll
        for (int q = 0; q < R; ++q) { v[q][j] = (v[q][j] * rstd[q] * g) * (sc + 1.f) + sh;
            u32x2 o; o.x = cvt_pk_bf16(v[q][j][0], v[q][j][1]); o.y = cvt_pk_bf16(v[q][j][2], v[q][j][3]); *(u32x2*)(H_ + (size_t)(r0 + q) * D + lane * 4 + 256 * j) = o; } }
#ifndef NO_NR_ROUTER
    if (which == 2 && dry != 2) {
        f32x2 p2[R][8];
#pragma unroll
        for (int q = 0; q < R; ++q)
#pragma unroll
            for (int e = 0; e < 8; ++e) p2[q][e] = (f32x2){0.f, 0.f};
#pragma unroll
        for (int j = 0; j < 4; ++j)
#pragma unroll
            for (int i = 0; i < 4; ++i) { const int col = lane * 4 + 256 * j + i; const LAS unsigned char* rp = rwl + col * 64 + (col >> 2) * 16;
                f32x2 w2[8];
#pragma unroll
                for (int e4 = 0; e4 < 4; ++e4) { const f32x4 w = *(const LAS f32x4*)(rp + e4 * 16); w2[2 * e4] = (f32x2){w[0], w[1]}; w2[2 * e4 + 1] = (f32x2){w[2], w[3]}; }
#pragma unroll
                for (int q = 0; q < R; ++q) { const float hv = v[q][j][i]; const f32x2 h2 = (f32x2){hv, hv};
#pragma unroll
                    for (int e = 0; e < 8; ++e) p2[q][e] = __builtin_elementwise_fma(h2, w2[e], p2[q][e]); }
                __builtin_amdgcn_sched_barrier(0); }
        float p[R][16];
#pragma unroll
        for (int q = 0; q < R; ++q)
#pragma unroll
            for (int e = 0; e < 8; ++e) { p[q][2 * e] = p2[q][e].x; p[q][2 * e + 1] = p2[q][e].y; asm volatile("" : "+v"(p[q][2 * e]), "+v"(p[q][2 * e + 1])); }
#pragma unroll
        for (int q = 0; q < R; ++q) {
            const bool b5 = (lane & 32) != 0, b4 = (lane & 16) != 0, b3 = (lane & 8) != 0, b2 = (lane & 4) != 0;
            float k8[8], k4[4], k2[2];
#pragma unroll
            for (int e = 0; e < 8; ++e) { const float send = b5 ? p[q][e] : p[q][e + 8]; k8[e] = (b5 ? p[q][e + 8] : p[q][e]) + xor32(send, b5); }
#pragma unroll
            for (int e = 0; e < 4; ++e) { const float send = b4 ? k8[e] : k8[e + 4]; k4[e] = (b4 ? k8[e + 4] : k8[e]) + swz_xor<16>(send); }
#pragma unroll
            for (int e = 0; e < 2; ++e) { const float send = b3 ? k4[e] : k4[e + 2]; k2[e] = (b3 ? k4[e + 2] : k4[e]) + swz_xor<8>(send); }
            float lg; { const float send = b2 ? k2[0] : k2[1]; lg = (b2 ? k2[1] : k2[0]) + swz_xor<4>(send); }
            lg += swz_xor<2>(lg); lg += swz_xor<1>(lg);
            const float mx = wave_max(lg), ex = __expf(lg - mx), sum = wave_sum(ex) * 0.25f;
            const int eid = (lane >> 2) & 15;
            if ((lane & 3) == 0) aff_[(size_t)(r0 + q) * 16 + eid] = ex / sum;
            if (lane < 16) slotw_[(size_t)(r0 + q) * 16 + lane] = -1;
        }
    }
#endif
}
__device__ __forceinline__ void norm_phase(const Fr& F, LAS unsigned char* lds, int layer, int which, int nrows, int comb, int xmode, const void* xlat, const void* xctx, void* xlat_d, void* xctx_d, int dry = 0, bool zero_vst = false) {
    const size_t esz_s = xmode == 0 ? 4 : 2, esz_d = xmode == 2 ? 4 : 2;
    const int tid = opaque_tid(), lane = tid & 63, wave = __builtin_amdgcn_readfirstlane(tid >> 6), gw = F.bx * NWAVES + wave, NGW = F.G * NWAVES;
    unsigned char* const ws_ = F.ws();
    float* const modv_ = (float*)(ws_ + WS_MODV); float* const aff_ = (float*)(ws_ + WS_AFF); int* const slot_ = (int*)(ws_ + WS_SLOT);
    bf16_t* const H_ = (bf16_t*)(ws_ + WS_H); bf16_t* const YEXP_ = (bf16_t*)(ws_ + WS_YEXP);
    float* const vst = zero_vst ? (float*)(ws_ + WS_VST) : nullptr;
    LAS unsigned char* rwl = lds;
    if (which == 2) {
        const float* rw = F.in(I_RW) + (size_t)layer * 1024 * 16;
        for (int idx = tid; idx < 4096; idx += NTHR) { const int col = idx >> 2, e4 = idx & 3; *(LAS f32x4*)(rwl + col * 64 + (col >> 2) * 16 + e4 * 16) = *(const f32x4*)(rw + col * 16 + e4 * 4); }
        __syncthreads();
    }
    const float* ng = F.in(which == 2 ? I_N2G : I_N1G) + (size_t)layer * 1024;
#pragma nounroll
    for (int g4 = gw; g4 < T / 4; g4 += NGW) { const int r0 = g4 * 4;
        norm_rows<4>(r0, false, lane, layer, which, comb, dry, vst, xmode, (const char*)xlat + (size_t)r0 * D * esz_s, (char*)xlat_d + (size_t)r0 * D * esz_d, modv_, ng, slot_, YEXP_, H_, aff_, slot_, rwl); }
    if (nrows > T) {
#pragma nounroll
        for (int r = T + gw; r < nrows; r += NGW)
            norm_rows<1>(r, true, lane, layer, which, comb, dry, vst, xmode, (const char*)xctx + (size_t)(r - T) * D * esz_s, (char*)xctx_d + (size_t)(r - T) * D * esz_d, modv_, ng, slot_, YEXP_, H_, aff_, slot_, rwl);
    }
}

__device__ __forceinline__ void topk_phase(const Fr& F, LAS unsigned char* lds, bool with_ctx) {
    const int tid = opaque_tid();
    unsigned char* const ws_ = F.ws();
    float* const aff_ = (float*)(ws_ + WS_AFF); int* const slot_ = (int*)(ws_ + WS_SLOT); float* const gate_ = (float*)(ws_ + WS_GATE);
    int* const idx_ = (int*)(ws_ + WS_IDX);
    LAS unsigned* vals = (LAS unsigned*)lds;
    LAS int* hist = (LAS int*)(lds + 8192);
    LAS int* suf = (LAS int*)(lds + 9216);
    LAS int* scan = (LAS int*)(lds + 12288);
    volatile LAS unsigned* sv = (volatile LAS unsigned*)(lds + 16384);
    const int nunits = with_ctx ? 256 : 128;
    for (int u = F.bx; u < nunits; u += F.G) {
        const bool isctx = u >= 128; const int uu = isctx ? u - 128 : u, e = uu >> 3, b = uu & 7;
        const int N = isctx ? CL : SEQ, cap = isctx ? CCAP : CAP, row0 = isctx ? T + b * CL : b * SEQ;
        const int tile = isctx ? 128 + e : uu, rbase = isctx ? b * 32 : 0;
        unsigned v[4]; const bool act = tid * 4 < N;
#pragma unroll
        for (int k = 0; k < 4; ++k) v[k] = act ? __float_as_uint(aff_[(size_t)(row0 + tid * 4 + k) * 16 + e]) : 0u;
        if (tid == 0) { sv[0] = 0u; sv[1] = (unsigned)cap; }
        unsigned prefix = 0u, mask = 0u; int need = cap;
#pragma nounroll
        for (int shift = 24; shift >= 0; shift -= 8) {
            if (tid < 256) hist[tid] = 0;
            __syncthreads();
            if (act) {
#pragma unroll
                for (int k = 0; k < 4; ++k) if ((v[k] & mask) == prefix) __hip_atomic_fetch_add(&hist[(v[k] >> shift) & 255u], 1, __ATOMIC_RELAXED, __HIP_MEMORY_SCOPE_WORKGROUP);
            }
            __syncthreads();
            if (tid < 256) { int sacc = 0; for (int d = 255; d >= tid; --d) sacc += hist[d]; suf[tid] = sacc; }
            if (tid == 0) suf[256] = 0;
            __syncthreads();
            if (tid < 256) { const int s0 = suf[tid], s1 = suf[tid + 1]; if (s0 >= need && s1 < need) { sv[0] = prefix | ((unsigned)tid << shift); sv[1] = (unsigned)(need - s1); } }
            __syncthreads();
            prefix = sv[0]; need = (int)sv[1]; mask |= 255u << shift;
        }
        int cg = 0, ce = 0;
#pragma unroll
        for (int k = 0; k < 4; ++k) { cg += (act && v[k] > prefix) ? 1 : 0; ce += (act && v[k] == prefix) ? 1 : 0; }
        int cur = 0; scan[tid] = cg | (ce << 16);
        __syncthreads();
#pragma nounroll
        for (int off = 1; off < NTHR; off <<= 1) {
            const int x = scan[cur * NTHR + tid] + (tid >= off ? scan[cur * NTHR + tid - off] : 0);
            scan[(cur ^ 1) * NTHR + tid] = x; cur ^= 1;
            __syncthreads();
        }
        const int incl = scan[cur * NTHR + tid]; int gb = (incl & 0xffff) - cg, eb = (incl >> 16) - ce;
        if (act) {
#pragma unroll
            for (int k = 0; k < 4; ++k) {
                const bool isg = v[k] > prefix, ise = v[k] == prefix;
                if (isg || (ise && eb < need)) { const int sl = gb + (eb < need ? eb : need); const int row = row0 + tid * 4 + k;
                    idx_[(size_t)tile * 256 + rbase + sl] = row; gate_[(size_t)tile * 256 + rbase + sl] = __uint_as_float(v[k]); slot_[(size_t)row * 16 + e] = sl; }
                gb += isg ? 1 : 0; eb += ise ? 1 : 0;
            }
        }
        __syncthreads();
    }
}

template <int OFF> __device__ __forceinline__ s16x4 sp_tr_read(int vb) {
    s16x4 r; asm volatile("ds_read_b64_tr_b16 %0, %1 offset:%2" : "=&v"(r) : "v"(vb), "i"(OFF) : "memory"); return r;
}
template <int KS> __device__ __forceinline__ void sp_kstep(f32x16& acc0, f32x16& acc1, const LAS bf16_t* Ap, int vb) {
    constexpr int LDB2 = 320;
    const bf16x8 a = *(const LAS bf16x8*)(Ap + KS * 16);
    const s16x4 l0 = sp_tr_read<(16 * KS) * LDB2>(vb), h0 = sp_tr_read<(16 * KS + 4) * LDB2>(vb);
    const s16x4 l1 = sp_tr_read<(16 * KS) * LDB2 + 64>(vb), h1 = sp_tr_read<(16 * KS + 4) * LDB2 + 64>(vb);
    asm volatile("s_waitcnt lgkmcnt(0)" ::: "memory"); __builtin_amdgcn_sched_barrier(0);
    const bf16x8 b0 = (bf16x8){l0[0], l0[1], l0[2], l0[3], h0[0], h0[1], h0[2], h0[3]};
    const bf16x8 b1 = (bf16x8){l1[0], l1[1], l1[2], l1[3], h1[0], h1[1], h1[2], h1[3]};
    acc0 = __builtin_amdgcn_mfma_f32_32x32x16_bf16(b0, a, acc0, 0, 0, 0);
    acc1 = __builtin_amdgcn_mfma_f32_32x32x16_bf16(b1, a, acc1, 0, 0, 0);
}
__device__ __forceinline__ void spatial_phase(const Fr& F, LAS unsigned char* lds, int j, int nchunks) {
    const int tid = opaque_tid(), lane = tid & 63, wave = __builtin_amdgcn_readfirstlane(tid >> 6);
    unsigned char* const ws_ = F.ws();
    const bf16_t* const wsw_ = (const bf16_t*)(ws_ + WS_WSW); const bf16_t* const S1_ = (const bf16_t*)(ws_ + WS_S1); bf16_t* const S2_ = (bf16_t*)(ws_ + WS_S2);
    const float* const vst_ = (const float*)(ws_ + WS_VST);
    constexpr int LDA = 136, LDB = 160;
    LAS bf16_t* As = (LAS bf16_t*)(lds + 1024);
    LAS bf16_t* Bs = (LAS bf16_t*)(lds + 1024 + 128 * LDA * 2);
    const float* vg = F.in(I_GVG) + (size_t)j * 1024; const float* sb = F.in(I_GSB) + (size_t)j * 8 * 128;
    const bf16_t* sw = wsw_ + (size_t)j * 8 * 128 * 128;
    const int r32 = lane & 31, hi = lane >> 5;
    const int pw = (wave >> 1) * 32, dw = (wave & 1) * 64;
    const LAS bf16_t* Ap = As + (pw + r32) * LDA + hi * 8;
    const int vb = (int)(unsigned)(uintptr_t)Bs + (8 * hi + ((lane & 15) >> 2)) * (LDB * 2) + (dw + 16 * ((lane >> 4) & 1) + 4 * (lane & 3)) * 2;
    const int p = pw + r32, c0 = dw + 4 * hi, nunits = nchunks * 8;
    u32x4 sa[4], wv[4]; u32x2 un[2][4]; f32x2 st[4];
#define SP_LOAD(U) do { const int _r0 = ((U) >> 3) * 128, _g = (U) & 7; _Pragma("unroll") for (int i = 0; i < 4; ++i) { const int id = tid + NTHR * i; \
            sa[i] = *(const u32x4*)(sw + (size_t)_g * 128 * 128 + (id >> 4) * 128 + (id & 15) * 8); \
            wv[i] = *(const u32x4*)(S1_ + (size_t)(_r0 + (id >> 4)) * 2048 + 1024 + _g * 128 + (id & 15) * 8); \
            st[i] = *(const f32x2*)(vst_ + ((size_t)(_r0 + (id >> 4)) * 16 + (id & 15)) * 2); } \
            _Pragma("unroll") for (int t = 0; t < 4; ++t) { un[0][t] = *(const u32x2*)(S1_ + (size_t)(_r0 + p) * 2048 + _g * 128 + c0 + 8 * t); un[1][t] = *(const u32x2*)(S1_ + (size_t)(_r0 + p) * 2048 + _g * 128 + c0 + 32 + 8 * t); } } while (0)
    int U = F.vcu;
    if (U < nunits) SP_LOAD(U);
#pragma nounroll
    for (; U < nunits; U += F.G) {
        const int r0 = (U >> 3) * 128, g = U & 7;
#pragma unroll
        for (int i = 0; i < 4; ++i) { const int id = tid + NTHR * i; *(LAS u32x4*)(As + (id >> 4) * LDA + (id & 15) * 8) = sa[i]; }
        { const int dc = tid & 15; const f32x4 g0 = *(const f32x4*)(vg + g * 128 + dc * 8), g1 = *(const f32x4*)(vg + g * 128 + dc * 8 + 4);
#pragma unroll
          for (int i = 0; i < 4; ++i) { const int id = tid + NTHR * i, q = id >> 4;
            float s1 = st[i].x, s2 = st[i].y;
            s1 += swz_xor<1>(s1); s2 += swz_xor<1>(s2); s1 += swz_xor<2>(s1); s2 += swz_xor<2>(s2); s1 += swz_xor<4>(s1); s2 += swz_xor<4>(s2); s1 += swz_xor<8>(s1); s2 += swz_xor<8>(s2);
            const float mean = s1 * (1.f / 1024.f), rstd = rsqrtf(fmaxf(s2 * (1.f / 1024.f) - mean * mean, 0.f) + EPS);
            float x[8];
#pragma unroll
            for (int k = 0; k < 4; ++k) { x[2 * k] = (bf_lo(wv[i][k]) - mean) * rstd; x[2 * k + 1] = (bf_hi(wv[i][k]) - mean) * rstd; }
            u32x4 o; o.x = cvt_pk_bf16(x[0] * g0[0], x[1] * g0[1]); o.y = cvt_pk_bf16(x[2] * g0[2], x[3] * g0[3]); o.z = cvt_pk_bf16(x[4] * g1[0], x[5] * g1[1]); o.w = cvt_pk_bf16(x[6] * g1[2], x[7] * g1[3]);
            *(LAS u32x4*)(Bs + q * LDB + dc * 8) = o; } }
        u32x2 uu[2][4];
#pragma unroll
        for (int t = 0; t < 4; ++t) { uu[0][t] = un[0][t]; uu[1][t] = un[1][t]; }
        const float bias = sb[g * 128 + p];
        __syncthreads();
        if (U + F.G < nunits) SP_LOAD(U + F.G);
        f32x16 acc0 = {}, acc1 = {};
        sp_kstep<0>(acc0, acc1, Ap, vb); sp_kstep<1>(acc0, acc1, Ap, vb); sp_kstep<2>(acc0, acc1, Ap, vb); sp_kstep<3>(acc0, acc1, Ap, vb);
        sp_kstep<4>(acc0, acc1, Ap, vb); sp_kstep<5>(acc0, acc1, Ap, vb); sp_kstep<6>(acc0, acc1, Ap, vb); sp_kstep<7>(acc0, acc1, Ap, vb);
        const size_t ro = (size_t)(r0 + p);
#pragma unroll
        for (int t = 0; t < 4; ++t) {
            u32x2 o0, o1;
            o0.x = cvt_pk_bf16((acc0[4 * t] + bias) * bf_lo(uu[0][t].x), (acc0[4 * t + 1] + bias) * bf_hi(uu[0][t].x)); o0.y = cvt_pk_bf16((acc0[4 * t + 2] + bias) * bf_lo(uu[0][t].y), (acc0[4 * t + 3] + bias) * bf_hi(uu[0][t].y));
            o1.x = cvt_pk_bf16((acc1[4 * t] + bias) * bf_lo(uu[1][t].x), (acc1[4 * t + 1] + bias) * bf_hi(uu[1][t].x)); o1.y = cvt_pk_bf16((acc1[4 * t + 2] + bias) * bf_lo(uu[1][t].y), (acc1[4 * t + 3] + bias) * bf_hi(uu[1][t].y));
            *(u32x2*)(S2_ + ro * D + g * 128 + c0 + 8 * t) = o0; *(u32x2*)(S2_ + ro * D + g * 128 + c0 + 32 + 8 * t) = o1; }
        __syncthreads();
    }
#undef SP_LOAD
}

__device__ __forceinline__ void qknorm_phase(const Fr& F) {
    const int tid = opaque_tid(), lane = tid & 63, wave = __builtin_amdgcn_readfirstlane(tid >> 6), gw = F.bx * NWAVES + wave, NGW = F.G * NWAVES;
    unsigned char* const ws_ = F.ws();
    const bf16_t* const S1_ = (const bf16_t*)(ws_ + WS_S1); bf16_t* const QB_ = (bf16_t*)(ws_ + WS_QB); bf16_t* const KB_ = (bf16_t*)(ws_ + WS_KB);
    const float* qg = F.in(I_AQG); const float* kg = F.in(I_AKG);
    const int hsel = lane >> 5, l5 = lane & 31;
    const f32x2 qg0 = *(const f32x2*)(qg + 2 * l5), qg1 = *(const f32x2*)(qg + 64 + 2 * l5), kg0 = *(const f32x2*)(kg + 2 * l5), kg1 = *(const f32x2*)(kg + 64 + 2 * l5);
    const float inv0 = exp2f(-(float)((2 * l5) & 31) * (13.287712379549449f / 32.f)), inv1 = exp2f(-(float)((2 * l5 + 1) & 31) * (13.287712379549449f / 32.f));
#pragma nounroll
    for (int g2 = gw; g2 < T / 2; g2 += NGW) {
        const int r0 = g2 * 2, b = r0 >> 11;
        unsigned u0[2][5], u1[2][5];
#pragma unroll
        for (int q = 0; q < 2; ++q)
#pragma unroll
            for (int ps = 0; ps < 5; ++ps) { const int hh = 2 * ps + hsel; const bf16_t* src = S1_ + (size_t)(r0 + q) * 2048 + (hh < 8 ? hh * 128 : 1024 + (hh - 8) * 128) + 2 * l5;
                u0[q][ps] = *(const unsigned*)src; u1[q][ps] = *(const unsigned*)(src + 64); }
#pragma unroll
        for (int q = 0; q < 2; ++q) {
            const int s = (r0 + q) & (SEQ - 1); const float pos = (float)(l5 < 16 ? (s >> 6) : (s & 63));
            float c0, s0, c1, s1; __sincosf(pos * inv0, &s0, &c0); __sincosf(pos * inv1, &s1, &c1);
            { c0 = cosf(pos * inv0); s0 = sinf(pos * inv0); c1 = cosf(pos * inv1); s1 = sinf(pos * inv1); }
#pragma unroll
            for (int ps = 0; ps < 5; ++ps) { const int hh = 2 * ps + hsel; const bool isk = ps == 4;
                float a0 = bf_lo(u0[q][ps]), a1 = bf_hi(u0[q][ps]), e0 = bf_lo(u1[q][ps]), e1 = bf_hi(u1[q][ps]);
                const float rs = rsqrtf(half_sum((a0 * a0 + a1 * a1) + (e0 * e0 + e1 * e1)) * (1.f / 128.f) + EPS);
                const f32x2 ga = isk ? kg0 : qg0, gb = isk ? kg1 : qg1;
                a0 *= rs * ga.x; a1 *= rs * ga.y; e0 *= rs * gb.x; e1 *= rs * gb.y;
                const float o10 = a0 * c0 - e0 * s0, o11 = a1 * c1 - e1 * s1, o20 = a0 * s0 + e0 * c0, o21 = a1 * s1 + e1 * c1;
                bf16_t* dst = isk ? KB_ + ((size_t)(b * 2 + (hh - 8)) * SKV + CL + s) * 128 + 2 * l5 : QB_ + (size_t)(r0 + q) * D + hh * 128 + 2 * l5;
                *(unsigned*)dst = cvt_pk_bf16(o10, o11); *(unsigned*)(dst + 64) = cvt_pk_bf16(o20, o21); }
        }
    }
#pragma nounroll
    for (int rc = gw; rc < TC; rc += NGW) {
        const int b = rc >> 8, s = rc & (CL - 1);
        const bf16_t* src = S1_ + (size_t)(T + rc) * 2048 + 1024 + hsel * 128 + 2 * l5;
        const unsigned u0 = *(const unsigned*)src, u1 = *(const unsigned*)(src + 64);
        float a0 = bf_lo(u0), a1 = bf_hi(u0), e0 = bf_lo(u1), e1 = bf_hi(u1);
        const float rs = rsqrtf(half_sum((a0 * a0 + a1 * a1) + (e0 * e0 + e1 * e1)) * (1.f / 128.f) + EPS);
        bf16_t* dst = KB_ + ((size_t)(b * 2 + hsel) * SKV + s) * 128 + 2 * l5;
        *(unsigned*)dst = cvt_pk_bf16(a0 * rs * kg0.x, a1 * rs * kg0.y); *(unsigned*)(dst + 64) = cvt_pk_bf16(e0 * rs * kg1.x, e1 * rs * kg1.y);
    }
}

template <int W> __device__ __forceinline__ void pool_item(const bf16_t* zb  , int s, bf16_t* dst) {
    constexpr int half = W / 2;
    u32x4 w[W];
#pragma unroll
    for (int k = 0; k < W; ++k) { int t = s - half + k; t = t < 0 ? 0 : (t > SEQ - 1 ? SEQ - 1 : t); w[k] = *(const u32x4*)(zb + (size_t)t * 2048); }
    float acc[8];
#pragma unroll
    for (int c = 0; c < 8; ++c) acc[c] = 0.f;
#pragma unroll
    for (int k = 0; k < W; ++k) { const int t = s - half + k; const float m = (t >= 0 && t < SEQ) ? 1.f : 0.f;
#pragma unroll
        for (int c = 0; c < 4; ++c) { acc[2 * c] += m * bf_lo(w[k][c]); acc[2 * c + 1] += m * bf_hi(w[k][c]); } }
    const int lo = s - half < 0 ? 0 : s - half, hi = s + half - 1 > SEQ - 1 ? SEQ - 1 : s + half - 1; const float ic = 1.f / (float)(hi - lo + 1);
    const u32x4 zc = w[half];
    float o[8];
#pragma unroll
    for (int c = 0; c < 4; ++c) { o[2 * c] = acc[2 * c] * ic - bf_lo(zc[c]); o[2 * c + 1] = acc[2 * c + 1] * ic - bf_hi(zc[c]); }
    u32x4 ov; ov.x = cvt_pk_bf16(o[0], o[1]); ov.y = cvt_pk_bf16(o[2], o[3]); ov.z = cvt_pk_bf16(o[4], o[5]); ov.w = cvt_pk_bf16(o[6], o[7]);
    *(u32x4*)dst = ov;
}
__device__ __forceinline__ void pool_phase(const Fr& F) {
    const int tid = opaque_tid(), lane = tid & 63, wave = __builtin_amdgcn_readfirstlane(tid >> 6);
    unsigned char* const ws_ = F.ws();
    const bf16_t* const S1_ = (const bf16_t*)(ws_ + WS_S1); bf16_t* const S2_ = (bf16_t*)(ws_ + WS_S2);
    const int gi = wave & 3, c8 = gi * 32 + (lane & 31), rsub = (wave >> 2) * 2 + (lane >> 5);
#pragma nounroll
    for (int r4 = F.bx; r4 < T / 4; r4 += F.G) {
        const int r = r4 * 4 + rsub, s = r & (SEQ - 1);
        const bf16_t* zb = S1_ + (size_t)(r - s) * 2048 + c8 * 8; bf16_t* dst = S2_ + (size_t)r * D + c8 * 8;
        if (gi == 0) pool_item<2>(zb, s, dst); else if (gi == 1) pool_item<4>(zb, s, dst); else if (gi == 2) pool_item<8>(zb, s, dst); else pool_item<16>(zb, s, dst);
    }
}

__global__ void __launch_bounds__(NTHR, 2) fwd_kernel(KArgs args) {
    extern __shared__ __attribute__((aligned(16))) unsigned char lds_raw[];
    LAS unsigned char* lds = (LAS unsigned char*)lds_raw;
    volatile LAS unsigned* MISC = (volatile LAS unsigned*)(lds + MISC_OFF);
    Fr F;
    F.PT = (volatile LAS unsigned long long*)(lds + MISC_OFF + 256);
    F.G = gridDim.x; F.bx = blockIdx.x; F.vcu = (F.G % 8 == 0) ? (F.bx % 8) * (F.G / 8) + F.bx / 8 : F.bx;
    { const int t0 = threadIdx.x;
      if (t0 < 64) MISC[t0] = 0u;
      if (t0 < 24) F.PT[t0] = (unsigned long long)args.in[t0];
      if (t0 == 24) F.PT[24] = (unsigned long long)args.out;
      if (t0 == 25) F.PT[25] = (unsigned long long)args.ws; }
    __syncthreads();
    XcdBarrier bar = xcd_barrier_post((unsigned*)(F.ws() + WS_CTL), MISC + 8);
    const int lo = args.ph_lo, hi = args.ph_hi;
    int p = 0;
#define RUN(...) RUNC(31, __VA_ARGS__)
#define RUNC(cls, ...) do { if (lo <= p && p < hi) { _Pragma("nounroll") for (int rep_ = 0; rep_ < 1 + (int)((REPEAT_MASK >> (cls)) & 1u); ++rep_) { __VA_ARGS__; if (REPEAT_MASK) __syncthreads(); } if (p + 1 < hi) xcd_barrier(bar); } ++p; } while (0)

#ifndef NO_P0
    RUNC(0, p0_phase(F, lds, 0));
    RUN({
        norm_phase(F, lds, 0, 1, TT, -1, 0, F.in(I_X), F.in(I_CTX), nullptr, nullptr, 0, true);
        __syncthreads();
        p0_phase(F, lds, 1);
    });
#endif
#pragma nounroll
    for (int L = 0; L < 4; ++L) {
        const int kind = L % 3, jm = L / 3;
        const bool with_ctx = (L == 0);
        if (L > 0) RUNC(1, {
            bf16_t* xo = WSP(F, bf16_t, WS_XB); bf16_t* xc = WSP(F, bf16_t, WS_XC);
#ifndef NO_NORM
            norm_phase(F, lds, L, 1, (L <= 1) ? TT : T, L - 1, 1, xo, xc, xo, xc, (REPEAT_MASK >> 1) & 1u ? (rep_ == 0) : 0, kind == 0);
#endif
        });
        RUNC(2, {
            unsigned char* ws = F.ws();
            pg8::SchedDense S; S.A = (bf16_t*)(ws + WS_H); S.G = F.G; S.c = F.bx; S.a_pn_stride = 0; S.a_pm_stride = 256 * D; S.b_pn_stride = 256 * D; S.extra = 0;
            pg8::EpiA E; E.O = (bf16_t*)(ws + WS_S1); E.ldc = 2048; E.act = 0; E.VB = nullptr; E.stats = nullptr;
            if (kind == 0) { S.Bt = (bf16_t*)(ws + WS_WGIN) + (size_t)jm * 2048 * 1024; S.nM = with_ctx ? 72 : 64; S.nN = 8; E.act = 1; E.stats = (float*)(ws + WS_VST); }
            else if (kind == 1) { S.Bt = (bf16_t*)(ws + WS_WAIN); S.nM = 64; S.nN = 6; S.extra = 16; E.VB = (bf16_t*)(ws + WS_VB); }
            else { S.Bt = (bf16_t*)(ws + WS_WPIN); S.nM = 64; S.nN = 4; }
            S.nwg = S.nM * S.nN;
            #ifndef NO_GA
            pg8::gemm_phase<pg8::EpiA, pg8::SchedDense>(lds, D, D, D, S, E);
#endif
            if (L == 0) convert_in_idle_slot(F, lds, F.bx, S.nwg + S.extra, CV_B_GA, CV_Q_GA, CV_N_GA);
            if (L == 1) convert_in_idle_slot(F, lds, F.bx, S.nwg + S.extra, CV_B_GA1, CV_Q_GA1, CV_N_GA1);
        });
        if (kind == 0) {
#ifndef NO_SPAT
            RUNC(3, spatial_phase(F, lds, jm, with_ctx ? 144 : 128));
#endif
        }
        else if (kind == 1) {
#ifndef NO_QKN
            RUNC(4, qknorm_phase(F));
#endif
            RUNC(5, {
                unsigned char* ws = F.ws();
                const bf16_t* QB = (const bf16_t*)(ws + WS_QB); const bf16_t* KB = (const bf16_t*)(ws + WS_KB); const bf16_t* VB = (const bf16_t*)(ws + WS_VB); bf16_t* S2 = (bf16_t*)(ws + WS_S2);
                for (int i = 0; i * F.G + F.vcu < 512; ++i) { const int Lu = i * F.G + F.vcu, bk = Lu >> 5, w = Lu & 31, b = bk >> 1, kvh = bk & 1, h = kvh * 4 + (w >> 3), qb = w & 7;
#ifndef NO_ATT
                    att::attn_body<D, D>(QB + ((size_t)(b * SEQ + qb * 256)) * D + h * 128, KB + (size_t)bk * SKV * 128, VB + (size_t)bk * SKV * 128,
                                         S2 + ((size_t)(b * SEQ + qb * 256)) * D + h * 128, SKV, lds);
#endif
                    __syncthreads(); }
            });
        } else {
#ifndef NO_POOL
            RUNC(6, pool_phase(F));
#endif
        }
        RUNC(7, {
            unsigned char* ws = F.ws();
            pg8::SchedDense S; S.A = (bf16_t*)(ws + WS_S2); S.G = F.G; S.c = F.bx; S.a_pm_stride = 256 * D; S.a_pn_stride = 0; S.b_pn_stride = 256 * D; S.extra = 0; S.nN = 4; S.nM = 64;
            pg8::EpiB E; E.xd_lat = (bf16_t*)(ws + WS_XB); E.xd_ctx = (bf16_t*)(ws + WS_XC); E.src_f32 = (L == 0); E.xs_lat = (L == 0) ? (const void*)F.in(I_X) : (const void*)E.xd_lat; E.xs_ctx = (L == 0) ? (const void*)F.in(I_CTX) : (const void*)E.xd_ctx;
            E.gt = (const float*)(ws + WS_MODV) + (size_t)L * 9 * 6144 + 2 * 1024; E.colscale = nullptr; E.dry = (REPEAT_MASK >> 7) & 1u ? (rep_ == 0) : 0;
            int K = D, ldb = D;
            if (kind == 0) { S.Bt = (bf16_t*)(ws + WS_WGOUT) + (size_t)jm * 1024 * 1024; S.nM = with_ctx ? 72 : 64; }
            else if (kind == 1) { S.Bt = (bf16_t*)(ws + WS_WAOUT); }
            else { S.Bt = (bf16_t*)(ws + WS_WPGRP); S.a_pn_stride = 256; S.b_pn_stride = 256 * 256; K = 256; ldb = 256; E.colscale = F.in(I_PSC); }
            S.nwg = S.nM * S.nN;
            #ifndef NO_GB
            pg8::gemm_phase<pg8::EpiB, pg8::SchedDense>(lds, K, D, ldb, S, E);
#endif
            if (L == 0) convert_in_idle_slot(F, lds, F.bx, S.nwg + S.extra, CV_B_GB, CV_Q_GB, CV_N_GB);
        });
        RUNC(8, {
            bf16_t* xo = WSP(F, bf16_t, WS_XB); bf16_t* xc = WSP(F, bf16_t, WS_XC);
#ifndef NO_NORM
            norm_phase(F, lds, L, 2, with_ctx ? TT : T, -1, 1, xo, xc, xo, xc, ((REPEAT_MASK >> 13) & 1u) && rep_ == 0 ? 2 : 0);
#endif
        });
#ifndef NO_TOPK
        RUNC(9, { topk_phase(F, lds, with_ctx); if (L == 1 || L == 2) convert_in_idle_slot(F, lds, F.bx, 128, L == 1 ? CV_B_TK1 : CV_B_TK2, CV_Q_TK, CV_N_TK); });
#endif
        RUNC(10, {
            unsigned char* ws = F.ws();
            pg8::SchedMoE<true> S; S.A = (bf16_t*)(ws + WS_H); S.IDX = (const int*)(ws + WS_IDX); S.Bt = (bf16_t*)(ws + WS_WUP) + (size_t)L * 16 * 2048 * 1024; S.nbt = with_ctx ? 9 : 8; S.nn = 8; S.G = F.G; S.vcu = F.vcu;
            pg8::EpiC E; E.HID = (bf16_t*)(ws + WS_HID);
            #ifndef NO_GC
            pg8::gemm_phase<pg8::EpiC, pg8::SchedMoE<true>>(lds, D, D, D, S, E);
#endif
            if (L == 0) convert_in_idle_slot(F, lds, F.vcu, NE * S.nbt * S.nn, CV_B_UP, CV_Q_UP, CV_N_UP);
        });
        RUNC(11, {
            unsigned char* ws = F.ws();
            pg8::SchedMoE<false> S; S.A = (bf16_t*)(ws + WS_HID); S.IDX = nullptr; S.Bt = (bf16_t*)(ws + WS_WDN) + (size_t)L * 16 * 1024 * 1024; S.nbt = with_ctx ? 9 : 8; S.nn = 4; S.G = F.G; S.vcu = F.vcu;
            pg8::EpiD E; E.Y = (bf16_t*)(ws + WS_YEXP); E.gate = (const float*)(ws + WS_GATE);
            #ifndef NO_GD
            pg8::gemm_phase<pg8::EpiD, pg8::SchedMoE<false>>(lds, D, D, D, S, E);
#endif
            if (L == 0) convert_in_idle_slot(F, lds, F.vcu, NE * S.nbt * S.nn, CV_B_DN, CV_Q_DN, CV_N_DN);
        });
    }
    RUN({
        bf16_t* xb = WSP(F, bf16_t, WS_XB);
#ifndef NO_NORM
        norm_phase(F, lds, 3, 0, T, 3, 2, xb, nullptr, F.out(), nullptr);
#endif
    });
#undef RUN
#undef RUNC
}

constexpr int N_PHASES = 1 + 8 + 9 + 8 + 8 + 1;

extern "C" void kernel_launch(void* const* d_in, const int* in_sizes, int n_in, void* d_out, int out_size, void* d_ws, size_t ws_size, hipStream_t stream) {
    static int grid = 0;
    if (grid == 0) {
        if (n_in != 24 || out_size != T * D || ws_size < WS_END) { fprintf(stderr, "kernel_launch: unexpected shapes (n_in %d out %d ws %zu need %zu)\n", n_in, out_size, ws_size, (size_t)WS_END); grid = -1; return; }
        int dev = 0, cus = 0;
        if (hipGetDevice(&dev) != hipSuccess || hipDeviceGetAttribute(&cus, hipDeviceAttributeMultiprocessorCount, dev) != hipSuccess) { grid = -1; return; }
        if (hipFuncSetAttribute((const void*)fwd_kernel, hipFuncAttributeMaxDynamicSharedMemorySize, LDS_BYTES) != hipSuccess) { fprintf(stderr, "kernel_launch: hipFuncSetAttribute failed\n"); grid = -1; return; }
        (void)hipGetLastError();
        grid = cus;
    }
    if (grid < 0) return;
    (void)hipMemsetAsync((char*)d_ws + WS_CTL, 0, CTL_BYTES, stream);
    KArgs a{};
    for (int i = 0; i < 24; ++i) a.in[i] = (const float*)d_in[i];
    a.out = (float*)d_out; a.ws = (unsigned char*)d_ws;
#if MK_PER_PHASE
    for (int k = 0; k < N_PHASES; ++k) { a.ph_lo = k; a.ph_hi = k + 1; hipLaunchKernelGGL(fwd_kernel, dim3(grid), dim3(NTHR), LDS_BYTES, stream, a); }
#else
    a.ph_lo = 0; a.ph_hi = N_PHASES;
    hipLaunchKernelGGL(fwd_kernel, dim3(grid), dim3(NTHR), LDS_BYTES, stream, a);
#endif
    const hipError_t le = hipPeekAtLastError();
    if (le != hipSuccess) fprintf(stderr, "kernel_launch: launch failed: %s\n", hipGetErrorName(le));
}
```

```cpp
#include <hip/hip_runtime.h>
#include <cstdio>
#include <cstdint>

#ifndef REPEAT_MASK
#define REPEAT_MASK 0u
#endif
#ifndef MK_PER_PHASE
#define MK_PER_PHASE 0
#endif

#define LAS __attribute__((address_space(3)))
#define GAS __attribute__((address_space(1)))
typedef unsigned short bf16_t;
typedef short bf16x8 __attribute__((ext_vector_type(8)));
typedef short s16x4 __attribute__((ext_vector_type(4)));
typedef float f32x2 __attribute__((ext_vector_type(2)));
typedef float f32x4 __attribute__((ext_vector_type(4)));
typedef float f32x16 __attribute__((ext_vector_type(16)));
typedef unsigned u32x2 __attribute__((ext_vector_type(2)));
typedef unsigned u32x4 __attribute__((ext_vector_type(4)));

constexpr int D = 1024, NB = 8, SEQ = 2048, T = NB * SEQ, CL = 256, TC = NB * CL, TT = T + TC, NE = 16, CAP = 256, CCAP = 32, NTILE = 144;
constexpr int SKV = CL + SEQ;
constexpr float EPS = 1e-6f;
constexpr int NWAVES = 8, NTHR = 512;

constexpr size_t al256(size_t x) { return (x + 255) / 256 * 256; }
constexpr size_t WS_CTL   = 0;
constexpr size_t CTL_BYTES = 65536;
constexpr size_t WS_MODV  = WS_CTL + CTL_BYTES;
constexpr size_t WS_AFF   = WS_MODV + al256((size_t)4 * 9 * 6144 * 4);
constexpr size_t WS_SLOT  = WS_AFF + (size_t)TT * 16 * 4;
constexpr size_t WS_GATE  = WS_SLOT + (size_t)TT * 16 * 4;
constexpr size_t WS_VST   = WS_GATE + (size_t)NTILE * 256 * 4;
constexpr size_t WS_WSW   = WS_VST + (size_t)TT * 16 * 2 * 4;
constexpr size_t WS_WGIN  = WS_WSW + (size_t)2 * 8 * 128 * 128 * 2;
constexpr size_t WS_WGOUT = WS_WGIN + (size_t)2 * 2048 * 1024 * 2;
constexpr size_t WS_WAIN  = WS_WGOUT + (size_t)2 * 1024 * 1024 * 2;
constexpr size_t WS_WAOUT = WS_WAIN + (size_t)1536 * 1024 * 2;
constexpr size_t WS_WPIN  = WS_WAOUT + (size_t)1024 * 1024 * 2;
constexpr size_t WS_WPGRP = WS_WPIN + (size_t)1024 * 1024 * 2;
constexpr size_t WS_WUP   = WS_WPGRP + (size_t)4 * 256 * 256 * 2;
constexpr size_t WS_WDN   = WS_WUP + (size_t)4 * 16 * 2048 * 1024 * 2;
constexpr size_t WS_XC    = WS_WDN + (size_t)4 * 16 * 1024 * 1024 * 2;
constexpr size_t WS_XB    = WS_XC + (size_t)TC * D * 2;
constexpr size_t WS_H     = WS_XB + (size_t)T * D * 2;
constexpr size_t WS_S1    = WS_H + (size_t)TT * D * 2;
constexpr size_t WS_S2    = WS_S1 + (size_t)TT * 2048 * 2;
constexpr size_t WS_QB    = WS_S2 + (size_t)TT * D * 2;
constexpr size_t WS_KB    = WS_QB + (size_t)T * D * 2;
constexpr size_t WS_VB    = WS_KB + (size_t)NB * 2 * SKV * 128 * 2;
constexpr size_t WS_IDX   = WS_VB + (size_t)NB * 2 * SKV * 128 * 2;
constexpr size_t WS_HID   = WS_IDX + (size_t)NTILE * 256 * 4;
constexpr size_t WS_YEXP  = WS_HID + (size_t)NTILE * 256 * D * 2;
constexpr size_t WS_END   = WS_YEXP + (size_t)NTILE * 256 * D * 2;

constexpr int RING_BYTES = 131072, MISC_OFF = RING_BYTES, LDS_BYTES = RING_BYTES + 1024;

__device__ __forceinline__ unsigned cvt_pk_bf16(float lo, float hi) { unsigned r; asm volatile("v_cvt_pk_bf16_f32 %0, %1, %2" : "=v"(r) : "v"(lo), "v"(hi)); return r; }
__device__ __forceinline__ float bf_lo(unsigned u) { return __uint_as_float(u << 16); }
__device__ __forceinline__ float bf_hi(unsigned u) { return __uint_as_float(u & 0xffff0000u); }
__device__ __forceinline__ float bf2f(bf16_t b) { return __uint_as_float(((unsigned)b) << 16); }
__device__ __forceinline__ bf16_t f2bf(float f) { return (bf16_t)(cvt_pk_bf16(f, 0.f) & 0xffffu); }
template <int K> __device__ __forceinline__ float swz_xor(float v) { return __int_as_float(__builtin_amdgcn_ds_swizzle(__float_as_int(v), 0x1F | (K << 10))); }
__device__ __forceinline__ float half_sum(float v) { v += swz_xor<1>(v); v += swz_xor<2>(v); v += swz_xor<4>(v); v += swz_xor<8>(v); v += swz_xor<16>(v); return v; }
__device__ __forceinline__ float half_max(float v) { v = fmaxf(v, swz_xor<1>(v)); v = fmaxf(v, swz_xor<2>(v)); v = fmaxf(v, swz_xor<4>(v)); v = fmaxf(v, swz_xor<8>(v)); v = fmaxf(v, swz_xor<16>(v)); return v; }
__device__ __forceinline__ float wave_sum(float v) { v = half_sum(v); auto rr = __builtin_amdgcn_permlane32_swap(__float_as_uint(v), __float_as_uint(v), false, false); return __uint_as_float(rr[0]) + __uint_as_float(rr[1]); }
__device__ __forceinline__ float wave_max(float v) { v = half_max(v); auto rr = __builtin_amdgcn_permlane32_swap(__float_as_uint(v), __float_as_uint(v), false, false); return fmaxf(__uint_as_float(rr[0]), __uint_as_float(rr[1])); }
__device__ __forceinline__ float xor32(float v, bool hi) { auto rr = __builtin_amdgcn_permlane32_swap(__float_as_uint(v), __float_as_uint(v), false, false); return __uint_as_float(hi ? rr[0] : rr[1]); }
__device__ __forceinline__ int opaque_tid() { int t = threadIdx.x; asm volatile("" : "+v"(t)); return t; }
__device__ __forceinline__ float silu_f(float x) { return x / (1.f + __expf(-x)); }
__device__ __forceinline__ float gelu_tanh_f(float x) {
    const float z = 0.7978845608028654f * (x + 0.044715f * x * x * x);
    return x / (1.f + __expf(-2.f * z));
}
#define LDS_WAIT() asm volatile("s_waitcnt lgkmcnt(0)" ::: "memory")

#define XB_TMO      128
#define XB_XCNT(j)  (256  + 64 * (j))
#define XB_XSUB(j)  (1280 + 64 * (j))
#define XB_XGEN(j)  (2304 + 64 * (j))
#define XB_TOP      3328
#define XB_TOPGEN   3392
#define XCD_BAR_WORDS 3456
#define XB_SPIN_CAP (1u << 22)
__device__ __forceinline__ unsigned xb_ld(unsigned* p)              { return __hip_atomic_load(p, __ATOMIC_RELAXED, __HIP_MEMORY_SCOPE_AGENT); }
__device__ __forceinline__ unsigned xb_add(unsigned* p, unsigned v) { return __hip_atomic_fetch_add(p, v, __ATOMIC_RELAXED, __HIP_MEMORY_SCOPE_AGENT); }
__device__ __forceinline__ unsigned xb_xcc_id() { return (unsigned)__builtin_amdgcn_s_getreg((3 << 11) | 20) & 0xFu; }
#define XB_SPIN(cond, bar) do { unsigned _sp = 0; while (cond) { __builtin_amdgcn_s_sleep(1); \
    if ((++_sp & 255u) == 0u) { if (xb_ld(&(bar)[XB_TMO])) break; if (_sp > XB_SPIN_CAP) { atomicAdd(&(bar)[XB_TMO], 1u); break; } } } } while (0)
struct XcdBarrier { unsigned* bar; unsigned x; volatile LAS unsigned* st; };
__device__ __forceinline__ XcdBarrier xcd_barrier_post(unsigned* bar, volatile LAS unsigned* st) {
    XcdBarrier b; b.bar = bar; b.x = xb_xcc_id(); b.st = st;
    if (threadIdx.x == 0) (void)xb_add(&bar[XB_XCNT(b.x)], 1u);
    return b;
}
__device__ __forceinline__ void xcd_barrier_complete(unsigned* bar, unsigned x, unsigned& nloc, unsigned& nx) {
    const unsigned G = gridDim.x * gridDim.y * gridDim.z;
    unsigned sum, cnt, mine, sp = 0u;
    for (;;) {
        sum = 0u; cnt = 0u; mine = 0u;
#pragma unroll
        for (unsigned j = 0; j < 16; ++j) { const unsigned c = xb_ld(&bar[XB_XCNT(j)]); sum += c; cnt += (c > 0u) ? 1u : 0u; }
        mine = xb_ld(&bar[XB_XCNT(x)]);
        if (sum == G) break;
        __builtin_amdgcn_s_sleep(1);
        if ((++sp & 255u) == 0u) { if (xb_ld(&bar[XB_TMO])) break; if (sp > XB_SPIN_CAP) { atomicAdd(&bar[XB_TMO], 1u); break; } }
    }
    nloc = mine > 0u ? mine : 1u; nx = cnt > 0u ? cnt : 1u;
}
__device__ __forceinline__ void xcd_barrier(const XcdBarrier& b) {
    asm volatile("s_waitcnt vmcnt(0)" ::: "memory");
    __syncthreads();
    if (threadIdx.x == 0) {
        unsigned* bar = b.bar;
        __builtin_amdgcn_s_waitcnt(0);
        unsigned nloc = b.st[0], nx = b.st[1];
        if (nloc == 0u) { xcd_barrier_complete(bar, b.x, nloc, nx); b.st[0] = nloc; b.st[1] = nx; }
        const unsigned old = xb_add(&bar[XB_XSUB(b.x)], 1u);
        const unsigned gen = old / nloc;
        if (old + 1u == (gen + 1u) * nloc) {
            __builtin_amdgcn_fence(__ATOMIC_RELEASE, "agent");
            asm volatile("s_waitcnt vmcnt(0)" ::: "memory");
            const unsigned og = xb_add(&bar[XB_TOP], 1u);
            const unsigned tg = og / nx;
            if (og + 1u == (tg + 1u) * nx) xb_add(&bar[XB_TOPGEN], 1u);
            else XB_SPIN(xb_ld(&bar[XB_TOPGEN]) == tg, bar);
            __builtin_amdgcn_fence(__ATOMIC_ACQUIRE, "agent");
            xb_add(&bar[XB_XGEN(b.x)], 1u);
            asm volatile("s_waitcnt vmcnt(0)" ::: "memory");
        } else {
            XB_SPIN(xb_ld(&bar[XB_XGEN(b.x)]) == gen, bar);
            __builtin_amdgcn_fence(__ATOMIC_ACQUIRE, "agent");
            asm volatile("s_waitcnt vmcnt(0)" ::: "memory");
        }
    }
    __syncthreads();
}

namespace pg8 {
constexpr int BM = 256, BK = 64, HALF = 128, HTB = HALF * BK * 2, NXCD = 8, WGM = 8;
__host__ __device__ __forceinline__ int lds_byte(int r, int c) { const int st = (r >> 4) * 2 + (c >> 5), rr = r & 15, cc = c & 31, ob = rr * 64 + cc * 2; return st * 1024 + (ob ^ (((ob >> 9) & 1) << 5)); }
__host__ __device__ __forceinline__ void stage_rc(int b, int& R, int& C) { const int st = b / 1024, sb = b % 1024, swz = sb ^ (((sb >> 9) & 1) << 5); R = (st >> 1) * 16 + swz / 64; C = (st & 1) * 32 + (swz % 64) / 2; }
__host__ __device__ __forceinline__ int perm32(int rho) { const int n = rho >> 4, i = rho & 15; return 8 * (i >> 2) + 4 * n + (i & 3); }
struct Unit { int pm, pn; };

template <class Epi, class Sched>
__device__ __forceinline__ void gemm_phase(LAS unsigned char* lds, const int K, const int lda, const int ldb, const Sched& S, const Epi& E) {
    const int tid = opaque_tid(), wid = __builtin_amdgcn_readfirstlane(tid >> 6), lane = tid & 63, wr = wid >> 2, wc = wid & 3, fr = lane & 15, fq = lane >> 4;
    const int nt = K / BK;
    constexpr bool GATHER = Sched::GATHER;
    unsigned voffA[2], voffB[2]; int rowA[2];
#pragma unroll
    for (int i = 0; i < 2; ++i) { int R, C; stage_rc(tid * 16 + i * 8192, R, C); const int Rb = Epi::PERM ? ((R & ~31) + perm32(R & 31)) : R;
        voffA[i] = GATHER ? (unsigned)C * 2u : (unsigned)(R * lda + C) * 2u; voffB[i] = (unsigned)(Rb * ldb + C) * 2u; rowA[i] = R; }
    unsigned gA[2][2], gN[2][2];
    const size_t kstep = (size_t)(BK * 2);
    const size_t hstepA = (size_t)HALF * lda * 2, hstepB = (size_t)HALF * ldb * 2;
    const unsigned ldsw = (unsigned)wid * 1024u;
    const int aoff = lds_byte(wr * 64 + fr, fq * 8), boff = lds_byte(wc * 32 + fr, fq * 8);
#define PG8_SA(b, h) (((b) * 2 + (h)) * HTB)
#define PG8_SB(b, h) ((4 + (b) * 2 + (h)) * HTB)
#define PG8_STAGE(bufoff, gbase, voff) do { _Pragma("unroll") for (int _i = 0; _i < 2; ++_i) \
        __builtin_amdgcn_global_load_lds((const unsigned*)((const char*)(gbase) + (voff)[_i]), (LAS unsigned*)(lds + (bufoff) + ldsw + _i * 8192), 16, 0, 0); } while (0)
#define PG8_STAGE_A(bufoff, ubase, kb, h, nx) do { if constexpr (GATHER) { unsigned _v[2]; _v[0] = ((nx) ? gN[h][0] : gA[h][0]) + voffA[0]; _v[1] = ((nx) ? gN[h][1] : gA[h][1]) + voffA[1]; \
        PG8_STAGE(bufoff, (const char*)S.abase() + (kb), _v); } else { PG8_STAGE(bufoff, (ubase) + (size_t)(h) * hstepA + (kb), voffA); } } while (0)
#define PG8_LOADG(u, g) do { if constexpr (GATHER) { const int* _ip = S.idx(u); _Pragma("unroll") for (int _h = 0; _h < 2; ++_h) _Pragma("unroll") for (int _i = 0; _i < 2; ++_i) \
        g[_h][_i] = (unsigned)_ip[_h * HALF + rowA[_i]] * (unsigned)(lda * 2); } } while (0)
#define PG8_LDA(dst, b, h) do { _Pragma("unroll") for (int m = 0; m < 4; ++m) _Pragma("unroll") for (int k = 0; k < 2; ++k) dst[m][k] = *(const LAS bf16x8*)(lds + PG8_SA(b, h) + aoff + m * 2048 + k * 1024); } while (0)
#define PG8_LDB(dst, b, h) do { _Pragma("unroll") for (int n = 0; n < 2; ++n) _Pragma("unroll") for (int k = 0; k < 2; ++k) dst[n][k] = *(const LAS bf16x8*)(lds + PG8_SB(b, h) + boff + n * 2048 + k * 1024); } while (0)
#define PG8_MMA(ai, bj, At, Bt) do { __builtin_amdgcn_s_setprio(1); _Pragma("unroll") for (int m = 0; m < 4; ++m) _Pragma("unroll") for (int n = 0; n < 2; ++n) _Pragma("unroll") for (int k = 0; k < 2; ++k) \
        acc[ai][bj][m][n] = __builtin_amdgcn_mfma_f32_16x16x32_bf16(Bt[n][k], At[m][k], acc[ai][bj][m][n], 0, 0, 0); __builtin_amdgcn_s_setprio(0); } while (0)
#define PG8_WAIT_V(n) asm volatile("s_waitcnt vmcnt(" #n ")" ::: "memory")
#define PG8_WAIT_L(n) asm volatile("s_waitcnt lgkmcnt(" #n ")" ::: "memory")
#define PG8_BAR __builtin_amdgcn_s_barrier()
#define PG8_SCHED __builtin_amdgcn_sched_barrier(0)
    Unit cur, nxt; int ui = 0;
    if (!S.next(0, cur)) return;
    f32x4 acc[2][2][4][2];
#pragma unroll
    for (int a = 0; a < 2; ++a)
#pragma unroll
        for (int b = 0; b < 2; ++b)
#pragma unroll
            for (int m = 0; m < 4; ++m)
#pragma unroll
                for (int n = 0; n < 2; ++n) acc[a][b][m][n] = (f32x4){0.f, 0.f, 0.f, 0.f};
    bf16x8 At[4][2], B0[2][2], B1[2][2];
    const char* cA = GATHER ? (const char*)nullptr : S.aptr(cur); const char* cB = S.bptr(cur);
    PG8_LOADG(cur, gA);
    PG8_STAGE(PG8_SB(0, 0), cB, voffB); PG8_STAGE(PG8_SB(0, 1), cB + hstepB, voffB); PG8_STAGE_A(PG8_SA(0, 0), cA, 0, 0, false); PG8_STAGE_A(PG8_SA(0, 1), cA, 0, 1, false);
    if (wr == 1) PG8_BAR;
    PG8_WAIT_V(2); PG8_BAR;
    PG8_STAGE(PG8_SB(1, 0), cB + kstep, voffB); PG8_STAGE_A(PG8_SA(1, 0), cA, kstep, 0, false); PG8_STAGE(PG8_SB(1, 1), cB + hstepB + kstep, voffB);
    PG8_WAIT_V(6); PG8_BAR;
    for (;;) {
        const bool has_next = S.next(ui + 1, nxt);
        const char* nA = (has_next && !GATHER) ? S.aptr(nxt) : cA; const char* nB = has_next ? S.bptr(nxt) : cB;
        if (has_next) PG8_LOADG(nxt, gN); else { if constexpr (GATHER) {
#pragma unroll
            for (int h_ = 0; h_ < 2; ++h_) { gN[h_][0] = gA[h_][0]; gN[h_][1] = gA[h_][1]; } } }
        for (int t = 0; t < nt; t += 2) {
            const bool last = (t == nt - 2);
            const size_t k1 = (size_t)(t + 1) * kstep, k2 = last ? 0 : (size_t)(t + 2) * kstep, k3 = k2 + kstep;
            const char* a2 = last ? nA : cA; const char* b2 = last ? nB : cB + (size_t)(t + 2) * kstep;
            const char* b3 = b2 + kstep;
            PG8_LDB(B0, 0, 0); PG8_LDB(B1, 0, 1); PG8_SCHED; PG8_LDA(At, 0, 0); PG8_STAGE_A(PG8_SA(1, 1), cA, k1, 1, false);
            PG8_WAIT_V(8); PG8_WAIT_L(0); PG8_BAR; PG8_MMA(0, 0, At, B0); PG8_MMA(0, 1, At, B1); PG8_BAR; PG8_SCHED;
            PG8_LDA(At, 0, 1); PG8_STAGE(PG8_SB(0, 0), b2, voffB); PG8_STAGE(PG8_SB(0, 1), b2 + hstepB, voffB); PG8_STAGE_A(PG8_SA(0, 0), a2, k2, 0, last);
            PG8_WAIT_V(8); PG8_WAIT_L(0); PG8_BAR; PG8_MMA(1, 0, At, B0); PG8_MMA(1, 1, At, B1); PG8_BAR; PG8_SCHED;
            PG8_LDB(B0, 1, 0); PG8_LDB(B1, 1, 1); PG8_SCHED; PG8_LDA(At, 1, 0); PG8_STAGE_A(PG8_SA(0, 1), a2, k2, 1, last);
            PG8_WAIT_V(8); PG8_WAIT_L(0); PG8_BAR; PG8_MMA(0, 0, At, B0); PG8_MMA(0, 1, At, B1); PG8_BAR; PG8_SCHED;
            PG8_LDA(At, 1, 1); PG8_STAGE(PG8_SB(1, 0), b3, voffB); PG8_STAGE(PG8_SB(1, 1), b3 + hstepB, voffB); PG8_STAGE_A(PG8_SA(1, 0), a2, k3, 0, last);
            PG8_WAIT_V(8); PG8_WAIT_L(0); PG8_BAR; PG8_MMA(1, 0, At, B0); PG8_MMA(1, 1, At, B1); PG8_BAR; PG8_SCHED;
        }
        if (wr == 0) PG8_BAR;
        E(acc, cur, wr, wc, fr, fq);
        if (!has_next) break;
#pragma unroll
        for (int a = 0; a < 2; ++a)
#pragma unroll
            for (int b = 0; b < 2; ++b)
#pragma unroll
                for (int m = 0; m < 4; ++m)
#pragma unroll
                    for (int n = 0; n < 2; ++n) acc[a][b][m][n] = (f32x4){0.f, 0.f, 0.f, 0.f};
        cur = nxt; cA = nA; cB = nB; ++ui;
        if constexpr (GATHER) {
#pragma unroll
            for (int h_ = 0; h_ < 2; ++h_) { gA[h_][0] = gN[h_][0]; gA[h_][1] = gN[h_][1]; } }
        if (wr == 1) PG8_BAR;
    }
    PG8_WAIT_V(0);
    PG8_BAR;
#undef PG8_SA
#undef PG8_SB
#undef PG8_STAGE
#undef PG8_STAGE_A
#undef PG8_LOADG
#undef PG8_LDA
#undef PG8_LDB
#undef PG8_MMA
#undef PG8_WAIT_V
#undef PG8_WAIT_L
#undef PG8_BAR
#undef PG8_SCHED
}

struct SchedDense {
    static constexpr bool GATHER = false;
    __device__ __forceinline__ const char* abase() const { return nullptr; }
    __device__ __forceinline__ const int* idx(const Unit&) const { return nullptr; }
    const bf16_t* A; const bf16_t* Bt; int a_pm_stride, a_pn_stride, b_pn_stride;
    int nM, nN, nwg, extra, G, c;
    __device__ __forceinline__ bool next(int i, Unit& u) const {
        const int L = i * G + c; if (L >= nwg + extra) return false;
        if (L >= nwg) { const int x = L - nwg; u.pm = nM + (x >> 1); u.pn = 4 + (x & 1); return true; }
        int wgid = L; { const int q = nwg / NXCD, r = nwg % NXCD, xcd = wgid % NXCD, off = wgid / NXCD; wgid = (xcd < r ? xcd * (q + 1) : r * (q + 1) + (xcd - r) * q) + off; }
        const int nig = WGM * nN, gid = wgid / nig, fm = gid * WGM, gsz = (nM - fm) < WGM ? (nM - fm) : WGM;
        u.pm = fm + ((wgid % nig) % gsz); u.pn = (wgid % nig) / gsz; return true;
    }
    __device__ __forceinline__ const char* aptr(const Unit& u) const { return (const char*)(A + (size_t)u.pm * a_pm_stride + (size_t)u.pn * a_pn_stride); }
    __device__ __forceinline__ const char* bptr(const Unit& u) const { return (const char*)(Bt + (size_t)u.pn * b_pn_stride); }
};
template <bool GATHER_>
struct SchedMoE {
    static constexpr bool GATHER = GATHER_;
    const bf16_t* A; const bf16_t* Bt; const int* IDX; int nbt, nn, G, vcu;
    __device__ __forceinline__ bool next(int i, Unit& u) const {
        const int L = i * G + vcu, per_e = nbt * nn; if (L >= NE * per_e) return false;
        const int e = L / per_e, rem = L - e * per_e, bt = rem / nn, j = rem - bt * nn;
        u.pm = bt < 8 ? e * 8 + bt : 128 + e; u.pn = e * nn + j; return true;
    }
    __device__ __forceinline__ const char* aptr(const Unit& u) const { return (const char*)(A + (size_t)u.pm * 256 * D); }
    __device__ __forceinline__ const char* abase() const { return (const char*)A; }
    __device__ __forceinline__ const int* idx(const Unit& u) const { return IDX + (size_t)u.pm * 256; }
    __device__ __forceinline__ const char* bptr(const Unit& u) const { return (const char*)(Bt + (size_t)u.pn * 256 * D); }
};

struct EpiA {
    static constexpr bool PERM = true;
    bf16_t* O; int ldc; int act; bf16_t* VB; float* stats;
    __device__ __forceinline__ void operator()(const f32x4 (&acc)[2][2][4][2], const Unit& u, int wr, int wc, int fr, int fq) const {
        const int row0 = u.pm * BM + wr * 64 + fr, cl = wc * 32 + 8 * fq;
        const bool vtile = (VB != nullptr) && (u.pn == 5);
        const bool dostat = (stats != nullptr) && (u.pn >= 4);
#pragma unroll
        for (int ai = 0; ai < 2; ++ai)
#pragma unroll
            for (int m = 0; m < 4; ++m) {
                const int r = row0 + ai * HALF + m * 16;
                float s1 = 0.f, s2 = 0.f;
#pragma unroll
                for (int bj = 0; bj < 2; ++bj) {
                    f32x4 v0 = acc[ai][bj][m][0], v1 = acc[ai][bj][m][1];
                    if (act) {
#pragma unroll
                        for (int j = 0; j < 4; ++j) { v0[j] = gelu_tanh_f(v0[j]); v1[j] = gelu_tanh_f(v1[j]); } }
#pragma unroll
                    for (int j = 0; j < 4; ++j) { s1 += v0[j] + v1[j]; s2 += v0[j] * v0[j] + v1[j] * v1[j]; }
                    u32x4 w; w.x = cvt_pk_bf16(v0[0], v0[1]); w.y = cvt_pk_bf16(v0[2], v0[3]); w.z = cvt_pk_bf16(v1[0], v1[1]); w.w = cvt_pk_bf16(v1[2], v1[3]);
                    bf16_t* dst;
                    if (vtile) { int b, pos; if (r < T) { b = r >> 11; pos = CL + (r & (SEQ - 1)); } else { const int rc = r - T; b = rc >> 8; pos = rc & (CL - 1); }
                        dst = VB + ((size_t)(b * 2 + bj) * SKV + pos) * 128 + cl; }
                    else dst = O + (size_t)r * ldc + u.pn * BM + bj * HALF + cl;
                    *(u32x4*)dst = w; }
                if (dostat) {
                    s1 += swz_xor<16>(s1); s2 += swz_xor<16>(s2);
                    { auto rr = __builtin_amdgcn_permlane32_swap(__float_as_uint(s1), __float_as_uint(s1), false, false); s1 = __uint_as_float(rr[0]) + __uint_as_float(rr[1]); }
                    { auto rr = __builtin_amdgcn_permlane32_swap(__float_as_uint(s2), __float_as_uint(s2), false, false); s2 = __uint_as_float(rr[0]) + __uint_as_float(rr[1]); }
                    if (fq == 0) *(f32x2*)(stats + ((size_t)r * 16 + (u.pn - 4) * 4 + wc) * 2) = (f32x2){s1, s2}; } }
    }
};
struct EpiB {
    static constexpr bool PERM = true;
    const void* xs_lat; const void* xs_ctx; bf16_t* xd_lat; bf16_t* xd_ctx; const float* gt; const float* colscale; int src_f32; int dry;
    __device__ __forceinline__ void operator()(const f32x4 (&acc)[2][2][4][2], const Unit& u, int wr, int wc, int fr, int fq) const {
        const int row0 = u.pm * BM + wr * 64 + fr, col0 = u.pn * BM + wc * 32 + 8 * fq;
        const bool isctx = row0 >= T;
        const int mrow = isctx ? 8 : (row0 >> 11);
        const size_t rbase = isctx ? (size_t)T : 0;
        const void* xs = isctx ? xs_ctx : xs_lat; bf16_t* xd = isctx ? xd_ctx : xd_lat;
        f32x4 gv[2][2];
#pragma unroll
        for (int bj = 0; bj < 2; ++bj)
#pragma unroll
            for (int n = 0; n < 2; ++n) { const int c = col0 + bj * HALF + n * 4; gv[bj][n] = *(const f32x4*)(gt + (size_t)mrow * 6144 + c);
                if (colscale) gv[bj][n] = gv[bj][n] * *(const f32x4*)(colscale + c); }
#pragma unroll
        for (int ai = 0; ai < 2; ++ai)
#pragma unroll
            for (int m = 0; m < 4; ++m) { const size_t off = ((size_t)(row0 + ai * HALF + m * 16) - rbase) * D + col0;
#pragma unroll
                for (int bj = 0; bj < 2; ++bj) { f32x4 x0, x1;
                    if (src_f32) { x0 = *(const f32x4*)((const float*)xs + off + bj * HALF); x1 = *(const f32x4*)((const float*)xs + off + bj * HALF + 4); }
                    else { const u32x4 w = *(const u32x4*)((const bf16_t*)xs + off + bj * HALF); x0 = (f32x4){bf_lo(w.x), bf_hi(w.x), bf_lo(w.y), bf_hi(w.y)}; x1 = (f32x4){bf_lo(w.z), bf_hi(w.z), bf_lo(w.w), bf_hi(w.w)}; }
                    x0 = x0 + gv[bj][0] * acc[ai][bj][m][0]; x1 = x1 + gv[bj][1] * acc[ai][bj][m][1];
                    u32x4 o; o.x = cvt_pk_bf16(x0[0], x0[1]); o.y = cvt_pk_bf16(x0[2], x0[3]); o.z = cvt_pk_bf16(x1[0], x1[1]); o.w = cvt_pk_bf16(x1[2], x1[3]);
                    if (!dry) *(u32x4*)(xd + off + bj * HALF) = o; } }
    }
};
struct EpiC {
    static constexpr bool PERM = true;
    bf16_t* HID;
    __device__ __forceinline__ void operator()(const f32x4 (&acc)[2][2][4][2], const Unit& u, int wr, int wc, int fr, int fq) const {
        const int n8 = u.pn & 7, rl = wr * 64 + fr, cl = n8 * 128 + wc * 32 + 8 * fq;
        bf16_t* base = HID + (size_t)u.pm * 256 * D;
#pragma unroll
        for (int ai = 0; ai < 2; ++ai)
#pragma unroll
            for (int m = 0; m < 4; ++m) {
                float h[8];
#pragma unroll
                for (int n = 0; n < 2; ++n)
#pragma unroll
                    for (int j = 0; j < 4; ++j) { const float g = acc[ai][0][m][n][j], up = acc[ai][1][m][n][j]; h[n * 4 + j] = silu_f(g) * up; }
                u32x4 w; w.x = cvt_pk_bf16(h[0], h[1]); w.y = cvt_pk_bf16(h[2], h[3]); w.z = cvt_pk_bf16(h[4], h[5]); w.w = cvt_pk_bf16(h[6], h[7]);
                *(u32x4*)(base + (size_t)(rl + ai * HALF + m * 16) * D + cl) = w; }
    }
};
struct EpiD {
    static constexpr bool PERM = true;
    bf16_t* Y; const float* gate;
    __device__ __forceinline__ void operator()(const f32x4 (&acc)[2][2][4][2], const Unit& u, int wr, int wc, int fr, int fq) const {
        const int n4 = u.pn & 3, rl = wr * 64 + fr, cl = n4 * 256 + wc * 32 + 8 * fq;
        bf16_t* base = Y + (size_t)u.pm * 256 * D; const float* gp = gate + (size_t)u.pm * 256;
#pragma unroll
        for (int ai = 0; ai < 2; ++ai)
#pragma unroll
            for (int m = 0; m < 4; ++m) { const int r = rl + ai * HALF + m * 16; const float g = gp[r];
#pragma unroll
                for (int bj = 0; bj < 2; ++bj) { const f32x4 v0 = acc[ai][bj][m][0] * g, v1 = acc[ai][bj][m][1] * g;
                    u32x4 w; w.x = cvt_pk_bf16(v0[0], v0[1]); w.y = cvt_pk_bf16(v0[2], v0[3]); w.z = cvt_pk_bf16(v1[0], v1[1]); w.w = cvt_pk_bf16(v1[2], v1[3]);
                    *(u32x4*)(base + (size_t)r * D + bj * HALF + cl) = w; } }
    }
};
}

namespace att {
constexpr int QBLK = 32, KVBLK = 64;
constexpr float SCALE = 0.088388347648318440f;
constexpr float THR = 8.f;
constexpr int SHM_V = KVBLK * 128 * 2, SHM_K = KVBLK * 128 * 2;
#define KSWZ(row, colB) ((row) * 256 + ((colB) ^ (((row) & 7) << 4)))
#define SBAR() __builtin_amdgcn_sched_barrier(0)
__device__ __forceinline__ int crow(int r, int hi) { return (r & 3) + 8 * (r >> 2) + 4 * hi; }
__device__ __forceinline__ void partialSM(f32x16& p0, f32x16& p1, float& m_reg, float& mn, float& alpha) {
    constexpr float C = SCALE * 1.4426950408889634f;
    float pmax = p0[0];
#pragma unroll
    for (int r = 1; r < 16; ++r) pmax = fmaxf(pmax, p0[r]);
#pragma unroll
    for (int r = 0; r < 16; ++r) pmax = fmaxf(pmax, p1[r]);
    { auto rr = __builtin_amdgcn_permlane32_swap(__float_as_uint(pmax), __float_as_uint(pmax), false, false);
      pmax = fmaxf(__uint_as_float(rr[0]), __uint_as_float(rr[1])); }
    if (__builtin_expect(__all(pmax - m_reg <= THR / SCALE), 1)) { mn = m_reg; alpha = 1.f; }
    else { mn = fmaxf(m_reg, pmax); alpha = __builtin_amdgcn_exp2f((m_reg - mn) * C); m_reg = mn; }
    float mnC = -mn * C;
#pragma unroll
    for (int r = 0; r < 16; ++r) p0[r] = fmaf(p0[r], C, mnC);
#pragma unroll
    for (int r = 0; r < 16; ++r) p1[r] = fmaf(p1[r], C, mnC);
#pragma unroll
    for (int r = 0; r < 16; ++r) p0[r] = __builtin_amdgcn_exp2f(p0[r]);
}
__device__ __forceinline__ void finishSM(f32x16& p0, f32x16& p1, float alpha, float& l_reg, bf16x8& pa0, bf16x8& pa1, bf16x8& pa2, bf16x8& pa3) {
#pragma unroll
    for (int r = 0; r < 16; ++r) p1[r] = __builtin_amdgcn_exp2f(p1[r]);
    float ps = 0;
#pragma unroll
    for (int r = 0; r < 16; ++r) ps += p0[r];
#pragma unroll
    for (int r = 0; r < 16; ++r) ps += p1[r];
    { auto rr = __builtin_amdgcn_permlane32_swap(__float_as_uint(ps), __float_as_uint(ps), false, false);
      ps = __uint_as_float(rr[0]) + __uint_as_float(rr[1]); }
    l_reg = l_reg * alpha + ps;
#define PK4(P, BASE, OUT) do { unsigned a0 = cvt_pk_bf16(P[BASE + 0], P[BASE + 1]), a1 = cvt_pk_bf16(P[BASE + 2], P[BASE + 3]);   \
    unsigned b0 = cvt_pk_bf16(P[BASE + 4], P[BASE + 5]), b1 = cvt_pk_bf16(P[BASE + 6], P[BASE + 7]);                              \
    auto r0 = __builtin_amdgcn_permlane32_swap(a0, b0, false, false); auto r1 = __builtin_amdgcn_permlane32_swap(a1, b1, false, false); \
    u32x4 w = {r0[0], r1[0], r0[1], r1[1]}; OUT = *reinterpret_cast<bf16x8*>(&w); } while (0)
    PK4(p0, 0, pa0); PK4(p0, 8, pa1); PK4(p1, 0, pa2); PK4(p1, 8, pa3);
#undef PK4
}
__device__ __forceinline__ void qkt(f32x16& p0, f32x16& p1, const LAS unsigned char* Ks, const bf16x8* qr, int r32, int hi) {
    p0 = f32x16{}; p1 = f32x16{};
#pragma unroll
    for (int d0 = 0; d0 < 8; ++d0) { int cb = (d0 * 16 + hi * 8) * 2;
        bf16x8 b0 = *reinterpret_cast<const LAS bf16x8*>(Ks + KSWZ(r32, cb));
        bf16x8 b1 = *reinterpret_cast<const LAS bf16x8*>(Ks + KSWZ(32 + r32, cb));
        p0 = __builtin_amdgcn_mfma_f32_32x32x16_bf16(b0, qr[d0], p0, 0, 0, 0);
        p1 = __builtin_amdgcn_mfma_f32_32x32x16_bf16(b1, qr[d0], p1, 0, 0, 0); }
}
__device__ __forceinline__ int v_st(int k, int c) { const int kk = (k & ~0xC) | ((k & 4) << 1) | ((k & 8) >> 1); return ((kk >> 3) * 4 + (c >> 5)) * 512 + ((kk & 7) * 32 + (c & 31)) * 2; }
__device__ __forceinline__ int v_rd_base(int lane) { return ((lane & 3) << 3) | (((lane >> 2) & 3) << 6) | (((lane >> 4) & 1) << 5) | (((lane >> 5) & 1) << 8); }
constexpr int v_rd_off(int d0, int ks, int half) { return d0 * 512 + ks * 4096 + half * 2048; }
template <int OFF> __device__ __forceinline__ s16x4 tr_read(int vb) {
    s16x4 r; asm volatile("ds_read_b64_tr_b16 %0, %1 offset:%2" : "=&v"(r) : "v"(vb), "i"(OFF) : "memory"); return r;
}
template <int D0> __device__ __forceinline__ void pv_one(f32x16& od, int vb, bf16x8 pa0, bf16x8 pa1, bf16x8 pa2, bf16x8 pa3) {
    const s16x4 l0 = tr_read<v_rd_off(D0, 0, 0)>(vb), h0 = tr_read<v_rd_off(D0, 0, 1)>(vb), l1 = tr_read<v_rd_off(D0, 1, 0)>(vb), h1 = tr_read<v_rd_off(D0, 1, 1)>(vb);
    const s16x4 l2 = tr_read<v_rd_off(D0, 2, 0)>(vb), h2 = tr_read<v_rd_off(D0, 2, 1)>(vb), l3 = tr_read<v_rd_off(D0, 3, 0)>(vb), h3 = tr_read<v_rd_off(D0, 3, 1)>(vb);
    asm volatile("s_waitcnt lgkmcnt(0)" ::: "memory"); SBAR();
#define PK(L, H) (bf16x8){L[0], L[1], L[2], L[3], H[0], H[1], H[2], H[3]}
    od = __builtin_amdgcn_mfma_f32_32x32x16_bf16(pa0, PK(l0, h0), od, 0, 0, 0);
    od = __builtin_amdgcn_mfma_f32_32x32x16_bf16(pa1, PK(l1, h1), od, 0, 0, 0);
    od = __builtin_amdgcn_mfma_f32_32x32x16_bf16(pa2, PK(l2, h2), od, 0, 0, 0);
    od = __builtin_amdgcn_mfma_f32_32x32x16_bf16(pa3, PK(l3, h3), od, 0, 0, 0);
#undef PK
}
__device__ __forceinline__ void pv_d0(f32x16* o, int vb, bf16x8 pa0, bf16x8 pa1, bf16x8 pa2, bf16x8 pa3) {
    pv_one<0>(o[0], vb, pa0, pa1, pa2, pa3); pv_one<1>(o[1], vb, pa0, pa1, pa2, pa3); pv_one<2>(o[2], vb, pa0, pa1, pa2, pa3); pv_one<3>(o[3], vb, pa0, pa1, pa2, pa3);
}
template <int LDQ, int LDO>
__device__ __forceinline__ void attn_body(const bf16_t* __restrict__ Qb, const bf16_t* __restrict__ Kh, const bf16_t* __restrict__ Vh, bf16_t* __restrict__ Ob, int seq, LAS unsigned char* lds) {
    constexpr int LDK = 128;
    const int tid = opaque_tid(), wid = tid >> 6, lane = tid & 63, r32 = lane & 31, hi = lane >> 5;
    LAS unsigned char* V_lds = lds; LAS unsigned char* K_lds = lds + 2 * SHM_V;
    LAS float* ws = (LAS float*)(lds + 2 * SHM_V + 2 * SHM_K) + wid * 64; LAS float* li_l = ws; LAS float* al_l = ws + 32;
    float m_reg = -1e30f, l_reg = 0; f32x16 o[4] = {}; bf16x8 qr[8];
    const bf16_t* Qw = Qb + (long)(wid * QBLK + r32) * LDQ + hi * 8;
#pragma unroll
    for (int d0 = 0; d0 < 8; ++d0) qr[d0] = *reinterpret_cast<const bf16x8*>(Qw + d0 * 16);
    const int sr = tid >> 4, sc = (tid & 15) * 8, vst0 = v_st(sr, sc), vst1 = v_st(32 + sr, sc);
    const int vb0 = (int)(unsigned)(uintptr_t)V_lds + v_rd_base(lane);
    struct { bf16x8 vs0, vs1, ks0, ks1; } sr_[2];
#define SLOAD(i, k0) do { sr_[i].vs0 = *reinterpret_cast<const bf16x8*>(&Vh[(long)((k0) + sr) * LDK + sc]); sr_[i].vs1 = *reinterpret_cast<const bf16x8*>(&Vh[(long)((k0) + 32 + sr) * LDK + sc]); \
    sr_[i].ks0 = *reinterpret_cast<const bf16x8*>(&Kh[(long)((k0) + sr) * LDK + sc]); sr_[i].ks1 = *reinterpret_cast<const bf16x8*>(&Kh[(long)((k0) + 32 + sr) * LDK + sc]); } while (0)
#define SWRITE(b, i) do { *(LAS bf16x8*)(V_lds + (b) * SHM_V + vst0) = sr_[i].vs0;          \
    *(LAS bf16x8*)(V_lds + (b) * SHM_V + vst1) = sr_[i].vs1; int kc = sc * 2;               \
    *(LAS bf16x8*)(K_lds + (b) * SHM_K + KSWZ(sr, kc)) = sr_[i].ks0;                       \
    *(LAS bf16x8*)(K_lds + (b) * SHM_K + KSWZ(32 + sr, kc)) = sr_[i].ks1; } while (0)
#define SWAIT() asm volatile("s_waitcnt vmcnt(4)" ::: "memory")
#define RESC(a) do { if (__any((a) < 1.f)) { if (hi == 0) al_l[r32] = (a); asm volatile("s_waitcnt lgkmcnt(0)" ::: "memory"); \
    for (int d = 0; d < 4; ++d) for (int r = 0; r < 16; ++r) o[d][r] *= al_l[crow(r, hi)]; } } while (0)
    f32x16 pA0, pA1, pB0, pB1; float mnA, mnB, alA, alB; bf16x8 pa0, pa1, pa2, pa3; const int NT = seq / KVBLK;
    constexpr int SE = 0, SO = 1;
    SLOAD(SE, 0); asm volatile("s_waitcnt vmcnt(0)" ::: "memory"); SWRITE(0, SE); __syncthreads();
    qkt(pA0, pA1, K_lds, qr, r32, hi); partialSM(pA0, pA1, m_reg, mnA, alA);
    SLOAD(SO, KVBLK); if (2 < NT) SLOAD(SE, 2 * KVBLK);
    SWAIT(); SWRITE(1, SO); __syncthreads();
    for (int j = 1; j + 1 < NT; j += 2) {
        SBAR(); qkt(pB0, pB1, K_lds + SHM_K, qr, r32, hi);
        finishSM(pA0, pA1, alA, l_reg, pa0, pa1, pa2, pa3); SBAR();
        SLOAD(SO, (j + 2) * KVBLK); SBAR();
        pv_d0(o, vb0, pa0, pa1, pa2, pa3); partialSM(pB0, pB1, m_reg, mnB, alB);
        __syncthreads(); SWAIT(); SWRITE(0, SE);
        RESC(alB); __syncthreads();
        SBAR(); qkt(pA0, pA1, K_lds, qr, r32, hi);
        finishSM(pB0, pB1, alB, l_reg, pa0, pa1, pa2, pa3); SBAR();
        if (j + 3 < NT) SLOAD(SE, (j + 3) * KVBLK); SBAR();
        pv_d0(o, vb0 + (int)SHM_V, pa0, pa1, pa2, pa3); partialSM(pA0, pA1, m_reg, mnA, alA);
        __syncthreads(); SWAIT(); SWRITE(1, SO);
        RESC(alA); __syncthreads();
    }
    SBAR(); qkt(pB0, pB1, K_lds + SHM_K, qr, r32, hi);
    finishSM(pA0, pA1, alA, l_reg, pa0, pa1, pa2, pa3); SBAR();
    pv_d0(o, vb0, pa0, pa1, pa2, pa3); partialSM(pB0, pB1, m_reg, mnB, alB);
    __syncthreads(); RESC(alB);
    finishSM(pB0, pB1, alB, l_reg, pa0, pa1, pa2, pa3); SBAR();
    pv_d0(o, vb0 + (int)SHM_V, pa0, pa1, pa2, pa3);
    if (hi == 0) li_l[r32] = l_reg; asm volatile("s_waitcnt lgkmcnt(0)" ::: "memory");
    float rli[16];
#pragma unroll
    for (int r = 0; r < 16; ++r) rli[r] = __builtin_amdgcn_rcpf(li_l[crow(r, hi)]);
    bf16_t* Ow = Ob + (long)(wid * QBLK) * LDO;
#pragma unroll
    for (int r = 0; r < 16; ++r) { int orow = crow(r, hi);
#pragma unroll
        for (int d0 = 0; d0 < 4; ++d0) Ow[(long)orow * LDO + d0 * 32 + r32] = f2bf(o[d0][r] * rli[r]); }
#undef SLOAD
#undef SWRITE
#undef SWAIT
#undef RESC
}
}

struct KArgs { const float* in[24]; float* out; unsigned char* ws; int ph_lo, ph_hi; };
enum { I_X = 0, I_C, I_CTX, I_CCTX, I_MODW, I_MODB, I_N1G, I_N2G, I_RW, I_WG, I_WU, I_WD, I_GWIN, I_GVG, I_GSW, I_GSB, I_GWOUT, I_AWIN, I_AQG, I_AKG, I_AWOUT, I_PWIN, I_PWG, I_PSC };

struct Fr {
    volatile LAS unsigned long long* PT;
    int G, bx, vcu;
    __device__ __forceinline__ unsigned long long ldp(int i) const { const unsigned long long v = PT[i];
        const unsigned lo = __builtin_amdgcn_readfirstlane((unsigned)v), hi = __builtin_amdgcn_readfirstlane((unsigned)(v >> 32)); return ((unsigned long long)hi << 32) | lo; }
    __device__ __forceinline__ const float* in(int i) const { return (const float*)(GAS const float*)ldp(i); }
    __device__ __forceinline__ float* out() const { return (float*)(GAS float*)ldp(24); }
    __device__ __forceinline__ unsigned char* ws() const { return (unsigned char*)(GAS unsigned char*)ldp(25); }
};
#define WSP(F, T_, OFF) ((T_*)((F).ws() + (OFF)))

constexpr int CV_NT_EXP = 4 * 16 * 3 * 64, CV_NT_ALL = CV_NT_EXP + 256 + 128 + 96 + 64 + 64 + 16;
constexpr int CV_L1_FIRST = 3072;
constexpr int CV_G_GA = 192, CV_G_GB = 144, CV_G_DN = 192;
constexpr int CV_Q_GA = 34, CV_N_GA = 256 - CV_G_GA, CV_Q_GB = 19, CV_N_GB = 256 - CV_G_GB, CV_Q_UP = 7, CV_N_UP = 128, CV_Q_DN = 34, CV_N_DN = 256 - CV_G_DN;
constexpr int CV_B_GA = CV_L1_FIRST, CV_B_GB = CV_B_GA + CV_Q_GA * CV_N_GA, CV_B_UP = CV_B_GB + CV_Q_GB * CV_N_GB, CV_B_DN = CV_B_UP + CV_Q_UP * CV_N_UP;
constexpr int CV_DEFER = CV_Q_GA * CV_N_GA + CV_Q_GB * CV_N_GB + CV_Q_UP * CV_N_UP + CV_Q_DN * CV_N_DN;
constexpr int CV_Q_GA1 = 7, CV_N_GA1 = 112, CV_Q_TK = 3, CV_N_TK = 128;
constexpr int CV_DEFER2 = CV_Q_GA1 * CV_N_GA1 + 2 * CV_Q_TK * CV_N_TK;
constexpr int CV_B_GA1 = CV_NT_EXP - CV_DEFER2, CV_B_TK1 = CV_B_GA1 + CV_Q_GA1 * CV_N_GA1, CV_B_TK2 = CV_B_TK1 + CV_Q_TK * CV_N_TK;
static_assert(CV_L1_FIRST + CV_DEFER <= CV_B_GA1 && CV_B_GA1 >= 3 * 3072, "deferred tiles: layers 1-3 (first range), layer 3 only (second range)");
__device__ __forceinline__ void convert_tiles(const Fr& F, LAS unsigned char* lds, const int j0, const int jstride, const int jend, const int skip_lo, const int skip_n, const int skip2_lo = 0x7fffffff, const int skip2_n = 0) {
    const int tid = opaque_tid(), wave = __builtin_amdgcn_readfirstlane(tid >> 6);
    unsigned char* const ws_ = F.ws();
    const int c4 = tid & 63, rr = tid >> 3, ch = tid & 7;
    f32x4 ld[8];
    const float* W = nullptr; int N = 0, k0 = 0, n0 = 0, ldt = 0, gu = 0; bf16_t* dst = nullptr;
#define P0_DECODE(jj) do { int r_ = (jj); r_ = r_ < skip_lo ? r_ : r_ + skip_n; r_ = r_ < skip2_lo ? r_ : r_ + skip2_n; \
        if (r_ < CV_NT_EXP) { const int mat = r_ >> 6, sub = r_ & 63, l = mat / 48, rem = mat % 48, e = rem / 3, which = rem % 3; k0 = (sub >> 2) * 64; n0 = (sub & 3) * 256; N = 1024; ldt = 1024; \
            if (which < 2) { W = F.in(which == 0 ? I_WG : I_WU) + (size_t)(l * 16 + e) * 1024 * 1024; dst = (bf16_t*)(ws_ + WS_WUP) + (size_t)l * 16 * 2048 * 1024 + (size_t)(e * 8 * 256 + which * 128) * 1024; gu = 1; } \
            else { W = F.in(I_WD) + (size_t)(l * 16 + e) * 1024 * 1024; dst = (bf16_t*)(ws_ + WS_WDN) + (size_t)l * 16 * 1024 * 1024 + (size_t)(e * 1024) * 1024; gu = 0; } } \
        else { r_ -= CV_NT_EXP; gu = 0; \
            if (r_ < 256) { const int j = r_ >> 7, sub = r_ & 127; k0 = (sub >> 3) * 64; n0 = (sub & 7) * 256; N = 2048; ldt = 1024; W = F.in(I_GWIN) + (size_t)j * 1024 * 2048; dst = (bf16_t*)(ws_ + WS_WGIN) + (size_t)j * 2048 * 1024; } \
            else if ((r_ -= 256) < 128) { const int j = r_ >> 6, sub = r_ & 63; k0 = (sub >> 2) * 64; n0 = (sub & 3) * 256; N = 1024; ldt = 1024; W = F.in(I_GWOUT) + (size_t)j * 1024 * 1024; dst = (bf16_t*)(ws_ + WS_WGOUT) + (size_t)j * 1024 * 1024; } \
            else if ((r_ -= 128) < 96) { k0 = (r_ / 6) * 64; n0 = (r_ % 6) * 256; N = 1536; ldt = 1024; W = F.in(I_AWIN); dst = (bf16_t*)(ws_ + WS_WAIN); } \
            else if ((r_ -= 96) < 64) { k0 = (r_ >> 2) * 64; n0 = (r_ & 3) * 256; N = 1024; ldt = 1024; W = F.in(I_AWOUT); dst = (bf16_t*)(ws_ + WS_WAOUT); } \
            else if ((r_ -= 64) < 64) { k0 = (r_ >> 2) * 64; n0 = (r_ & 3) * 256; N = 1024; ldt = 1024; W = F.in(I_PWIN); dst = (bf16_t*)(ws_ + WS_WPIN); } \
            else { r_ -= 64; const int g = r_ >> 2; k0 = (r_ & 3) * 64; n0 = 0; N = 256; ldt = 256; W = F.in(I_PWG) + (size_t)g * 256 * 256; dst = (bf16_t*)(ws_ + WS_WPGRP) + (size_t)g * 256 * 256; } } } while (0)
#define P0_LOAD() do { const float* wp_ = W + (size_t)(k0 + wave * 8) * N + n0 + c4 * 4; _Pragma("unroll") for (int s_ = 0; s_ < 8; ++s_) ld[s_] = __builtin_nontemporal_load((const f32x4*)(wp_ + (size_t)s_ * N)); } while (0)
    int it = j0, buf = 0;
    if (it < jend) { P0_DECODE(it); P0_LOAD(); }
#pragma nounroll
    for (; it < jend; it += jstride) {
        LAS unsigned char* Lt = lds + buf * 32768;
#pragma unroll
        for (int j = 0; j < 4; ++j) { const int n = c4 * 4 + j;
            u32x4 o; o.x = cvt_pk_bf16(ld[0][j], ld[1][j]); o.y = cvt_pk_bf16(ld[2][j], ld[3][j]); o.z = cvt_pk_bf16(ld[4][j], ld[5][j]); o.w = cvt_pk_bf16(ld[6][j], ld[7][j]);
            *(LAS u32x4*)(Lt + n * 128 + ((wave ^ ((n >> 2) & 7)) << 4)) = o; }
        bf16_t* const cdst = dst; const int ck0 = k0, cn0 = n0, cldt = ldt, cgu = gu;
        __syncthreads();
        if (it + jstride < jend) { P0_DECODE(it + jstride); P0_LOAD(); }
#pragma unroll
        for (int s_ = 0; s_ < 4; ++s_) { const int n = s_ * 64 + rr; const u32x4 o = *(const LAS u32x4*)(Lt + n * 128 + ((ch ^ ((n >> 2) & 7)) << 4));
            const int nn = cn0 + n; const size_t row = cgu ? (size_t)((nn >> 7) * 256 + (nn & 127)) : (size_t)nn;
            __builtin_nontemporal_store(o, (u32x4*)(cdst + row * cldt + ck0 + ch * 8)); }
        buf ^= 1;
    }
#undef P0_DECODE
#undef P0_LOAD
}
__device__ __forceinline__ int split_role(const Fr& F, const int ng) { const int q = F.bx >> 3, x = F.bx & 7, qg = ng >> 3; return q < qg ? q * 8 + x : -1 - ((q - qg) * 8 + x); }
__device__ __forceinline__ void convert_in_idle_slot(const Fr& F, LAS unsigned char* lds, const int c, const int total, const int base, const int quota, const int nidle) {
    const int rounds = (total + F.G - 1) / F.G, first_idle = total - (rounds - 1) * F.G;
    if (F.G != 256 || c < first_idle || c - first_idle >= nidle) return;
    __syncthreads();
    const int j0 = base + (c - first_idle) * quota;
    convert_tiles(F, lds, j0, 1, j0 + quota, 0x7fffffff, 0);
}

__device__ __forceinline__ void p0_phase(const Fr& F, LAS unsigned char* lds, const int part) {
    const int tid = opaque_tid(), lane = tid & 63, wave = __builtin_amdgcn_readfirstlane(tid >> 6), gw = F.bx * NWAVES + wave, NGW = F.G * NWAVES; (void)gw; (void)NGW; (void)lane; (void)wave;
    unsigned char* const ws_ = F.ws();
    float* const modv_ = (float*)(ws_ + WS_MODV);
    bf16_t* const wsw_ = (bf16_t*)(ws_ + WS_WSW);
    bf16_t* const wgin_ = (bf16_t*)(ws_ + WS_WGIN);
    bf16_t* const wgout_ = (bf16_t*)(ws_ + WS_WGOUT);
    bf16_t* const wain_ = (bf16_t*)(ws_ + WS_WAIN);
    bf16_t* const waout_ = (bf16_t*)(ws_ + WS_WAOUT);
    bf16_t* const wpin_ = (bf16_t*)(ws_ + WS_WPIN);
    bf16_t* const wpgrp_ = (bf16_t*)(ws_ + WS_WPGRP);
    bf16_t* const wup_ = (bf16_t*)(ws_ + WS_WUP);
    bf16_t* const wdn_ = (bf16_t*)(ws_ + WS_WDN);
    const float* const in_I_AWIN = F.in(I_AWIN);
    const float* const in_I_AWOUT = F.in(I_AWOUT);
    const float* const in_I_C = F.in(I_C);
    const float* const in_I_CCTX = F.in(I_CCTX);
    const float* const in_I_GSW = F.in(I_GSW);
    const float* const in_I_GWIN = F.in(I_GWIN);
    const float* const in_I_GWOUT = F.in(I_GWOUT);
    const float* const in_I_MODB = F.in(I_MODB);
    const float* const in_I_MODW = F.in(I_MODW);
    const float* const in_I_PWG = F.in(I_PWG);
    const float* const in_I_PWIN = F.in(I_PWIN);
    const float* const in_I_WD = F.in(I_WD);
    const float* const in_I_WG = F.in(I_WG);
    const float* const in_I_WU = F.in(I_WU);

    if (part == 0) {
    LAS float* sact = (LAS float*)lds;
    LAS float* red = (LAS float*)(lds + 49152);
    for (int idx = tid; idx < 9 * 1024; idx += NTHR) { const int r = idx >> 10, k = idx & 1023; const float v = r < 8 ? in_I_C[r * 1024 + k] : in_I_CCTX[k]; sact[k * 12 + r] = silu_f(v); }
    __syncthreads();
    for (int chunk = F.bx; chunk < 768; chunk += F.G) {
        const int layer = chunk / 192, n0 = (chunk % 192) * 32, k0 = wave * 128 + (lane >> 5);
        const float* wp = in_I_MODW + (size_t)layer * 1024 * 6144 + (size_t)k0 * 6144 + n0 + (lane & 31);
        float acc[9];
#pragma unroll
        for (int r = 0; r < 9; ++r) acc[r] = 0.f;
#pragma nounroll
        for (int hb = 0; hb < 4; ++hb) {
            float w[16];
#pragma unroll
            for (int i = 0; i < 16; ++i) w[i] = __builtin_nontemporal_load(wp + (size_t)(2 * (hb * 16 + i)) * 6144);
#pragma unroll
            for (int i = 0; i < 16; ++i) { const LAS float* sa = sact + (k0 + 2 * (hb * 16 + i)) * 12;
                const f32x4 s0 = *(const LAS f32x4*)sa, s1 = *(const LAS f32x4*)(sa + 4); const float s8 = sa[8];
                acc[0] += s0[0] * w[i]; acc[1] += s0[1] * w[i]; acc[2] += s0[2] * w[i]; acc[3] += s0[3] * w[i];
                acc[4] += s1[0] * w[i]; acc[5] += s1[1] * w[i]; acc[6] += s1[2] * w[i]; acc[7] += s1[3] * w[i]; acc[8] += s8 * w[i];
                __builtin_amdgcn_sched_barrier(0); }
        }
#pragma unroll
        for (int r = 0; r < 9; ++r) { acc[r] += xor32(acc[r], lane >= 32); if (lane < 32) red[(wave * 9 + r) * 32 + lane] = acc[r]; }
        __syncthreads();
        for (int idx = tid; idx < 288; idx += NTHR) { const int r = idx >> 5, l = idx & 31; float sacc = 0.f;
#pragma unroll
            for (int w = 0; w < 8; ++w) sacc += red[(w * 9 + r) * 32 + l];
            const int nn = n0 + l; modv_[(size_t)(layer * 9 + r) * 6144 + nn] = sacc + in_I_MODB[layer * 6144 + nn]; }
        __syncthreads();
    }
    return;
    }
    { const int defer = (F.G == 256) ? CV_DEFER : 0, defer2 = (F.G == 256) ? CV_DEFER2 : 0; convert_tiles(F, lds, F.bx, F.G, CV_NT_ALL - defer - defer2, CV_L1_FIRST, defer, CV_B_GA1, defer2); }
    __syncthreads();
    for (int i4 = F.bx * NTHR + tid; i4 < 2 * 8 * 128 * 128 / 4; i4 += F.G * NTHR) { const f32x4 v = *(const f32x4*)(in_I_GSW + (size_t)i4 * 4);
        u32x2 o; o.x = cvt_pk_bf16(v[0], v[1]); o.y = cvt_pk_bf16(v[2], v[3]); *(u32x2*)(wsw_ + (size_t)i4 * 4) = o; }
}

template <int R>
__device__ __forceinline__ void norm_rows(const int r0, const bool isctx, const int lane, const int layer, const int which, const int comb, const int dry, float* vst,
                                          const int xmode  , const void* xsrc, void* xdst, const float* modv_, const float* ng, const int* slot_, const bf16_t* YEXP_, bf16_t* H_, float* aff_, int* slotw_, const LAS unsigned char* rwl) {
    const int rc0 = r0 - T; const int b = isctx ? (rc0 >> 8) : (r0 >> 11); const int mrow = isctx ? 8 : b;
    f32x4 v[R][4];
#pragma unroll
    for (int q = 0; q < R; ++q)
#pragma unroll
        for (int j = 0; j < 4; ++j) {
            if (xmode == 0) v[q][j] = *(const f32x4*)((const float*)xsrc + (size_t)q * D + lane * 4 + 256 * j);
            else { const u32x2 w = *(const u32x2*)((const bf16_t*)xsrc + (size_t)q * D + lane * 4 + 256 * j); v[q][j] = (f32x4){bf_lo(w.x), bf_hi(w.x), bf_lo(w.y), bf_hi(w.y)}; } }
#ifndef NO_NR_COMB
    if (comb >= 0) {
        int sl[R];
#pragma unroll
        for (int q = 0; q < R; ++q) sl[q] = slot_[(size_t)(r0 + q) * 16 + (lane & 15)];
        f32x4 a[R][4];
#pragma unroll
        for (int q = 0; q < R; ++q)
#pragma unroll
            for (int j = 0; j < 4; ++j) a[q][j] = (f32x4){0.f, 0.f, 0.f, 0.f};
#pragma nounroll
        for (int e = 0; e < 16; ++e) {
            u32x2 w[R][4];
#pragma unroll
            for (int q = 0; q < R; ++q) {
                const int s = __builtin_amdgcn_readlane(sl[q], e);
                if (s >= 0) {
                    const int tile = isctx ? 128 + e : e * 8 + b, rin = isctx ? (((rc0 + q) >> 8) * 32 + s) : s;
                    const bf16_t* yp = YEXP_ + ((size_t)tile * 256 + rin) * D + lane * 4;
#pragma unroll
                    for (int j = 0; j < 4; ++j) w[q][j] = __builtin_nontemporal_load((const u32x2*)(yp + 256 * j));
                } else {
#pragma unroll
                    for (int j = 0; j < 4; ++j) w[q][j] = (u32x2){0u, 0u};
                }
            }
#pragma unroll
            for (int q = 0; q < R; ++q)
#pragma unroll
                for (int j = 0; j < 4; ++j) { a[q][j][0] += bf_lo(w[q][j].x); a[q][j][1] += bf_hi(w[q][j].x); a[q][j][2] += bf_lo(w[q][j].y); a[q][j][3] += bf_hi(w[q][j].y); }
        }
        const float* g2 = modv_ + (size_t)(comb * 9 + mrow) * 6144 + 5 * 1024 + lane * 4;
#pragma unroll
        for (int j = 0; j < 4; ++j) { const f32x4 gg = *(const f32x4*)(g2 + 256 * j);
#pragma unroll
            for (int q = 0; q < R; ++q) { v[q][j] = v[q][j] + gg * a[q][j];
                if (!dry) { if (xmode == 2) __builtin_nontemporal_store(v[q][j], (f32x4*)((float*)xdst + (size_t)q * D + lane * 4 + 256 * j));
                            else { u32x2 o; o.x = cvt_pk_bf16(v[q][j][0], v[q][j][1]); o.y = cvt_pk_bf16(v[q][j][2], v[q][j][3]); *(u32x2*)((bf16_t*)xdst + (size_t)q * D + lane * 4 + 256 * j) = o; } } } }
    }
#endif
    if (which == 0) return;
    float rstd[R];
#pragma unroll
    for (int q = 0; q < R; ++q) { float ss = 0.f;
#pragma unroll
        for (int j = 0; j < 4; ++j) ss += (v[q][j][0] * v[q][j][0] + v[q][j][1] * v[q][j][1]) + (v[q][j][2] * v[q][j][2] + v[q][j][3] * v[q][j][3]);
        rstd[q] = ss; }
#pragma unroll
    for (int q = 0; q < R; ++q) rstd[q] = rsqrtf(wave_sum(rstd[q]) * (1.f / D) + EPS);
    const float* mv = modv_ + (size_t)(layer * 9 + mrow) * 6144 + (which == 2 ? 3 * 1024 : 0) + lane * 4;
#pragma unroll
    for (int j = 0; j < 4; ++j) { const f32x4 g = *(const f32x4*)(ng + lane * 4 + 256 * j), sh = *(const f32x4*)(mv + 256 * j), sc = *(const f32x4*)(mv + 1024 + 256 * j);
#pragma unroll
        for (int q = 0; q < R; ++q) { v[q][j] = (v[q][j] * rstd[q] * g) * (sc + 1.f) + sh;
            u32x2 o; o.x = cvt_pk_bf16(v[q][j][0], v[q][j][1]); o.y = cvt_pk_bf16(v[q][j][2], v[q][j][3]); *(u32x2*)(H_ + (size_t)(r0 + q) * D + lane * 4 + 256 * j) = o; } }
#ifndef NO_NR_ROUTER
    if (which == 2 && dry != 2) {
        f32x2 p2[R][8];
#pragma unroll
        for (int q = 0; q < R; ++q)
#pragma unroll
            for (int e = 0; e < 8; ++e) p2[q][e] = (f32x2){0.f, 0.f};
#pragma unroll
        for (int j = 0; j < 4; ++j)
#pragma unroll
            for (int i = 0; i < 4; ++i) { const int col = lane * 4 + 256 * j + i; const LAS unsigned char* rp = rwl + col * 64 + (col >> 2) * 16;
                f32x2 w2[8];
#pragma unroll
                for (int e4 = 0; e4 < 4; ++e4) { const f32x4 w = *(const LAS f32x4*)(rp + e4 * 16); w2[2 * e4] = (f32x2){w[0], w[1]}; w2[2 * e4 + 1] = (f32x2){w[2], w[3]}; }
#pragma unroll
                for (int q = 0; q < R; ++q) { const float hv = v[q][j][i]; const f32x2 h2 = (f32x2){hv, hv};
#pragma unroll
                    for (int e = 0; e < 8; ++e) p2[q][e] = __builtin_elementwise_fma(h2, w2[e], p2[q][e]); }
                __builtin_amdgcn_sched_barrier(0); }
        float p[R][16];
#pragma unroll
        for (int q = 0; q < R; ++q)
#pragma unroll
            for (int e = 0; e < 8; ++e) { p[q][2 * e] = p2[q][e].x; p[q][2 * e + 1] = p2[q][e].y; asm volatile("" : "+v"(p[q][2 * e]), "+v"(p[q][2 * e + 1])); }
#pragma unroll
        for (int q = 0; q < R; ++q) {
            const bool b5 = (lane & 32) != 0, b4 = (lane & 16) != 0, b3 = (lane & 8) != 0, b2 = (lane & 4) != 0;
            float k8[8], k4[4], k2[2];
#pragma unroll
            for (int e = 0; e < 8; ++e) { const float send = b5 ? p[q][e] : p[q][e + 8]; k8[e] = (b5 ? p[q][e + 8] : p[q][e]) + xor32(send, b5); }
#pragma unroll
            for (int e = 0; e < 4; ++e) { const float send = b4 ? k8[e] : k8[e + 4]; k4[e] = (b4 ? k8[e + 4] : k8[e]) + swz_xor<16>(send); }
#pragma unroll
            for (int e = 0; e < 2; ++e) { const float send = b3 ? k4[e] : k4[e + 2]; k2[e] = (b3 ? k4[e + 2] : k4[e]) + swz_xor<8>(send); }
            float lg; { const float send = b2 ? k2[0] : k2[1]; lg = (b2 ? k2[1] : k2[0]) + swz_xor<4>(send); }
            lg += swz_xor<2>(lg); lg += swz_xor<1>(lg);
            const float mx = wave_max(lg), ex = __expf(lg - mx), sum = wave_sum(ex) * 0.25f;
            const int eid = (lane >> 2) & 15;
            if ((lane & 3) == 0) aff_[(size_t)(r0 + q) * 16 + eid] = ex / sum;
            if (lane < 16) slotw_[(size_t)(r0 + q) * 16 + lane] = -1;
        }
    }
#endif
}
__device__ __forceinline__ void norm_phase(const Fr& F, LAS unsigned char* lds, int layer, int which, int nrows, int comb, int xmode, const void* xlat, const void* xctx, void* xlat_d, void* xctx_d, int dry = 0, bool zero_vst = false) {
    const size_t esz_s = xmode == 0 ? 4 : 2, esz_d = xmode == 2 ? 4 : 2;
    const int tid = opaque_tid(), lane = tid & 63, wave = __builtin_amdgcn_readfirstlane(tid >> 6), gw = F.bx * NWAVES + wave, NGW = F.G * NWAVES;
    unsigned char* const ws_ = F.ws();
    float* const modv_ = (float*)(ws_ + WS_MODV); float* const aff_ = (float*)(ws_ + WS_AFF); int* const slot_ = (int*)(ws_ + WS_SLOT);
    bf16_t* const H_ = (bf16_t*)(ws_ + WS_H); bf16_t* const YEXP_ = (bf16_t*)(ws_ + WS_YEXP);
    float* const vst = zero_vst ? (float*)(ws_ + WS_VST) : nullptr;
    LAS unsigned char* rwl = lds;
    if (which == 2) {
        const float* rw = F.in(I_RW) + (size_t)layer * 1024 * 16;
        for (int idx = tid; idx < 4096; idx += NTHR) { const int col = idx >> 2, e4 = idx & 3; *(LAS f32x4*)(rwl + col * 64 + (col >> 2) * 16 + e4 * 16) = *(const f32x4*)(rw + col * 16 + e4 * 4); }
        __syncthreads();
    }
    const float* ng = F.in(which == 2 ? I_N2G : I_N1G) + (size_t)layer * 1024;
#pragma nounroll
    for (int g4 = gw; g4 < T / 4; g4 += NGW) { const int r0 = g4 * 4;
        norm_rows<4>(r0, false, lane, layer, which, comb, dry, vst, xmode, (const char*)xlat + (size_t)r0 * D * esz_s, (char*)xlat_d + (size_t)r0 * D * esz_d, modv_, ng, slot_, YEXP_, H_, aff_, slot_, rwl); }
    if (nrows > T) {
#pragma nounroll
        for (int r = T + gw; r < nrows; r += NGW)
            norm_rows<1>(r, true, lane, layer, which, comb, dry, vst, xmode, (const char*)xctx + (size_t)(r - T) * D * esz_s, (char*)xctx_d + (size_t)(r - T) * D * esz_d, modv_, ng, slot_, YEXP_, H_, aff_, slot_, rwl);
    }
}

__device__ __forceinline__ void topk_phase(const Fr& F, LAS unsigned char* lds, bool with_ctx) {
    const int tid = opaque_tid();
    unsigned char* const ws_ = F.ws();
    float* const aff_ = (float*)(ws_ + WS_AFF); int* const slot_ = (int*)(ws_ + WS_SLOT); float* const gate_ = (float*)(ws_ + WS_GATE);
    int* const idx_ = (int*)(ws_ + WS_IDX);
    LAS unsigned* vals = (LAS unsigned*)lds;
    LAS int* hist = (LAS int*)(lds + 8192);
    LAS int* suf = (LAS int*)(lds + 9216);
    LAS int* scan = (LAS int*)(lds + 12288);
    volatile LAS unsigned* sv = (volatile LAS unsigned*)(lds + 16384);
    const int nunits = with_ctx ? 256 : 128;
    for (int u = F.bx; u < nunits; u += F.G) {
        const bool isctx = u >= 128; const int uu = isctx ? u - 128 : u, e = uu >> 3, b = uu & 7;
        const int N = isctx ? CL : SEQ, cap = isctx ? CCAP : CAP, row0 = isctx ? T + b * CL : b * SEQ;
        const int tile = isctx ? 128 + e : uu, rbase = isctx ? b * 32 : 0;
        unsigned v[4]; const bool act = tid * 4 < N;
#pragma unroll
        for (int k = 0; k < 4; ++k) v[k] = act ? __float_as_uint(aff_[(size_t)(row0 + tid * 4 + k) * 16 + e]) : 0u;
        if (tid == 0) { sv[0] = 0u; sv[1] = (unsigned)cap; }
        unsigned prefix = 0u, mask = 0u; int need = cap;
#pragma nounroll
        for (int shift = 24; shift >= 0; shift -= 8) {
            if (tid < 256) hist[tid] = 0;
            __syncthreads();
            if (act) {
#pragma unroll
                for (int k = 0; k < 4; ++k) if ((v[k] & mask) == prefix) __hip_atomic_fetch_add(&hist[(v[k] >> shift) & 255u], 1, __ATOMIC_RELAXED, __HIP_MEMORY_SCOPE_WORKGROUP);
            }
            __syncthreads();
            if (tid < 256) { int sacc = 0; for (int d = 255; d >= tid; --d) sacc += hist[d]; suf[tid] = sacc; }
            if (tid == 0) suf[256] = 0;
            __syncthreads();
            if (tid < 256) { const int s0 = suf[tid], s1 = suf[tid + 1]; if (s0 >= need && s1 < need) { sv[0] = prefix | ((unsigned)tid << shift); sv[1] = (unsigned)(need - s1); } }
            __syncthreads();
            prefix = sv[0]; need = (int)sv[1]; mask |= 255u << shift;
        }
        int cg = 0, ce = 0;
#pragma unroll
        for (int k = 0; k < 4; ++k) { cg += (act && v[k] > prefix) ? 1 : 0; ce += (act && v[k] == prefix) ? 1 : 0; }
        int cur = 0; scan[tid] = cg | (ce << 16);
        __syncthreads();
#pragma nounroll
        for (int off = 1; off < NTHR; off <<= 1) {
            const int x = scan[cur * NTHR + tid] + (tid >= off ? scan[cur * NTHR + tid - off] : 0);
            scan[(cur ^ 1) * NTHR + tid] = x; cur ^= 1;
            __syncthreads();
        }
        const int incl = scan[cur * NTHR + tid]; int gb = (incl & 0xffff) - cg, eb = (incl >> 16) - ce;
        if (act) {
#pragma unroll
            for (int k = 0; k < 4; ++k) {
                const bool isg = v[k] > prefix, ise = v[k] == prefix;
                if (isg || (ise && eb < need)) { const int sl = gb + (eb < need ? eb : need); const int row = row0 + tid * 4 + k;
                    idx_[(size_t)tile * 256 + rbase + sl] = row; gate_[(size_t)tile * 256 + rbase + sl] = __uint_as_float(v[k]); slot_[(size_t)row * 16 + e] = sl; }
                gb += isg ? 1 : 0; eb += ise ? 1 : 0;
            }
        }
        __syncthreads();
    }
}

template <int OFF> __device__ __forceinline__ s16x4 sp_tr_read(int vb) {
    s16x4 r; asm volatile("ds_read_b64_tr_b16 %0, %1 offset:%2" : "=&v"(r) : "v"(vb), "i"(OFF) : "memory"); return r;
}
template <int KS> __device__ __forceinline__ void sp_kstep(f32x16& acc0, f32x16& acc1, const LAS bf16_t* Ap, int vb) {
    constexpr int LDB2 = 320;
    const bf16x8 a = *(const LAS bf16x8*)(Ap + KS * 16);
    const s16x4 l0 = sp_tr_read<(16 * KS) * LDB2>(vb), h0 = sp_tr_read<(16 * KS + 4) * LDB2>(vb);
    const s16x4 l1 = sp_tr_read<(16 * KS) * LDB2 + 64>(vb), h1 = sp_tr_read<(16 * KS + 4) * LDB2 + 64>(vb);
    asm volatile("s_waitcnt lgkmcnt(0)" ::: "memory"); __builtin_amdgcn_sched_barrier(0);
    const bf16x8 b0 = (bf16x8){l0[0], l0[1], l0[2], l0[3], h0[0], h0[1], h0[2], h0[3]};
    const bf16x8 b1 = (bf16x8){l1[0], l1[1], l1[2], l1[3], h1[0], h1[1], h1[2], h1[3]};
    acc0 = __builtin_amdgcn_mfma_f32_32x32x16_bf16(b0, a, acc0, 0, 0, 0);
    acc1 = __builtin_amdgcn_mfma_f32_32x32x16_bf16(b1, a, acc1, 0, 0, 0);
}
__device__ __forceinline__ void spatial_phase(const Fr& F, LAS unsigned char* lds, int j, int nchunks) {
    const int tid = opaque_tid(), lane = tid & 63, wave = __builtin_amdgcn_readfirstlane(tid >> 6);
    unsigned char* const ws_ = F.ws();
    const bf16_t* const wsw_ = (const bf16_t*)(ws_ + WS_WSW); const bf16_t* const S1_ = (const bf16_t*)(ws_ + WS_S1); bf16_t* const S2_ = (bf16_t*)(ws_ + WS_S2);
    const float* const vst_ = (const float*)(ws_ + WS_VST);
    constexpr int LDA = 136, LDB = 160;
    LAS bf16_t* As = (LAS bf16_t*)(lds + 1024);
    LAS bf16_t* Bs = (LAS bf16_t*)(lds + 1024 + 128 * LDA * 2);
    const float* vg = F.in(I_GVG) + (size_t)j * 1024; const float* sb = F.in(I_GSB) + (size_t)j * 8 * 128;
    const bf16_t* sw = wsw_ + (size_t)j * 8 * 128 * 128;
    const int r32 = lane & 31, hi = lane >> 5;
    const int pw = (wave >> 1) * 32, dw = (wave & 1) * 64;
    const LAS bf16_t* Ap = As + (pw + r32) * LDA + hi * 8;
    const int vb = (int)(unsigned)(uintptr_t)Bs + (8 * hi + ((lane & 15) >> 2)) * (LDB * 2) + (dw + 16 * ((lane >> 4) & 1) + 4 * (lane & 3)) * 2;
    const int p = pw + r32, c0 = dw + 4 * hi, nunits = nchunks * 8;
    u32x4 sa[4], wv[4]; u32x2 un[2][4]; f32x2 st[4];
#define SP_LOAD(U) do { const int _r0 = ((U) >> 3) * 128, _g = (U) & 7; _Pragma("unroll") for (int i = 0; i < 4; ++i) { const int id = tid + NTHR * i; \
            sa[i] = *(const u32x4*)(sw + (size_t)_g * 128 * 128 + (id >> 4) * 128 + (id & 15) * 8); \
            wv[i] = *(const u32x4*)(S1_ + (size_t)(_r0 + (id >> 4)) * 2048 + 1024 + _g * 128 + (id & 15) * 8); \
            st[i] = *(const f32x2*)(vst_ + ((size_t)(_r0 + (id >> 4)) * 16 + (id & 15)) * 2); } \
            _Pragma("unroll") for (int t = 0; t < 4; ++t) { un[0][t] = *(const u32x2*)(S1_ + (size_t)(_r0 + p) * 2048 + _g * 128 + c0 + 8 * t); un[1][t] = *(const u32x2*)(S1_ + (size_t)(_r0 + p) * 2048 + _g * 128 + c0 + 32 + 8 * t); } } while (0)
    int U = F.vcu;
    if (U < nunits) SP_LOAD(U);
#pragma nounroll
    for (; U < nunits; U += F.G) {
        const int r0 = (U >> 3) * 128, g = U & 7;
#pragma unroll
        for (int i = 0; i < 4; ++i) { const int id = tid + NTHR * i; *(LAS u32x4*)(As + (id >> 4) * LDA + (id & 15) * 8) = sa[i]; }
        { const int dc = tid & 15; const f32x4 g0 = *(const f32x4*)(vg + g * 128 + dc * 8), g1 = *(const f32x4*)(vg + g * 128 + dc * 8 + 4);
#pragma unroll
          for (int i = 0; i < 4; ++i) { const int id = tid + NTHR * i, q = id >> 4;
            float s1 = st[i].x, s2 = st[i].y;
            s1 += swz_xor<1>(s1); s2 += swz_xor<1>(s2); s1 += swz_xor<2>(s1); s2 += swz_xor<2>(s2); s1 += swz_xor<4>(s1); s2 += swz_xor<4>(s2); s1 += swz_xor<8>(s1); s2 += swz_xor<8>(s2);
            const float mean = s1 * (1.f / 1024.f), rstd = rsqrtf(fmaxf(s2 * (1.f / 1024.f) - mean * mean, 0.f) + EPS);
            float x[8];
#pragma unroll
            for (int k = 0; k < 4; ++k) { x[2 * k] = (bf_lo(wv[i][k]) - mean) * rstd; x[2 * k + 1] = (bf_hi(wv[i][k]) - mean) * rstd; }
            u32x4 o; o.x = cvt_pk_bf16(x[0] * g0[0], x[1] * g0[1]); o.y = cvt_pk_bf16(x[2] * g0[2], x[3] * g0[3]); o.z = cvt_pk_bf16(x[4] * g1[0], x[5] * g1[1]); o.w = cvt_pk_bf16(x[6] * g1[2], x[7] * g1[3]);
            *(LAS u32x4*)(Bs + q * LDB + dc * 8) = o; } }
        u32x2 uu[2][4];
#pragma unroll
        for (int t = 0; t < 4; ++t) { uu[0][t] = un[0][t]; uu[1][t] = un[1][t]; }
        const float bias = sb[g * 128 + p];
        __syncthreads();
        if (U + F.G < nunits) SP_LOAD(U + F.G);
        f32x16 acc0 = {}, acc1 = {};
        sp_kstep<0>(acc0, acc1, Ap, vb); sp_kstep<1>(acc0, acc1, Ap, vb); sp_kstep<2>(acc0, acc1, Ap, vb); sp_kstep<3>(acc0, acc1, Ap, vb);
        sp_kstep<4>(acc0, acc1, Ap, vb); sp_kstep<5>(acc0, acc1, Ap, vb); sp_kstep<6>(acc0, acc1, Ap, vb); sp_kstep<7>(acc0, acc1, Ap, vb);
        const size_t ro = (size_t)(r0 + p);
#pragma unroll
        for (int t = 0; t < 4; ++t) {
            u32x2 o0, o1;
            o0.x = cvt_pk_bf16((acc0[4 * t] + bias) * bf_lo(uu[0][t].x), (acc0[4 * t + 1] + bias) * bf_hi(uu[0][t].x)); o0.y = cvt_pk_bf16((acc0[4 * t + 2] + bias) * bf_lo(uu[0][t].y), (acc0[4 * t + 3] + bias) * bf_hi(uu[0][t].y));
            o1.x = cvt_pk_bf16((acc1[4 * t] + bias) * bf_lo(uu[1][t].x), (acc1[4 * t + 1] + bias) * bf_hi(uu[1][t].x)); o1.y = cvt_pk_bf16((acc1[4 * t + 2] + bias) * bf_lo(uu[1][t].y), (acc1[4 * t + 3] + bias) * bf_hi(uu[1][t].y));
            *(u32x2*)(S2_ + ro * D + g * 128 + c0 + 8 * t) = o0; *(u32x2*)(S2_ + ro * D + g * 128 + c0 + 32 + 8 * t) = o1; }
        __syncthreads();
    }
#undef SP_LOAD
}

__device__ __forceinline__ void qknorm_phase(const Fr& F) {
    const int tid = opaque_tid(), lane = tid & 63, wave = __builtin_amdgcn_readfirstlane(tid >> 6), gw = F.bx * NWAVES + wave, NGW = F.G * NWAVES;
    unsigned char* const ws_ = F.ws();
    const bf16_t* const S1_ = (const bf16_t*)(ws_ + WS_S1); bf16_t* const QB_ = (bf16_t*)(ws_ + WS_QB); bf16_t* const KB_ = (bf16_t*)(ws_ + WS_KB);
    const float* qg = F.in(I_AQG); const float* kg = F.in(I_AKG);
    const int hsel = lane >> 5, l5 = lane & 31;
    const f32x2 qg0 = *(const f32x2*)(qg + 2 * l5), qg1 = *(const f32x2*)(qg + 64 + 2 * l5), kg0 = *(const f32x2*)(kg + 2 * l5), kg1 = *(const f32x2*)(kg + 64 + 2 * l5);
    const float inv0 = exp2f(-(float)((2 * l5) & 31) * (13.287712379549449f / 32.f)), inv1 = exp2f(-(float)((2 * l5 + 1) & 31) * (13.287712379549449f / 32.f));
#pragma nounroll
    for (int g2 = gw; g2 < T / 2; g2 += NGW) {
        const int r0 = g2 * 2, b = r0 >> 11;
        unsigned u0[2][5], u1[2][5];
#pragma unroll
        for (int q = 0; q < 2; ++q)
#pragma unroll
            for (int ps = 0; ps < 5; ++ps) { const int hh = 2 * ps + hsel; const bf16_t* src = S1_ + (size_t)(r0 + q) * 2048 + (hh < 8 ? hh * 128 : 1024 + (hh - 8) * 128) + 2 * l5;
                u0[q][ps] = *(const unsigned*)src; u1[q][ps] = *(const unsigned*)(src + 64); }
#pragma unroll
        for (int q = 0; q < 2; ++q) {
            const int s = (r0 + q) & (SEQ - 1); const float pos = (float)(l5 < 16 ? (s >> 6) : (s & 63));
            float c0, s0, c1, s1; __sincosf(pos * inv0, &s0, &c0); __sincosf(pos * inv1, &s1, &c1);
            { c0 = cosf(pos * inv0); s0 = sinf(pos * inv0); c1 = cosf(pos * inv1); s1 = sinf(pos * inv1); }
#pragma unroll
            for (int ps = 0; ps < 5; ++ps) { const int hh = 2 * ps + hsel; const bool isk = ps == 4;
                float a0 = bf_lo(u0[q][ps]), a1 = bf_hi(u0[q][ps]), e0 = bf_lo(u1[q][ps]), e1 = bf_hi(u1[q][ps]);
                const float rs = rsqrtf(half_sum((a0 * a0 + a1 * a1) + (e0 * e0 + e1 * e1)) * (1.f / 128.f) + EPS);
                const f32x2 ga = isk ? kg0 : qg0, gb = isk ? kg1 : qg1;
                a0 *= rs * ga.x; a1 *= rs * ga.y; e0 *= rs * gb.x; e1 *= rs * gb.y;
                const float o10 = a0 * c0 - e0 * s0, o11 = a1 * c1 - e1 * s1, o20 = a0 * s0 + e0 * c0, o21 = a1 * s1 + e1 * c1;
                bf16_t* dst = isk ? KB_ + ((size_t)(b * 2 + (hh - 8)) * SKV + CL + s) * 128 + 2 * l5 : QB_ + (size_t)(r0 + q) * D + hh * 128 + 2 * l5;
                *(unsigned*)dst = cvt_pk_bf16(o10, o11); *(unsigned*)(dst + 64) = cvt_pk_bf16(o20, o21); }
        }
    }
#pragma nounroll
    for (int rc = gw; rc < TC; rc += NGW) {
        const int b = rc >> 8, s = rc & (CL - 1);
        const bf16_t* src = S1_ + (size_t)(T + rc) * 2048 + 1024 + hsel * 128 + 2 * l5;
        const unsigned u0 = *(const unsigned*)src, u1 = *(const unsigned*)(src + 64);
        float a0 = bf_lo(u0), a1 = bf_hi(u0), e0 = bf_lo(u1), e1 = bf_hi(u1);
        const float rs = rsqrtf(half_sum((a0 * a0 + a1 * a1) + (e0 * e0 + e1 * e1)) * (1.f / 128.f) + EPS);
        bf16_t* dst = KB_ + ((size_t)(b * 2 + hsel) * SKV + s) * 128 + 2 * l5;
        *(unsigned*)dst = cvt_pk_bf16(a0 * rs * kg0.x, a1 * rs * kg0.y); *(unsigned*)(dst + 64) = cvt_pk_bf16(e0 * rs * kg1.x, e1 * rs * kg1.y);
    }
}

template <int W> __device__ __forceinline__ void pool_item(const bf16_t* zb  , int s, bf16_t* dst) {
    constexpr int half = W / 2;
    u32x4 w[W];
#pragma unroll
    for (int k = 0; k < W; ++k) { int t = s - half + k; t = t < 0 ? 0 : (t > SEQ - 1 ? SEQ - 1 : t); w[k] = *(const u32x4*)(zb + (size_t)t * 2048); }
    float acc[8];
#pragma unroll
    for (int c = 0; c < 8; ++c) acc[c] = 0.f;
#pragma unroll
    for (int k = 0; k < W; ++k) { const int t = s - half + k; const float m = (t >= 0 && t < SEQ) ? 1.f : 0.f;
#pragma unroll
        for (int c = 0; c < 4; ++c) { acc[2 * c] += m * bf_lo(w[k][c]); acc[2 * c + 1] += m * bf_hi(w[k][c]); } }
    const int lo = s - half < 0 ? 0 : s - half, hi = s + half - 1 > SEQ - 1 ? SEQ - 1 : s + half - 1; const float ic = 1.f / (float)(hi - lo + 1);
    const u32x4 zc = w[half];
    float o[8];
#pragma unroll
    for (int c = 0; c < 4; ++c) { o[2 * c] = acc[2 * c] * ic - bf_lo(zc[c]); o[2 * c + 1] = acc[2 * c + 1] * ic - bf_hi(zc[c]); }
    u32x4 ov; ov.x = cvt_pk_bf16(o[0], o[1]); ov.y = cvt_pk_bf16(o[2], o[3]); ov.z = cvt_pk_bf16(o[4], o[5]); ov.w = cvt_pk_bf16(o[6], o[7]);
    *(u32x4*)dst = ov;
}
__device__ __forceinline__ void pool_phase(const Fr& F) {
    const int tid = opaque_tid(), lane = tid & 63, wave = __builtin_amdgcn_readfirstlane(tid >> 6);
    unsigned char* const ws_ = F.ws();
    const bf16_t* const S1_ = (const bf16_t*)(ws_ + WS_S1); bf16_t* const S2_ = (bf16_t*)(ws_ + WS_S2);
    const int gi = wave & 3, c8 = gi * 32 + (lane & 31), rsub = (wave >> 2) * 2 + (lane >> 5);
#pragma nounroll
    for (int r4 = F.bx; r4 < T / 4; r4 += F.G) {
        const int r = r4 * 4 + rsub, s = r & (SEQ - 1);
        const bf16_t* zb = S1_ + (size_t)(r - s) * 2048 + c8 * 8; bf16_t* dst = S2_ + (size_t)r * D + c8 * 8;
        if (gi == 0) pool_item<2>(zb, s, dst); else if (gi == 1) pool_item<4>(zb, s, dst); else if (gi == 2) pool_item<8>(zb, s, dst); else pool_item<16>(zb, s, dst);
    }
}

__global__ void __launch_bounds__(NTHR, 2) fwd_kernel(KArgs args) {
    extern __shared__ __attribute__((aligned(16))) unsigned char lds_raw[];
    LAS unsigned char* lds = (LAS unsigned char*)lds_raw;
    volatile LAS unsigned* MISC = (volatile LAS unsigned*)(lds + MISC_OFF);
    Fr F;
    F.PT = (volatile LAS unsigned long long*)(lds + MISC_OFF + 256);
    F.G = gridDim.x; F.bx = blockIdx.x; F.vcu = (F.G % 8 == 0) ? (F.bx % 8) * (F.G / 8) + F.bx / 8 : F.bx;
    { const int t0 = threadIdx.x;
      if (t0 < 64) MISC[t0] = 0u;
      if (t0 < 24) F.PT[t0] = (unsigned long long)args.in[t0];
      if (t0 == 24) F.PT[24] = (unsigned long long)args.out;
      if (t0 == 25) F.PT[25] = (unsigned long long)args.ws; }
    __syncthreads();
    XcdBarrier bar = xcd_barrier_post((unsigned*)(F.ws() + WS_CTL), MISC + 8);
    const int lo = args.ph_lo, hi = args.ph_hi;
    int p = 0;
#define RUN(...) RUNC(31, __VA_ARGS__)
#define RUNC(cls, ...) do { if (lo <= p && p < hi) { _Pragma("nounroll") for (int rep_ = 0; rep_ < 1 + (int)((REPEAT_MASK >> (cls)) & 1u); ++rep_) { __VA_ARGS__; if (REPEAT_MASK) __syncthreads(); } if (p + 1 < hi) xcd_barrier(bar); } ++p; } while (0)

#ifndef NO_P0
    RUNC(0, p0_phase(F, lds, 0));
    RUN({
        norm_phase(F, lds, 0, 1, TT, -1, 0, F.in(I_X), F.in(I_CTX), nullptr, nullptr, 0, true);
        __syncthreads();
        p0_phase(F, lds, 1);
    });
#endif
#pragma nounroll
    for (int L = 0; L < 4; ++L) {
        const int kind = L % 3, jm = L / 3;
        const bool with_ctx = (L == 0);
        if (L > 0) RUNC(1, {
            bf16_t* xo = WSP(F, bf16_t, WS_XB); bf16_t* xc = WSP(F, bf16_t, WS_XC);
#ifndef NO_NORM
            norm_phase(F, lds, L, 1, (L <= 1) ? TT : T, L - 1, 1, xo, xc, xo, xc, (REPEAT_MASK >> 1) & 1u ? (rep_ == 0) : 0, kind == 0);
#endif
        });
        RUNC(2, {
            unsigned char* ws = F.ws();
            pg8::SchedDense S; S.A = (bf16_t*)(ws + WS_H); S.G = F.G; S.c = F.bx; S.a_pn_stride = 0; S.a_pm_stride = 256 * D; S.b_pn_stride = 256 * D; S.extra = 0;
            pg8::EpiA E; E.O = (bf16_t*)(ws + WS_S1); E.ldc = 2048; E.act = 0; E.VB = nullptr; E.stats = nullptr;
            if (kind == 0) { S.Bt = (bf16_t*)(ws + WS_WGIN) + (size_t)jm * 2048 * 1024; S.nM = with_ctx ? 72 : 64; S.nN = 8; E.act = 1; E.stats = (float*)(ws + WS_VST); }
            else if (kind == 1) { S.Bt = (bf16_t*)(ws + WS_WAIN); S.nM = 64; S.nN = 6; S.extra = 16; E.VB = (bf16_t*)(ws + WS_VB); }
            else { S.Bt = (bf16_t*)(ws + WS_WPIN); S.nM = 64; S.nN = 4; }
            S.nwg = S.nM * S.nN;
            int role = F.bx;
            if (L == 0 && F.G == 256) { role = split_role(F, CV_G_GA); S.G = CV_G_GA; S.c = role; }
#ifndef NO_GA
            if (role >= 0) pg8::gemm_phase<pg8::EpiA, pg8::SchedDense>(lds, D, D, D, S, E);
#endif
            if (role < 0) { const int j0 = CV_B_GA + (-1 - role) * CV_Q_GA; convert_tiles(F, lds, j0, 1, j0 + CV_Q_GA, 0x7fffffff, 0); }
            if (L == 1) convert_in_idle_slot(F, lds, F.bx, S.nwg + S.extra, CV_B_GA1, CV_Q_GA1, CV_N_GA1);
        });
        if (kind == 0) {
#ifndef NO_SPAT
            RUNC(3, spatial_phase(F, lds, jm, with_ctx ? 144 : 128));
#endif
        }
        else if (kind == 1) {
#ifndef NO_QKN
            RUNC(4, qknorm_phase(F));
#endif
            RUNC(5, {
                unsigned char* ws = F.ws();
                const bf16_t* QB = (const bf16_t*)(ws + WS_QB); const bf16_t* KB = (const bf16_t*)(ws + WS_KB); const bf16_t* VB = (const bf16_t*)(ws + WS_VB); bf16_t* S2 = (bf16_t*)(ws + WS_S2);
                for (int i = 0; i * F.G + F.vcu < 512; ++i) { const int Lu = i * F.G + F.vcu, bk = Lu >> 5, w = Lu & 31, b = bk >> 1, kvh = bk & 1, h = kvh * 4 + (w >> 3), qb = w & 7;
#ifndef NO_ATT
                    att::attn_body<D, D>(QB + ((size_t)(b * SEQ + qb * 256)) * D + h * 128, KB + (size_t)bk * SKV * 128, VB + (size_t)bk * SKV * 128,
                                         S2 + ((size_t)(b * SEQ + qb * 256)) * D + h * 128, SKV, lds);
#endif
                    __syncthreads(); }
            });
        } else {
#ifndef NO_POOL
            RUNC(6, pool_phase(F));
#endif
        }
        RUNC(7, {
            unsigned char* ws = F.ws();
            pg8::SchedDense S; S.A = (bf16_t*)(ws + WS_S2); S.G = F.G; S.c = F.bx; S.a_pm_stride = 256 * D; S.a_pn_stride = 0; S.b_pn_stride = 256 * D; S.extra = 0; S.nN = 4; S.nM = 64;
            pg8::EpiB E; E.xd_lat = (bf16_t*)(ws + WS_XB); E.xd_ctx = (bf16_t*)(ws + WS_XC); E.src_f32 = (L == 0); E.xs_lat = (L == 0) ? (const void*)F.in(I_X) : (const void*)E.xd_lat; E.xs_ctx = (L == 0) ? (const void*)F.in(I_CTX) : (const void*)E.xd_ctx;
            E.gt = (const float*)(ws + WS_MODV) + (size_t)L * 9 * 6144 + 2 * 1024; E.colscale = nullptr; E.dry = (REPEAT_MASK >> 7) & 1u ? (rep_ == 0) : 0;
            int K = D, ldb = D;
            if (kind == 0) { S.Bt = (bf16_t*)(ws + WS_WGOUT) + (size_t)jm * 1024 * 1024; S.nM = with_ctx ? 72 : 64; }
            else if (kind == 1) { S.Bt = (bf16_t*)(ws + WS_WAOUT); }
            else { S.Bt = (bf16_t*)(ws + WS_WPGRP); S.a_pn_stride = 256; S.b_pn_stride = 256 * 256; K = 256; ldb = 256; E.colscale = F.in(I_PSC); }
            S.nwg = S.nM * S.nN;
            int role = F.bx;
            if (L == 0 && F.G == 256) { role = split_role(F, CV_G_GB); S.G = CV_G_GB; S.c = role; }
#ifndef NO_GB
            if (role >= 0) pg8::gemm_phase<pg8::EpiB, pg8::SchedDense>(lds, K, D, ldb, S, E);
#endif
            if (role < 0) { const int j0 = CV_B_GB + (-1 - role) * CV_Q_GB; convert_tiles(F, lds, j0, 1, j0 + CV_Q_GB, 0x7fffffff, 0); }
        });
        RUNC(8, {
            bf16_t* xo = WSP(F, bf16_t, WS_XB); bf16_t* xc = WSP(F, bf16_t, WS_XC);
#ifndef NO_NORM
            norm_phase(F, lds, L, 2, with_ctx ? TT : T, -1, 1, xo, xc, xo, xc, ((REPEAT_MASK >> 13) & 1u) && rep_ == 0 ? 2 : 0);
#endif
        });
#ifndef NO_TOPK
        RUNC(9, { topk_phase(F, lds, with_ctx); if (L == 1 || L == 2) convert_in_idle_slot(F, lds, F.bx, 128, L == 1 ? CV_B_TK1 : CV_B_TK2, CV_Q_TK, CV_N_TK); });
#endif
        RUNC(10, {
            unsigned char* ws = F.ws();
            pg8::SchedMoE<true> S; S.A = (bf16_t*)(ws + WS_H); S.IDX = (const int*)(ws + WS_IDX); S.Bt = (bf16_t*)(ws + WS_WUP) + (size_t)L * 16 * 2048 * 1024; S.nbt = with_ctx ? 9 : 8; S.nn = 8; S.G = F.G; S.vcu = F.vcu;
            pg8::EpiC E; E.HID = (bf16_t*)(ws + WS_HID);
            #ifndef NO_GC
            pg8::gemm_phase<pg8::EpiC, pg8::SchedMoE<true>>(lds, D, D, D, S, E);
#endif
            if (L == 0) convert_in_idle_slot(F, lds, F.vcu, NE * S.nbt * S.nn, CV_B_UP, CV_Q_UP, CV_N_UP);
        });
        RUNC(11, {
            unsigned char* ws = F.ws();
            pg8::SchedMoE<false> S; S.A = (bf16_t*)(ws + WS_HID); S.IDX = nullptr; S.Bt = (bf16_t*)(ws + WS_WDN) + (size_t)L * 16 * 1024 * 1024; S.nbt = with_ctx ? 9 : 8; S.nn = 4; S.G = F.G; S.vcu = F.vcu;
            pg8::EpiD E; E.Y = (bf16_t*)(ws + WS_YEXP); E.gate = (const float*)(ws + WS_GATE);
            int role = F.bx;
            if (L == 0 && F.G == 256) { role = split_role(F, CV_G_DN); S.G = CV_G_DN; S.vcu = role >= 0 ? (role & 7) * (CV_G_DN / 8) + (role >> 3) : 0; }
#ifndef NO_GD
            if (role >= 0) pg8::gemm_phase<pg8::EpiD, pg8::SchedMoE<false>>(lds, D, D, D, S, E);
#endif
            if (role < 0) { const int j0 = CV_B_DN + (-1 - role) * CV_Q_DN; convert_tiles(F, lds, j0, 1, j0 + CV_Q_DN, 0x7fffffff, 0); }
        });
    }
    RUN({
        bf16_t* xb = WSP(F, bf16_t, WS_XB);
#ifndef NO_NORM
        norm_phase(F, lds, 3, 0, T, 3, 2, xb, nullptr, F.out(), nullptr);
#endif
    });
#undef RUN
#undef RUNC
}

constexpr int N_PHASES = 1 + 8 + 9 + 8 + 8 + 1;

extern "C" void kernel_launch(void* const* d_in, const int* in_sizes, int n_in, void* d_out, int out_size, void* d_ws, size_t ws_size, hipStream_t stream) {
    static int grid = 0;
    if (grid == 0) {
        if (n_in != 24 || out_size != T * D || ws_size < WS_END) { fprintf(stderr, "kernel_launch: unexpected shapes (n_in %d out %d ws %zu need %zu)\n", n_in, out_size, ws_size, (size_t)WS_END); grid = -1; return; }
        int dev = 0, cus = 0;
        if (hipGetDevice(&dev) != hipSuccess || hipDeviceGetAttribute(&cus, hipDeviceAttributeMultiprocessorCount, dev) != hipSuccess) { grid = -1; return; }
        if (hipFuncSetAttribute((const void*)fwd_kernel, hipFuncAttributeMaxDynamicSharedMemorySize, LDS_BYTES) != hipSuccess) { fprintf(stderr, "kernel_launch: hipFuncSetAttribute failed\n"); grid = -1; return; }
        (void)hipGetLastError();
        grid = cus;
    }
    if (grid < 0) return;
    (void)hipMemsetAsync((char*)d_ws + WS_CTL, 0, CTL_BYTES, stream);
    KArgs a{};
    for (int i = 0; i < 24; ++i) a.in[i] = (const float*)d_in[i];
    a.out = (float*)d_out; a.ws = (unsigned char*)d_ws;
#if MK_PER_PHASE
    for (int k = 0; k < N_PHASES; ++k) { a.ph_lo = k; a.ph_hi = k + 1; hipLaunchKernelGGL(fwd_kernel, dim3(grid), dim3(NTHR), LDS_BYTES, stream, a); }
#else
    a.ph_lo = 0; a.ph_hi = N_PHASES;
    hipLaunchKernelGGL(fwd_kernel, dim3(grid), dim3(NTHR), LDS_BYTES, stream, a);
#endif
    const hipError_t le = hipPeekAtLastError();
    if (le != hipSuccess) fprintf(stderr, "kernel_launch: launch failed: %s\n", hipGetErrorName(le));
}
```

```cpp
#include <hip/hip_runtime.h>
#include <cstdio>
#include <cstdint>

#ifndef REPEAT_MASK
#define REPEAT_MASK 0u
#endif
#ifndef MK_PER_PHASE
#define MK_PER_PHASE 0
#endif

#define LAS __attribute__((address_space(3)))
#define GAS __attribute__((address_space(1)))
typedef unsigned short bf16_t;
typedef short bf16x8 __attribute__((ext_vector_type(8)));
typedef short s16x4 __attribute__((ext_vector_type(4)));
typedef float f32x2 __attribute__((ext_vector_type(2)));
typedef float f32x4 __attribute__((ext_vector_type(4)));
typedef float f32x16 __attribute__((ext_vector_type(16)));
typedef unsigned u32x2 __attribute__((ext_vector_type(2)));
typedef unsigned u32x4 __attribute__((ext_vector_type(4)));

constexpr int D = 1024, NB = 8, SEQ = 2048, T = NB * SEQ, CL = 256, TC = NB * CL, TT = T + TC, NE = 16, CAP = 256, CCAP = 32, NTILE = 144;
constexpr int SKV = CL + SEQ;
constexpr float EPS = 1e-6f;
constexpr int NWAVES = 8, NTHR = 512;

constexpr size_t al256(size_t x) { return (x + 255) / 256 * 256; }
constexpr size_t WS_CTL   = 0;
constexpr size_t CTL_BYTES = 65536;
constexpr size_t WS_MODV  = WS_CTL + CTL_BYTES;
constexpr size_t WS_AFF   = WS_MODV + al256((size_t)4 * 9 * 6144 * 4);
constexpr size_t WS_SLOT  = WS_AFF + (size_t)TT * 16 * 4;
constexpr size_t WS_GATE  = WS_SLOT + (size_t)TT * 16 * 4;
constexpr size_t WS_VST   = WS_GATE + (size_t)NTILE * 256 * 4;
constexpr size_t WS_WSW   = WS_VST + (size_t)TT * 16 * 2 * 4;
constexpr size_t WS_WGIN  = WS_WSW + (size_t)2 * 8 * 128 * 128 * 2;
constexpr size_t WS_WGOUT = WS_WGIN + (size_t)2 * 2048 * 1024 * 2;
constexpr size_t WS_WAIN  = WS_WGOUT + (size_t)2 * 1024 * 1024 * 2;
constexpr size_t WS_WAOUT = WS_WAIN + (size_t)1536 * 1024 * 2;
constexpr size_t WS_WPIN  = WS_WAOUT + (size_t)1024 * 1024 * 2;
constexpr size_t WS_WPGRP = WS_WPIN + (size_t)1024 * 1024 * 2;
constexpr size_t WS_WUP   = WS_WPGRP + (size_t)4 * 256 * 256 * 2;
constexpr size_t WS_WDN   = WS_WUP + (size_t)4 * 16 * 2048 * 1024 * 2;
constexpr size_t WS_XC    = WS_WDN + (size_t)4 * 16 * 1024 * 1024 * 2;
constexpr size_t WS_XB    = WS_XC + (size_t)TC * D * 2;
constexpr size_t WS_H     = WS_XB + (size_t)T * D * 2;
constexpr size_t WS_S1    = WS_H + (size_t)TT * D * 2;
constexpr size_t WS_S2    = WS_S1 + (size_t)TT * 2048 * 2;
constexpr size_t WS_QB    = WS_S2 + (size_t)TT * D * 2;
constexpr size_t WS_KB    = WS_QB + (size_t)T * D * 2;
constexpr size_t WS_VB    = WS_KB + (size_t)NB * 2 * SKV * 128 * 2;
constexpr size_t WS_IDX   = WS_VB + (size_t)NB * 2 * SKV * 128 * 2;
constexpr size_t WS_HID   = WS_IDX + (size_t)NTILE * 256 * 4;
constexpr size_t WS_YEXP  = WS_HID + (size_t)NTILE * 256 * D * 2;
constexpr size_t WS_END   = WS_YEXP + (size_t)NTILE * 256 * D * 2;

constexpr int RING_BYTES = 131072, MISC_OFF = RING_BYTES, LDS_BYTES = RING_BYTES + 1024;

__device__ __forceinline__ unsigned cvt_pk_bf16(float lo, float hi) { unsigned r; asm volatile("v_cvt_pk_bf16_f32 %0, %1, %2" : "=v"(r) : "v"(lo), "v"(hi)); return r; }
__device__ __forceinline__ float bf_lo(unsigned u) { return __uint_as_float(u << 16); }
__device__ __forceinline__ float bf_hi(unsigned u) { return __uint_as_float(u & 0xffff0000u); }
__device__ __forceinline__ float bf2f(bf16_t b) { return __uint_as_float(((unsigned)b) << 16); }
__device__ __forceinline__ bf16_t f2bf(float f) { return (bf16_t)(cvt_pk_bf16(f, 0.f) & 0xffffu); }
template <int K> __device__ __forceinline__ float swz_xor(float v) { return __int_as_float(__builtin_amdgcn_ds_swizzle(__float_as_int(v), 0x1F | (K << 10))); }
__device__ __forceinline__ float half_sum(float v) { v += swz_xor<1>(v); v += swz_xor<2>(v); v += swz_xor<4>(v); v += swz_xor<8>(v); v += swz_xor<16>(v); return v; }
__device__ __forceinline__ float half_max(float v) { v = fmaxf(v, swz_xor<1>(v)); v = fmaxf(v, swz_xor<2>(v)); v = fmaxf(v, swz_xor<4>(v)); v = fmaxf(v, swz_xor<8>(v)); v = fmaxf(v, swz_xor<16>(v)); return v; }
__device__ __forceinline__ float wave_sum(float v) { v = half_sum(v); auto rr = __builtin_amdgcn_permlane32_swap(__float_as_uint(v), __float_as_uint(v), false, false); return __uint_as_float(rr[0]) + __uint_as_float(rr[1]); }
__device__ __forceinline__ float wave_max(float v) { v = half_max(v); auto rr = __builtin_amdgcn_permlane32_swap(__float_as_uint(v), __float_as_uint(v), false, false); return fmaxf(__uint_as_float(rr[0]), __uint_as_float(rr[1])); }
__device__ __forceinline__ float xor32(float v, bool hi) { auto rr = __builtin_amdgcn_permlane32_swap(__float_as_uint(v), __float_as_uint(v), false, false); return __uint_as_float(hi ? rr[0] : rr[1]); }
__device__ __forceinline__ int opaque_tid() { int t = threadIdx.x; asm volatile("" : "+v"(t)); return t; }
__device__ __forceinline__ float silu_f(float x) { return x / (1.f + __expf(-x)); }
__device__ __forceinline__ float gelu_tanh_f(float x) {
    const float z = 0.7978845608028654f * (x + 0.044715f * x * x * x);
    return x / (1.f + __expf(-2.f * z));
}
#define LDS_WAIT() asm volatile("s_waitcnt lgkmcnt(0)" ::: "memory")

#define XB_TMO      128
#define XB_XCNT(j)  (256  + 64 * (j))
#define XB_XSUB(j)  (1280 + 64 * (j))
#define XB_XGEN(j)  (2304 + 64 * (j))
#define XB_TOP      3328
#define XB_TOPGEN   3392
#define XCD_BAR_WORDS 3456
#define XB_SPIN_CAP (1u << 22)
__device__ __forceinline__ unsigned xb_ld(unsigned* p)              { return __hip_atomic_load(p, __ATOMIC_RELAXED, __HIP_MEMORY_SCOPE_AGENT); }
__device__ __forceinline__ unsigned xb_add(unsigned* p, unsigned v) { return __hip_atomic_fetch_add(p, v, __ATOMIC_RELAXED, __HIP_MEMORY_SCOPE_AGENT); }
__device__ __forceinline__ unsigned xb_xcc_id() { return (unsigned)__builtin_amdgcn_s_getreg((3 << 11) | 20) & 0xFu; }
#define XB_SPIN(cond, bar) do { unsigned _sp = 0; while (cond) { __builtin_amdgcn_s_sleep(1); \
    if ((++_sp & 255u) == 0u) { if (xb_ld(&(bar)[XB_TMO])) break; if (_sp > XB_SPIN_CAP) { atomicAdd(&(bar)[XB_TMO], 1u); break; } } } } while (0)
struct XcdBarrier { unsigned* bar; unsigned x; volatile LAS unsigned* st; };
__device__ __forceinline__ XcdBarrier xcd_barrier_post(unsigned* bar, volatile LAS unsigned* st) {
    XcdBarrier b; b.bar = bar; b.x = xb_xcc_id(); b.st = st;
    if (threadIdx.x == 0) (void)xb_add(&bar[XB_XCNT(b.x)], 1u);
    return b;
}
__device__ __forceinline__ void xcd_barrier_complete(unsigned* bar, unsigned x, unsigned& nloc, unsigned& nx) {
    const unsigned G = gridDim.x * gridDim.y * gridDim.z;
    unsigned sum, cnt, mine, sp = 0u;
    for (;;) {
        sum = 0u; cnt = 0u; mine = 0u;
#pragma unroll
        for (unsigned j = 0; j < 16; ++j) { const unsigned c = xb_ld(&bar[XB_XCNT(j)]); sum += c; cnt += (c > 0u) ? 1u : 0u; }
        mine = xb_ld(&bar[XB_XCNT(x)]);
        if (sum == G) break;
        __builtin_amdgcn_s_sleep(1);
        if ((++sp & 255u) == 0u) { if (xb_ld(&bar[XB_TMO])) break; if (sp > XB_SPIN_CAP) { atomicAdd(&bar[XB_TMO], 1u); break; } }
    }
    nloc = mine > 0u ? mine : 1u; nx = cnt > 0u ? cnt : 1u;
}
__device__ __forceinline__ void xcd_barrier(const XcdBarrier& b) {
    asm volatile("s_waitcnt vmcnt(0)" ::: "memory");
    __syncthreads();
    if (threadIdx.x == 0) {
        unsigned* bar = b.bar;
        __builtin_amdgcn_s_waitcnt(0);
        unsigned nloc = b.st[0], nx = b.st[1];
        if (nloc == 0u) { xcd_barrier_complete(bar, b.x, nloc, nx); b.st[0] = nloc; b.st[1] = nx; }
        const unsigned old = xb_add(&bar[XB_XSUB(b.x)], 1u);
        const unsigned gen = old / nloc;
        if (old + 1u == (gen + 1u) * nloc) {
            __builtin_amdgcn_fence(__ATOMIC_RELEASE, "agent");
            asm volatile("s_waitcnt vmcnt(0)" ::: "memory");
            const unsigned og = xb_add(&bar[XB_TOP], 1u);
            const unsigned tg = og / nx;
            if (og + 1u == (tg + 1u) * nx) xb_add(&bar[XB_TOPGEN], 1u);
            else XB_SPIN(xb_ld(&bar[XB_TOPGEN]) == tg, bar);
            __builtin_amdgcn_fence(__ATOMIC_ACQUIRE, "agent");
            xb_add(&bar[XB_XGEN(b.x)], 1u);
            asm volatile("s_waitcnt vmcnt(0)" ::: "memory");
        } else {
            XB_SPIN(xb_ld(&bar[XB_XGEN(b.x)]) == gen, bar);
            __builtin_amdgcn_fence(__ATOMIC_ACQUIRE, "agent");
            asm volatile("s_waitcnt vmcnt(0)" ::: "memory");
        }
    }
    __syncthreads();
}

namespace pg8 {
constexpr int BM = 256, BK = 64, HALF = 128, HTB = HALF * BK * 2, NXCD = 8, WGM = 8;
__host__ __device__ __forceinline__ int lds_byte(int r, int c) { const int st = (r >> 4) * 2 + (c >> 5), rr = r & 15, cc = c & 31, ob = rr * 64 + cc * 2; return st * 1024 + (ob ^ (((ob >> 9) & 1) << 5)); }
__host__ __device__ __forceinline__ void stage_rc(int b, int& R, int& C) { const int st = b / 1024, sb = b % 1024, swz = sb ^ (((sb >> 9) & 1) << 5); R = (st >> 1) * 16 + swz / 64; C = (st & 1) * 32 + (swz % 64) / 2; }
__host__ __device__ __forceinline__ int perm32(int rho) { const int n = rho >> 4, i = rho & 15; return 8 * (i >> 2) + 4 * n + (i & 3); }
struct Unit { int pm, pn; };

template <class Epi, class Sched>
__device__ __forceinline__ void gemm_phase(LAS unsigned char* lds, const int K, const int lda, const int ldb, const Sched& S, const Epi& E) {
    const int tid = opaque_tid(), wid = __builtin_amdgcn_readfirstlane(tid >> 6), lane = tid & 63, wr = wid >> 2, wc = wid & 3, fr = lane & 15, fq = lane >> 4;
    const int nt = K / BK;
    constexpr bool GATHER = Sched::GATHER;
    unsigned voffA[2], voffB[2]; int rowA[2];
#pragma unroll
    for (int i = 0; i < 2; ++i) { int R, C; stage_rc(tid * 16 + i * 8192, R, C); const int Rb = Epi::PERM ? ((R & ~31) + perm32(R & 31)) : R;
        voffA[i] = GATHER ? (unsigned)C * 2u : (unsigned)(R * lda + C) * 2u; voffB[i] = (unsigned)(Rb * ldb + C) * 2u; rowA[i] = R; }
    unsigned gA[2][2], gN[2][2];
    const size_t kstep = (size_t)(BK * 2);
    const size_t hstepA = (size_t)HALF * lda * 2, hstepB = (size_t)HALF * ldb * 2;
    const unsigned ldsw = (unsigned)wid * 1024u;
    const int aoff = lds_byte(wr * 64 + fr, fq * 8), boff = lds_byte(wc * 32 + fr, fq * 8);
#define PG8_SA(b, h) (((b) * 2 + (h)) * HTB)
#define PG8_SB(b, h) ((4 + (b) * 2 + (h)) * HTB)
#define PG8_STAGE(bufoff, gbase, voff) do { _Pragma("unroll") for (int _i = 0; _i < 2; ++_i) \
        __builtin_amdgcn_global_load_lds((const unsigned*)((const char*)(gbase) + (voff)[_i]), (LAS unsigned*)(lds + (bufoff) + ldsw + _i * 8192), 16, 0, 0); } while (0)
#define PG8_STAGE_A(bufoff, ubase, kb, h, nx) do { if constexpr (GATHER) { unsigned _v[2]; _v[0] = ((nx) ? gN[h][0] : gA[h][0]) + voffA[0]; _v[1] = ((nx) ? gN[h][1] : gA[h][1]) + voffA[1]; \
        PG8_STAGE(bufoff, (const char*)S.abase() + (kb), _v); } else { PG8_STAGE(bufoff, (ubase) + (size_t)(h) * hstepA + (kb), voffA); } } while (0)
#define PG8_LOADG(u, g) do { if constexpr (GATHER) { const int* _ip = S.idx(u); _Pragma("unroll") for (int _h = 0; _h < 2; ++_h) _Pragma("unroll") for (int _i = 0; _i < 2; ++_i) \
        g[_h][_i] = (unsigned)_ip[_h * HALF + rowA[_i]] * (unsigned)(lda * 2); } } while (0)
#define PG8_LDA(dst, b, h) do { _Pragma("unroll") for (int m = 0; m < 4; ++m) _Pragma("unroll") for (int k = 0; k < 2; ++k) dst[m][k] = *(const LAS bf16x8*)(lds + PG8_SA(b, h) + aoff + m * 2048 + k * 1024); } while (0)
#define PG8_LDB(dst, b, h) do { _Pragma("unroll") for (int n = 0; n < 2; ++n) _Pragma("unroll") for (int k = 0; k < 2; ++k) dst[n][k] = *(const LAS bf16x8*)(lds + PG8_SB(b, h) + boff + n * 2048 + k * 1024); } while (0)
#define PG8_MMA(ai, bj, At, Bt) do { __builtin_amdgcn_s_setprio(1); _Pragma("unroll") for (int m = 0; m < 4; ++m) _Pragma("unroll") for (int n = 0; n < 2; ++n) _Pragma("unroll") for (int k = 0; k < 2; ++k) \
        acc[ai][bj][m][n] = __builtin_amdgcn_mfma_f32_16x16x32_bf16(Bt[n][k], At[m][k], acc[ai][bj][m][n], 0, 0, 0); __builtin_amdgcn_s_setprio(0); } while (0)
#define PG8_WAIT_V(n) asm volatile("s_waitcnt vmcnt(" #n ")" ::: "memory")
#define PG8_WAIT_L(n) asm volatile("s_waitcnt lgkmcnt(" #n ")" ::: "memory")
#define PG8_BAR __builtin_amdgcn_s_barrier()
#define PG8_SCHED __builtin_amdgcn_sched_barrier(0)
    Unit cur, nxt; int ui = 0;
    if (!S.next(0, cur)) return;
    f32x4 acc[2][2][4][2];
#pragma unroll
    for (int a = 0; a < 2; ++a)
#pragma unroll
        for (int b = 0; b < 2; ++b)
#pragma unroll
            for (int m = 0; m < 4; ++m)
#pragma unroll
                for (int n = 0; n < 2; ++n) acc[a][b][m][n] = (f32x4){0.f, 0.f, 0.f, 0.f};
    bf16x8 At[4][2], B0[2][2], B1[2][2];
    const char* cA = GATHER ? (const char*)nullptr : S.aptr(cur); const char* cB = S.bptr(cur);
    PG8_LOADG(cur, gA);
    PG8_STAGE(PG8_SB(0, 0), cB, voffB); PG8_STAGE(PG8_SB(0, 1), cB + hstepB, voffB); PG8_STAGE_A(PG8_SA(0, 0), cA, 0, 0, false); PG8_STAGE_A(PG8_SA(0, 1), cA, 0, 1, false);
    if (wr == 1) PG8_BAR;
    PG8_WAIT_V(2); PG8_BAR;
    PG8_STAGE(PG8_SB(1, 0), cB + kstep, voffB); PG8_STAGE_A(PG8_SA(1, 0), cA, kstep, 0, false); PG8_STAGE(PG8_SB(1, 1), cB + hstepB + kstep, voffB);
    PG8_WAIT_V(6); PG8_BAR;
    for (;;) {
        const bool has_next = S.next(ui + 1, nxt);
        const char* nA = (has_next && !GATHER) ? S.aptr(nxt) : cA; const char* nB = has_next ? S.bptr(nxt) : cB;
        if (has_next) PG8_LOADG(nxt, gN); else { if constexpr (GATHER) {
#pragma unroll
            for (int h_ = 0; h_ < 2; ++h_) { gN[h_][0] = gA[h_][0]; gN[h_][1] = gA[h_][1]; } } }
        for (int t = 0; t < nt; t += 2) {
            const bool last = (t == nt - 2);
            const size_t k1 = (size_t)(t + 1) * kstep, k2 = last ? 0 : (size_t)(t + 2) * kstep, k3 = k2 + kstep;
            const char* a2 = last ? nA : cA; const char* b2 = last ? nB : cB + (size_t)(t + 2) * kstep;
            const char* b3 = b2 + kstep;
            PG8_LDB(B0, 0, 0); PG8_LDB(B1, 0, 1); PG8_SCHED; PG8_LDA(At, 0, 0); PG8_STAGE_A(PG8_SA(1, 1), cA, k1, 1, false);
            PG8_WAIT_V(8); PG8_WAIT_L(0); PG8_BAR; PG8_MMA(0, 0, At, B0); PG8_MMA(0, 1, At, B1); PG8_BAR; PG8_SCHED;
            PG8_LDA(At, 0, 1); PG8_STAGE(PG8_SB(0, 0), b2, voffB); PG8_STAGE(PG8_SB(0, 1), b2 + hstepB, voffB); PG8_STAGE_A(PG8_SA(0, 0), a2, k2, 0, last);
            PG8_WAIT_V(8); PG8_WAIT_L(0); PG8_BAR; PG8_MMA(1, 0, At, B0); PG8_MMA(1, 1, At, B1); PG8_BAR; PG8_SCHED;
            PG8_LDB(B0, 1, 0); PG8_LDB(B1, 1, 1); PG8_SCHED; PG8_LDA(At, 1, 0); PG8_STAGE_A(PG8_SA(0, 1), a2, k2, 1, last);
            PG8_WAIT_V(8); PG8_WAIT_L(0); PG8_BAR; PG8_MMA(0, 0, At, B0); PG8_MMA(0, 1, At, B1); PG8_BAR; PG8_SCHED;
            PG8_LDA(At, 1, 1); PG8_STAGE(PG8_SB(1, 0), b3, voffB); PG8_STAGE(PG8_SB(1, 1), b3 + hstepB, voffB); PG8_STAGE_A(PG8_SA(1, 0), a2, k3, 0, last);
            PG8_WAIT_V(8); PG8_WAIT_L(0); PG8_BAR; PG8_MMA(1, 0, At, B0); PG8_MMA(1, 1, At, B1); PG8_BAR; PG8_SCHED;
        }
        if (wr == 0) PG8_BAR;
        E(acc, cur, wr, wc, fr, fq);
        if (!has_next) break;
#pragma unroll
        for (int a = 0; a < 2; ++a)
#pragma unroll
            for (int b = 0; b < 2; ++b)
#pragma unroll
                for (int m = 0; m < 4; ++m)
#pragma unroll
                    for (int n = 0; n < 2; ++n) acc[a][b][m][n] = (f32x4){0.f, 0.f, 0.f, 0.f};
        cur = nxt; cA = nA; cB = nB; ++ui;
        if constexpr (GATHER) {
#pragma unroll
            for (int h_ = 0; h_ < 2; ++h_) { gA[h_][0] = gN[h_][0]; gA[h_][1] = gN[h_][1]; } }
        if (wr == 1) PG8_BAR;
    }
    PG8_WAIT_V(0);
    PG8_BAR;
#undef PG8_SA
#undef PG8_SB
#undef PG8_STAGE
#undef PG8_STAGE_A
#undef PG8_LOADG
#undef PG8_LDA
#undef PG8_LDB
#undef PG8_MMA
#undef PG8_WAIT_V
#undef PG8_WAIT_L
#undef PG8_BAR
#undef PG8_SCHED
}

struct SchedDense {
    static constexpr bool GATHER = false;
    __device__ __forceinline__ const char* abase() const { return nullptr; }
    __device__ __forceinline__ const int* idx(const Unit&) const { return nullptr; }
    const bf16_t* A; const bf16_t* Bt; int a_pm_stride, a_pn_stride, b_pn_stride;
    int nM, nN, nwg, extra, G, c;
    __device__ __forceinline__ bool next(int i, Unit& u) const {
        const int L = i * G + c; if (L >= nwg + extra) return false;
        if (L >= nwg) { const int x = L - nwg; u.pm = nM + (x >> 1); u.pn = 4 + (x & 1); return true; }
        int wgid = L; { const int q = nwg / NXCD, r = nwg % NXCD, xcd = wgid % NXCD, off = wgid / NXCD; wgid = (xcd < r ? xcd * (q + 1) : r * (q + 1) + (xcd - r) * q) + off; }
        const int nig = WGM * nN, gid = wgid / nig, fm = gid * WGM, gsz = (nM - fm) < WGM ? (nM - fm) : WGM;
        u.pm = fm + ((wgid % nig) % gsz); u.pn = (wgid % nig) / gsz; return true;
    }
    __device__ __forceinline__ const char* aptr(const Unit& u) const { return (const char*)(A + (size_t)u.pm * a_pm_stride + (size_t)u.pn * a_pn_stride); }
    __device__ __forceinline__ const char* bptr(const Unit& u) const { return (const char*)(Bt + (size_t)u.pn * b_pn_stride); }
};
template <bool GATHER_>
struct SchedMoE {
    static constexpr bool GATHER = GATHER_;
    const bf16_t* A; const bf16_t* Bt; const int* IDX; int nbt, nn, G, vcu;
    __device__ __forceinline__ bool next(int i, Unit& u) const {
        const int L = i * G + vcu, per_e = nbt * nn; if (L >= NE * per_e) return false;
        const int e = L / per_e, rem = L - e * per_e, bt = rem / nn, j = rem - bt * nn;
        u.pm = bt < 8 ? e * 8 + bt : 128 + e; u.pn = e * nn + j; return true;
    }
    __device__ __forceinline__ const char* aptr(const Unit& u) const { return (const char*)(A + (size_t)u.pm * 256 * D); }
    __device__ __forceinline__ const char* abase() const { return (const char*)A; }
    __device__ __forceinline__ const int* idx(const Unit& u) const { return IDX + (size_t)u.pm * 256; }
    __device__ __forceinline__ const char* bptr(const Unit& u) const { return (const char*)(Bt + (size_t)u.pn * 256 * D); }
};

struct EpiA {
    static constexpr bool PERM = true;
    bf16_t* O; int ldc; int act; bf16_t* VB; float* stats;
    __device__ __forceinline__ void operator()(const f32x4 (&acc)[2][2][4][2], const Unit& u, int wr, int wc, int fr, int fq) const {
        const int row0 = u.pm * BM + wr * 64 + fr, cl = wc * 32 + 8 * fq;
        const bool vtile = (VB != nullptr) && (u.pn == 5);
        const bool dostat = (stats != nullptr) && (u.pn >= 4);
#pragma unroll
        for (int ai = 0; ai < 2; ++ai)
#pragma unroll
            for (int m = 0; m < 4; ++m) {
                const int r = row0 + ai * HALF + m * 16;
                float s1 = 0.f, s2 = 0.f;
#pragma unroll
                for (int bj = 0; bj < 2; ++bj) {
                    f32x4 v0 = acc[ai][bj][m][0], v1 = acc[ai][bj][m][1];
                    if (act) {
#pragma unroll
                        for (int j = 0; j < 4; ++j) { v0[j] = gelu_tanh_f(v0[j]); v1[j] = gelu_tanh_f(v1[j]); } }
#pragma unroll
                    for (int j = 0; j < 4; ++j) { s1 += v0[j] + v1[j]; s2 += v0[j] * v0[j] + v1[j] * v1[j]; }
                    u32x4 w; w.x = cvt_pk_bf16(v0[0], v0[1]); w.y = cvt_pk_bf16(v0[2], v0[3]); w.z = cvt_pk_bf16(v1[0], v1[1]); w.w = cvt_pk_bf16(v1[2], v1[3]);
                    bf16_t* dst;
                    if (vtile) { int b, pos; if (r < T) { b = r >> 11; pos = CL + (r & (SEQ - 1)); } else { const int rc = r - T; b = rc >> 8; pos = rc & (CL - 1); }
                        dst = VB + ((size_t)(b * 2 + bj) * SKV + pos) * 128 + cl; }
                    else dst = O + (size_t)r * ldc + u.pn * BM + bj * HALF + cl;
                    *(u32x4*)dst = w; }
                if (dostat) {
                    s1 += swz_xor<16>(s1); s2 += swz_xor<16>(s2);
                    { auto rr = __builtin_amdgcn_permlane32_swap(__float_as_uint(s1), __float_as_uint(s1), false, false); s1 = __uint_as_float(rr[0]) + __uint_as_float(rr[1]); }
                    { auto rr = __builtin_amdgcn_permlane32_swap(__float_as_uint(s2), __float_as_uint(s2), false, false); s2 = __uint_as_float(rr[0]) + __uint_as_float(rr[1]); }
                    if (fq == 0) *(f32x2*)(stats + ((size_t)r * 16 + (u.pn - 4) * 4 + wc) * 2) = (f32x2){s1, s2}; } }
    }
};
struct EpiB {
    static constexpr bool PERM = true;
    const void* xs_lat; const void* xs_ctx; bf16_t* xd_lat; bf16_t* xd_ctx; const float* gt; const float* colscale; int src_f32; int dry;
    __device__ __forceinline__ void operator()(const f32x4 (&acc)[2][2][4][2], const Unit& u, int wr, int wc, int fr, int fq) const {
        const int row0 = u.pm * BM + wr * 64 + fr, col0 = u.pn * BM + wc * 32 + 8 * fq;
        const bool isctx = row0 >= T;
        const int mrow = isctx ? 8 : (row0 >> 11);
        const size_t rbase = isctx ? (size_t)T : 0;
        const void* xs = isctx ? xs_ctx : xs_lat; bf16_t* xd = isctx ? xd_ctx : xd_lat;
        f32x4 gv[2][2];
#pragma unroll
        for (int bj = 0; bj < 2; ++bj)
#pragma unroll
            for (int n = 0; n < 2; ++n) { const int c = col0 + bj * HALF + n * 4; gv[bj][n] = *(const f32x4*)(gt + (size_t)mrow * 6144 + c);
                if (colscale) gv[bj][n] = gv[bj][n] * *(const f32x4*)(colscale + c); }
#pragma unroll
        for (int ai = 0; ai < 2; ++ai)
#pragma unroll
            for (int m = 0; m < 4; ++m) { const size_t off = ((size_t)(row0 + ai * HALF + m * 16) - rbase) * D + col0;
#pragma unroll
                for (int bj = 0; bj < 2; ++bj) { f32x4 x0, x1;
                    if (src_f32) { x0 = *(const f32x4*)((const float*)xs + off + bj * HALF); x1 = *(const f32x4*)((const float*)xs + off + bj * HALF + 4); }
                    else { const u32x4 w = *(const u32x4*)((const bf16_t*)xs + off + bj * HALF); x0 = (f32x4){bf_lo(w.x), bf_hi(w.x), bf_lo(w.y), bf_hi(w.y)}; x1 = (f32x4){bf_lo(w.z), bf_hi(w.z), bf_lo(w.w), bf_hi(w.w)}; }
                    x0 = x0 + gv[bj][0] * acc[ai][bj][m][0]; x1 = x1 + gv[bj][1] * acc[ai][bj][m][1];
                    u32x4 o; o.x = cvt_pk_bf16(x0[0], x0[1]); o.y = cvt_pk_bf16(x0[2], x0[3]); o.z = cvt_pk_bf16(x1[0], x1[1]); o.w = cvt_pk_bf16(x1[2], x1[3]);
                    if (!dry) *(u32x4*)(xd + off + bj * HALF) = o; } }
    }
};
struct EpiC {
    static constexpr bool PERM = true;
    bf16_t* HID;
    __device__ __forceinline__ void operator()(const f32x4 (&acc)[2][2][4][2], const Unit& u, int wr, int wc, int fr, int fq) const {
        const int n8 = u.pn & 7, rl = wr * 64 + fr, cl = n8 * 128 + wc * 32 + 8 * fq;
        bf16_t* base = HID + (size_t)u.pm * 256 * D;
#pragma unroll
        for (int ai = 0; ai < 2; ++ai)
#pragma unroll
            for (int m = 0; m < 4; ++m) {
                float h[8];
#pragma unroll
                for (int n = 0; n < 2; ++n)
#pragma unroll
                    for (int j = 0; j < 4; ++j) { const float g = acc[ai][0][m][n][j], up = acc[ai][1][m][n][j]; h[n * 4 + j] = silu_f(g) * up; }
                u32x4 w; w.x = cvt_pk_bf16(h[0], h[1]); w.y = cvt_pk_bf16(h[2], h[3]); w.z = cvt_pk_bf16(h[4], h[5]); w.w = cvt_pk_bf16(h[6], h[7]);
                *(u32x4*)(base + (size_t)(rl + ai * HALF + m * 16) * D + cl) = w; }
    }
};
struct EpiD {
    static constexpr bool PERM = true;
    bf16_t* Y; const float* gate;
    __device__ __forceinline__ void operator()(const f32x4 (&acc)[2][2][4][2], const Unit& u, int wr, int wc, int fr, int fq) const {
        const int n4 = u.pn & 3, rl = wr * 64 + fr, cl = n4 * 256 + wc * 32 + 8 * fq;
        bf16_t* base = Y + (size_t)u.pm * 256 * D; const float* gp = gate + (size_t)u.pm * 256;
#pragma unroll
        for (int ai = 0; ai < 2; ++ai)
#pragma unroll
            for (int m = 0; m < 4; ++m) { const int r = rl + ai * HALF + m * 16; const float g = gp[r];
#pragma unroll
                for (int bj = 0; bj < 2; ++bj) { const f32x4 v0 = acc[ai][bj][m][0] * g, v1 = acc[ai][bj][m][1] * g;
                    u32x4 w; w.x = cvt_pk_bf16(v0[0], v0[1]); w.y = cvt_pk_bf16(v0[2], v0[3]); w.z = cvt_pk_bf16(v1[0], v1[1]); w.w = cvt_pk_bf16(v1[2], v1[3]);
                    *(u32x4*)(base + (size_t)r * D + bj * HALF + cl) = w; } }
    }
};
}

namespace att {
constexpr int QBLK = 32, KVBLK = 64;
constexpr float SCALE = 0.088388347648318440f;
constexpr float THR = 8.f;
constexpr int SHM_V = KVBLK * 128 * 2, SHM_K = KVBLK * 128 * 2;
#define KSWZ(row, colB) ((row) * 256 + ((colB) ^ (((row) & 7) << 4)))
#define SBAR() __builtin_amdgcn_sched_barrier(0)
__device__ __forceinline__ int crow(int r, int hi) { return (r & 3) + 8 * (r >> 2) + 4 * hi; }
__device__ __forceinline__ void partialSM(f32x16& p0, f32x16& p1, float& m_reg, float& mn, float& alpha) {
    constexpr float C = SCALE * 1.4426950408889634f;
    float pmax = p0[0];
#pragma unroll
    for (int r = 1; r < 16; ++r) pmax = fmaxf(pmax, p0[r]);
#pragma unroll
    for (int r = 0; r < 16; ++r) pmax = fmaxf(pmax, p1[r]);
    { auto rr = __builtin_amdgcn_permlane32_swap(__float_as_uint(pmax), __float_as_uint(pmax), false, false);
      pmax = fmaxf(__uint_as_float(rr[0]), __uint_as_float(rr[1])); }
    if (__builtin_expect(__all(pmax - m_reg <= THR / SCALE), 1)) { mn = m_reg; alpha = 1.f; }
    else { mn = fmaxf(m_reg, pmax); alpha = __builtin_amdgcn_exp2f((m_reg - mn) * C); m_reg = mn; }
    float mnC = -mn * C;
#pragma unroll
    for (int r = 0; r < 16; ++r) p0[r] = fmaf(p0[r], C, mnC);
#pragma unroll
    for (int r = 0; r < 16; ++r) p1[r] = fmaf(p1[r], C, mnC);
#pragma unroll
    for (int r = 0; r < 16; ++r) p0[r] = __builtin_amdgcn_exp2f(p0[r]);
}
__device__ __forceinline__ void finishSM(f32x16& p0, f32x16& p1, float alpha, float& l_reg, bf16x8& pa0, bf16x8& pa1, bf16x8& pa2, bf16x8& pa3) {
#pragma unroll
    for (int r = 0; r < 16; ++r) p1[r] = __builtin_amdgcn_exp2f(p1[r]);
    float ps = 0;
#pragma unroll
    for (int r = 0; r < 16; ++r) ps += p0[r];
#pragma unroll
    for (int r = 0; r < 16; ++r) ps += p1[r];
    { auto rr = __builtin_amdgcn_permlane32_swap(__float_as_uint(ps), __float_as_uint(ps), false, false);
      ps = __uint_as_float(rr[0]) + __uint_as_float(rr[1]); }
    l_reg = l_reg * alpha + ps;
#define PK4(P, BASE, OUT) do { unsigned a0 = cvt_pk_bf16(P[BASE + 0], P[BASE + 1]), a1 = cvt_pk_bf16(P[BASE + 2], P[BASE + 3]);   \
    unsigned b0 = cvt_pk_bf16(P[BASE + 4], P[BASE + 5]), b1 = cvt_pk_bf16(P[BASE + 6], P[BASE + 7]);                              \
    auto r0 = __builtin_amdgcn_permlane32_swap(a0, b0, false, false); auto r1 = __builtin_amdgcn_permlane32_swap(a1, b1, false, false); \
    u32x4 w = {r0[0], r1[0], r0[1], r1[1]}; OUT = *reinterpret_cast<bf16x8*>(&w); } while (0)
    PK4(p0, 0, pa0); PK4(p0, 8, pa1); PK4(p1, 0, pa2); PK4(p1, 8, pa3);
#undef PK4
}
__device__ __forceinline__ void qkt(f32x16& p0, f32x16& p1, const LAS unsigned char* Ks, const bf16x8* qr, int r32, int hi) {
    p0 = f32x16{}; p1 = f32x16{};
#pragma unroll
    for (int d0 = 0; d0 < 8; ++d0) { int cb = (d0 * 16 + hi * 8) * 2;
        bf16x8 b0 = *reinterpret_cast<const LAS bf16x8*>(Ks + KSWZ(r32, cb));
        bf16x8 b1 = *reinterpret_cast<const LAS bf16x8*>(Ks + KSWZ(32 + r32, cb));
        p0 = __builtin_amdgcn_mfma_f32_32x32x16_bf16(b0, qr[d0], p0, 0, 0, 0);
        p1 = __builtin_amdgcn_mfma_f32_32x32x16_bf16(b1, qr[d0], p1, 0, 0, 0); }
}
__device__ __forceinline__ int v_st(int k, int c) { const int kk = (k & ~0xC) | ((k & 4) << 1) | ((k & 8) >> 1); return ((kk >> 3) * 4 + (c >> 5)) * 512 + ((kk & 7) * 32 + (c & 31)) * 2; }
__device__ __forceinline__ int v_rd_base(int lane) { return ((lane & 3) << 3) | (((lane >> 2) & 3) << 6) | (((lane >> 4) & 1) << 5) | (((lane >> 5) & 1) << 8); }
constexpr int v_rd_off(int d0, int ks, int half) { return d0 * 512 + ks * 4096 + half * 2048; }
template <int OFF> __device__ __forceinline__ s16x4 tr_read(int vb) {
    s16x4 r; asm volatile("ds_read_b64_tr_b16 %0, %1 offset:%2" : "=&v"(r) : "v"(vb), "i"(OFF) : "memory"); return r;
}
template <int D0> __device__ __forceinline__ void pv_one(f32x16& od, int vb, bf16x8 pa0, bf16x8 pa1, bf16x8 pa2, bf16x8 pa3) {
    const s16x4 l0 = tr_read<v_rd_off(D0, 0, 0)>(vb), h0 = tr_read<v_rd_off(D0, 0, 1)>(vb), l1 = tr_read<v_rd_off(D0, 1, 0)>(vb), h1 = tr_read<v_rd_off(D0, 1, 1)>(vb);
    const s16x4 l2 = tr_read<v_rd_off(D0, 2, 0)>(vb), h2 = tr_read<v_rd_off(D0, 2, 1)>(vb), l3 = tr_read<v_rd_off(D0, 3, 0)>(vb), h3 = tr_read<v_rd_off(D0, 3, 1)>(vb);
    asm volatile("s_waitcnt lgkmcnt(0)" ::: "memory"); SBAR();
#define PK(L, H) (bf16x8){L[0], L[1], L[2], L[3], H[0], H[1], H[2], H[3]}
    od = __builtin_amdgcn_mfma_f32_32x32x16_bf16(pa0, PK(l0, h0), od, 0, 0, 0);
    od = __builtin_amdgcn_mfma_f32_32x32x16_bf16(pa1, PK(l1, h1), od, 0, 0, 0);
    od = __builtin_amdgcn_mfma_f32_32x32x16_bf16(pa2, PK(l2, h2), od, 0, 0, 0);
    od = __builtin_amdgcn_mfma_f32_32x32x16_bf16(pa3, PK(l3, h3), od, 0, 0, 0);
#undef PK
}
__device__ __forceinline__ void pv_d0(f32x16* o, int vb, bf16x8 pa0, bf16x8 pa1, bf16x8 pa2, bf16x8 pa3) {
    pv_one<0>(o[0], vb, pa0, pa1, pa2, pa3); pv_one<1>(o[1], vb, pa0, pa1, pa2, pa3); pv_one<2>(o[2], vb, pa0, pa1, pa2, pa3); pv_one<3>(o[3], vb, pa0, pa1, pa2, pa3);
}
template <int LDQ, int LDO>
__device__ __forceinline__ void attn_body(const bf16_t* __restrict__ Qb, const bf16_t* __restrict__ Kh, const bf16_t* __restrict__ Vh, bf16_t* __restrict__ Ob, int seq, LAS unsigned char* lds) {
    constexpr int LDK = 128;
    const int tid = opaque_tid(), wid = tid >> 6, lane = tid & 63, r32 = lane & 31, hi = lane >> 5;
    LAS unsigned char* V_lds = lds; LAS unsigned char* K_lds = lds + 2 * SHM_V;
    LAS float* ws = (LAS float*)(lds + 2 * SHM_V + 2 * SHM_K) + wid * 64; LAS float* li_l = ws; LAS float* al_l = ws + 32;
    float m_reg = -1e30f, l_reg = 0; f32x16 o[4] = {}; bf16x8 qr[8];
    const bf16_t* Qw = Qb + (long)(wid * QBLK + r32) * LDQ + hi * 8;
#pragma unroll
    for (int d0 = 0; d0 < 8; ++d0) qr[d0] = *reinterpret_cast<const bf16x8*>(Qw + d0 * 16);
    const int sr = tid >> 4, sc = (tid & 15) * 8, vst0 = v_st(sr, sc), vst1 = v_st(32 + sr, sc);
    const int vb0 = (int)(unsigned)(uintptr_t)V_lds + v_rd_base(lane);
    struct { bf16x8 vs0, vs1, ks0, ks1; } sr_[2];
#define SLOAD(i, k0) do { sr_[i].vs0 = *reinterpret_cast<const bf16x8*>(&Vh[(long)((k0) + sr) * LDK + sc]); sr_[i].vs1 = *reinterpret_cast<const bf16x8*>(&Vh[(long)((k0) + 32 + sr) * LDK + sc]); \
    sr_[i].ks0 = *reinterpret_cast<const bf16x8*>(&Kh[(long)((k0) + sr) * LDK + sc]); sr_[i].ks1 = *reinterpret_cast<const bf16x8*>(&Kh[(long)((k0) + 32 + sr) * LDK + sc]); } while (0)
#define SWRITE(b, i) do { *(LAS bf16x8*)(V_lds + (b) * SHM_V + vst0) = sr_[i].vs0;          \
    *(LAS bf16x8*)(V_lds + (b) * SHM_V + vst1) = sr_[i].vs1; int kc = sc * 2;               \
    *(LAS bf16x8*)(K_lds + (b) * SHM_K + KSWZ(sr, kc)) = sr_[i].ks0;                       \
    *(LAS bf16x8*)(K_lds + (b) * SHM_K + KSWZ(32 + sr, kc)) = sr_[i].ks1; } while (0)
#define SWAIT() asm volatile("s_waitcnt vmcnt(4)" ::: "memory")
#define RESC(a) do { if (__any((a) < 1.f)) { if (hi == 0) al_l[r32] = (a); asm volatile("s_waitcnt lgkmcnt(0)" ::: "memory"); \
    for (int d = 0; d < 4; ++d) for (int r = 0; r < 16; ++r) o[d][r] *= al_l[crow(r, hi)]; } } while (0)
    f32x16 pA0, pA1, pB0, pB1; float mnA, mnB, alA, alB; bf16x8 pa0, pa1, pa2, pa3; const int NT = seq / KVBLK;
    constexpr int SE = 0, SO = 1;
    SLOAD(SE, 0); asm volatile("s_waitcnt vmcnt(0)" ::: "memory"); SWRITE(0, SE); __syncthreads();
    qkt(pA0, pA1, K_lds, qr, r32, hi); partialSM(pA0, pA1, m_reg, mnA, alA);
    SLOAD(SO, KVBLK); if (2 < NT) SLOAD(SE, 2 * KVBLK);
    SWAIT(); SWRITE(1, SO); __syncthreads();
    for (int j = 1; j + 1 < NT; j += 2) {
        SBAR(); qkt(pB0, pB1, K_lds + SHM_K, qr, r32, hi);
        finishSM(pA0, pA1, alA, l_reg, pa0, pa1, pa2, pa3); SBAR();
        SLOAD(SO, (j + 2) * KVBLK); SBAR();
        pv_d0(o, vb0, pa0, pa1, pa2, pa3); partialSM(pB0, pB1, m_reg, mnB, alB);
        __syncthreads(); SWAIT(); SWRITE(0, SE);
        RESC(alB); __syncthreads();
        SBAR(); qkt(pA0, pA1, K_lds, qr, r32, hi);
        finishSM(pB0, pB1, alB, l_reg, pa0, pa1, pa2, pa3); SBAR();
        if (j + 3 < NT) SLOAD(SE, (j + 3) * KVBLK); SBAR();
        pv_d0(o, vb0 + (int)SHM_V, pa0, pa1, pa2, pa3); partialSM(pA0, pA1, m_reg, mnA, alA);
        __syncthreads(); SWAIT(); SWRITE(1, SO);
        RESC(alA); __syncthreads();
    }
    SBAR(); qkt(pB0, pB1, K_lds + SHM_K, qr, r32, hi);
    finishSM(pA0, pA1, alA, l_reg, pa0, pa1, pa2, pa3); SBAR();
    pv_d0(o, vb0, pa0, pa1, pa2, pa3); partialSM(pB0, pB1, m_reg, mnB, alB);
    __syncthreads(); RESC(alB);
    finishSM(pB0, pB1, alB, l_reg, pa0, pa1, pa2, pa3); SBAR();
    pv_d0(o, vb0 + (int)SHM_V, pa0, pa1, pa2, pa3);
    if (hi == 0) li_l[r32] = l_reg; asm volatile("s_waitcnt lgkmcnt(0)" ::: "memory");
    float rli[16];
#pragma unroll
    for (int r = 0; r < 16; ++r) rli[r] = __builtin_amdgcn_rcpf(li_l[crow(r, hi)]);
    bf16_t* Ow = Ob + (long)(wid * QBLK) * LDO;
#pragma unroll
    for (int r = 0; r < 16; ++r) { int orow = crow(r, hi);
#pragma unroll
        for (int d0 = 0; d0 < 4; ++d0) Ow[(long)orow * LDO + d0 * 32 + r32] = f2bf(o[d0][r] * rli[r]); }
#undef SLOAD
#undef SWRITE
#undef SWAIT
#undef RESC
}
}

struct KArgs { const float* in[24]; float* out; unsigned char* ws; int ph_lo, ph_hi; };
enum { I_X = 0, I_C, I_CTX, I_CCTX, I_MODW, I_MODB, I_N1G, I_N2G, I_RW, I_WG, I_WU, I_WD, I_GWIN, I_GVG, I_GSW, I_GSB, I_GWOUT, I_AWIN, I_AQG, I_AKG, I_AWOUT, I_PWIN, I_PWG, I_PSC };

struct Fr {
    volatile LAS unsigned long long* PT;
    int G, bx, vcu;
    __device__ __forceinline__ unsigned long long ldp(int i) const { const unsigned long long v = PT[i];
        const unsigned lo = __builtin_amdgcn_readfirstlane((unsigned)v), hi = __builtin_amdgcn_readfirstlane((unsigned)(v >> 32)); return ((unsigned long long)hi << 32) | lo; }
    __device__ __forceinline__ const float* in(int i) const { return (const float*)(GAS const float*)ldp(i); }
    __device__ __forceinline__ float* out() const { return (float*)(GAS float*)ldp(24); }
    __device__ __forceinline__ unsigned char* ws() const { return (unsigned char*)(GAS unsigned char*)ldp(25); }
};
#define WSP(F, T_, OFF) ((T_*)((F).ws() + (OFF)))

constexpr int CV_NT_EXP = 4 * 16 * 3 * 64, CV_NT_ALL = CV_NT_EXP + 256 + 128 + 96 + 64 + 64 + 16;
constexpr int CV_G_GA = 192, CV_G_GB = 144, CV_G_DN = 192, CV_G_UP = 232, CV_G_GA1 = 200;
constexpr int CV_Q_GA = 34, CV_N_GA = 256 - CV_G_GA, CV_Q_GB = 19, CV_N_GB = 256 - CV_G_GB, CV_Q_UP = 46, CV_N_UP = 256 - CV_G_UP, CV_Q_DN = 34, CV_N_DN = 256 - CV_G_DN;
constexpr int CV_Q_GA1 = 20, CV_N_GA1 = 256 - CV_G_GA1, CV_Q_TK = 3, CV_N_TK = 128;
constexpr int CV_B_GA = 0, CV_B_GB = CV_B_GA + CV_Q_GA * CV_N_GA, CV_B_UP = CV_B_GB + CV_Q_GB * CV_N_GB, CV_B_DN = CV_B_UP + CV_Q_UP * CV_N_UP;
constexpr int CV_B_GA1 = CV_B_DN + CV_Q_DN * CV_N_DN, CV_B_TK1 = CV_B_GA1 + CV_Q_GA1 * CV_N_GA1, CV_B_TK2 = CV_B_TK1 + CV_Q_TK * CV_N_TK, CV_DEFER = CV_B_TK2 + CV_Q_TK * CV_N_TK;
static_assert(CV_B_UP >= 3072, "layer 0's expert tiles must be converted before its UP GEMM (by GA0 / GB0's converters)");
static_assert(CV_B_GA1 >= 2 * 3072, "layer 1's expert tiles must be converted by the end of layer 0");
static_assert(CV_DEFER >= 3 * 3072 && CV_DEFER <= CV_NT_EXP, "layer 2's expert tiles must be converted before layer 2's UP GEMM (top-k phase of layer 2 at the latest)");
__device__ __forceinline__ void convert_tiles(const Fr& F, LAS unsigned char* lds, const int j0, const int jstride, const int jend, const int skip_lo, const int skip_n, const int skip2_lo = 0x7fffffff, const int skip2_n = 0) {
    const int tid = opaque_tid(), wave = __builtin_amdgcn_readfirstlane(tid >> 6);
    unsigned char* const ws_ = F.ws();
    const int c4 = tid & 63, rr = tid >> 3, ch = tid & 7;
    f32x4 ld[8];
    const float* W = nullptr; int N = 0, k0 = 0, n0 = 0, ldt = 0, gu = 0; bf16_t* dst = nullptr;
#define P0_DECODE(jj) do { int r_ = (jj); r_ = r_ < skip_lo ? r_ : r_ + skip_n; r_ = r_ < skip2_lo ? r_ : r_ + skip2_n; \
        if (r_ < CV_NT_EXP) { const int mat = r_ >> 6, sub = r_ & 63, l = mat / 48, rem = mat % 48, e = rem / 3, which = rem % 3; k0 = (sub >> 2) * 64; n0 = (sub & 3) * 256; N = 1024; ldt = 1024; \
            if (which < 2) { W = F.in(which == 0 ? I_WG : I_WU) + (size_t)(l * 16 + e) * 1024 * 1024; dst = (bf16_t*)(ws_ + WS_WUP) + (size_t)l * 16 * 2048 * 1024 + (size_t)(e * 8 * 256 + which * 128) * 1024; gu = 1; } \
            else { W = F.in(I_WD) + (size_t)(l * 16 + e) * 1024 * 1024; dst = (bf16_t*)(ws_ + WS_WDN) + (size_t)l * 16 * 1024 * 1024 + (size_t)(e * 1024) * 1024; gu = 0; } } \
        else { r_ -= CV_NT_EXP; gu = 0; \
            if (r_ < 256) { const int j = r_ >> 7, sub = r_ & 127; k0 = (sub >> 3) * 64; n0 = (sub & 7) * 256; N = 2048; ldt = 1024; W = F.in(I_GWIN) + (size_t)j * 1024 * 2048; dst = (bf16_t*)(ws_ + WS_WGIN) + (size_t)j * 2048 * 1024; } \
            else if ((r_ -= 256) < 128) { const int j = r_ >> 6, sub = r_ & 63; k0 = (sub >> 2) * 64; n0 = (sub & 3) * 256; N = 1024; ldt = 1024; W = F.in(I_GWOUT) + (size_t)j * 1024 * 1024; dst = (bf16_t*)(ws_ + WS_WGOUT) + (size_t)j * 1024 * 1024; } \
            else if ((r_ -= 128) < 96) { k0 = (r_ / 6) * 64; n0 = (r_ % 6) * 256; N = 1536; ldt = 1024; W = F.in(I_AWIN); dst = (bf16_t*)(ws_ + WS_WAIN); } \
            else if ((r_ -= 96) < 64) { k0 = (r_ >> 2) * 64; n0 = (r_ & 3) * 256; N = 1024; ldt = 1024; W = F.in(I_AWOUT); dst = (bf16_t*)(ws_ + WS_WAOUT); } \
            else if ((r_ -= 64) < 64) { k0 = (r_ >> 2) * 64; n0 = (r_ & 3) * 256; N = 1024; ldt = 1024; W = F.in(I_PWIN); dst = (bf16_t*)(ws_ + WS_WPIN); } \
            else { r_ -= 64; const int g = r_ >> 2; k0 = (r_ & 3) * 64; n0 = 0; N = 256; ldt = 256; W = F.in(I_PWG) + (size_t)g * 256 * 256; dst = (bf16_t*)(ws_ + WS_WPGRP) + (size_t)g * 256 * 256; } } } while (0)
#define P0_LOAD() do { const float* wp_ = W + (size_t)(k0 + wave * 8) * N + n0 + c4 * 4; _Pragma("unroll") for (int s_ = 0; s_ < 8; ++s_) ld[s_] = __builtin_nontemporal_load((const f32x4*)(wp_ + (size_t)s_ * N)); } while (0)
    int it = j0, buf = 0;
    if (it < jend) { P0_DECODE(it); P0_LOAD(); }
#pragma nounroll
    for (; it < jend; it += jstride) {
        LAS unsigned char* Lt = lds + buf * 32768;
#pragma unroll
        for (int j = 0; j < 4; ++j) { const int n = c4 * 4 + j;
            u32x4 o; o.x = cvt_pk_bf16(ld[0][j], ld[1][j]); o.y = cvt_pk_bf16(ld[2][j], ld[3][j]); o.z = cvt_pk_bf16(ld[4][j], ld[5][j]); o.w = cvt_pk_bf16(ld[6][j], ld[7][j]);
            *(LAS u32x4*)(Lt + n * 128 + ((wave ^ ((n >> 2) & 7)) << 4)) = o; }
        bf16_t* const cdst = dst; const int ck0 = k0, cn0 = n0, cldt = ldt, cgu = gu;
        __syncthreads();
        if (it + jstride < jend) { P0_DECODE(it + jstride); P0_LOAD(); }
#pragma unroll
        for (int s_ = 0; s_ < 4; ++s_) { const int n = s_ * 64 + rr; const u32x4 o = *(const LAS u32x4*)(Lt + n * 128 + ((ch ^ ((n >> 2) & 7)) << 4));
            const int nn = cn0 + n; const size_t row = cgu ? (size_t)((nn >> 7) * 256 + (nn & 127)) : (size_t)nn;
            __builtin_nontemporal_store(o, (u32x4*)(cdst + row * cldt + ck0 + ch * 8)); }
        buf ^= 1;
    }
#undef P0_DECODE
#undef P0_LOAD
}
__device__ __forceinline__ int split_role(const Fr& F, const int ng) { const int q = F.bx >> 3, x = F.bx & 7, qg = ng >> 3; return q < qg ? q * 8 + x : -1 - ((q - qg) * 8 + x); }
__device__ __forceinline__ void convert_in_idle_slot(const Fr& F, LAS unsigned char* lds, const int c, const int total, const int base, const int quota, const int nidle) {
    const int rounds = (total + F.G - 1) / F.G, first_idle = total - (rounds - 1) * F.G;
    if (F.G != 256 || c < first_idle || c - first_idle >= nidle) return;
    __syncthreads();
    const int j0 = base + (c - first_idle) * quota;
    convert_tiles(F, lds, j0, 1, j0 + quota, 0x7fffffff, 0);
}

__device__ __forceinline__ void p0_phase(const Fr& F, LAS unsigned char* lds, const int part) {
    const int tid = opaque_tid(), lane = tid & 63, wave = __builtin_amdgcn_readfirstlane(tid >> 6), gw = F.bx * NWAVES + wave, NGW = F.G * NWAVES; (void)gw; (void)NGW; (void)lane; (void)wave;
    unsigned char* const ws_ = F.ws();
    float* const modv_ = (float*)(ws_ + WS_MODV);
    bf16_t* const wsw_ = (bf16_t*)(ws_ + WS_WSW);
    bf16_t* const wgin_ = (bf16_t*)(ws_ + WS_WGIN);
    bf16_t* const wgout_ = (bf16_t*)(ws_ + WS_WGOUT);
    bf16_t* const wain_ = (bf16_t*)(ws_ + WS_WAIN);
    bf16_t* const waout_ = (bf16_t*)(ws_ + WS_WAOUT);
    bf16_t* const wpin_ = (bf16_t*)(ws_ + WS_WPIN);
    bf16_t* const wpgrp_ = (bf16_t*)(ws_ + WS_WPGRP);
    bf16_t* const wup_ = (bf16_t*)(ws_ + WS_WUP);
    bf16_t* const wdn_ = (bf16_t*)(ws_ + WS_WDN);
    const float* const in_I_AWIN = F.in(I_AWIN);
    const float* const in_I_AWOUT = F.in(I_AWOUT);
    const float* const in_I_C = F.in(I_C);
    const float* const in_I_CCTX = F.in(I_CCTX);
    const float* const in_I_GSW = F.in(I_GSW);
    const float* const in_I_GWIN = F.in(I_GWIN);
    const float* const in_I_GWOUT = F.in(I_GWOUT);
    const float* const in_I_MODB = F.in(I_MODB);
    const float* const in_I_MODW = F.in(I_MODW);
    const float* const in_I_PWG = F.in(I_PWG);
    const float* const in_I_PWIN = F.in(I_PWIN);
    const float* const in_I_WD = F.in(I_WD);
    const float* const in_I_WG = F.in(I_WG);
    const float* const in_I_WU = F.in(I_WU);

    if (part == 0) {
    LAS float* sact = (LAS float*)lds;
    LAS float* red = (LAS float*)(lds + 49152);
    for (int idx = tid; idx < 9 * 1024; idx += NTHR) { const int r = idx >> 10, k = idx & 1023; const float v = r < 8 ? in_I_C[r * 1024 + k] : in_I_CCTX[k]; sact[k * 12 + r] = silu_f(v); }
    __syncthreads();
    for (int chunk = F.bx; chunk < 768; chunk += F.G) {
        const int layer = chunk / 192, n0 = (chunk % 192) * 32, k0 = wave * 128 + (lane >> 5);
        const float* wp = in_I_MODW + (size_t)layer * 1024 * 6144 + (size_t)k0 * 6144 + n0 + (lane & 31);
        float acc[9];
#pragma unroll
        for (int r = 0; r < 9; ++r) acc[r] = 0.f;
#pragma nounroll
        for (int hb = 0; hb < 4; ++hb) {
            float w[16];
#pragma unroll
            for (int i = 0; i < 16; ++i) w[i] = __builtin_nontemporal_load(wp + (size_t)(2 * (hb * 16 + i)) * 6144);
#pragma unroll
            for (int i = 0; i < 16; ++i) { const LAS float* sa = sact + (k0 + 2 * (hb * 16 + i)) * 12;
                const f32x4 s0 = *(const LAS f32x4*)sa, s1 = *(const LAS f32x4*)(sa + 4); const float s8 = sa[8];
                acc[0] += s0[0] * w[i]; acc[1] += s0[1] * w[i]; acc[2] += s0[2] * w[i]; acc[3] += s0[3] * w[i];
                acc[4] += s1[0] * w[i]; acc[5] += s1[1] * w[i]; acc[6] += s1[2] * w[i]; acc[7] += s1[3] * w[i]; acc[8] += s8 * w[i];
                __builtin_amdgcn_sched_barrier(0); }
        }
#pragma unroll
        for (int r = 0; r < 9; ++r) { acc[r] += xor32(acc[r], lane >= 32); if (lane < 32) red[(wave * 9 + r) * 32 + lane] = acc[r]; }
        __syncthreads();
        for (int idx = tid; idx < 288; idx += NTHR) { const int r = idx >> 5, l = idx & 31; float sacc = 0.f;
#pragma unroll
            for (int w = 0; w < 8; ++w) sacc += red[(w * 9 + r) * 32 + l];
            const int nn = n0 + l; modv_[(size_t)(layer * 9 + r) * 6144 + nn] = sacc + in_I_MODB[layer * 6144 + nn]; }
        __syncthreads();
    }
    return;
    }
    { const int defer = (F.G == 256) ? CV_DEFER : 0; convert_tiles(F, lds, defer + F.bx, F.G, CV_NT_ALL, 0x7fffffff, 0); }
    __syncthreads();
    for (int i4 = F.bx * NTHR + tid; i4 < 2 * 8 * 128 * 128 / 4; i4 += F.G * NTHR) { const f32x4 v = *(const f32x4*)(in_I_GSW + (size_t)i4 * 4);
        u32x2 o; o.x = cvt_pk_bf16(v[0], v[1]); o.y = cvt_pk_bf16(v[2], v[3]); *(u32x2*)(wsw_ + (size_t)i4 * 4) = o; }
}

template <int R>
__device__ __forceinline__ void norm_rows(const int r0, const bool isctx, const int lane, const int layer, const int which, const int comb, const int dry, float* vst,
                                          const int xmode  , const void* xsrc, void* xdst, const float* modv_, const float* ng, const int* slot_, const bf16_t* YEXP_, bf16_t* H_, float* aff_, int* slotw_, const LAS unsigned char* rwl) {
    const int rc0 = r0 - T; const int b = isctx ? (rc0 >> 8) : (r0 >> 11); const int mrow = isctx ? 8 : b;
    f32x4 v[R][4];
#pragma unroll
    for (int q = 0; q < R; ++q)
#pragma unroll
        for (int j = 0; j < 4; ++j) {
            if (xmode == 0) v[q][j] = *(const f32x4*)((const float*)xsrc + (size_t)q * D + lane * 4 + 256 * j);
            else { const u32x2 w = *(const u32x2*)((const bf16_t*)xsrc + (size_t)q * D + lane * 4 + 256 * j); v[q][j] = (f32x4){bf_lo(w.x), bf_hi(w.x), bf_lo(w.y), bf_hi(w.y)}; } }
#ifndef NO_NR_COMB
    if (comb >= 0) {
        int sl[R];
#pragma unroll
        for (int q = 0; q < R; ++q) sl[q] = slot_[(size_t)(r0 + q) * 16 + (lane & 15)];
        f32x4 a[R][4];
#pragma unroll
        for (int q = 0; q < R; ++q)
#pragma unroll
            for (int j = 0; j < 4; ++j) a[q][j] = (f32x4){0.f, 0.f, 0.f, 0.f};
#pragma nounroll
        for (int e = 0; e < 16; ++e) {
            u32x2 w[R][4];
#pragma unroll
            for (int q = 0; q < R; ++q) {
                const int s = __builtin_amdgcn_readlane(sl[q], e);
                if (s >= 0) {
                    const int tile = isctx ? 128 + e : e * 8 + b, rin = isctx ? (((rc0 + q) >> 8) * 32 + s) : s;
                    const bf16_t* yp = YEXP_ + ((size_t)tile * 256 + rin) * D + lane * 4;
#pragma unroll
                    for (int j = 0; j < 4; ++j) w[q][j] = __builtin_nontemporal_load((const u32x2*)(yp + 256 * j));
                } else {
#pragma unroll
                    for (int j = 0; j < 4; ++j) w[q][j] = (u32x2){0u, 0u};
                }
            }
#pragma unroll
            for (int q = 0; q < R; ++q)
#pragma unroll
                for (int j = 0; j < 4; ++j) { a[q][j][0] += bf_lo(w[q][j].x); a[q][j][1] += bf_hi(w[q][j].x); a[q][j][2] += bf_lo(w[q][j].y); a[q][j][3] += bf_hi(w[q][j].y); }
        }
        const float* g2 = modv_ + (size_t)(comb * 9 + mrow) * 6144 + 5 * 1024 + lane * 4;
#pragma unroll
        for (int j = 0; j < 4; ++j) { const f32x4 gg = *(const f32x4*)(g2 + 256 * j);
#pragma unroll
            for (int q = 0; q < R; ++q) { v[q][j] = v[q][j] + gg * a[q][j];
                if (!dry) { if (xmode == 2) __builtin_nontemporal_store(v[q][j], (f32x4*)((float*)xdst + (size_t)q * D + lane * 4 + 256 * j));
                            else { u32x2 o; o.x = cvt_pk_bf16(v[q][j][0], v[q][j][1]); o.y = cvt_pk_bf16(v[q][j][2], v[q][j][3]); *(u32x2*)((bf16_t*)xdst + (size_t)q * D + lane * 4 + 256 * j) = o; } } } }
    }
#endif
    if (which == 0) return;
    float rstd[R];
#pragma unroll
    for (int q = 0; q < R; ++q) { float ss = 0.f;
#pragma unroll
        for (int j = 0; j < 4; ++j) ss += (v[q][j][0] * v[q][j][0] + v[q][j][1] * v[q][j][1]) + (v[q][j][2] * v[q][j][2] + v[q][j][3] * v[q][j][3]);
        rstd[q] = ss; }
#pragma unroll
    for (int q = 0; q < R; ++q) rstd[q] = rsqrtf(wave_sum(rstd[q]) * (1.f / D) + EPS);
    const float* mv = modv_ + (size_t)(layer * 9 + mrow) * 6144 + (which == 2 ? 3 * 1024 : 0) + lane * 4;
#pragma unroll
    for (int j = 0; j < 4; ++j) { const f32x4 g = *(const f32x4*)(ng + lane * 4 + 256 * j), sh = *(const f32x4*)(mv + 256 * j), sc = *(const f32x4*)(mv + 1024 + 256 * j);
#pragma unroll
        for (int q = 0; q < R; ++q) { v[q][j] = (v[q][j] * rstd[q] * g) * (sc + 1.f) + sh;
            u32x2 o; o.x = cvt_pk_bf16(v[q][j][0], v[q][j][1]); o.y = cvt_pk_bf16(v[q][j][2], v[q][j][3]); *(u32x2*)(H_ + (size_t)(r0 + q) * D + lane * 4 + 256 * j) = o; } }
#ifndef NO_NR_ROUTER
    if (which == 2 && dry != 2) {
        f32x2 p2[R][8];
#pragma unroll
        for (int q = 0; q < R; ++q)
#pragma unroll
            for (int e = 0; e < 8; ++e) p2[q][e] = (f32x2){0.f, 0.f};
#pragma unroll
        for (int j = 0; j < 4; ++j)
#pragma unroll
            for (int i = 0; i < 4; ++i) { const int col = lane * 4 + 256 * j + i; const LAS unsigned char* rp = rwl + col * 64 + (col >> 2) * 16;
                f32x2 w2[8];
#pragma unroll
                for (int e4 = 0; e4 < 4; ++e4) { const f32x4 w = *(const LAS f32x4*)(rp + e4 * 16); w2[2 * e4] = (f32x2){w[0], w[1]}; w2[2 * e4 + 1] = (f32x2){w[2], w[3]}; }
#pragma unroll
                for (int q = 0; q < R; ++q) { const float hv = v[q][j][i]; const f32x2 h2 = (f32x2){hv, hv};
#pragma unroll
                    for (int e = 0; e < 8; ++e) p2[q][e] = __builtin_elementwise_fma(h2, w2[e], p2[q][e]); }
                __builtin_amdgcn_sched_barrier(0); }
        float p[R][16];
#pragma unroll
        for (int q = 0; q < R; ++q)
#pragma unroll
            for (int e = 0; e < 8; ++e) { p[q][2 * e] = p2[q][e].x; p[q][2 * e + 1] = p2[q][e].y; asm volatile("" : "+v"(p[q][2 * e]), "+v"(p[q][2 * e + 1])); }
#pragma unroll
        for (int q = 0; q < R; ++q) {
            const bool b5 = (lane & 32) != 0, b4 = (lane & 16) != 0, b3 = (lane & 8) != 0, b2 = (lane & 4) != 0;
            float k8[8], k4[4], k2[2];
#pragma unroll
            for (int e = 0; e < 8; ++e) { const float send = b5 ? p[q][e] : p[q][e + 8]; k8[e] = (b5 ? p[q][e + 8] : p[q][e]) + xor32(send, b5); }
#pragma unroll
            for (int e = 0; e < 4; ++e) { const float send = b4 ? k8[e] : k8[e + 4]; k4[e] = (b4 ? k8[e + 4] : k8[e]) + swz_xor<16>(send); }
#pragma unroll
            for (int e = 0; e < 2; ++e) { const float send = b3 ? k4[e] : k4[e + 2]; k2[e] = (b3 ? k4[e + 2] : k4[e]) + swz_xor<8>(send); }
            float lg; { const float send = b2 ? k2[0] : k2[1]; lg = (b2 ? k2[1] : k2[0]) + swz_xor<4>(send); }
            lg += swz_xor<2>(lg); lg += swz_xor<1>(lg);
            const float mx = wave_max(lg), ex = __expf(lg - mx), sum = wave_sum(ex) * 0.25f;
            const int eid = (lane >> 2) & 15;
            if ((lane & 3) == 0) aff_[(size_t)(r0 + q) * 16 + eid] = ex / sum;
            if (lane < 16) slotw_[(size_t)(r0 + q) * 16 + lane] = -1;
        }
    }
#endif
}
__device__ __forceinline__ void norm_phase(const Fr& F, LAS unsigned char* lds, int layer, int which, int nrows, int comb, int xmode, const void* xlat, const void* xctx, void* xlat_d, void* xctx_d, int dry = 0, bool zero_vst = false) {
    const size_t esz_s = xmode == 0 ? 4 : 2, esz_d = xmode == 2 ? 4 : 2;
    const int tid = opaque_tid(), lane = tid & 63, wave = __builtin_amdgcn_readfirstlane(tid >> 6), gw = F.bx * NWAVES + wave, NGW = F.G * NWAVES;
    unsigned char* const ws_ = F.ws();
    float* const modv_ = (float*)(ws_ + WS_MODV); float* const aff_ = (float*)(ws_ + WS_AFF); int* const slot_ = (int*)(ws_ + WS_SLOT);
    bf16_t* const H_ = (bf16_t*)(ws_ + WS_H); bf16_t* const YEXP_ = (bf16_t*)(ws_ + WS_YEXP);
    float* const vst = zero_vst ? (float*)(ws_ + WS_VST) : nullptr;
    LAS unsigned char* rwl = lds;
    if (which == 2) {
        const float* rw = F.in(I_RW) + (size_t)layer * 1024 * 16;
        for (int idx = tid; idx < 4096; idx += NTHR) { const int col = idx >> 2, e4 = idx & 3; *(LAS f32x4*)(rwl + col * 64 + (col >> 2) * 16 + e4 * 16) = *(const f32x4*)(rw + col * 16 + e4 * 4); }
        __syncthreads();
    }
    const float* ng = F.in(which == 2 ? I_N2G : I_N1G) + (size_t)layer * 1024;
#pragma nounroll
    for (int g4 = gw; g4 < T / 4; g4 += NGW) { const int r0 = g4 * 4;
        norm_rows<4>(r0, false, lane, layer, which, comb, dry, vst, xmode, (const char*)xlat + (size_t)r0 * D * esz_s, (char*)xlat_d + (size_t)r0 * D * esz_d, modv_, ng, slot_, YEXP_, H_, aff_, slot_, rwl); }
    if (nrows > T) {
#pragma nounroll
        for (int r = T + gw; r < nrows; r += NGW)
            norm_rows<1>(r, true, lane, layer, which, comb, dry, vst, xmode, (const char*)xctx + (size_t)(r - T) * D * esz_s, (char*)xctx_d + (size_t)(r - T) * D * esz_d, modv_, ng, slot_, YEXP_, H_, aff_, slot_, rwl);
    }
}

__device__ __forceinline__ void topk_phase(const Fr& F, LAS unsigned char* lds, bool with_ctx) {
    const int tid = opaque_tid();
    unsigned char* const ws_ = F.ws();
    float* const aff_ = (float*)(ws_ + WS_AFF); int* const slot_ = (int*)(ws_ + WS_SLOT); float* const gate_ = (float*)(ws_ + WS_GATE);
    int* const idx_ = (int*)(ws_ + WS_IDX);
    LAS unsigned* vals = (LAS unsigned*)lds;
    LAS int* hist = (LAS int*)(lds + 8192);
    LAS int* suf = (LAS int*)(lds + 9216);
    LAS int* scan = (LAS int*)(lds + 12288);
    volatile LAS unsigned* sv = (volatile LAS unsigned*)(lds + 16384);
    const int nunits = with_ctx ? 256 : 128;
    for (int u = F.bx; u < nunits; u += F.G) {
        const bool isctx = u >= 128; const int uu = isctx ? u - 128 : u, e = uu >> 3, b = uu & 7;
        const int N = isctx ? CL : SEQ, cap = isctx ? CCAP : CAP, row0 = isctx ? T + b * CL : b * SEQ;
        const int tile = isctx ? 128 + e : uu, rbase = isctx ? b * 32 : 0;
        unsigned v[4]; const bool act = tid * 4 < N;
#pragma unroll
        for (int k = 0; k < 4; ++k) v[k] = act ? __float_as_uint(aff_[(size_t)(row0 + tid * 4 + k) * 16 + e]) : 0u;
        if (tid == 0) { sv[0] = 0u; sv[1] = (unsigned)cap; }
        unsigned prefix = 0u, mask = 0u; int need = cap;
#pragma nounroll
        for (int shift = 24; shift >= 0; shift -= 8) {
            if (tid < 256) hist[tid] = 0;
            __syncthreads();
            if (act) {
#pragma unroll
                for (int k = 0; k < 4; ++k) if ((v[k] & mask) == prefix) __hip_atomic_fetch_add(&hist[(v[k] >> shift) & 255u], 1, __ATOMIC_RELAXED, __HIP_MEMORY_SCOPE_WORKGROUP);
            }
            __syncthreads();
            if (tid < 256) { int sacc = 0; for (int d = 255; d >= tid; --d) sacc += hist[d]; suf[tid] = sacc; }
            if (tid == 0) suf[256] = 0;
            __syncthreads();
            if (tid < 256) { const int s0 = suf[tid], s1 = suf[tid + 1]; if (s0 >= need && s1 < need) { sv[0] = prefix | ((unsigned)tid << shift); sv[1] = (unsigned)(need - s1); } }
            __syncthreads();
            prefix = sv[0]; need = (int)sv[1]; mask |= 255u << shift;
        }
        int cg = 0, ce = 0;
#pragma unroll
        for (int k = 0; k < 4; ++k) { cg += (act && v[k] > prefix) ? 1 : 0; ce += (act && v[k] == prefix) ? 1 : 0; }
        int cur = 0; scan[tid] = cg | (ce << 16);
        __syncthreads();
#pragma nounroll
        for (int off = 1; off < NTHR; off <<= 1) {
            const int x = scan[cur * NTHR + tid] + (tid >= off ? scan[cur * NTHR + tid - off] : 0);
            scan[(cur ^ 1) * NTHR + tid] = x; cur ^= 1;
            __syncthreads();
        }
        const int incl = scan[cur * NTHR + tid]; int gb = (incl & 0xffff) - cg, eb = (incl >> 16) - ce;
        if (act) {
#pragma unroll
            for (int k = 0; k < 4; ++k) {
                const bool isg = v[k] > prefix, ise = v[k] == prefix;
                if (isg || (ise && eb < need)) { const int sl = gb + (eb < need ? eb : need); const int row = row0 + tid * 4 + k;
                    idx_[(size_t)tile * 256 + rbase + sl] = row; gate_[(size_t)tile * 256 + rbase + sl] = __uint_as_float(v[k]); slot_[(size_t)row * 16 + e] = sl; }
                gb += isg ? 1 : 0; eb += ise ? 1 : 0;
            }
        }
        __syncthreads();
    }
}

template <int OFF> __device__ __forceinline__ s16x4 sp_tr_read(int vb) {
    s16x4 r; asm volatile("ds_read_b64_tr_b16 %0, %1 offset:%2" : "=&v"(r) : "v"(vb), "i"(OFF) : "memory"); return r;
}
template <int KS> __device__ __forceinline__ void sp_kstep(f32x16& acc0, f32x16& acc1, const LAS bf16_t* Ap, int vb) {
    constexpr int LDB2 = 320;
    const bf16x8 a = *(const LAS bf16x8*)(Ap + KS * 16);
    const s16x4 l0 = sp_tr_read<(16 * KS) * LDB2>(vb), h0 = sp_tr_read<(16 * KS + 4) * LDB2>(vb);
    const s16x4 l1 = sp_tr_read<(16 * KS) * LDB2 + 64>(vb), h1 = sp_tr_read<(16 * KS + 4) * LDB2 + 64>(vb);
    asm volatile("s_waitcnt lgkmcnt(0)" ::: "memory"); __builtin_amdgcn_sched_barrier(0);
    const bf16x8 b0 = (bf16x8){l0[0], l0[1], l0[2], l0[3], h0[0], h0[1], h0[2], h0[3]};
    const bf16x8 b1 = (bf16x8){l1[0], l1[1], l1[2], l1[3], h1[0], h1[1], h1[2], h1[3]};
    acc0 = __builtin_amdgcn_mfma_f32_32x32x16_bf16(b0, a, acc0, 0, 0, 0);
    acc1 = __builtin_amdgcn_mfma_f32_32x32x16_bf16(b1, a, acc1, 0, 0, 0);
}
__device__ __forceinline__ void spatial_phase(const Fr& F, LAS unsigned char* lds, int j, int nchunks) {
    const int tid = opaque_tid(), lane = tid & 63, wave = __builtin_amdgcn_readfirstlane(tid >> 6);
    unsigned char* const ws_ = F.ws();
    const bf16_t* const wsw_ = (const bf16_t*)(ws_ + WS_WSW); const bf16_t* const S1_ = (const bf16_t*)(ws_ + WS_S1); bf16_t* const S2_ = (bf16_t*)(ws_ + WS_S2);
    const float* const vst_ = (const float*)(ws_ + WS_VST);
    constexpr int LDA = 136, LDB = 160;
    LAS bf16_t* As = (LAS bf16_t*)(lds + 1024);
    LAS bf16_t* Bs = (LAS bf16_t*)(lds + 1024 + 128 * LDA * 2);
    const float* vg = F.in(I_GVG) + (size_t)j * 1024; const float* sb = F.in(I_GSB) + (size_t)j * 8 * 128;
    const bf16_t* sw = wsw_ + (size_t)j * 8 * 128 * 128;
    const int r32 = lane & 31, hi = lane >> 5;
    const int pw = (wave >> 1) * 32, dw = (wave & 1) * 64;
    const LAS bf16_t* Ap = As + (pw + r32) * LDA + hi * 8;
    const int vb = (int)(unsigned)(uintptr_t)Bs + (8 * hi + ((lane & 15) >> 2)) * (LDB * 2) + (dw + 16 * ((lane >> 4) & 1) + 4 * (lane & 3)) * 2;
    const int p = pw + r32, c0 = dw + 4 * hi, nunits = nchunks * 8;
    u32x4 sa[4], wv[4]; u32x2 un[2][4]; f32x2 st[4];
#define SP_LOAD(U) do { const int _r0 = ((U) >> 3) * 128, _g = (U) & 7; _Pragma("unroll") for (int i = 0; i < 4; ++i) { const int id = tid + NTHR * i; \
            sa[i] = *(const u32x4*)(sw + (size_t)_g * 128 * 128 + (id >> 4) * 128 + (id & 15) * 8); \
            wv[i] = *(const u32x4*)(S1_ + (size_t)(_r0 + (id >> 4)) * 2048 + 1024 + _g * 128 + (id & 15) * 8); \
            st[i] = *(const f32x2*)(vst_ + ((size_t)(_r0 + (id >> 4)) * 16 + (id & 15)) * 2); } \
            _Pragma("unroll") for (int t = 0; t < 4; ++t) { un[0][t] = *(const u32x2*)(S1_ + (size_t)(_r0 + p) * 2048 + _g * 128 + c0 + 8 * t); un[1][t] = *(const u32x2*)(S1_ + (size_t)(_r0 + p) * 2048 + _g * 128 + c0 + 32 + 8 * t); } } while (0)
    int U = F.vcu;
    if (U < nunits) SP_LOAD(U);
#pragma nounroll
    for (; U < nunits; U += F.G) {
        const int r0 = (U >> 3) * 128, g = U & 7;
#pragma unroll
        for (int i = 0; i < 4; ++i) { const int id = tid + NTHR * i; *(LAS u32x4*)(As + (id >> 4) * LDA + (id & 15) * 8) = sa[i]; }
        { const int dc = tid & 15; const f32x4 g0 = *(const f32x4*)(vg + g * 128 + dc * 8), g1 = *(const f32x4*)(vg + g * 128 + dc * 8 + 4);
#pragma unroll
          for (int i = 0; i < 4; ++i) { const int id = tid + NTHR * i, q = id >> 4;
            float s1 = st[i].x, s2 = st[i].y;
            s1 += swz_xor<1>(s1); s2 += swz_xor<1>(s2); s1 += swz_xor<2>(s1); s2 += swz_xor<2>(s2); s1 += swz_xor<4>(s1); s2 += swz_xor<4>(s2); s1 += swz_xor<8>(s1); s2 += swz_xor<8>(s2);
            const float mean = s1 * (1.f / 1024.f), rstd = rsqrtf(fmaxf(s2 * (1.f / 1024.f) - mean * mean, 0.f) + EPS);
            float x[8];
#pragma unroll
            for (int k = 0; k < 4; ++k) { x[2 * k] = (bf_lo(wv[i][k]) - mean) * rstd; x[2 * k + 1] = (bf_hi(wv[i][k]) - mean) * rstd; }
            u32x4 o; o.x = cvt_pk_bf16(x[0] * g0[0], x[1] * g0[1]); o.y = cvt_pk_bf16(x[2] * g0[2], x[3] * g0[3]); o.z = cvt_pk_bf16(x[4] * g1[0], x[5] * g1[1]); o.w = cvt_pk_bf16(x[6] * g1[2], x[7] * g1[3]);
            *(LAS u32x4*)(Bs + q * LDB + dc * 8) = o; } }
        u32x2 uu[2][4];
#pragma unroll
        for (int t = 0; t < 4; ++t) { uu[0][t] = un[0][t]; uu[1][t] = un[1][t]; }
        const float bias = sb[g * 128 + p];
        __syncthreads();
        if (U + F.G < nunits) SP_LOAD(U + F.G);
        f32x16 acc0 = {}, acc1 = {};
        sp_kstep<0>(acc0, acc1, Ap, vb); sp_kstep<1>(acc0, acc1, Ap, vb); sp_kstep<2>(acc0, acc1, Ap, vb); sp_kstep<3>(acc0, acc1, Ap, vb);
        sp_kstep<4>(acc0, acc1, Ap, vb); sp_kstep<5>(acc0, acc1, Ap, vb); sp_kstep<6>(acc0, acc1, Ap, vb); sp_kstep<7>(acc0, acc1, Ap, vb);
        const size_t ro = (size_t)(r0 + p);
#pragma unroll
        for (int t = 0; t < 4; ++t) {
            u32x2 o0, o1;
            o0.x = cvt_pk_bf16((acc0[4 * t] + bias) * bf_lo(uu[0][t].x), (acc0[4 * t + 1] + bias) * bf_hi(uu[0][t].x)); o0.y = cvt_pk_bf16((acc0[4 * t + 2] + bias) * bf_lo(uu[0][t].y), (acc0[4 * t + 3] + bias) * bf_hi(uu[0][t].y));
            o1.x = cvt_pk_bf16((acc1[4 * t] + bias) * bf_lo(uu[1][t].x), (acc1[4 * t + 1] + bias) * bf_hi(uu[1][t].x)); o1.y = cvt_pk_bf16((acc1[4 * t + 2] + bias) * bf_lo(uu[1][t].y), (acc1[4 * t + 3] + bias) * bf_hi(uu[1][t].y));
            *(u32x2*)(S2_ + ro * D + g * 128 + c0 + 8 * t) = o0; *(u32x2*)(S2_ + ro * D + g * 128 + c0 + 32 + 8 * t) = o1; }
        __syncthreads();
    }
#undef SP_LOAD
}

__device__ __forceinline__ void qknorm_phase(const Fr& F) {
    const int tid = opaque_tid(), lane = tid & 63, wave = __builtin_amdgcn_readfirstlane(tid >> 6), gw = F.bx * NWAVES + wave, NGW = F.G * NWAVES;
    unsigned char* const ws_ = F.ws();
    const bf16_t* const S1_ = (const bf16_t*)(ws_ + WS_S1); bf16_t* const QB_ = (bf16_t*)(ws_ + WS_QB); bf16_t* const KB_ = (bf16_t*)(ws_ + WS_KB);
    const float* qg = F.in(I_AQG); const float* kg = F.in(I_AKG);
    const int hsel = lane >> 5, l5 = lane & 31;
    const f32x2 qg0 = *(const f32x2*)(qg + 2 * l5), qg1 = *(const f32x2*)(qg + 64 + 2 * l5), kg0 = *(const f32x2*)(kg + 2 * l5), kg1 = *(const f32x2*)(kg + 64 + 2 * l5);
    const float inv0 = exp2f(-(float)((2 * l5) & 31) * (13.287712379549449f / 32.f)), inv1 = exp2f(-(float)((2 * l5 + 1) & 31) * (13.287712379549449f / 32.f));
#pragma nounroll
    for (int g2 = gw; g2 < T / 2; g2 += NGW) {
        const int r0 = g2 * 2, b = r0 >> 11;
        unsigned u0[2][5], u1[2][5];
#pragma unroll
        for (int q = 0; q < 2; ++q)
#pragma unroll
            for (int ps = 0; ps < 5; ++ps) { const int hh = 2 * ps + hsel; const bf16_t* src = S1_ + (size_t)(r0 + q) * 2048 + (hh < 8 ? hh * 128 : 1024 + (hh - 8) * 128) + 2 * l5;
                u0[q][ps] = *(const unsigned*)src; u1[q][ps] = *(const unsigned*)(src + 64); }
#pragma unroll
        for (int q = 0; q < 2; ++q) {
            const int s = (r0 + q) & (SEQ - 1); const float pos = (float)(l5 < 16 ? (s >> 6) : (s & 63));
            float c0, s0, c1, s1; __sincosf(pos * inv0, &s0, &c0); __sincosf(pos * inv1, &s1, &c1);
            { c0 = cosf(pos * inv0); s0 = sinf(pos * inv0); c1 = cosf(pos * inv1); s1 = sinf(pos * inv1); }
#pragma unroll
            for (int ps = 0; ps < 5; ++ps) { const int hh = 2 * ps + hsel; const bool isk = ps == 4;
                float a0 = bf_lo(u0[q][ps]), a1 = bf_hi(u0[q][ps]), e0 = bf_lo(u1[q][ps]), e1 = bf_hi(u1[q][ps]);
                const float rs = rsqrtf(half_sum((a0 * a0 + a1 * a1) + (e0 * e0 + e1 * e1)) * (1.f / 128.f) + EPS);
                const f32x2 ga = isk ? kg0 : qg0, gb = isk ? kg1 : qg1;
                a0 *= rs * ga.x; a1 *= rs * ga.y; e0 *= rs * gb.x; e1 *= rs * gb.y;
                const float o10 = a0 * c0 - e0 * s0, o11 = a1 * c1 - e1 * s1, o20 = a0 * s0 + e0 * c0, o21 = a1 * s1 + e1 * c1;
                bf16_t* dst = isk ? KB_ + ((size_t)(b * 2 + (hh - 8)) * SKV + CL + s) * 128 + 2 * l5 : QB_ + (size_t)(r0 + q) * D + hh * 128 + 2 * l5;
                *(unsigned*)dst = cvt_pk_bf16(o10, o11); *(unsigned*)(dst + 64) = cvt_pk_bf16(o20, o21); }
        }
    }
#pragma nounroll
    for (int rc = gw; rc < TC; rc += NGW) {
        const int b = rc >> 8, s = rc & (CL - 1);
        const bf16_t* src = S1_ + (size_t)(T + rc) * 2048 + 1024 + hsel * 128 + 2 * l5;
        const unsigned u0 = *(const unsigned*)src, u1 = *(const unsigned*)(src + 64);
        float a0 = bf_lo(u0), a1 = bf_hi(u0), e0 = bf_lo(u1), e1 = bf_hi(u1);
        const float rs = rsqrtf(half_sum((a0 * a0 + a1 * a1) + (e0 * e0 + e1 * e1)) * (1.f / 128.f) + EPS);
        bf16_t* dst = KB_ + ((size_t)(b * 2 + hsel) * SKV + s) * 128 + 2 * l5;
        *(unsigned*)dst = cvt_pk_bf16(a0 * rs * kg0.x, a1 * rs * kg0.y); *(unsigned*)(dst + 64) = cvt_pk_bf16(e0 * rs * kg1.x, e1 * rs * kg1.y);
    }
}

template <int W> __device__ __forceinline__ void pool_item(const bf16_t* zb  , int s, bf16_t* dst) {
    constexpr int half = W / 2;
    u32x4 w[W];
#pragma unroll
    for (int k = 0; k < W; ++k) { int t = s - half + k; t = t < 0 ? 0 : (t > SEQ - 1 ? SEQ - 1 : t); w[k] = *(const u32x4*)(zb + (size_t)t * 2048); }
    float acc[8];
#pragma unroll
    for (int c = 0; c < 8; ++c) acc[c] = 0.f;
#pragma unroll
    for (int k = 0; k < W; ++k) { const int t = s - half + k; const float m = (t >= 0 && t < SEQ) ? 1.f : 0.f;
#pragma unroll
        for (int c = 0; c < 4; ++c) { acc[2 * c] += m * bf_lo(w[k][c]); acc[2 * c + 1] += m * bf_hi(w[k][c]); } }
    const int lo = s - half < 0 ? 0 : s - half, hi = s + half - 1 > SEQ - 1 ? SEQ - 1 : s + half - 1; const float ic = 1.f / (float)(hi - lo + 1);
    const u32x4 zc = w[half];
    float o[8];
#pragma unroll
    for (int c = 0; c < 4; ++c) { o[2 * c] = acc[2 * c] * ic - bf_lo(zc[c]); o[2 * c + 1] = acc[2 * c + 1] * ic - bf_hi(zc[c]); }
    u32x4 ov; ov.x = cvt_pk_bf16(o[0], o[1]); ov.y = cvt_pk_bf16(o[2], o[3]); ov.z = cvt_pk_bf16(o[4], o[5]); ov.w = cvt_pk_bf16(o[6], o[7]);
    *(u32x4*)dst = ov;
}
__device__ __forceinline__ void pool_phase(const Fr& F) {
    const int tid = opaque_tid(), lane = tid & 63, wave = __builtin_amdgcn_readfirstlane(tid >> 6);
    unsigned char* const ws_ = F.ws();
    const bf16_t* const S1_ = (const bf16_t*)(ws_ + WS_S1); bf16_t* const S2_ = (bf16_t*)(ws_ + WS_S2);
    const int gi = wave & 3, c8 = gi * 32 + (lane & 31), rsub = (wave >> 2) * 2 + (lane >> 5);
#pragma nounroll
    for (int r4 = F.bx; r4 < T / 4; r4 += F.G) {
        const int r = r4 * 4 + rsub, s = r & (SEQ - 1);
        const bf16_t* zb = S1_ + (size_t)(r - s) * 2048 + c8 * 8; bf16_t* dst = S2_ + (size_t)r * D + c8 * 8;
        if (gi == 0) pool_item<2>(zb, s, dst); else if (gi == 1) pool_item<4>(zb, s, dst); else if (gi == 2) pool_item<8>(zb, s, dst); else pool_item<16>(zb, s, dst);
    }
}

__global__ void __launch_bounds__(NTHR, 2) fwd_kernel(KArgs args) {
    extern __shared__ __attribute__((aligned(16))) unsigned char lds_raw[];
    LAS unsigned char* lds = (LAS unsigned char*)lds_raw;
    volatile LAS unsigned* MISC = (volatile LAS unsigned*)(lds + MISC_OFF);
    Fr F;
    F.PT = (volatile LAS unsigned long long*)(lds + MISC_OFF + 256);
    F.G = gridDim.x; F.bx = blockIdx.x; F.vcu = (F.G % 8 == 0) ? (F.bx % 8) * (F.G / 8) + F.bx / 8 : F.bx;
    { const int t0 = threadIdx.x;
      if (t0 < 64) MISC[t0] = 0u;
      if (t0 < 24) F.PT[t0] = (unsigned long long)args.in[t0];
      if (t0 == 24) F.PT[24] = (unsigned long long)args.out;
      if (t0 == 25) F.PT[25] = (unsigned long long)args.ws; }
    __syncthreads();
    XcdBarrier bar = xcd_barrier_post((unsigned*)(F.ws() + WS_CTL), MISC + 8);
    const int lo = args.ph_lo, hi = args.ph_hi;
    int p = 0;
#define RUN(...) RUNC(31, __VA_ARGS__)
#define RUNC(cls, ...) do { if (lo <= p && p < hi) { _Pragma("nounroll") for (int rep_ = 0; rep_ < 1 + (int)((REPEAT_MASK >> (cls)) & 1u); ++rep_) { __VA_ARGS__; if (REPEAT_MASK) __syncthreads(); } if (p + 1 < hi) xcd_barrier(bar); } ++p; } while (0)

#ifndef NO_P0
    RUNC(0, p0_phase(F, lds, 0));
    RUN({
        norm_phase(F, lds, 0, 1, TT, -1, 0, F.in(I_X), F.in(I_CTX), nullptr, nullptr, 0, true);
        __syncthreads();
        p0_phase(F, lds, 1);
    });
#endif
#pragma nounroll
    for (int L = 0; L < 4; ++L) {
        const int kind = L % 3, jm = L / 3;
        const bool with_ctx = (L == 0);
        if (L > 0) RUNC(1, {
            bf16_t* xo = WSP(F, bf16_t, WS_XB); bf16_t* xc = WSP(F, bf16_t, WS_XC);
#ifndef NO_NORM
            norm_phase(F, lds, L, 1, (L <= 1) ? TT : T, L - 1, 1, xo, xc, xo, xc, (REPEAT_MASK >> 1) & 1u ? (rep_ == 0) : 0, kind == 0);
#endif
        });
        RUNC(2, {
            unsigned char* ws = F.ws();
            pg8::SchedDense S; S.A = (bf16_t*)(ws + WS_H); S.G = F.G; S.c = F.bx; S.a_pn_stride = 0; S.a_pm_stride = 256 * D; S.b_pn_stride = 256 * D; S.extra = 0;
            pg8::EpiA E; E.O = (bf16_t*)(ws + WS_S1); E.ldc = 2048; E.act = 0; E.VB = nullptr; E.stats = nullptr;
            if (kind == 0) { S.Bt = (bf16_t*)(ws + WS_WGIN) + (size_t)jm * 2048 * 1024; S.nM = with_ctx ? 72 : 64; S.nN = 8; E.act = 1; E.stats = (float*)(ws + WS_VST); }
            else if (kind == 1) { S.Bt = (bf16_t*)(ws + WS_WAIN); S.nM = 64; S.nN = 6; S.extra = 16; E.VB = (bf16_t*)(ws + WS_VB); }
            else { S.Bt = (bf16_t*)(ws + WS_WPIN); S.nM = 64; S.nN = 4; }
            S.nwg = S.nM * S.nN;
            int role = F.bx;
            if (L == 0 && F.G == 256) { role = split_role(F, CV_G_GA); S.G = CV_G_GA; S.c = role; }
            if (L == 1 && F.G == 256) { role = split_role(F, CV_G_GA1); S.G = CV_G_GA1; S.c = role; }
#ifndef NO_GA
            if (role >= 0) pg8::gemm_phase<pg8::EpiA, pg8::SchedDense>(lds, D, D, D, S, E);
#endif
            if (role < 0) { const int q_ = L == 0 ? CV_Q_GA : CV_Q_GA1, j0 = (L == 0 ? CV_B_GA : CV_B_GA1) + (-1 - role) * q_; convert_tiles(F, lds, j0, 1, j0 + q_, 0x7fffffff, 0); }
        });
        if (kind == 0) {
#ifndef NO_SPAT
            RUNC(3, spatial_phase(F, lds, jm, with_ctx ? 144 : 128));
#endif
        }
        else if (kind == 1) {
#ifndef NO_QKN
            RUNC(4, qknorm_phase(F));
#endif
            RUNC(5, {
                unsigned char* ws = F.ws();
                const bf16_t* QB = (const bf16_t*)(ws + WS_QB); const bf16_t* KB = (const bf16_t*)(ws + WS_KB); const bf16_t* VB = (const bf16_t*)(ws + WS_VB); bf16_t* S2 = (bf16_t*)(ws + WS_S2);
                for (int i = 0; i * F.G + F.vcu < 512; ++i) { const int Lu = i * F.G + F.vcu, bk = Lu >> 5, w = Lu & 31, b = bk >> 1, kvh = bk & 1, h = kvh * 4 + (w >> 3), qb = w & 7;
#ifndef NO_ATT
                    att::attn_body<D, D>(QB + ((size_t)(b * SEQ + qb * 256)) * D + h * 128, KB + (size_t)bk * SKV * 128, VB + (size_t)bk * SKV * 128,
                                         S2 + ((size_t)(b * SEQ + qb * 256)) * D + h * 128, SKV, lds);
#endif
                    __syncthreads(); }
            });
        } else {
#ifndef NO_POOL
            RUNC(6, pool_phase(F));
#endif
        }
        RUNC(7, {
            unsigned char* ws = F.ws();
            pg8::SchedDense S; S.A = (bf16_t*)(ws + WS_S2); S.G = F.G; S.c = F.bx; S.a_pm_stride = 256 * D; S.a_pn_stride = 0; S.b_pn_stride = 256 * D; S.extra = 0; S.nN = 4; S.nM = 64;
            pg8::EpiB E; E.xd_lat = (bf16_t*)(ws + WS_XB); E.xd_ctx = (bf16_t*)(ws + WS_XC); E.src_f32 = (L == 0); E.xs_lat = (L == 0) ? (const void*)F.in(I_X) : (const void*)E.xd_lat; E.xs_ctx = (L == 0) ? (const void*)F.in(I_CTX) : (const void*)E.xd_ctx;
            E.gt = (const float*)(ws + WS_MODV) + (size_t)L * 9 * 6144 + 2 * 1024; E.colscale = nullptr; E.dry = (REPEAT_MASK >> 7) & 1u ? (rep_ == 0) : 0;
            int K = D, ldb = D;
            if (kind == 0) { S.Bt = (bf16_t*)(ws + WS_WGOUT) + (size_t)jm * 1024 * 1024; S.nM = with_ctx ? 72 : 64; }
            else if (kind == 1) { S.Bt = (bf16_t*)(ws + WS_WAOUT); }
            else { S.Bt = (bf16_t*)(ws + WS_WPGRP); S.a_pn_stride = 256; S.b_pn_stride = 256 * 256; K = 256; ldb = 256; E.colscale = F.in(I_PSC); }
            S.nwg = S.nM * S.nN;
            int role = F.bx;
            if (L == 0 && F.G == 256) { role = split_role(F, CV_G_GB); S.G = CV_G_GB; S.c = role; }
#ifndef NO_GB
            if (role >= 0) pg8::gemm_phase<pg8::EpiB, pg8::SchedDense>(lds, K, D, ldb, S, E);
#endif
            if (role < 0) { const int j0 = CV_B_GB + (-1 - role) * CV_Q_GB; convert_tiles(F, lds, j0, 1, j0 + CV_Q_GB, 0x7fffffff, 0); }
        });
        RUNC(8, {
            bf16_t* xo = WSP(F, bf16_t, WS_XB); bf16_t* xc = WSP(F, bf16_t, WS_XC);
#ifndef NO_NORM
            norm_phase(F, lds, L, 2, with_ctx ? TT : T, -1, 1, xo, xc, xo, xc, ((REPEAT_MASK >> 13) & 1u) && rep_ == 0 ? 2 : 0);
#endif
        });
#ifndef NO_TOPK
        RUNC(9, { topk_phase(F, lds, with_ctx); if (L == 1 || L == 2) convert_in_idle_slot(F, lds, F.bx, 128, L == 1 ? CV_B_TK1 : CV_B_TK2, CV_Q_TK, CV_N_TK); });
#endif
        RUNC(10, {
            unsigned char* ws = F.ws();
            pg8::SchedMoE<true> S; S.A = (bf16_t*)(ws + WS_H); S.IDX = (const int*)(ws + WS_IDX); S.Bt = (bf16_t*)(ws + WS_WUP) + (size_t)L * 16 * 2048 * 1024; S.nbt = with_ctx ? 9 : 8; S.nn = 8; S.G = F.G; S.vcu = F.vcu;
            pg8::EpiC E; E.HID = (bf16_t*)(ws + WS_HID);
            int role = F.bx;
            if (L == 0 && F.G == 256) { role = split_role(F, CV_G_UP); S.G = CV_G_UP; S.vcu = role >= 0 ? (role & 7) * (CV_G_UP / 8) + (role >> 3) : 0; }
#ifndef NO_GC
            if (role >= 0) pg8::gemm_phase<pg8::EpiC, pg8::SchedMoE<true>>(lds, D, D, D, S, E);
#endif
            if (role < 0) { const int j0 = CV_B_UP + (-1 - role) * CV_Q_UP; convert_tiles(F, lds, j0, 1, j0 + CV_Q_UP, 0x7fffffff, 0); }
        });
        RUNC(11, {
            unsigned char* ws = F.ws();
            pg8::SchedMoE<false> S; S.A = (bf16_t*)(ws + WS_HID); S.IDX = nullptr; S.Bt = (bf16_t*)(ws + WS_WDN) + (size_t)L * 16 * 1024 * 1024; S.nbt = with_ctx ? 9 : 8; S.nn = 4; S.G = F.G; S.vcu = F.vcu;
            pg8::EpiD E; E.Y = (bf16_t*)(ws + WS_YEXP); E.gate = (const float*)(ws + WS_GATE);
            int role = F.bx;
            if (L == 0 && F.G == 256) { role = split_role(F, CV_G_DN); S.G = CV_G_DN; S.vcu = role >= 0 ? (role & 7) * (CV_G_DN / 8) + (role >> 3) : 0; }
#ifndef NO_GD
            if (role >= 0) pg8::gemm_phase<pg8::EpiD, pg8::SchedMoE<false>>(lds, D, D, D, S, E);
#endif
            if (role < 0) { const int j0 = CV_B_DN + (-1 - role) * CV_Q_DN; convert_tiles(F, lds, j0, 1, j0 + CV_Q_DN, 0x7fffffff, 0); }
        });
    }
    RUN({
        bf16_t* xb = WSP(F, bf16_t, WS_XB);
#ifndef NO_NORM
        norm_phase(F, lds, 3, 0, T, 3, 2, xb, nullptr, F.out(), nullptr);
#endif
    });
#undef RUN
#undef RUNC
}

constexpr int N_PHASES = 1 + 8 + 9 + 8 + 8 + 1;

extern "C" void kernel_launch(void* const* d_in, const int* in_sizes, int n_in, void* d_out, int out_size, void* d_ws, size_t ws_size, hipStream_t stream) {
    static int grid = 0;
    if (grid == 0) {
        if (n_in != 24 || out_size != T * D || ws_size < WS_END) { fprintf(stderr, "kernel_launch: unexpected shapes (n_in %d out %d ws %zu need %zu)\n", n_in, out_size, ws_size, (size_t)WS_END); grid = -1; return; }
        int dev = 0, cus = 0;
        if (hipGetDevice(&dev) != hipSuccess || hipDeviceGetAttribute(&cus, hipDeviceAttributeMultiprocessorCount, dev) != hipSuccess) { grid = -1; return; }
        if (hipFuncSetAttribute((const void*)fwd_kernel, hipFuncAttributeMaxDynamicSharedMemorySize, LDS_BYTES) != hipSuccess) { fprintf(stderr, "kernel_launch: hipFuncSetAttribute failed\n"); grid = -1; return; }
        (void)hipGetLastError();
        grid = cus;
    }
    if (grid < 0) return;
    (void)hipMemsetAsync((char*)d_ws + WS_CTL, 0, CTL_BYTES, stream);
    KArgs a{};
    for (int i = 0; i < 24; ++i) a.in[i] = (const float*)d_in[i];
    a.out = (float*)d_out; a.ws = (unsigned char*)d_ws;
#if MK_PER_PHASE
    for (int k = 0; k < N_PHASES; ++k) { a.ph_lo = k; a.ph_hi = k + 1; hipLaunchKernelGGL(fwd_kernel, dim3(grid), dim3(NTHR), LDS_BYTES, stream, a); }
#else
    a.ph_lo = 0; a.ph_hi = N_PHASES;
    hipLaunchKernelGGL(fwd_kernel, dim3(grid), dim3(NTHR), LDS_BYTES, stream, a);
#endif
    const hipError_t le = hipPeekAtLastError();
    if (le != hipSuccess) fprintf(stderr, "kernel_launch: launch failed: %s\n", hipGetErrorName(le));
}
```

```cpp
#include <hip/hip_runtime.h>
#include <cstdio>
#include <cstdint>

#ifndef REPEAT_MASK
#define REPEAT_MASK 0u
#endif
#ifndef MK_PER_PHASE
#define MK_PER_PHASE 0
#endif

#define LAS __attribute__((address_space(3)))
#define GAS __attribute__((address_space(1)))
typedef unsigned short bf16_t;
typedef short bf16x8 __attribute__((ext_vector_type(8)));
typedef short s16x4 __attribute__((ext_vector_type(4)));
typedef float f32x2 __attribute__((ext_vector_type(2)));
typedef float f32x4 __attribute__((ext_vector_type(4)));
typedef float f32x16 __attribute__((ext_vector_type(16)));
typedef unsigned u32x2 __attribute__((ext_vector_type(2)));
typedef unsigned u32x4 __attribute__((ext_vector_type(4)));

constexpr int D = 1024, NB = 8, SEQ = 2048, T = NB * SEQ, CL = 256, TC = NB * CL, TT = T + TC, NE = 16, CAP = 256, CCAP = 32, NTILE = 144;
constexpr int SKV = CL + SEQ;
constexpr float EPS = 1e-6f;
constexpr int NWAVES = 8, NTHR = 512;

constexpr size_t al256(size_t x) { return (x + 255) / 256 * 256; }
constexpr size_t WS_CTL   = 0;
constexpr size_t CTL_BYTES = 65536;
constexpr size_t WS_MODV  = WS_CTL + CTL_BYTES;
constexpr size_t WS_AFF   = WS_MODV + al256((size_t)4 * 9 * 6144 * 4);
constexpr size_t WS_SLOT  = WS_AFF + (size_t)TT * 16 * 4;
constexpr size_t WS_GATE  = WS_SLOT + (size_t)TT * 16 * 4;
constexpr size_t WS_VST   = WS_GATE + (size_t)NTILE * 256 * 4;
constexpr size_t WS_WSW   = WS_VST + (size_t)TT * 16 * 2 * 4;
constexpr size_t WS_WGIN  = WS_WSW + (size_t)2 * 8 * 128 * 128 * 2;
constexpr size_t WS_WGOUT = WS_WGIN + (size_t)2 * 2048 * 1024 * 2;
constexpr size_t WS_WAIN  = WS_WGOUT + (size_t)2 * 1024 * 1024 * 2;
constexpr size_t WS_WAOUT = WS_WAIN + (size_t)1536 * 1024 * 2;
constexpr size_t WS_WPIN  = WS_WAOUT + (size_t)1024 * 1024 * 2;
constexpr size_t WS_WPGRP = WS_WPIN + (size_t)1024 * 1024 * 2;
constexpr size_t WS_WUP   = WS_WPGRP + (size_t)4 * 256 * 256 * 2;
constexpr size_t WS_WDN   = WS_WUP + (size_t)4 * 16 * 2048 * 1024 * 2;
constexpr size_t WS_XC    = WS_WDN + (size_t)4 * 16 * 1024 * 1024 * 2;
constexpr size_t WS_XB    = WS_XC + (size_t)TC * D * 2;
constexpr size_t WS_H     = WS_XB + (size_t)T * D * 2;
constexpr size_t WS_S1    = WS_H + (size_t)TT * D * 2;
constexpr size_t WS_S2    = WS_S1 + (size_t)TT * 2048 * 2;
constexpr size_t WS_QB    = WS_S2 + (size_t)TT * D * 2;
constexpr size_t WS_KB    = WS_QB + (size_t)T * D * 2;
constexpr size_t WS_VB    = WS_KB + (size_t)NB * 2 * SKV * 128 * 2;
constexpr size_t WS_IDX   = WS_VB + (size_t)NB * 2 * SKV * 128 * 2;
constexpr size_t WS_HID   = WS_IDX + (size_t)NTILE * 256 * 4;
constexpr size_t WS_YEXP  = WS_HID + (size_t)NTILE * 256 * D * 2;
constexpr size_t WS_END   = WS_YEXP + (size_t)NTILE * 256 * D * 2;

constexpr int RING_BYTES = 131072, MISC_OFF = RING_BYTES, LDS_BYTES = RING_BYTES + 1024;

__device__ __forceinline__ unsigned cvt_pk_bf16(float lo, float hi) { unsigned r; asm volatile("v_cvt_pk_bf16_f32 %0, %1, %2" : "=v"(r) : "v"(lo), "v"(hi)); return r; }
__device__ __forceinline__ float bf_lo(unsigned u) { return __uint_as_float(u << 16); }
__device__ __forceinline__ float bf_hi(unsigned u) { return __uint_as_float(u & 0xffff0000u); }
__device__ __forceinline__ float bf2f(bf16_t b) { return __uint_as_float(((unsigned)b) << 16); }
__device__ __forceinline__ bf16_t f2bf(float f) { return (bf16_t)(cvt_pk_bf16(f, 0.f) & 0xffffu); }
template <int K> __device__ __forceinline__ float swz_xor(float v) { return __int_as_float(__builtin_amdgcn_ds_swizzle(__float_as_int(v), 0x1F | (K << 10))); }
__device__ __forceinline__ float half_sum(float v) { v += swz_xor<1>(v); v += swz_xor<2>(v); v += swz_xor<4>(v); v += swz_xor<8>(v); v += swz_xor<16>(v); return v; }
__device__ __forceinline__ float half_max(float v) { v = fmaxf(v, swz_xor<1>(v)); v = fmaxf(v, swz_xor<2>(v)); v = fmaxf(v, swz_xor<4>(v)); v = fmaxf(v, swz_xor<8>(v)); v = fmaxf(v, swz_xor<16>(v)); return v; }
__device__ __forceinline__ float wave_sum(float v) { v = half_sum(v); auto rr = __builtin_amdgcn_permlane32_swap(__float_as_uint(v), __float_as_uint(v), false, false); return __uint_as_float(rr[0]) + __uint_as_float(rr[1]); }
__device__ __forceinline__ float wave_max(float v) { v = half_max(v); auto rr = __builtin_amdgcn_permlane32_swap(__float_as_uint(v), __float_as_uint(v), false, false); return fmaxf(__uint_as_float(rr[0]), __uint_as_float(rr[1])); }
__device__ __forceinline__ float xor32(float v, bool hi) { auto rr = __builtin_amdgcn_permlane32_swap(__float_as_uint(v), __float_as_uint(v), false, false); return __uint_as_float(hi ? rr[0] : rr[1]); }
__device__ __forceinline__ int opaque_tid() { int t = threadIdx.x; asm volatile("" : "+v"(t)); return t; }
__device__ __forceinline__ float silu_f(float x) { return x / (1.f + __expf(-x)); }
__device__ __forceinline__ float gelu_tanh_f(float x) {
    const float z = 0.7978845608028654f * (x + 0.044715f * x * x * x);
    return x / (1.f + __expf(-2.f * z));
}
#define LDS_WAIT() asm volatile("s_waitcnt lgkmcnt(0)" ::: "memory")

#define XB_TMO      128
#define XB_XCNT(j)  (256  + 64 * (j))
#define XB_XSUB(j)  (1280 + 64 * (j))
#define XB_XGEN(j)  (2304 + 64 * (j))
#define XB_TOP      3328
#define XB_TOPGEN   3392
#define XCD_BAR_WORDS 3456
#define XB_SPIN_CAP (1u << 22)
__device__ __forceinline__ unsigned xb_ld(unsigned* p)              { return __hip_atomic_load(p, __ATOMIC_RELAXED, __HIP_MEMORY_SCOPE_AGENT); }
__device__ __forceinline__ unsigned xb_add(unsigned* p, unsigned v) { return __hip_atomic_fetch_add(p, v, __ATOMIC_RELAXED, __HIP_MEMORY_SCOPE_AGENT); }
__device__ __forceinline__ unsigned xb_xcc_id() { return (unsigned)__builtin_amdgcn_s_getreg((3 << 11) | 20) & 0xFu; }
#define XB_SPIN(cond, bar) do { unsigned _sp = 0; while (cond) { __builtin_amdgcn_s_sleep(1); \
    if ((++_sp & 255u) == 0u) { if (xb_ld(&(bar)[XB_TMO])) break; if (_sp > XB_SPIN_CAP) { atomicAdd(&(bar)[XB_TMO], 1u); break; } } } } while (0)
struct XcdBarrier { unsigned* bar; unsigned x; volatile LAS unsigned* st; };
__device__ __forceinline__ XcdBarrier xcd_barrier_post(unsigned* bar, volatile LAS unsigned* st) {
    XcdBarrier b; b.bar = bar; b.x = xb_xcc_id(); b.st = st;
    if (threadIdx.x == 0) (void)xb_add(&bar[XB_XCNT(b.x)], 1u);
    return b;
}
__device__ __forceinline__ void xcd_barrier_complete(unsigned* bar, unsigned x, unsigned& nloc, unsigned& nx) {
    const unsigned G = gridDim.x * gridDim.y * gridDim.z;
    unsigned sum, cnt, mine, sp = 0u;
    for (;;) {
        sum = 0u; cnt = 0u; mine = 0u;
#pragma unroll
        for (unsigned j = 0; j < 16; ++j) { const unsigned c = xb_ld(&bar[XB_XCNT(j)]); sum += c; cnt += (c > 0u) ? 1u : 0u; }
        mine = xb_ld(&bar[XB_XCNT(x)]);
        if (sum == G) break;
        __builtin_amdgcn_s_sleep(1);
        if ((++sp & 255u) == 0u) { if (xb_ld(&bar[XB_TMO])) break; if (sp > XB_SPIN_CAP) { atomicAdd(&bar[XB_TMO], 1u); break; } }
    }
    nloc = mine > 0u ? mine : 1u; nx = cnt > 0u ? cnt : 1u;
}
__device__ __forceinline__ void xcd_barrier(const XcdBarrier& b) {
    asm volatile("s_waitcnt vmcnt(0)" ::: "memory");
    __syncthreads();
    if (threadIdx.x == 0) {
        unsigned* bar = b.bar;
        __builtin_amdgcn_s_waitcnt(0);
        unsigned nloc = b.st[0], nx = b.st[1];
        if (nloc == 0u) { xcd_barrier_complete(bar, b.x, nloc, nx); b.st[0] = nloc; b.st[1] = nx; }
        const unsigned old = xb_add(&bar[XB_XSUB(b.x)], 1u);
        const unsigned gen = old / nloc;
        if (old + 1u == (gen + 1u) * nloc) {
            __builtin_amdgcn_fence(__ATOMIC_RELEASE, "agent");
            asm volatile("s_waitcnt vmcnt(0)" ::: "memory");
            const unsigned og = xb_add(&bar[XB_TOP], 1u);
            const unsigned tg = og / nx;
            if (og + 1u == (tg + 1u) * nx) xb_add(&bar[XB_TOPGEN], 1u);
            else XB_SPIN(xb_ld(&bar[XB_TOPGEN]) == tg, bar);
            __builtin_amdgcn_fence(__ATOMIC_ACQUIRE, "agent");
            xb_add(&bar[XB_XGEN(b.x)], 1u);
            asm volatile("s_waitcnt vmcnt(0)" ::: "memory");
        } else {
            XB_SPIN(xb_ld(&bar[XB_XGEN(b.x)]) == gen, bar);
            __builtin_amdgcn_fence(__ATOMIC_ACQUIRE, "agent");
            asm volatile("s_waitcnt vmcnt(0)" ::: "memory");
        }
    }
    __syncthreads();
}

namespace pg8 {
constexpr int BM = 256, BK = 64, HALF = 128, HTB = HALF * BK * 2, NXCD = 8, WGM = 8;
__host__ __device__ __forceinline__ int lds_byte(int r, int c) { const int st = (r >> 4) * 2 + (c >> 5), rr = r & 15, cc = c & 31, ob = rr * 64 + cc * 2; return st * 1024 + (ob ^ (((ob >> 9) & 1) << 5)); }
__host__ __device__ __forceinline__ void stage_rc(int b, int& R, int& C) { const int st = b / 1024, sb = b % 1024, swz = sb ^ (((sb >> 9) & 1) << 5); R = (st >> 1) * 16 + swz / 64; C = (st & 1) * 32 + (swz % 64) / 2; }
__host__ __device__ __forceinline__ int perm32(int rho) { const int n = rho >> 4, i = rho & 15; return 8 * (i >> 2) + 4 * n + (i & 3); }
struct Unit { int pm, pn; };

template <class Epi, class Sched>
__device__ __forceinline__ void gemm_phase(LAS unsigned char* lds, const int K, const int lda, const int ldb, const Sched& S, const Epi& E) {
    const int tid = opaque_tid(), wid = __builtin_amdgcn_readfirstlane(tid >> 6), lane = tid & 63, wr = wid >> 2, wc = wid & 3, fr = lane & 15, fq = lane >> 4;
    const int nt = K / BK;
    constexpr bool GATHER = Sched::GATHER;
    unsigned voffA[2], voffB[2]; int rowA[2];
#pragma unroll
    for (int i = 0; i < 2; ++i) { int R, C; stage_rc(tid * 16 + i * 8192, R, C); const int Rb = Epi::PERM ? ((R & ~31) + perm32(R & 31)) : R;
        voffA[i] = GATHER ? (unsigned)C * 2u : (unsigned)(R * lda + C) * 2u; voffB[i] = (unsigned)(Rb * ldb + C) * 2u; rowA[i] = R; }
    unsigned gA[2][2], gN[2][2];
    const size_t kstep = (size_t)(BK * 2);
    const size_t hstepA = (size_t)HALF * lda * 2, hstepB = (size_t)HALF * ldb * 2;
    const unsigned ldsw = (unsigned)wid * 1024u;
    const int aoff = lds_byte(wr * 64 + fr, fq * 8), boff = lds_byte(wc * 32 + fr, fq * 8);
#define PG8_SA(b, h) (((b) * 2 + (h)) * HTB)
#define PG8_SB(b, h) ((4 + (b) * 2 + (h)) * HTB)
#define PG8_STAGE(bufoff, gbase, voff) do { _Pragma("unroll") for (int _i = 0; _i < 2; ++_i) \
        __builtin_amdgcn_global_load_lds((const unsigned*)((const char*)(gbase) + (voff)[_i]), (LAS unsigned*)(lds + (bufoff) + ldsw + _i * 8192), 16, 0, 0); } while (0)
#define PG8_STAGE_A(bufoff, ubase, kb, h, nx) do { if constexpr (GATHER) { unsigned _v[2]; _v[0] = ((nx) ? gN[h][0] : gA[h][0]) + voffA[0]; _v[1] = ((nx) ? gN[h][1] : gA[h][1]) + voffA[1]; \
        PG8_STAGE(bufoff, (const char*)S.abase() + (kb), _v); } else { PG8_STAGE(bufoff, (ubase) + (size_t)(h) * hstepA + (kb), voffA); } } while (0)
#define PG8_LOADG(u, g) do { if constexpr (GATHER) { const int* _ip = S.idx(u); _Pragma("unroll") for (int _h = 0; _h < 2; ++_h) _Pragma("unroll") for (int _i = 0; _i < 2; ++_i) \
        g[_h][_i] = (unsigned)_ip[_h * HALF + rowA[_i]] * (unsigned)(lda * 2); } } while (0)
#define PG8_LDA(dst, b, h) do { _Pragma("unroll") for (int m = 0; m < 4; ++m) _Pragma("unroll") for (int k = 0; k < 2; ++k) dst[m][k] = *(const LAS bf16x8*)(lds + PG8_SA(b, h) + aoff + m * 2048 + k * 1024); } while (0)
#define PG8_LDB(dst, b, h) do { _Pragma("unroll") for (int n = 0; n < 2; ++n) _Pragma("unroll") for (int k = 0; k < 2; ++k) dst[n][k] = *(const LAS bf16x8*)(lds + PG8_SB(b, h) + boff + n * 2048 + k * 1024); } while (0)
#define PG8_MMA(ai, bj, At, Bt) do { __builtin_amdgcn_s_setprio(1); _Pragma("unroll") for (int m = 0; m < 4; ++m) _Pragma("unroll") for (int n = 0; n < 2; ++n) _Pragma("unroll") for (int k = 0; k < 2; ++k) \
        acc[ai][bj][m][n] = __builtin_amdgcn_mfma_f32_16x16x32_bf16(Bt[n][k], At[m][k], acc[ai][bj][m][n], 0, 0, 0); __builtin_amdgcn_s_setprio(0); } while (0)
#define PG8_WAIT_V(n) asm volatile("s_waitcnt vmcnt(" #n ")" ::: "memory")
#define PG8_WAIT_L(n) asm volatile("s_waitcnt lgkmcnt(" #n ")" ::: "memory")
#define PG8_BAR __builtin_amdgcn_s_barrier()
#define PG8_SCHED __builtin_amdgcn_sched_barrier(0)
    Unit cur, nxt; int ui = 0;
    if (!S.next(0, cur)) return;
    f32x4 acc[2][2][4][2];
#pragma unroll
    for (int a = 0; a < 2; ++a)
#pragma unroll
        for (int b = 0; b < 2; ++b)
#pragma unroll
            for (int m = 0; m < 4; ++m)
#pragma unroll
                for (int n = 0; n < 2; ++n) acc[a][b][m][n] = (f32x4){0.f, 0.f, 0.f, 0.f};
    bf16x8 At[4][2], B0[2][2], B1[2][2];
    const char* cA = GATHER ? (const char*)nullptr : S.aptr(cur); const char* cB = S.bptr(cur);
    PG8_LOADG(cur, gA);
    PG8_STAGE(PG8_SB(0, 0), cB, voffB); PG8_STAGE(PG8_SB(0, 1), cB + hstepB, voffB); PG8_STAGE_A(PG8_SA(0, 0), cA, 0, 0, false); PG8_STAGE_A(PG8_SA(0, 1), cA, 0, 1, false);
    if (wr == 1) PG8_BAR;
    PG8_WAIT_V(2); PG8_BAR;
    PG8_STAGE(PG8_SB(1, 0), cB + kstep, voffB); PG8_STAGE_A(PG8_SA(1, 0), cA, kstep, 0, false); PG8_STAGE(PG8_SB(1, 1), cB + hstepB + kstep, voffB);
    PG8_WAIT_V(6); PG8_BAR;
    for (;;) {
        const bool has_next = S.next(ui + 1, nxt);
        const char* nA = (has_next && !GATHER) ? S.aptr(nxt) : cA; const char* nB = has_next ? S.bptr(nxt) : cB;
        if (has_next) PG8_LOADG(nxt, gN); else { if constexpr (GATHER) {
#pragma unroll
            for (int h_ = 0; h_ < 2; ++h_) { gN[h_][0] = gA[h_][0]; gN[h_][1] = gA[h_][1]; } } }
        for (int t = 0; t < nt; t += 2) {
            const bool last = (t == nt - 2);
            const size_t k1 = (size_t)(t + 1) * kstep, k2 = last ? 0 : (size_t)(t + 2) * kstep, k3 = k2 + kstep;
            const char* a2 = last ? nA : cA; const char* b2 = last ? nB : cB + (size_t)(t + 2) * kstep;
            const char* b3 = b2 + kstep;
            PG8_LDB(B0, 0, 0); PG8_LDB(B1, 0, 1); PG8_SCHED; PG8_LDA(At, 0, 0); PG8_STAGE_A(PG8_SA(1, 1), cA, k1, 1, false);
            PG8_WAIT_V(8); PG8_WAIT_L(0); PG8_BAR; PG8_MMA(0, 0, At, B0); PG8_MMA(0, 1, At, B1); PG8_BAR; PG8_SCHED;
            PG8_LDA(At, 0, 1); PG8_STAGE(PG8_SB(0, 0), b2, voffB); PG8_STAGE(PG8_SB(0, 1), b2 + hstepB, voffB); PG8_STAGE_A(PG8_SA(0, 0), a2, k2, 0, last);
            PG8_WAIT_V(8); PG8_WAIT_L(0); PG8_BAR; PG8_MMA(1, 0, At, B0); PG8_MMA(1, 1, At, B1); PG8_BAR; PG8_SCHED;
            PG8_LDB(B0, 1, 0); PG8_LDB(B1, 1, 1); PG8_SCHED; PG8_LDA(At, 1, 0); PG8_STAGE_A(PG8_SA(0, 1), a2, k2, 1, last);
            PG8_WAIT_V(8); PG8_WAIT_L(0); PG8_BAR; PG8_MMA(0, 0, At, B0); PG8_MMA(0, 1, At, B1); PG8_BAR; PG8_SCHED;
            PG8_LDA(At, 1, 1); PG8_STAGE(PG8_SB(1, 0), b3, voffB); PG8_STAGE(PG8_SB(1, 1), b3 + hstepB, voffB); PG8_STAGE_A(PG8_SA(1, 0), a2, k3, 0, last);
            PG8_WAIT_V(8); PG8_WAIT_L(0); PG8_BAR; PG8_MMA(1, 0, At, B0); PG8_MMA(1, 1, At, B1); PG8_BAR; PG8_SCHED;
        }
        if (wr == 0) PG8_BAR;
        E(acc, cur, wr, wc, fr, fq);
        if (!has_next) break;
#pragma unroll
        for (int a = 0; a < 2; ++a)
#pragma unroll
            for (int b = 0; b < 2; ++b)
#pragma unroll
                for (int m = 0; m < 4; ++m)
#pragma unroll
                    for (int n = 0; n < 2; ++n) acc[a][b][m][n] = (f32x4){0.f, 0.f, 0.f, 0.f};
        cur = nxt; cA = nA; cB = nB; ++ui;
        if constexpr (GATHER) {
#pragma unroll
            for (int h_ = 0; h_ < 2; ++h_) { gA[h_][0] = gN[h_][0]; gA[h_][1] = gN[h_][1]; } }
        if (wr == 1) PG8_BAR;
    }
    PG8_WAIT_V(0);
    PG8_BAR;
#undef PG8_SA
#undef PG8_SB
#undef PG8_STAGE
#undef PG8_STAGE_A
#undef PG8_LOADG
#undef PG8_LDA
#undef PG8_LDB
#undef PG8_MMA
#undef PG8_WAIT_V
#undef PG8_WAIT_L
#undef PG8_BAR
#undef PG8_SCHED
}

struct SchedDense {
    static constexpr bool GATHER = false;
    __device__ __forceinline__ const char* abase() const { return nullptr; }
    __device__ __forceinline__ const int* idx(const Unit&) const { return nullptr; }
    const bf16_t* A; const bf16_t* Bt; int a_pm_stride, a_pn_stride, b_pn_stride;
    int nM, nN, nwg, extra, G, c;
    __device__ __forceinline__ bool next(int i, Unit& u) const {
        const int L = i * G + c; if (L >= nwg + extra) return false;
        if (L >= nwg) { const int x = L - nwg; u.pm = nM + (x >> 1); u.pn = 4 + (x & 1); return true; }
        int wgid = L; { const int q = nwg / NXCD, r = nwg % NXCD, xcd = wgid % NXCD, off = wgid / NXCD; wgid = (xcd < r ? xcd * (q + 1) : r * (q + 1) + (xcd - r) * q) + off; }
        const int nig = WGM * nN, gid = wgid / nig, fm = gid * WGM, gsz = (nM - fm) < WGM ? (nM - fm) : WGM;
        u.pm = fm + ((wgid % nig) % gsz); u.pn = (wgid % nig) / gsz; return true;
    }
    __device__ __forceinline__ const char* aptr(const Unit& u) const { return (const char*)(A + (size_t)u.pm * a_pm_stride + (size_t)u.pn * a_pn_stride); }
    __device__ __forceinline__ const char* bptr(const Unit& u) const { return (const char*)(Bt + (size_t)u.pn * b_pn_stride); }
};
template <bool GATHER_>
struct SchedMoE {
    static constexpr bool GATHER = GATHER_;
    const bf16_t* A; const bf16_t* Bt; const int* IDX; int nbt, nn, G, vcu;
    __device__ __forceinline__ bool next(int i, Unit& u) const {
        const int L = i * G + vcu, per_e = nbt * nn; if (L >= NE * per_e) return false;
        const int e = L / per_e, rem = L - e * per_e, bt = rem / nn, j = rem - bt * nn;
        u.pm = bt < 8 ? e * 8 + bt : 128 + e; u.pn = e * nn + j; return true;
    }
    __device__ __forceinline__ const char* aptr(const Unit& u) const { return (const char*)(A + (size_t)u.pm * 256 * D); }
    __device__ __forceinline__ const char* abase() const { return (const char*)A; }
    __device__ __forceinline__ const int* idx(const Unit& u) const { return IDX + (size_t)u.pm * 256; }
    __device__ __forceinline__ const char* bptr(const Unit& u) const { return (const char*)(Bt + (size_t)u.pn * 256 * D); }
};

struct EpiA {
    static constexpr bool PERM = true;
    bf16_t* O; int ldc; int act; bf16_t* VB; float* stats;
    __device__ __forceinline__ void operator()(const f32x4 (&acc)[2][2][4][2], const Unit& u, int wr, int wc, int fr, int fq) const {
        const int row0 = u.pm * BM + wr * 64 + fr, cl = wc * 32 + 8 * fq;
        const bool vtile = (VB != nullptr) && (u.pn == 5);
        const bool dostat = (stats != nullptr) && (u.pn >= 4);
#pragma unroll
        for (int ai = 0; ai < 2; ++ai)
#pragma unroll
            for (int m = 0; m < 4; ++m) {
                const int r = row0 + ai * HALF + m * 16;
                float s1 = 0.f, s2 = 0.f;
#pragma unroll
                for (int bj = 0; bj < 2; ++bj) {
                    f32x4 v0 = acc[ai][bj][m][0], v1 = acc[ai][bj][m][1];
                    if (act) {
#pragma unroll
                        for (int j = 0; j < 4; ++j) { v0[j] = gelu_tanh_f(v0[j]); v1[j] = gelu_tanh_f(v1[j]); } }
#pragma unroll
                    for (int j = 0; j < 4; ++j) { s1 += v0[j] + v1[j]; s2 += v0[j] * v0[j] + v1[j] * v1[j]; }
                    u32x4 w; w.x = cvt_pk_bf16(v0[0], v0[1]); w.y = cvt_pk_bf16(v0[2], v0[3]); w.z = cvt_pk_bf16(v1[0], v1[1]); w.w = cvt_pk_bf16(v1[2], v1[3]);
                    bf16_t* dst;
                    if (vtile) { int b, pos; if (r < T) { b = r >> 11; pos = CL + (r & (SEQ - 1)); } else { const int rc = r - T; b = rc >> 8; pos = rc & (CL - 1); }
                        dst = VB + ((size_t)(b * 2 + bj) * SKV + pos) * 128 + cl; }
                    else dst = O + (size_t)r * ldc + u.pn * BM + bj * HALF + cl;
                    *(u32x4*)dst = w; }
                if (dostat) {
                    s1 += swz_xor<16>(s1); s2 += swz_xor<16>(s2);
                    { auto rr = __builtin_amdgcn_permlane32_swap(__float_as_uint(s1), __float_as_uint(s1), false, false); s1 = __uint_as_float(rr[0]) + __uint_as_float(rr[1]); }
                    { auto rr = __builtin_amdgcn_permlane32_swap(__float_as_uint(s2), __float_as_uint(s2), false, false); s2 = __uint_as_float(rr[0]) + __uint_as_float(rr[1]); }
                    if (fq == 0) *(f32x2*)(stats + ((size_t)r * 16 + (u.pn - 4) * 4 + wc) * 2) = (f32x2){s1, s2}; } }
    }
};
struct EpiB {
    static constexpr bool PERM = true;
    const void* xs_lat; const void* xs_ctx; bf16_t* xd_lat; bf16_t* xd_ctx; const float* gt; const float* colscale; int src_f32; int dry;
    __device__ __forceinline__ void operator()(const f32x4 (&acc)[2][2][4][2], const Unit& u, int wr, int wc, int fr, int fq) const {
        const int row0 = u.pm * BM + wr * 64 + fr, col0 = u.pn * BM + wc * 32 + 8 * fq;
        const bool isctx = row0 >= T;
        const int mrow = isctx ? 8 : (row0 >> 11);
        const size_t rbase = isctx ? (size_t)T : 0;
        const void* xs = isctx ? xs_ctx : xs_lat; bf16_t* xd = isctx ? xd_ctx : xd_lat;
        f32x4 gv[2][2];
#pragma unroll
        for (int bj = 0; bj < 2; ++bj)
#pragma unroll
            for (int n = 0; n < 2; ++n) { const int c = col0 + bj * HALF + n * 4; gv[bj][n] = *(const f32x4*)(gt + (size_t)mrow * 6144 + c);
                if (colscale) gv[bj][n] = gv[bj][n] * *(const f32x4*)(colscale + c); }
#pragma unroll
        for (int ai = 0; ai < 2; ++ai)
#pragma unroll
            for (int m = 0; m < 4; ++m) { const size_t off = ((size_t)(row0 + ai * HALF + m * 16) - rbase) * D + col0;
#pragma unroll
                for (int bj = 0; bj < 2; ++bj) { f32x4 x0, x1;
                    if (src_f32) { x0 = *(const f32x4*)((const float*)xs + off + bj * HALF); x1 = *(const f32x4*)((const float*)xs + off + bj * HALF + 4); }
                    else { const u32x4 w = *(const u32x4*)((const bf16_t*)xs + off + bj * HALF); x0 = (f32x4){bf_lo(w.x), bf_hi(w.x), bf_lo(w.y), bf_hi(w.y)}; x1 = (f32x4){bf_lo(w.z), bf_hi(w.z), bf_lo(w.w), bf_hi(w.w)}; }
                    x0 = x0 + gv[bj][0] * acc[ai][bj][m][0]; x1 = x1 + gv[bj][1] * acc[ai][bj][m][1];
                    u32x4 o; o.x = cvt_pk_bf16(x0[0], x0[1]); o.y = cvt_pk_bf16(x0[2], x0[3]); o.z = cvt_pk_bf16(x1[0], x1[1]); o.w = cvt_pk_bf16(x1[2], x1[3]);
                    if (!dry) *(u32x4*)(xd + off + bj * HALF) = o; } }
    }
};
struct EpiC {
    static constexpr bool PERM = true;
    bf16_t* HID;
    __device__ __forceinline__ void operator()(const f32x4 (&acc)[2][2][4][2], const Unit& u, int wr, int wc, int fr, int fq) const {
        const int n8 = u.pn & 7, rl = wr * 64 + fr, cl = n8 * 128 + wc * 32 + 8 * fq;
        bf16_t* base = HID + (size_t)u.pm * 256 * D;
#pragma unroll
        for (int ai = 0; ai < 2; ++ai)
#pragma unroll
            for (int m = 0; m < 4; ++m) {
                float h[8];
#pragma unroll
                for (int n = 0; n < 2; ++n)
#pragma unroll
                    for (int j = 0; j < 4; ++j) { const float g = acc[ai][0][m][n][j], up = acc[ai][1][m][n][j]; h[n * 4 + j] = silu_f(g) * up; }
                u32x4 w; w.x = cvt_pk_bf16(h[0], h[1]); w.y = cvt_pk_bf16(h[2], h[3]); w.z = cvt_pk_bf16(h[4], h[5]); w.w = cvt_pk_bf16(h[6], h[7]);
                *(u32x4*)(base + (size_t)(rl + ai * HALF + m * 16) * D + cl) = w; }
    }
};
struct EpiD {
    static constexpr bool PERM = true;
    bf16_t* Y; const float* gate;
    __device__ __forceinline__ void operator()(const f32x4 (&acc)[2][2][4][2], const Unit& u, int wr, int wc, int fr, int fq) const {
        const int n4 = u.pn & 3, rl = wr * 64 + fr, cl = n4 * 256 + wc * 32 + 8 * fq;
        bf16_t* base = Y + (size_t)u.pm * 256 * D; const float* gp = gate + (size_t)u.pm * 256;
#pragma unroll
        for (int ai = 0; ai < 2; ++ai)
#pragma unroll
            for (int m = 0; m < 4; ++m) { const int r = rl + ai * HALF + m * 16; const float g = gp[r];
#pragma unroll
                for (int bj = 0; bj < 2; ++bj) { const f32x4 v0 = acc[ai][bj][m][0] * g, v1 = acc[ai][bj][m][1] * g;
                    u32x4 w; w.x = cvt_pk_bf16(v0[0], v0[1]); w.y = cvt_pk_bf16(v0[2], v0[3]); w.z = cvt_pk_bf16(v1[0], v1[1]); w.w = cvt_pk_bf16(v1[2], v1[3]);
                    *(u32x4*)(base + (size_t)r * D + bj * HALF + cl) = w; } }
    }
};
}

namespace att {
constexpr int QBLK = 32, KVBLK = 64;
constexpr float SCALE = 0.088388347648318440f;
constexpr float THR = 8.f;
constexpr int SHM_V = KVBLK * 128 * 2, SHM_K = KVBLK * 128 * 2;
#define KSWZ(row, colB) ((row) * 256 + ((colB) ^ (((row) & 7) << 4)))
#define SBAR() __builtin_amdgcn_sched_barrier(0)
__device__ __forceinline__ int crow(int r, int hi) { return (r & 3) + 8 * (r >> 2) + 4 * hi; }
__device__ __forceinline__ void partialSM(f32x16& p0, f32x16& p1, float& m_reg, float& mn, float& alpha) {
    constexpr float C = SCALE * 1.4426950408889634f;
    float pmax = p0[0];
#pragma unroll
    for (int r = 1; r < 16; ++r) pmax = fmaxf(pmax, p0[r]);
#pragma unroll
    for (int r = 0; r < 16; ++r) pmax = fmaxf(pmax, p1[r]);
    { auto rr = __builtin_amdgcn_permlane32_swap(__float_as_uint(pmax), __float_as_uint(pmax), false, false);
      pmax = fmaxf(__uint_as_float(rr[0]), __uint_as_float(rr[1])); }
    if (__builtin_expect(__all(pmax - m_reg <= THR / SCALE), 1)) { mn = m_reg; alpha = 1.f; }
    else { mn = fmaxf(m_reg, pmax); alpha = __builtin_amdgcn_exp2f((m_reg - mn) * C); m_reg = mn; }
    float mnC = -mn * C;
#pragma unroll
    for (int r = 0; r < 16; ++r) p0[r] = fmaf(p0[r], C, mnC);
#pragma unroll
    for (int r = 0; r < 16; ++r) p1[r] = fmaf(p1[r], C, mnC);
#pragma unroll
    for (int r = 0; r < 16; ++r) p0[r] = __builtin_amdgcn_exp2f(p0[r]);
}
__device__ __forceinline__ void finishSM(f32x16& p0, f32x16& p1, float alpha, float& l_reg, bf16x8& pa0, bf16x8& pa1, bf16x8& pa2, bf16x8& pa3) {
#pragma unroll
    for (int r = 0; r < 16; ++r) p1[r] = __builtin_amdgcn_exp2f(p1[r]);
    float ps = 0;
#pragma unroll
    for (int r = 0; r < 16; ++r) ps += p0[r];
#pragma unroll
    for (int r = 0; r < 16; ++r) ps += p1[r];
    { auto rr = __builtin_amdgcn_permlane32_swap(__float_as_uint(ps), __float_as_uint(ps), false, false);
      ps = __uint_as_float(rr[0]) + __uint_as_float(rr[1]); }
    l_reg = l_reg * alpha + ps;
#define PK4(P, BASE, OUT) do { unsigned a0 = cvt_pk_bf16(P[BASE + 0], P[BASE + 1]), a1 = cvt_pk_bf16(P[BASE + 2], P[BASE + 3]);   \
    unsigned b0 = cvt_pk_bf16(P[BASE + 4], P[BASE + 5]), b1 = cvt_pk_bf16(P[BASE + 6], P[BASE + 7]);                              \
    auto r0 = __builtin_amdgcn_permlane32_swap(a0, b0, false, false); auto r1 = __builtin_amdgcn_permlane32_swap(a1, b1, false, false); \
    u32x4 w = {r0[0], r1[0], r0[1], r1[1]}; OUT = *reinterpret_cast<bf16x8*>(&w); } while (0)
    PK4(p0, 0, pa0); PK4(p0, 8, pa1); PK4(p1, 0, pa2); PK4(p1, 8, pa3);
#undef PK4
}
__device__ __forceinline__ void qkt(f32x16& p0, f32x16& p1, const LAS unsigned char* Ks, const bf16x8* qr, int r32, int hi) {
    p0 = f32x16{}; p1 = f32x16{};
#pragma unroll
    for (int d0 = 0; d0 < 8; ++d0) { int cb = (d0 * 16 + hi * 8) * 2;
        bf16x8 b0 = *reinterpret_cast<const LAS bf16x8*>(Ks + KSWZ(r32, cb));
        bf16x8 b1 = *reinterpret_cast<const LAS bf16x8*>(Ks + KSWZ(32 + r32, cb));
        p0 = __builtin_amdgcn_mfma_f32_32x32x16_bf16(b0, qr[d0], p0, 0, 0, 0);
        p1 = __builtin_amdgcn_mfma_f32_32x32x16_bf16(b1, qr[d0], p1, 0, 0, 0); }
}
__device__ __forceinline__ int v_st(int k, int c) { const int kk = (k & ~0xC) | ((k & 4) << 1) | ((k & 8) >> 1); return ((kk >> 3) * 4 + (c >> 5)) * 512 + ((kk & 7) * 32 + (c & 31)) * 2; }
__device__ __forceinline__ int v_rd_base(int lane) { return ((lane & 3) << 3) | (((lane >> 2) & 3) << 6) | (((lane >> 4) & 1) << 5) | (((lane >> 5) & 1) << 8); }
constexpr int v_rd_off(int d0, int ks, int half) { return d0 * 512 + ks * 4096 + half * 2048; }
template <int OFF> __device__ __forceinline__ s16x4 tr_read(int vb) {
    s16x4 r; asm volatile("ds_read_b64_tr_b16 %0, %1 offset:%2" : "=&v"(r) : "v"(vb), "i"(OFF) : "memory"); return r;
}
template <int D0> __device__ __forceinline__ void pv_one(f32x16& od, int vb, bf16x8 pa0, bf16x8 pa1, bf16x8 pa2, bf16x8 pa3) {
    const s16x4 l0 = tr_read<v_rd_off(D0, 0, 0)>(vb), h0 = tr_read<v_rd_off(D0, 0, 1)>(vb), l1 = tr_read<v_rd_off(D0, 1, 0)>(vb), h1 = tr_read<v_rd_off(D0, 1, 1)>(vb);
    const s16x4 l2 = tr_read<v_rd_off(D0, 2, 0)>(vb), h2 = tr_read<v_rd_off(D0, 2, 1)>(vb), l3 = tr_read<v_rd_off(D0, 3, 0)>(vb), h3 = tr_read<v_rd_off(D0, 3, 1)>(vb);
    asm volatile("s_waitcnt lgkmcnt(0)" ::: "memory"); SBAR();
#define PK(L, H) (bf16x8){L[0], L[1], L[2], L[3], H[0], H[1], H[2], H[3]}
    od = __builtin_amdgcn_mfma_f32_32x32x16_bf16(pa0, PK(l0, h0), od, 0, 0, 0);
    od = __builtin_amdgcn_mfma_f32_32x32x16_bf16(pa1, PK(l1, h1), od, 0, 0, 0);
    od = __builtin_amdgcn_mfma_f32_32x32x16_bf16(pa2, PK(l2, h2), od, 0, 0, 0);
    od = __builtin_amdgcn_mfma_f32_32x32x16_bf16(pa3, PK(l3, h3), od, 0, 0, 0);
#undef PK
}
__device__ __forceinline__ void pv_d0(f32x16* o, int vb, bf16x8 pa0, bf16x8 pa1, bf16x8 pa2, bf16x8 pa3) {
    pv_one<0>(o[0], vb, pa0, pa1, pa2, pa3); pv_one<1>(o[1], vb, pa0, pa1, pa2, pa3); pv_one<2>(o[2], vb, pa0, pa1, pa2, pa3); pv_one<3>(o[3], vb, pa0, pa1, pa2, pa3);
}
template <int LDQ, int LDO>
__device__ __forceinline__ void attn_body(const bf16_t* __restrict__ Qb, const bf16_t* __restrict__ Kh, const bf16_t* __restrict__ Vh, bf16_t* __restrict__ Ob, int seq, LAS unsigned char* lds) {
    constexpr int LDK = 128;
    const int tid = opaque_tid(), wid = tid >> 6, lane = tid & 63, r32 = lane & 31, hi = lane >> 5;
    LAS unsigned char* V_lds = lds; LAS unsigned char* K_lds = lds + 2 * SHM_V;
    LAS float* ws = (LAS float*)(lds + 2 * SHM_V + 2 * SHM_K) + wid * 64; LAS float* li_l = ws; LAS float* al_l = ws + 32;
    float m_reg = -1e30f, l_reg = 0; f32x16 o[4] = {}; bf16x8 qr[8];
    const bf16_t* Qw = Qb + (long)(wid * QBLK + r32) * LDQ + hi * 8;
#pragma unroll
    for (int d0 = 0; d0 < 8; ++d0) qr[d0] = *reinterpret_cast<const bf16x8*>(Qw + d0 * 16);
    const int sr = tid >> 4, sc = (tid & 15) * 8, vst0 = v_st(sr, sc), vst1 = v_st(32 + sr, sc);
    const int vb0 = (int)(unsigned)(uintptr_t)V_lds + v_rd_base(lane);
    struct { bf16x8 vs0, vs1, ks0, ks1; } sr_[2];
#define SLOAD(i, k0) do { sr_[i].vs0 = *reinterpret_cast<const bf16x8*>(&Vh[(long)((k0) + sr) * LDK + sc]); sr_[i].vs1 = *reinterpret_cast<const bf16x8*>(&Vh[(long)((k0) + 32 + sr) * LDK + sc]); \
    sr_[i].ks0 = *reinterpret_cast<const bf16x8*>(&Kh[(long)((k0) + sr) * LDK + sc]); sr_[i].ks1 = *reinterpret_cast<const bf16x8*>(&Kh[(long)((k0) + 32 + sr) * LDK + sc]); } while (0)
#define SWRITE(b, i) do { *(LAS bf16x8*)(V_lds + (b) * SHM_V + vst0) = sr_[i].vs0;          \
    *(LAS bf16x8*)(V_lds + (b) * SHM_V + vst1) = sr_[i].vs1; int kc = sc * 2;               \
    *(LAS bf16x8*)(K_lds + (b) * SHM_K + KSWZ(sr, kc)) = sr_[i].ks0;                       \
    *(LAS bf16x8*)(K_lds + (b) * SHM_K + KSWZ(32 + sr, kc)) = sr_[i].ks1; } while (0)
#define SWAIT() asm volatile("s_waitcnt vmcnt(4)" ::: "memory")
#define RESC(a) do { if (__any((a) < 1.f)) { if (hi == 0) al_l[r32] = (a); asm volatile("s_waitcnt lgkmcnt(0)" ::: "memory"); \
    for (int d = 0; d < 4; ++d) for (int r = 0; r < 16; ++r) o[d][r] *= al_l[crow(r, hi)]; } } while (0)
    f32x16 pA0, pA1, pB0, pB1; float mnA, mnB, alA, alB; bf16x8 pa0, pa1, pa2, pa3; const int NT = seq / KVBLK;
    constexpr int SE = 0, SO = 1;
    SLOAD(SE, 0); asm volatile("s_waitcnt vmcnt(0)" ::: "memory"); SWRITE(0, SE); __syncthreads();
    qkt(pA0, pA1, K_lds, qr, r32, hi); partialSM(pA0, pA1, m_reg, mnA, alA);
    SLOAD(SO, KVBLK); if (2 < NT) SLOAD(SE, 2 * KVBLK);
    SWAIT(); SWRITE(1, SO); __syncthreads();
    for (int j = 1; j + 1 < NT; j += 2) {
        SBAR(); qkt(pB0, pB1, K_lds + SHM_K, qr, r32, hi);
        finishSM(pA0, pA1, alA, l_reg, pa0, pa1, pa2, pa3); SBAR();
        SLOAD(SO, (j + 2) * KVBLK); SBAR();
        pv_d0(o, vb0, pa0, pa1, pa2, pa3); partialSM(pB0, pB1, m_reg, mnB, alB);
        __syncthreads(); SWAIT(); SWRITE(0, SE);
        RESC(alB); __syncthreads();
        SBAR(); qkt(pA0, pA1, K_lds, qr, r32, hi);
        finishSM(pB0, pB1, alB, l_reg, pa0, pa1, pa2, pa3); SBAR();
        if (j + 3 < NT) SLOAD(SE, (j + 3) * KVBLK); SBAR();
        pv_d0(o, vb0 + (int)SHM_V, pa0, pa1, pa2, pa3); partialSM(pA0, pA1, m_reg, mnA, alA);
        __syncthreads(); SWAIT(); SWRITE(1, SO);
        RESC(alA); __syncthreads();
    }
    SBAR(); qkt(pB0, pB1, K_lds + SHM_K, qr, r32, hi);
    finishSM(pA0, pA1, alA, l_reg, pa0, pa1, pa2, pa3); SBAR();
    pv_d0(o, vb0, pa0, pa1, pa2, pa3); partialSM(pB0, pB1, m_reg, mnB, alB);
    __syncthreads(); RESC(alB);
    finishSM(pB0, pB1, alB, l_reg, pa0, pa1, pa2, pa3); SBAR();
    pv_d0(o, vb0 + (int)SHM_V, pa0, pa1, pa2, pa3);
    if (hi == 0) li_l[r32] = l_reg; asm volatile("s_waitcnt lgkmcnt(0)" ::: "memory");
    float rli[16];
#pragma unroll
    for (int r = 0; r < 16; ++r) rli[r] = __builtin_amdgcn_rcpf(li_l[crow(r, hi)]);
    bf16_t* Ow = Ob + (long)(wid * QBLK) * LDO;
#pragma unroll
    for (int r = 0; r < 16; ++r) { int orow = crow(r, hi);
#pragma unroll
        for (int d0 = 0; d0 < 4; ++d0) Ow[(long)orow * LDO + d0 * 32 + r32] = f2bf(o[d0][r] * rli[r]); }
#undef SLOAD
#undef SWRITE
#undef SWAIT
#undef RESC
}
}

struct KArgs { const float* in[24]; float* out; unsigned char* ws; int ph_lo, ph_hi; };
enum { I_X = 0, I_C, I_CTX, I_CCTX, I_MODW, I_MODB, I_N1G, I_N2G, I_RW, I_WG, I_WU, I_WD, I_GWIN, I_GVG, I_GSW, I_GSB, I_GWOUT, I_AWIN, I_AQG, I_AKG, I_AWOUT, I_PWIN, I_PWG, I_PSC };

struct Fr {
    volatile LAS unsigned long long* PT;
    int G, bx, vcu;
    __device__ __forceinline__ unsigned long long ldp(int i) const { const unsigned long long v = PT[i];
        const unsigned lo = __builtin_amdgcn_readfirstlane((unsigned)v), hi = __builtin_amdgcn_readfirstlane((unsigned)(v >> 32)); return ((unsigned long long)hi << 32) | lo; }
    __device__ __forceinline__ const float* in(int i) const { return (const float*)(GAS const float*)ldp(i); }
    __device__ __forceinline__ float* out() const { return (float*)(GAS float*)ldp(24); }
    __device__ __forceinline__ unsigned char* ws() const { return (unsigned char*)(GAS unsigned char*)ldp(25); }
};
#define WSP(F, T_, OFF) ((T_*)((F).ws() + (OFF)))

constexpr int CV_NT_EXP = 4 * 16 * 3 * 64, CV_NT_ALL = CV_NT_EXP + 256 + 128 + 96 + 64 + 64 + 16;
constexpr int CV_G_GA = 192, CV_G_GB = 144, CV_G_DN = 192, CV_G_UP = 232, CV_G_GA1 = 200;
constexpr int CV_Q_GA = 34, CV_N_GA = 256 - CV_G_GA, CV_Q_GB = 19, CV_N_GB = 256 - CV_G_GB, CV_Q_UP = 46, CV_N_UP = 256 - CV_G_UP, CV_Q_DN = 34, CV_N_DN = 256 - CV_G_DN;
constexpr int CV_Q_GA1 = 20, CV_N_GA1 = 256 - CV_G_GA1, CV_Q_TK = 3, CV_N_TK = 128;
constexpr int CV_B_GA = 0, CV_B_GB = CV_B_GA + CV_Q_GA * CV_N_GA, CV_B_UP = CV_B_GB + CV_Q_GB * CV_N_GB, CV_B_DN = CV_B_UP + CV_Q_UP * CV_N_UP;
constexpr int CV_B_GA1 = CV_B_DN + CV_Q_DN * CV_N_DN, CV_B_TK1 = CV_B_GA1 + CV_Q_GA1 * CV_N_GA1, CV_B_TK2 = CV_B_TK1 + CV_Q_TK * CV_N_TK, CV_DEFER = CV_B_TK2 + CV_Q_TK * CV_N_TK;
static_assert(CV_B_UP >= 3072, "layer 0's expert tiles must be converted before its UP GEMM (by GA0 / GB0's converters)");
static_assert(CV_B_GA1 >= 2 * 3072, "layer 1's expert tiles must be converted by the end of layer 0");
static_assert(CV_DEFER >= 3 * 3072 && CV_DEFER <= CV_NT_EXP, "layer 2's expert tiles must be converted before layer 2's UP GEMM (top-k phase of layer 2 at the latest)");
__device__ __forceinline__ void convert_tiles(const Fr& F, LAS unsigned char* lds, const int j0, const int jstride, const int jend, const int skip_lo, const int skip_n, const int skip2_lo = 0x7fffffff, const int skip2_n = 0) {
    const int tid = opaque_tid(), wave = __builtin_amdgcn_readfirstlane(tid >> 6);
    unsigned char* const ws_ = F.ws();
    const int c4 = tid & 63, rr = tid >> 3, ch = tid & 7;
    f32x4 ld[8];
    const float* W = nullptr; int N = 0, k0 = 0, n0 = 0, ldt = 0, gu = 0; bf16_t* dst = nullptr;
#define P0_DECODE(jj) do { int r_ = (jj); r_ = r_ < skip_lo ? r_ : r_ + skip_n; r_ = r_ < skip2_lo ? r_ : r_ + skip2_n; \
        if (r_ < CV_NT_EXP) { const int mat = r_ >> 6, sub = r_ & 63, l = mat / 48, rem = mat % 48, e = rem / 3, which = rem % 3; k0 = (sub >> 2) * 64; n0 = (sub & 3) * 256; N = 1024; ldt = 1024; \
            if (which < 2) { W = F.in(which == 0 ? I_WG : I_WU) + (size_t)(l * 16 + e) * 1024 * 1024; dst = (bf16_t*)(ws_ + WS_WUP) + (size_t)l * 16 * 2048 * 1024 + (size_t)(e * 8 * 256 + which * 128) * 1024; gu = 1; } \
            else { W = F.in(I_WD) + (size_t)(l * 16 + e) * 1024 * 1024; dst = (bf16_t*)(ws_ + WS_WDN) + (size_t)l * 16 * 1024 * 1024 + (size_t)(e * 1024) * 1024; gu = 0; } } \
        else { r_ -= CV_NT_EXP; gu = 0; \
            if (r_ < 256) { const int j = r_ >> 7, sub = r_ & 127; k0 = (sub >> 3) * 64; n0 = (sub & 7) * 256; N = 2048; ldt = 1024; W = F.in(I_GWIN) + (size_t)j * 1024 * 2048; dst = (bf16_t*)(ws_ + WS_WGIN) + (size_t)j * 2048 * 1024; } \
            else if ((r_ -= 256) < 128) { const int j = r_ >> 6, sub = r_ & 63; k0 = (sub >> 2) * 64; n0 = (sub & 3) * 256; N = 1024; ldt = 1024; W = F.in(I_GWOUT) + (size_t)j * 1024 * 1024; dst = (bf16_t*)(ws_ + WS_WGOUT) + (size_t)j * 1024 * 1024; } \
            else if ((r_ -= 128) < 96) { k0 = (r_ / 6) * 64; n0 = (r_ % 6) * 256; N = 1536; ldt = 1024; W = F.in(I_AWIN); dst = (bf16_t*)(ws_ + WS_WAIN); } \
            else if ((r_ -= 96) < 64) { k0 = (r_ >> 2) * 64; n0 = (r_ & 3) * 256; N = 1024; ldt = 1024; W = F.in(I_AWOUT); dst = (bf16_t*)(ws_ + WS_WAOUT); } \
            else if ((r_ -= 64) < 64) { k0 = (r_ >> 2) * 64; n0 = (r_ & 3) * 256; N = 1024; ldt = 1024; W = F.in(I_PWIN); dst = (bf16_t*)(ws_ + WS_WPIN); } \
            else { r_ -= 64; const int g = r_ >> 2; k0 = (r_ & 3) * 64; n0 = 0; N = 256; ldt = 256; W = F.in(I_PWG) + (size_t)g * 256 * 256; dst = (bf16_t*)(ws_ + WS_WPGRP) + (size_t)g * 256 * 256; } } } while (0)
#define P0_LOAD() do { const float* wp_ = W + (size_t)(k0 + wave * 8) * N + n0 + c4 * 4; _Pragma("unroll") for (int s_ = 0; s_ < 8; ++s_) ld[s_] = __builtin_nontemporal_load((const f32x4*)(wp_ + (size_t)s_ * N)); } while (0)
    int it = j0, buf = 0;
    if (it < jend) { P0_DECODE(it); P0_LOAD(); }
#pragma nounroll
    for (; it < jend; it += jstride) {
        LAS unsigned char* Lt = lds + buf * 32768;
#pragma unroll
        for (int j = 0; j < 4; ++j) { const int n = c4 * 4 + j;
            u32x4 o; o.x = cvt_pk_bf16(ld[0][j], ld[1][j]); o.y = cvt_pk_bf16(ld[2][j], ld[3][j]); o.z = cvt_pk_bf16(ld[4][j], ld[5][j]); o.w = cvt_pk_bf16(ld[6][j], ld[7][j]);
            *(LAS u32x4*)(Lt + n * 128 + ((wave ^ ((n >> 2) & 7)) << 4)) = o; }
        bf16_t* const cdst = dst; const int ck0 = k0, cn0 = n0, cldt = ldt, cgu = gu;
        __syncthreads();
        if (it + jstride < jend) { P0_DECODE(it + jstride); P0_LOAD(); }
#pragma unroll
        for (int s_ = 0; s_ < 4; ++s_) { const int n = s_ * 64 + rr; const u32x4 o = *(const LAS u32x4*)(Lt + n * 128 + ((ch ^ ((n >> 2) & 7)) << 4));
            const int nn = cn0 + n; const size_t row = cgu ? (size_t)((nn >> 7) * 256 + (nn & 127)) : (size_t)nn;
            __builtin_nontemporal_store(o, (u32x4*)(cdst + row * cldt + ck0 + ch * 8)); }
        buf ^= 1;
    }
#undef P0_DECODE
#undef P0_LOAD
}
__device__ __forceinline__ int split_role(const Fr& F, const int ng) { const int q = F.bx >> 3, x = F.bx & 7, qg = ng >> 3; return q < qg ? q * 8 + x : -1 - ((q - qg) * 8 + x); }
__device__ __forceinline__ void convert_in_idle_slot(const Fr& F, LAS unsigned char* lds, const int c, const int total, const int base, const int quota, const int nidle) {
    const int rounds = (total + F.G - 1) / F.G, first_idle = total - (rounds - 1) * F.G;
    if (F.G != 256 || c < first_idle || c - first_idle >= nidle) return;
    __syncthreads();
    const int j0 = base + (c - first_idle) * quota;
    convert_tiles(F, lds, j0, 1, j0 + quota, 0x7fffffff, 0);
}

__device__ __forceinline__ void p0_phase(const Fr& F, LAS unsigned char* lds, const int part) {
    const int tid = opaque_tid(), lane = tid & 63, wave = __builtin_amdgcn_readfirstlane(tid >> 6), gw = F.bx * NWAVES + wave, NGW = F.G * NWAVES; (void)gw; (void)NGW; (void)lane; (void)wave;
    unsigned char* const ws_ = F.ws();
    float* const modv_ = (float*)(ws_ + WS_MODV);
    bf16_t* const wsw_ = (bf16_t*)(ws_ + WS_WSW);
    bf16_t* const wgin_ = (bf16_t*)(ws_ + WS_WGIN);
    bf16_t* const wgout_ = (bf16_t*)(ws_ + WS_WGOUT);
    bf16_t* const wain_ = (bf16_t*)(ws_ + WS_WAIN);
    bf16_t* const waout_ = (bf16_t*)(ws_ + WS_WAOUT);
    bf16_t* const wpin_ = (bf16_t*)(ws_ + WS_WPIN);
    bf16_t* const wpgrp_ = (bf16_t*)(ws_ + WS_WPGRP);
    bf16_t* const wup_ = (bf16_t*)(ws_ + WS_WUP);
    bf16_t* const wdn_ = (bf16_t*)(ws_ + WS_WDN);
    const float* const in_I_AWIN = F.in(I_AWIN);
    const float* const in_I_AWOUT = F.in(I_AWOUT);
    const float* const in_I_C = F.in(I_C);
    const float* const in_I_CCTX = F.in(I_CCTX);
    const float* const in_I_GSW = F.in(I_GSW);
    const float* const in_I_GWIN = F.in(I_GWIN);
    const float* const in_I_GWOUT = F.in(I_GWOUT);
    const float* const in_I_MODB = F.in(I_MODB);
    const float* const in_I_MODW = F.in(I_MODW);
    const float* const in_I_PWG = F.in(I_PWG);
    const float* const in_I_PWIN = F.in(I_PWIN);
    const float* const in_I_WD = F.in(I_WD);
    const float* const in_I_WG = F.in(I_WG);
    const float* const in_I_WU = F.in(I_WU);

    if (part == 0) {
    LAS float* sact = (LAS float*)lds;
    LAS float* red = (LAS float*)(lds + 49152);
    for (int idx = tid; idx < 9 * 1024; idx += NTHR) { const int r = idx >> 10, k = idx & 1023; const float v = r < 8 ? in_I_C[r * 1024 + k] : in_I_CCTX[k]; sact[k * 12 + r] = silu_f(v); }
    __syncthreads();
    for (int chunk = F.bx; chunk < 768; chunk += F.G) {
        const int layer = chunk / 192, n0 = (chunk % 192) * 32, k0 = wave * 128 + (lane >> 5);
        const float* wp = in_I_MODW + (size_t)layer * 1024 * 6144 + (size_t)k0 * 6144 + n0 + (lane & 31);
        float acc[9];
#pragma unroll
        for (int r = 0; r < 9; ++r) acc[r] = 0.f;
#pragma nounroll
        for (int hb = 0; hb < 4; ++hb) {
            float w[16];
#pragma unroll
            for (int i = 0; i < 16; ++i) w[i] = __builtin_nontemporal_load(wp + (size_t)(2 * (hb * 16 + i)) * 6144);
#pragma unroll
            for (int i = 0; i < 16; ++i) { const LAS float* sa = sact + (k0 + 2 * (hb * 16 + i)) * 12;
                const f32x4 s0 = *(const LAS f32x4*)sa, s1 = *(const LAS f32x4*)(sa + 4); const float s8 = sa[8];
                acc[0] += s0[0] * w[i]; acc[1] += s0[1] * w[i]; acc[2] += s0[2] * w[i]; acc[3] += s0[3] * w[i];
                acc[4] += s1[0] * w[i]; acc[5] += s1[1] * w[i]; acc[6] += s1[2] * w[i]; acc[7] += s1[3] * w[i]; acc[8] += s8 * w[i];
                __builtin_amdgcn_sched_barrier(0); }
        }
#pragma unroll
        for (int r = 0; r < 9; ++r) { acc[r] += xor32(acc[r], lane >= 32); if (lane < 32) red[(wave * 9 + r) * 32 + lane] = acc[r]; }
        __syncthreads();
        for (int idx = tid; idx < 288; idx += NTHR) { const int r = idx >> 5, l = idx & 31; float sacc = 0.f;
#pragma unroll
            for (int w = 0; w < 8; ++w) sacc += red[(w * 9 + r) * 32 + l];
            const int nn = n0 + l; modv_[(size_t)(layer * 9 + r) * 6144 + nn] = sacc + in_I_MODB[layer * 6144 + nn]; }
        __syncthreads();
    }
    return;
    }
    { const int defer = (F.G == 256) ? CV_DEFER : 0; convert_tiles(F, lds, defer + F.bx, F.G, CV_NT_ALL, 0x7fffffff, 0); }
    __syncthreads();
    for (int i4 = F.bx * NTHR + tid; i4 < 2 * 8 * 128 * 128 / 4; i4 += F.G * NTHR) { const f32x4 v = *(const f32x4*)(in_I_GSW + (size_t)i4 * 4);
        u32x2 o; o.x = cvt_pk_bf16(v[0], v[1]); o.y = cvt_pk_bf16(v[2], v[3]); *(u32x2*)(wsw_ + (size_t)i4 * 4) = o; }
}

template <int R>
__device__ __forceinline__ void norm_rows(const int r0, const bool isctx, const int lane, const int layer, const int which, const int comb, const int dry, float* vst,
                                          const int xmode  , const void* xsrc, void* xdst, const float* modv_, const float* ng, const int* slot_, const bf16_t* YEXP_, bf16_t* H_, float* aff_, int* slotw_, const LAS unsigned char* rwl) {
    const int rc0 = r0 - T; const int b = isctx ? (rc0 >> 8) : (r0 >> 11); const int mrow = isctx ? 8 : b;
    f32x4 v[R][4];
#pragma unroll
    for (int q = 0; q < R; ++q)
#pragma unroll
        for (int j = 0; j < 4; ++j) {
            if (xmode == 0) v[q][j] = *(const f32x4*)((const float*)xsrc + (size_t)q * D + lane * 4 + 256 * j);
            else { const u32x2 w = *(const u32x2*)((const bf16_t*)xsrc + (size_t)q * D + lane * 4 + 256 * j); v[q][j] = (f32x4){bf_lo(w.x), bf_hi(w.x), bf_lo(w.y), bf_hi(w.y)}; } }
#ifndef NO_NR_COMB
    if (comb >= 0) {
        int sl[R];
#pragma unroll
        for (int q = 0; q < R; ++q) sl[q] = slot_[(size_t)(r0 + q) * 16 + (lane & 15)];
        f32x4 a[R][4];
#pragma unroll
        for (int q = 0; q < R; ++q)
#pragma unroll
            for (int j = 0; j < 4; ++j) a[q][j] = (f32x4){0.f, 0.f, 0.f, 0.f};
#pragma nounroll
        for (int e = 0; e < 16; ++e) {
            u32x2 w[R][4];
#pragma unroll
            for (int q = 0; q < R; ++q) {
                const int s = __builtin_amdgcn_readlane(sl[q], e);
                if (s >= 0) {
                    const int tile = isctx ? 128 + e : e * 8 + b, rin = isctx ? (((rc0 + q) >> 8) * 32 + s) : s;
                    const bf16_t* yp = YEXP_ + ((size_t)tile * 256 + rin) * D + lane * 4;
#pragma unroll
                    for (int j = 0; j < 4; ++j) w[q][j] = __builtin_nontemporal_load((const u32x2*)(yp + 256 * j));
                } else {
#pragma unroll
                    for (int j = 0; j < 4; ++j) w[q][j] = (u32x2){0u, 0u};
                }
            }
#pragma unroll
            for (int q = 0; q < R; ++q)
#pragma unroll
                for (int j = 0; j < 4; ++j) { a[q][j][0] += bf_lo(w[q][j].x); a[q][j][1] += bf_hi(w[q][j].x); a[q][j][2] += bf_lo(w[q][j].y); a[q][j][3] += bf_hi(w[q][j].y); }
        }
        const float* g2 = modv_ + (size_t)(comb * 9 + mrow) * 6144 + 5 * 1024 + lane * 4;
#pragma unroll
        for (int j = 0; j < 4; ++j) { const f32x4 gg = *(const f32x4*)(g2 + 256 * j);
#pragma unroll
            for (int q = 0; q < R; ++q) { v[q][j] = v[q][j] + gg * a[q][j];
                if (!dry) { if (xmode == 2) __builtin_nontemporal_store(v[q][j], (f32x4*)((float*)xdst + (size_t)q * D + lane * 4 + 256 * j));
                            else { u32x2 o; o.x = cvt_pk_bf16(v[q][j][0], v[q][j][1]); o.y = cvt_pk_bf16(v[q][j][2], v[q][j][3]); *(u32x2*)((bf16_t*)xdst + (size_t)q * D + lane * 4 + 256 * j) = o; } } } }
    }
#endif
    if (which == 0) return;
    float rstd[R];
#pragma unroll
    for (int q = 0; q < R; ++q) { float ss = 0.f;
#pragma unroll
        for (int j = 0; j < 4; ++j) ss += (v[q][j][0] * v[q][j][0] + v[q][j][1] * v[q][j][1]) + (v[q][j][2] * v[q][j][2] + v[q][j][3] * v[q][j][3]);
        rstd[q] = ss; }
#pragma unroll
    for (int q = 0; q < R; ++q) rstd[q] = rsqrtf(wave_sum(rstd[q]) * (1.f / D) + EPS);
    const float* mv = modv_ + (size_t)(layer * 9 + mrow) * 6144 + (which == 2 ? 3 * 1024 : 0) + lane * 4;
#pragma unroll
    for (int j = 0; j < 4; ++j) { const f32x4 g = *(const f32x4*)(ng + lane * 4 + 256 * j), sh = *(const f32x4*)(mv + 256 * j), sc = *(const f32x4*)(mv + 1024 + 256 * j);
#pragma unroll
        for (int q = 0; q < R; ++q) { v[q][j] = (v[q][j] * rstd[q] * g) * (sc + 1.f) + sh;
            u32x2 o; o.x = cvt_pk_bf16(v[q][j][0], v[q][j][1]); o.y = cvt_pk_bf16(v[q][j][2], v[q][j][3]); *(u32x2*)(H_ + (size_t)(r0 + q) * D + lane * 4 + 256 * j) = o; } }
#ifndef NO_NR_ROUTER
    if (which == 2 && dry != 2) {
        f32x2 p2[R][8];
#pragma unroll
        for (int q = 0; q < R; ++q)
#pragma unroll
            for (int e = 0; e < 8; ++e) p2[q][e] = (f32x2){0.f, 0.f};
#pragma unroll
        for (int j = 0; j < 4; ++j)
#pragma unroll
            for (int i = 0; i < 4; ++i) { const int col = lane * 4 + 256 * j + i; const LAS unsigned char* rp = rwl + col * 64 + (col >> 2) * 16;
                f32x2 w2[8];
#pragma unroll
                for (int e4 = 0; e4 < 4; ++e4) { const f32x4 w = *(const LAS f32x4*)(rp + e4 * 16); w2[2 * e4] = (f32x2){w[0], w[1]}; w2[2 * e4 + 1] = (f32x2){w[2], w[3]}; }
#pragma unroll
                for (int q = 0; q < R; ++q) { const float hv = v[q][j][i]; const f32x2 h2 = (f32x2){hv, hv};
#pragma unroll
                    for (int e = 0; e < 8; ++e) p2[q][e] = __builtin_elementwise_fma(h2, w2[e], p2[q][e]); }
                __builtin_amdgcn_sched_barrier(0); }
        float p[R][16];
#pragma unroll
        for (int q = 0; q < R; ++q)
#pragma unroll
            for (int e = 0; e < 8; ++e) { p[q][2 * e] = p2[q][e].x; p[q][2 * e + 1] = p2[q][e].y; asm volatile("" : "+v"(p[q][2 * e]), "+v"(p[q][2 * e + 1])); }
#pragma unroll
        for (int q = 0; q < R; ++q) {
            const bool b5 = (lane & 32) != 0, b4 = (lane & 16) != 0, b3 = (lane & 8) != 0, b2 = (lane & 4) != 0;
            float k8[8], k4[4], k2[2];
#pragma unroll
            for (int e = 0; e < 8; ++e) { const float send = b5 ? p[q][e] : p[q][e + 8]; k8[e] = (b5 ? p[q][e + 8] : p[q][e]) + xor32(send, b5); }
#pragma unroll
            for (int e = 0; e < 4; ++e) { const float send = b4 ? k8[e] : k8[e + 4]; k4[e] = (b4 ? k8[e + 4] : k8[e]) + swz_xor<16>(send); }
#pragma unroll
            for (int e = 0; e < 2; ++e) { const float send = b3 ? k4[e] : k4[e + 2]; k2[e] = (b3 ? k4[e + 2] : k4[e]) + swz_xor<8>(send); }
            float lg; { const float send = b2 ? k2[0] : k2[1]; lg = (b2 ? k2[1] : k2[0]) + swz_xor<4>(send); }
            lg += swz_xor<2>(lg); lg += swz_xor<1>(lg);
            const float mx = wave_max(lg), ex = __expf(lg - mx), sum = wave_sum(ex) * 0.25f;
            const int eid = (lane >> 2) & 15;
            if ((lane & 3) == 0) aff_[(size_t)(r0 + q) * 16 + eid] = ex / sum;
            if (lane < 16) slotw_[(size_t)(r0 + q) * 16 + lane] = -1;
        }
    }
#endif
}
__device__ __forceinline__ void norm_phase(const Fr& F, LAS unsigned char* lds, int layer, int which, int nrows, int comb, int xmode, const void* xlat, const void* xctx, void* xlat_d, void* xctx_d, int dry = 0, bool zero_vst = false) {
    const size_t esz_s = xmode == 0 ? 4 : 2, esz_d = xmode == 2 ? 4 : 2;
    const int tid = opaque_tid(), lane = tid & 63, wave = __builtin_amdgcn_readfirstlane(tid >> 6), gw = F.bx * NWAVES + wave, NGW = F.G * NWAVES;
    unsigned char* const ws_ = F.ws();
    float* const modv_ = (float*)(ws_ + WS_MODV); float* const aff_ = (float*)(ws_ + WS_AFF); int* const slot_ = (int*)(ws_ + WS_SLOT);
    bf16_t* const H_ = (bf16_t*)(ws_ + WS_H); bf16_t* const YEXP_ = (bf16_t*)(ws_ + WS_YEXP);
    float* const vst = zero_vst ? (float*)(ws_ + WS_VST) : nullptr;
    LAS unsigned char* rwl = lds;
    if (which == 2) {
        const float* rw = F.in(I_RW) + (size_t)layer * 1024 * 16;
        for (int idx = tid; idx < 4096; idx += NTHR) { const int col = idx >> 2, e4 = idx & 3; *(LAS f32x4*)(rwl + col * 64 + (col >> 2) * 16 + e4 * 16) = *(const f32x4*)(rw + col * 16 + e4 * 4); }
        __syncthreads();
    }
    const float* ng = F.in(which == 2 ? I_N2G : I_N1G) + (size_t)layer * 1024;
#pragma nounroll
    for (int g4 = gw; g4 < T / 4; g4 += NGW) { const int r0 = g4 * 4;
        norm_rows<4>(r0, false, lane, layer, which, comb, dry, vst, xmode, (const char*)xlat + (size_t)r0 * D * esz_s, (char*)xlat_d + (size_t)r0 * D * esz_d, modv_, ng, slot_, YEXP_, H_, aff_, slot_, rwl); }
    if (nrows > T) {
#pragma nounroll
        for (int r = T + gw; r < nrows; r += NGW)
            norm_rows<1>(r, true, lane, layer, which, comb, dry, vst, xmode, (const char*)xctx + (size_t)(r - T) * D * esz_s, (char*)xctx_d + (size_t)(r - T) * D * esz_d, modv_, ng, slot_, YEXP_, H_, aff_, slot_, rwl);
    }
}

__device__ __forceinline__ void topk_phase(const Fr& F, LAS unsigned char* lds, bool with_ctx) {
    const int tid = opaque_tid();
    unsigned char* const ws_ = F.ws();
    float* const aff_ = (float*)(ws_ + WS_AFF); int* const slot_ = (int*)(ws_ + WS_SLOT); float* const gate_ = (float*)(ws_ + WS_GATE);
    int* const idx_ = (int*)(ws_ + WS_IDX);
    LAS unsigned* vals = (LAS unsigned*)lds;
    LAS int* hist = (LAS int*)(lds + 8192);
    LAS int* suf = (LAS int*)(lds + 9216);
    LAS int* scan = (LAS int*)(lds + 12288);
    volatile LAS unsigned* sv = (volatile LAS unsigned*)(lds + 16384);
    const int nunits = with_ctx ? 256 : 128;
    for (int u = F.bx; u < nunits; u += F.G) {
        const bool isctx = u >= 128; const int uu = isctx ? u - 128 : u, e = uu >> 3, b = uu & 7;
        const int N = isctx ? CL : SEQ, cap = isctx ? CCAP : CAP, row0 = isctx ? T + b * CL : b * SEQ;
        const int tile = isctx ? 128 + e : uu, rbase = isctx ? b * 32 : 0;
        unsigned v[4]; const bool act = tid * 4 < N;
#pragma unroll
        for (int k = 0; k < 4; ++k) v[k] = act ? __float_as_uint(aff_[(size_t)(row0 + tid * 4 + k) * 16 + e]) : 0u;
        if (tid == 0) { sv[0] = 0u; sv[1] = (unsigned)cap; }
        unsigned prefix = 0u, mask = 0u; int need = cap;
#pragma nounroll
        for (int shift = 24; shift >= 0; shift -= 8) {
            if (tid < 256) hist[tid] = 0;
            __syncthreads();
            if (act) {
#pragma unroll
                for (int k = 0; k < 4; ++k) if ((v[k] & mask) == prefix) __hip_atomic_fetch_add(&hist[(v[k] >> shift) & 255u], 1, __ATOMIC_RELAXED, __HIP_MEMORY_SCOPE_WORKGROUP);
            }
            __syncthreads();
            if (tid < 256) { int sacc = 0; for (int d = 255; d >= tid; --d) sacc += hist[d]; suf[tid] = sacc; }
            if (tid == 0) suf[256] = 0;
            __syncthreads();
            if (tid < 256) { const int s0 = suf[tid], s1 = suf[tid + 1]; if (s0 >= need && s1 < need) { sv[0] = prefix | ((unsigned)tid << shift); sv[1] = (unsigned)(need - s1); } }
            __syncthreads();
            prefix = sv[0]; need = (int)sv[1]; mask |= 255u << shift;
        }
        int cg = 0, ce = 0;
#pragma unroll
        for (int k = 0; k < 4; ++k) { cg += (act && v[k] > prefix) ? 1 : 0; ce += (act && v[k] == prefix) ? 1 : 0; }
        int cur = 0; scan[tid] = cg | (ce << 16);
        __syncthreads();
#pragma nounroll
        for (int off = 1; off < NTHR; off <<= 1) {
            const int x = scan[cur * NTHR + tid] + (tid >= off ? scan[cur * NTHR + tid - off] : 0);
            scan[(cur ^ 1) * NTHR + tid] = x; cur ^= 1;
            __syncthreads();
        }
        const int incl = scan[cur * NTHR + tid]; int gb = (incl & 0xffff) - cg, eb = (incl >> 16) - ce;
        if (act) {
#pragma unroll
            for (int k = 0; k < 4; ++k) {
                const bool isg = v[k] > prefix, ise = v[k] == prefix;
                if (isg || (ise && eb < need)) { const int sl = gb + (eb < need ? eb : need); const int row = row0 + tid * 4 + k;
                    idx_[(size_t)tile * 256 + rbase + sl] = row; gate_[(size_t)tile * 256 + rbase + sl] = __uint_as_float(v[k]); slot_[(size_t)row * 16 + e] = sl; }
                gb += isg ? 1 : 0; eb += ise ? 1 : 0;
            }
        }
        __syncthreads();
    }
}

template <int OFF> __device__ __forceinline__ s16x4 sp_tr_read(int vb) {
    s16x4 r; asm volatile("ds_read_b64_tr_b16 %0, %1 offset:%2" : "=&v"(r) : "v"(vb), "i"(OFF) : "memory"); return r;
}
template <int KS> __device__ __forceinline__ void sp_kstep(f32x16& acc0, f32x16& acc1, const LAS bf16_t* Ap, int vb) {
    constexpr int LDB2 = 320;
    const bf16x8 a = *(const LAS bf16x8*)(Ap + KS * 16);
    const s16x4 l0 = sp_tr_read<(16 * KS) * LDB2>(vb), h0 = sp_tr_read<(16 * KS + 4) * LDB2>(vb);
    const s16x4 l1 = sp_tr_read<(16 * KS) * LDB2 + 64>(vb), h1 = sp_tr_read<(16 * KS + 4) * LDB2 + 64>(vb);
    asm volatile("s_waitcnt lgkmcnt(0)" ::: "memory"); __builtin_amdgcn_sched_barrier(0);
    const bf16x8 b0 = (bf16x8){l0[0], l0[1], l0[2], l0[3], h0[0], h0[1], h0[2], h0[3]};
    const bf16x8 b1 = (bf16x8){l1[0], l1[1], l1[2], l1[3], h1[0], h1[1], h1[2], h1[3]};
    acc0 = __builtin_amdgcn_mfma_f32_32x32x16_bf16(b0, a, acc0, 0, 0, 0);
    acc1 = __builtin_amdgcn_mfma_f32_32x32x16_bf16(b1, a, acc1, 0, 0, 0);
}
__device__ __forceinline__ void spatial_phase(const Fr& F, LAS unsigned char* lds, int j, int nchunks) {
    const int tid = opaque_tid(), lane = tid & 63, wave = __builtin_amdgcn_readfirstlane(tid >> 6);
    unsigned char* const ws_ = F.ws();
    const bf16_t* const wsw_ = (const bf16_t*)(ws_ + WS_WSW); const bf16_t* const S1_ = (const bf16_t*)(ws_ + WS_S1); bf16_t* const S2_ = (bf16_t*)(ws_ + WS_S2);
    const float* const vst_ = (const float*)(ws_ + WS_VST);
    constexpr int LDA = 136, LDB = 160;
    LAS bf16_t* As = (LAS bf16_t*)(lds + 1024);
    LAS bf16_t* Bs = (LAS bf16_t*)(lds + 1024 + 128 * LDA * 2);
    LAS bf16_t* Us = (LAS bf16_t*)(lds + 1024 + 128 * LDA * 2 + 128 * LDB * 2);
    const float* vg = F.in(I_GVG) + (size_t)j * 1024; const float* sb = F.in(I_GSB) + (size_t)j * 8 * 128;
    const bf16_t* sw = wsw_ + (size_t)j * 8 * 128 * 128;
    const int r32 = lane & 31, hi = lane >> 5;
    const int pw = (wave >> 1) * 32, dw = (wave & 1) * 64;
    const LAS bf16_t* Ap = As + (pw + r32) * LDA + hi * 8;
    const int vb = (int)(unsigned)(uintptr_t)Bs + (8 * hi + ((lane & 15) >> 2)) * (LDB * 2) + (dw + 16 * ((lane >> 4) & 1) + 4 * (lane & 3)) * 2;
    const int p = pw + r32, c0 = dw + 4 * hi, nunits = nchunks * 8;
    u32x4 sa[4], wv[4], ut[4]; f32x2 st[4];
#define SP_LOAD(U) do { const int _r0 = ((U) >> 3) * 128, _g = (U) & 7; _Pragma("unroll") for (int i = 0; i < 4; ++i) { const int id = tid + NTHR * i; \
            sa[i] = *(const u32x4*)(sw + (size_t)_g * 128 * 128 + (id >> 4) * 128 + (id & 15) * 8); \
            wv[i] = *(const u32x4*)(S1_ + (size_t)(_r0 + (id >> 4)) * 2048 + 1024 + _g * 128 + (id & 15) * 8); \
            ut[i] = *(const u32x4*)(S1_ + (size_t)(_r0 + (id >> 4)) * 2048 + _g * 128 + (id & 15) * 8); \
            st[i] = *(const f32x2*)(vst_ + ((size_t)(_r0 + (id >> 4)) * 16 + (id & 15)) * 2); } } while (0)
    int U = F.vcu;
    if (U < nunits) SP_LOAD(U);
#pragma nounroll
    for (; U < nunits; U += F.G) {
        const int r0 = (U >> 3) * 128, g = U & 7;
#pragma unroll
        for (int i = 0; i < 4; ++i) { const int id = tid + NTHR * i; *(LAS u32x4*)(As + (id >> 4) * LDA + (id & 15) * 8) = sa[i]; *(LAS u32x4*)(Us + (id >> 4) * LDA + (id & 15) * 8) = ut[i]; }
        { const int dc = tid & 15; const f32x4 g0 = *(const f32x4*)(vg + g * 128 + dc * 8), g1 = *(const f32x4*)(vg + g * 128 + dc * 8 + 4);
#pragma unroll
          for (int i = 0; i < 4; ++i) { const int id = tid + NTHR * i, q = id >> 4;
            float s1 = st[i].x, s2 = st[i].y;
            s1 += swz_xor<1>(s1); s2 += swz_xor<1>(s2); s1 += swz_xor<2>(s1); s2 += swz_xor<2>(s2); s1 += swz_xor<4>(s1); s2 += swz_xor<4>(s2); s1 += swz_xor<8>(s1); s2 += swz_xor<8>(s2);
            const float mean = s1 * (1.f / 1024.f), rstd = rsqrtf(fmaxf(s2 * (1.f / 1024.f) - mean * mean, 0.f) + EPS);
            float x[8];
#pragma unroll
            for (int k = 0; k < 4; ++k) { x[2 * k] = (bf_lo(wv[i][k]) - mean) * rstd; x[2 * k + 1] = (bf_hi(wv[i][k]) - mean) * rstd; }
            u32x4 o; o.x = cvt_pk_bf16(x[0] * g0[0], x[1] * g0[1]); o.y = cvt_pk_bf16(x[2] * g0[2], x[3] * g0[3]); o.z = cvt_pk_bf16(x[4] * g1[0], x[5] * g1[1]); o.w = cvt_pk_bf16(x[6] * g1[2], x[7] * g1[3]);
            *(LAS u32x4*)(Bs + q * LDB + dc * 8) = o; } }
        const float bias = sb[g * 128 + p];
        __syncthreads();
        if (U + F.G < nunits) SP_LOAD(U + F.G);
        f32x16 acc0 = {}, acc1 = {};
        sp_kstep<0>(acc0, acc1, Ap, vb); sp_kstep<1>(acc0, acc1, Ap, vb); sp_kstep<2>(acc0, acc1, Ap, vb); sp_kstep<3>(acc0, acc1, Ap, vb);
        sp_kstep<4>(acc0, acc1, Ap, vb); sp_kstep<5>(acc0, acc1, Ap, vb); sp_kstep<6>(acc0, acc1, Ap, vb); sp_kstep<7>(acc0, acc1, Ap, vb);
        __syncthreads();
#pragma unroll
        for (int t = 0; t < 4; ++t) {
            const u32x2 u0 = *(const LAS u32x2*)(Us + p * LDA + c0 + 8 * t), u1 = *(const LAS u32x2*)(Us + p * LDA + c0 + 32 + 8 * t);
            u32x2 o0, o1;
            o0.x = cvt_pk_bf16((acc0[4 * t] + bias) * bf_lo(u0.x), (acc0[4 * t + 1] + bias) * bf_hi(u0.x)); o0.y = cvt_pk_bf16((acc0[4 * t + 2] + bias) * bf_lo(u0.y), (acc0[4 * t + 3] + bias) * bf_hi(u0.y));
            o1.x = cvt_pk_bf16((acc1[4 * t] + bias) * bf_lo(u1.x), (acc1[4 * t + 1] + bias) * bf_hi(u1.x)); o1.y = cvt_pk_bf16((acc1[4 * t + 2] + bias) * bf_lo(u1.y), (acc1[4 * t + 3] + bias) * bf_hi(u1.y));
            *(LAS u32x2*)(As + p * LDA + c0 + 8 * t) = o0; *(LAS u32x2*)(As + p * LDA + c0 + 32 + 8 * t) = o1; }
        __syncthreads();
#pragma unroll
        for (int i = 0; i < 4; ++i) { const int id = tid + NTHR * i; *(u32x4*)(S2_ + (size_t)(r0 + (id >> 4)) * D + g * 128 + (id & 15) * 8) = *(const LAS u32x4*)(As + (id >> 4) * LDA + (id & 15) * 8); }
        __syncthreads();
    }
#undef SP_LOAD
}

__device__ __forceinline__ void qknorm_phase(const Fr& F) {
    const int tid = opaque_tid(), lane = tid & 63, wave = __builtin_amdgcn_readfirstlane(tid >> 6), gw = F.bx * NWAVES + wave, NGW = F.G * NWAVES;
    unsigned char* const ws_ = F.ws();
    const bf16_t* const S1_ = (const bf16_t*)(ws_ + WS_S1); bf16_t* const QB_ = (bf16_t*)(ws_ + WS_QB); bf16_t* const KB_ = (bf16_t*)(ws_ + WS_KB);
    const float* qg = F.in(I_AQG); const float* kg = F.in(I_AKG);
    const int hsel = lane >> 5, l5 = lane & 31;
    const f32x2 qg0 = *(const f32x2*)(qg + 2 * l5), qg1 = *(const f32x2*)(qg + 64 + 2 * l5), kg0 = *(const f32x2*)(kg + 2 * l5), kg1 = *(const f32x2*)(kg + 64 + 2 * l5);
    const float inv0 = exp2f(-(float)((2 * l5) & 31) * (13.287712379549449f / 32.f)), inv1 = exp2f(-(float)((2 * l5 + 1) & 31) * (13.287712379549449f / 32.f));
#pragma nounroll
    for (int g2 = gw; g2 < T / 2; g2 += NGW) {
        const int r0 = g2 * 2, b = r0 >> 11;
        unsigned u0[2][5], u1[2][5];
#pragma unroll
        for (int q = 0; q < 2; ++q)
#pragma unroll
            for (int ps = 0; ps < 5; ++ps) { const int hh = 2 * ps + hsel; const bf16_t* src = S1_ + (size_t)(r0 + q) * 2048 + (hh < 8 ? hh * 128 : 1024 + (hh - 8) * 128) + 2 * l5;
                u0[q][ps] = *(const unsigned*)src; u1[q][ps] = *(const unsigned*)(src + 64); }
#pragma unroll
        for (int q = 0; q < 2; ++q) {
            const int s = (r0 + q) & (SEQ - 1); const float pos = (float)(l5 < 16 ? (s >> 6) : (s & 63));
            float c0, s0, c1, s1; __sincosf(pos * inv0, &s0, &c0); __sincosf(pos * inv1, &s1, &c1);
            { c0 = cosf(pos * inv0); s0 = sinf(pos * inv0); c1 = cosf(pos * inv1); s1 = sinf(pos * inv1); }
#pragma unroll
            for (int ps = 0; ps < 5; ++ps) { const int hh = 2 * ps + hsel; const bool isk = ps == 4;
                float a0 = bf_lo(u0[q][ps]), a1 = bf_hi(u0[q][ps]), e0 = bf_lo(u1[q][ps]), e1 = bf_hi(u1[q][ps]);
                const float rs = rsqrtf(half_sum((a0 * a0 + a1 * a1) + (e0 * e0 + e1 * e1)) * (1.f / 128.f) + EPS);
                const f32x2 ga = isk ? kg0 : qg0, gb = isk ? kg1 : qg1;
                a0 *= rs * ga.x; a1 *= rs * ga.y; e0 *= rs * gb.x; e1 *= rs * gb.y;
                const float o10 = a0 * c0 - e0 * s0, o11 = a1 * c1 - e1 * s1, o20 = a0 * s0 + e0 * c0, o21 = a1 * s1 + e1 * c1;
                bf16_t* dst = isk ? KB_ + ((size_t)(b * 2 + (hh - 8)) * SKV + CL + s) * 128 + 2 * l5 : QB_ + (size_t)(r0 + q) * D + hh * 128 + 2 * l5;
                *(unsigned*)dst = cvt_pk_bf16(o10, o11); *(unsigned*)(dst + 64) = cvt_pk_bf16(o20, o21); }
        }
    }
#pragma nounroll
    for (int rc = gw; rc < TC; rc += NGW) {
        const int b = rc >> 8, s = rc & (CL - 1);
        const bf16_t* src = S1_ + (size_t)(T + rc) * 2048 + 1024 + hsel * 128 + 2 * l5;
        const unsigned u0 = *(const unsigned*)src, u1 = *(const unsigned*)(src + 64);
        float a0 = bf_lo(u0), a1 = bf_hi(u0), e0 = bf_lo(u1), e1 = bf_hi(u1);
        const float rs = rsqrtf(half_sum((a0 * a0 + a1 * a1) + (e0 * e0 + e1 * e1)) * (1.f / 128.f) + EPS);
        bf16_t* dst = KB_ + ((size_t)(b * 2 + hsel) * SKV + s) * 128 + 2 * l5;
        *(unsigned*)dst = cvt_pk_bf16(a0 * rs * kg0.x, a1 * rs * kg0.y); *(unsigned*)(dst + 64) = cvt_pk_bf16(e0 * rs * kg1.x, e1 * rs * kg1.y);
    }
}

template <int W> __device__ __forceinline__ void pool_item(const bf16_t* zb  , int s, bf16_t* dst) {
    constexpr int half = W / 2;
    u32x4 w[W];
#pragma unroll
    for (int k = 0; k < W; ++k) { int t = s - half + k; t = t < 0 ? 0 : (t > SEQ - 1 ? SEQ - 1 : t); w[k] = *(const u32x4*)(zb + (size_t)t * 2048); }
    float acc[8];
#pragma unroll
    for (int c = 0; c < 8; ++c) acc[c] = 0.f;
#pragma unroll
    for (int k = 0; k < W; ++k) { const int t = s - half + k; const float m = (t >= 0 && t < SEQ) ? 1.f : 0.f;
#pragma unroll
        for (int c = 0; c < 4; ++c) { acc[2 * c] += m * bf_lo(w[k][c]); acc[2 * c + 1] += m * bf_hi(w[k][c]); } }
    const int lo = s - half < 0 ? 0 : s - half, hi = s + half - 1 > SEQ - 1 ? SEQ - 1 : s + half - 1; const float ic = 1.f / (float)(hi - lo + 1);
    const u32x4 zc = w[half];
    float o[8];
#pragma unroll
    for (int c = 0; c < 4; ++c) { o[2 * c] = acc[2 * c] * ic - bf_lo(zc[c]); o[2 * c + 1] = acc[2 * c + 1] * ic - bf_hi(zc[c]); }
    u32x4 ov; ov.x = cvt_pk_bf16(o[0], o[1]); ov.y = cvt_pk_bf16(o[2], o[3]); ov.z = cvt_pk_bf16(o[4], o[5]); ov.w = cvt_pk_bf16(o[6], o[7]);
    *(u32x4*)dst = ov;
}
__device__ __forceinline__ void pool_phase(const Fr& F) {
    const int tid = opaque_tid(), lane = tid & 63, wave = __builtin_amdgcn_readfirstlane(tid >> 6);
    unsigned char* const ws_ = F.ws();
    const bf16_t* const S1_ = (const bf16_t*)(ws_ + WS_S1); bf16_t* const S2_ = (bf16_t*)(ws_ + WS_S2);
    const int gi = wave & 3, c8 = gi * 32 + (lane & 31), rsub = (wave >> 2) * 2 + (lane >> 5);
#pragma nounroll
    for (int r4 = F.bx; r4 < T / 4; r4 += F.G) {
        const int r = r4 * 4 + rsub, s = r & (SEQ - 1);
        const bf16_t* zb = S1_ + (size_t)(r - s) * 2048 + c8 * 8; bf16_t* dst = S2_ + (size_t)r * D + c8 * 8;
        if (gi == 0) pool_item<2>(zb, s, dst); else if (gi == 1) pool_item<4>(zb, s, dst); else if (gi == 2) pool_item<8>(zb, s, dst); else pool_item<16>(zb, s, dst);
    }
}

__global__ void __launch_bounds__(NTHR, 2) fwd_kernel(KArgs args) {
    extern __shared__ __attribute__((aligned(16))) unsigned char lds_raw[];
    LAS unsigned char* lds = (LAS unsigned char*)lds_raw;
    volatile LAS unsigned* MISC = (volatile LAS unsigned*)(lds + MISC_OFF);
    Fr F;
    F.PT = (volatile LAS unsigned long long*)(lds + MISC_OFF + 256);
    F.G = gridDim.x; F.bx = blockIdx.x; F.vcu = (F.G % 8 == 0) ? (F.bx % 8) * (F.G / 8) + F.bx / 8 : F.bx;
    { const int t0 = threadIdx.x;
      if (t0 < 64) MISC[t0] = 0u;
      if (t0 < 24) F.PT[t0] = (unsigned long long)args.in[t0];
      if (t0 == 24) F.PT[24] = (unsigned long long)args.out;
      if (t0 == 25) F.PT[25] = (unsigned long long)args.ws; }
    __syncthreads();
    XcdBarrier bar = xcd_barrier_post((unsigned*)(F.ws() + WS_CTL), MISC + 8);
    const int lo = args.ph_lo, hi = args.ph_hi;
    int p = 0;
#define RUN(...) RUNC(31, __VA_ARGS__)
#define RUNC(cls, ...) do { if (lo <= p && p < hi) { _Pragma("nounroll") for (int rep_ = 0; rep_ < 1 + (int)((REPEAT_MASK >> (cls)) & 1u); ++rep_) { __VA_ARGS__; if (REPEAT_MASK) __syncthreads(); } if (p + 1 < hi) xcd_barrier(bar); } ++p; } while (0)

#ifndef NO_P0
    RUNC(0, p0_phase(F, lds, 0));
    RUN({
        norm_phase(F, lds, 0, 1, TT, -1, 0, F.in(I_X), F.in(I_CTX), nullptr, nullptr, 0, true);
        __syncthreads();
        p0_phase(F, lds, 1);
    });
#endif
#pragma nounroll
    for (int L = 0; L < 4; ++L) {
        const int kind = L % 3, jm = L / 3;
        const bool with_ctx = (L == 0);
        if (L > 0) RUNC(1, {
            bf16_t* xo = WSP(F, bf16_t, WS_XB); bf16_t* xc = WSP(F, bf16_t, WS_XC);
#ifndef NO_NORM
            norm_phase(F, lds, L, 1, (L <= 1) ? TT : T, L - 1, 1, xo, xc, xo, xc, (REPEAT_MASK >> 1) & 1u ? (rep_ == 0) : 0, kind == 0);
#endif
        });
        RUNC(2, {
            unsigned char* ws = F.ws();
            pg8::SchedDense S; S.A = (bf16_t*)(ws + WS_H); S.G = F.G; S.c = F.bx; S.a_pn_stride = 0; S.a_pm_stride = 256 * D; S.b_pn_stride = 256 * D; S.extra = 0;
            pg8::EpiA E; E.O = (bf16_t*)(ws + WS_S1); E.ldc = 2048; E.act = 0; E.VB = nullptr; E.stats = nullptr;
            if (kind == 0) { S.Bt = (bf16_t*)(ws + WS_WGIN) + (size_t)jm * 2048 * 1024; S.nM = with_ctx ? 72 : 64; S.nN = 8; E.act = 1; E.stats = (float*)(ws + WS_VST); }
            else if (kind == 1) { S.Bt = (bf16_t*)(ws + WS_WAIN); S.nM = 64; S.nN = 6; S.extra = 16; E.VB = (bf16_t*)(ws + WS_VB); }
            else { S.Bt = (bf16_t*)(ws + WS_WPIN); S.nM = 64; S.nN = 4; }
            S.nwg = S.nM * S.nN;
            int role = F.bx;
            if (L == 0 && F.G == 256) { role = split_role(F, CV_G_GA); S.G = CV_G_GA; S.c = role; }
            if (L == 1 && F.G == 256) { role = split_role(F, CV_G_GA1); S.G = CV_G_GA1; S.c = role; }
#ifndef NO_GA
            if (role >= 0) pg8::gemm_phase<pg8::EpiA, pg8::SchedDense>(lds, D, D, D, S, E);
#endif
            if (role < 0) { const int q_ = L == 0 ? CV_Q_GA : CV_Q_GA1, j0 = (L == 0 ? CV_B_GA : CV_B_GA1) + (-1 - role) * q_; convert_tiles(F, lds, j0, 1, j0 + q_, 0x7fffffff, 0); }
        });
        if (kind == 0) {
#ifndef NO_SPAT
            RUNC(3, spatial_phase(F, lds, jm, with_ctx ? 144 : 128));
#endif
        }
        else if (kind == 1) {
#ifndef NO_QKN
            RUNC(4, qknorm_phase(F));
#endif
            RUNC(5, {
                unsigned char* ws = F.ws();
                const bf16_t* QB = (const bf16_t*)(ws + WS_QB); const bf16_t* KB = (const bf16_t*)(ws + WS_KB); const bf16_t* VB = (const bf16_t*)(ws + WS_VB); bf16_t* S2 = (bf16_t*)(ws + WS_S2);
                for (int i = 0; i * F.G + F.vcu < 512; ++i) { const int Lu = i * F.G + F.vcu, bk = Lu >> 5, w = Lu & 31, b = bk >> 1, kvh = bk & 1, h = kvh * 4 + (w >> 3), qb = w & 7;
#ifndef NO_ATT
                    att::attn_body<D, D>(QB + ((size_t)(b * SEQ + qb * 256)) * D + h * 128, KB + (size_t)bk * SKV * 128, VB + (size_t)bk * SKV * 128,
                                         S2 + ((size_t)(b * SEQ + qb * 256)) * D + h * 128, SKV, lds);
#endif
                    __syncthreads(); }
            });
        } else {
#ifndef NO_POOL
            RUNC(6, pool_phase(F));
#endif
        }
        RUNC(7, {
            unsigned char* ws = F.ws();
            pg8::SchedDense S; S.A = (bf16_t*)(ws + WS_S2); S.G = F.G; S.c = F.bx; S.a_pm_stride = 256 * D; S.a_pn_stride = 0; S.b_pn_stride = 256 * D; S.extra = 0; S.nN = 4; S.nM = 64;
            pg8::EpiB E; E.xd_lat = (bf16_t*)(ws + WS_XB); E.xd_ctx = (bf16_t*)(ws + WS_XC); E.src_f32 = (L == 0); E.xs_lat = (L == 0) ? (const void*)F.in(I_X) : (const void*)E.xd_lat; E.xs_ctx = (L == 0) ? (const void*)F.in(I_CTX) : (const void*)E.xd_ctx;
            E.gt = (const float*)(ws + WS_MODV) + (size_t)L * 9 * 6144 + 2 * 1024; E.colscale = nullptr; E.dry = (REPEAT_MASK >> 7) & 1u ? (rep_ == 0) : 0;
            int K = D, ldb = D;
            if (kind == 0) { S.Bt = (bf16_t*)(ws + WS_WGOUT) + (size_t)jm * 1024 * 1024; S.nM = with_ctx ? 72 : 64; }
            else if (kind == 1) { S.Bt = (bf16_t*)(ws + WS_WAOUT); }
            else { S.Bt = (bf16_t*)(ws + WS_WPGRP); S.a_pn_stride = 256; S.b_pn_stride = 256 * 256; K = 256; ldb = 256; E.colscale = F.in(I_PSC); }
            S.nwg = S.nM * S.nN;
            int role = F.bx;
            if (L == 0 && F.G == 256) { role = split_role(F, CV_G_GB); S.G = CV_G_GB; S.c = role; }
#ifndef NO_GB
            if (role >= 0) pg8::gemm_phase<pg8::EpiB, pg8::SchedDense>(lds, K, D, ldb, S, E);
#endif
            if (role < 0) { const int j0 = CV_B_GB + (-1 - role) * CV_Q_GB; convert_tiles(F, lds, j0, 1, j0 + CV_Q_GB, 0x7fffffff, 0); }
        });
        RUNC(8, {
            bf16_t* xo = WSP(F, bf16_t, WS_XB); bf16_t* xc = WSP(F, bf16_t, WS_XC);
#ifndef NO_NORM
            norm_phase(F, lds, L, 2, with_ctx ? TT : T, -1, 1, xo, xc, xo, xc, ((REPEAT_MASK >> 13) & 1u) && rep_ == 0 ? 2 : 0);
#endif
        });
#ifndef NO_TOPK
        RUNC(9, { topk_phase(F, lds, with_ctx); if (L == 1 || L == 2) convert_in_idle_slot(F, lds, F.bx, 128, L == 1 ? CV_B_TK1 : CV_B_TK2, CV_Q_TK, CV_N_TK); });
#endif
        RUNC(10, {
            unsigned char* ws = F.ws();
            pg8::SchedMoE<true> S; S.A = (bf16_t*)(ws + WS_H); S.IDX = (const int*)(ws + WS_IDX); S.Bt = (bf16_t*)(ws + WS_WUP) + (size_t)L * 16 * 2048 * 1024; S.nbt = with_ctx ? 9 : 8; S.nn = 8; S.G = F.G; S.vcu = F.vcu;
            pg8::EpiC E; E.HID = (bf16_t*)(ws + WS_HID);
            int role = F.bx;
            if (L == 0 && F.G == 256) { role = split_role(F, CV_G_UP); S.G = CV_G_UP; S.vcu = role >= 0 ? (role & 7) * (CV_G_UP / 8) + (role >> 3) : 0; }
#ifndef NO_GC
            if (role >= 0) pg8::gemm_phase<pg8::EpiC, pg8::SchedMoE<true>>(lds, D, D, D, S, E);
#endif
            if (role < 0) { const int j0 = CV_B_UP + (-1 - role) * CV_Q_UP; convert_tiles(F, lds, j0, 1, j0 + CV_Q_UP, 0x7fffffff, 0); }
        });
        RUNC(11, {
            unsigned char* ws = F.ws();
            pg8::SchedMoE<false> S; S.A = (bf16_t*)(ws + WS_HID); S.IDX = nullptr; S.Bt = (bf16_t*)(ws + WS_WDN) + (size_t)L * 16 * 1024 * 1024; S.nbt = with_ctx ? 9 : 8; S.nn = 4; S.G = F.G; S.vcu = F.vcu;
            pg8::EpiD E; E.Y = (bf16_t*)(ws + WS_YEXP); E.gate = (const float*)(ws + WS_GATE);
            int role = F.bx;
            if (L == 0 && F.G == 256) { role = split_role(F, CV_G_DN); S.G = CV_G_DN; S.vcu = role >= 0 ? (role & 7) * (CV_G_DN / 8) + (role >> 3) : 0; }
#ifndef NO_GD
            if (role >= 0) pg8::gemm_phase<pg8::EpiD, pg8::SchedMoE<false>>(lds, D, D, D, S, E);
#endif
            if (role < 0) { const int j0 = CV_B_DN + (-1 - role) * CV_Q_DN; convert_tiles(F, lds, j0, 1, j0 + CV_Q_DN, 0x7fffffff, 0); }
        });
    }
    RUN({
        bf16_t* xb = WSP(F, bf16_t, WS_XB);
#ifndef NO_NORM
        norm_phase(F, lds, 3, 0, T, 3, 2, xb, nullptr, F.out(), nullptr);
#endif
    });
#undef RUN
#undef RUNC
}

constexpr int N_PHASES = 1 + 8 + 9 + 8 + 8 + 1;

extern "C" void kernel_launch(void* const* d_in, const int* in_sizes, int n_in, void* d_out, int out_size, void* d_ws, size_t ws_size, hipStream_t stream) {
    static int grid = 0;
    if (grid == 0) {
        if (n_in != 24 || out_size != T * D || ws_size < WS_END) { fprintf(stderr, "kernel_launch: unexpected shapes (n_in %d out %d ws %zu need %zu)\n", n_in, out_size, ws_size, (size_t)WS_END); grid = -1; return; }
        int dev = 0, cus = 0;
        if (hipGetDevice(&dev) != hipSuccess || hipDeviceGetAttribute(&cus, hipDeviceAttributeMultiprocessorCount, dev) != hipSuccess) { grid = -1; return; }
        if (hipFuncSetAttribute((const void*)fwd_kernel, hipFuncAttributeMaxDynamicSharedMemorySize, LDS_BYTES) != hipSuccess) { fprintf(stderr, "kernel_launch: hipFuncSetAttribute failed\n"); grid = -1; return; }
        (void)hipGetLastError();
        grid = cus;
    }
    if (grid < 0) return;
    (void)hipMemsetAsync((char*)d_ws + WS_CTL, 0, CTL_BYTES, stream);
    KArgs a{};
    for (int i = 0; i < 24; ++i) a.in[i] = (const float*)d_in[i];
    a.out = (float*)d_out; a.ws = (unsigned char*)d_ws;
#if MK_PER_PHASE
    for (int k = 0; k < N_PHASES; ++k) { a.ph_lo = k; a.ph_hi = k + 1; hipLaunchKernelGGL(fwd_kernel, dim3(grid), dim3(NTHR), LDS_BYTES, stream, a); }
#else
    a.ph_lo = 0; a.ph_hi = N_PHASES;
    hipLaunchKernelGGL(fwd_kernel, dim3(grid), dim3(NTHR), LDS_BYTES, stream, a);
#endif
    const hipError_t le = hipPeekAtLastError();
    if (le != hipSuccess) fprintf(stderr, "kernel_launch: launch failed: %s\n", hipGetErrorName(le));
}
```
